# Optimizing an MI355X kernel written in HIP

```python
import jax, jax.numpy as jnp
from jax import lax
import numpy as np

D_MODEL = 2048
BATCH = 1
SEQ = 8192
DEPTH = 2
DEC_BATCH = 32
DEC_SEQ = 64
PAST_LEN = 4096

CHUNK = 64
Q_BLOCK = 128
N_HEADS = 16
QK_NOPE = 128
QK_ROPE = 64
QK_HEAD = QK_NOPE + QK_ROPE
V_HEAD = 128
Q_LORA = 512
KV_LORA = 512
MLA_WIDTH = N_HEADS * V_HEAD
MLA_SCALE = QK_HEAD ** -0.5
ROPE_THETA = 10000.0
CONV_WIDTH = 1024
CONV_K = 31
CONV_STATE = CONV_K - 1
N_MEM = 256
X_HEADS = 4
X_HEAD = 256
X_WIDTH = X_HEADS * X_HEAD
X_SCALE = X_HEAD ** -0.5
N_BRANCH = 3
EPS = 1e-6
IN_SIZES = (Q_LORA, KV_LORA, QK_ROPE, MLA_WIDTH, 2 * CONV_WIDTH, CONV_WIDTH, X_WIDTH, X_WIDTH, N_BRANCH * D_MODEL)
IN_COLS = Q_LORA + KV_LORA + QK_ROPE + MLA_WIDTH + 2 * CONV_WIDTH + CONV_WIDTH + X_WIDTH + X_WIDTH + N_BRANCH * D_MODEL

kernel_name = "hybrid_mla_conformer_memory_stream_step"


def rmsnorm(x, g):
    xf = x.astype(jnp.float32)
    y = xf * lax.rsqrt(jnp.mean(xf * xf, axis=-1, keepdims=True) + EPS)
    return (y * g.astype(jnp.float32)).astype(x.dtype)


def layernorm(x, g, b):
    xf = x.astype(jnp.float32)
    mu = jnp.mean(xf, axis=-1, keepdims=True)
    xc = xf - mu
    var = jnp.mean(xc * xc, axis=-1, keepdims=True)
    return (xc * lax.rsqrt(var + EPS) * g.astype(jnp.float32) + b.astype(jnp.float32)).astype(x.dtype)


def rope(x, pos):
    half = QK_ROPE // 2
    inv = jnp.power(ROPE_THETA, -jnp.arange(half, dtype=jnp.float32) / half)
    ang = pos.astype(jnp.float32)[:, None] * inv[None, :]
    cos = jnp.cos(ang)[:, None, :]
    sin = jnp.sin(ang)[:, None, :]
    xf = x.astype(jnp.float32)
    x1, x2 = xf[..., :half], xf[..., half:]
    return jnp.concatenate([x1 * cos - x2 * sin, x2 * cos + x1 * sin], axis=-1).astype(x.dtype)


def attend(q, k, v, scale, visible=None):
    s = jnp.einsum('bqhd,bkhd->bhqk', q, k).astype(jnp.float32) * scale
    if visible is not None:
        s = jnp.where(visible, s, -jnp.inf)
    p = jax.nn.softmax(s, axis=-1)
    return jnp.einsum('bhqk,bkhd->bqhd', p.astype(v.dtype), v)


def chunk_causal_attention(q, k, v, scale):
    B, S, H, D = q.shape
    nb = S // Q_BLOCK
    qb = jnp.moveaxis(q.reshape(B, nb, Q_BLOCK, H, D), 1, 0)
    k_pos = jnp.arange(k.shape[1])

    def block(args):
        q_i, i = args
        q_pos = i * Q_BLOCK + jnp.arange(Q_BLOCK)
        visible = k_pos[None, :] < ((q_pos // CHUNK + 1) * CHUNK)[:, None]
        return attend(q_i, k, v, scale, visible)

    o = lax.map(block, (qb, jnp.arange(nb)))
    return jnp.moveaxis(o, 0, 1).reshape(B, S, H, v.shape[-1])


def mixer_projections(x, lp):
    h = rmsnorm(x, lp['g_pre'])
    proj = h @ lp['w_in']
    outs = []
    off = 0
    for size in IN_SIZES:
        outs.append(proj[..., off:off + size])
        off += size
    return outs


def mla_queries(q_lat, pos, lp):
    B, S = q_lat.shape[:2]
    q = (rmsnorm(q_lat, lp['g_qlat']) @ lp['w_uq']).reshape(B, S, N_HEADS, QK_HEAD)
    q = rmsnorm(q, lp['g_qnorm'])
    return jnp.concatenate([q[..., :QK_NOPE], rope(q[..., QK_NOPE:], pos)], axis=-1)


def mla_keys(c_kv, k_rope, pos, lp):
    B, T = c_kv.shape[:2]
    kv = (rmsnorm(c_kv, lp['g_kvlat']) @ lp['w_ukv']).reshape(B, T, N_HEADS, QK_NOPE + V_HEAD)
    k_pe = jnp.broadcast_to(k_rope[:, :, None, :], (B, T, N_HEADS, QK_ROPE))
    k = rmsnorm(jnp.concatenate([kv[..., :QK_NOPE], k_pe], axis=-1), lp['g_knorm'])
    k = jnp.concatenate([k[..., :QK_NOPE], rope(k[..., QK_NOPE:], pos)], axis=-1)
    return k, kv[..., QK_NOPE:]


def conv_module(u2, conv_state, lp):
    u = u2[..., :CONV_WIDTH] * jax.nn.sigmoid(u2[..., CONV_WIDTH:])
    u_pad = jnp.concatenate([conv_state, u], axis=1)
    y = lax.conv_general_dilated(u_pad, lp['conv_w'][:, None, :], window_strides=(1,), padding='VALID',
                                 dimension_numbers=('NWC', 'WIO', 'NWC'),
                                 feature_group_count=CONV_WIDTH) + lp['conv_b']
    y = jax.nn.silu(layernorm(y, lp['ln_g'], lp['ln_b']))
    y = y @ lp['w_pw2'] + lp['b_pw2']
    return y, u_pad[:, -CONV_STATE:]


def memory_kv(mem, lp):
    B, M = mem.shape[:2]
    kv = (rmsnorm(mem, lp['g_mem']) @ lp['w_mem_kv']).reshape(B, M, 2, X_HEADS, X_HEAD)
    return rmsnorm(kv[:, :, 0], lp['g_xk']), kv[:, :, 1]


def cross_attend(xq, mk, mv, lp):
    B, S = xq.shape[:2]
    q = rmsnorm(xq.reshape(B, S, X_HEADS, X_HEAD), lp['g_xq'])
    return attend(q, mk, mv, X_SCALE).reshape(B, S, X_WIDTH)


def merge_branches(x, o_mla, z_mla, o_conv, z_conv, o_x, z_x, g_merge, lp):
    B, S = x.shape[:2]
    p_mla = (o_mla * jax.nn.silu(z_mla)) @ lp['w_p_mla']
    p_conv = (o_conv * jax.nn.silu(z_conv)) @ lp['w_p_conv']
    p_x = (o_x * jax.nn.silu(z_x)) @ lp['w_p_x']
    gates = jax.nn.sigmoid(g_merge + lp['b_merge']).reshape(B, S, N_BRANCH, D_MODEL)
    merged = gates[:, :, 0] * p_mla + gates[:, :, 1] * p_conv + gates[:, :, 2] * p_x
    return x + merged @ lp['w_out']


def prompt_layer(x, mem, lp):
    B, S = x.shape[:2]
    q_lat, c_kv, k_rope, z_mla, u2, z_conv, xq, z_x, g_merge = mixer_projections(x, lp)
    pos = jnp.arange(S)
    q = mla_queries(q_lat, pos, lp)
    k, v = mla_keys(c_kv, k_rope, pos, lp)
    o_mla = chunk_causal_attention(q, k, v, MLA_SCALE).reshape(B, S, MLA_WIDTH)
    o_conv, conv_new = conv_module(u2, jnp.zeros((B, CONV_STATE, CONV_WIDTH), u2.dtype), lp)
    mk, mv = memory_kv(mem, lp)
    o_x = cross_attend(xq, mk, mv, lp)
    y = merge_branches(x, o_mla, z_mla, o_conv, z_conv, o_x, z_x, g_merge, lp)
    return y, c_kv, k_rope, mk, mv, conv_new


def sample_layer(x, ckv_past, krope_past, mk, mv, conv_state, lp):
    B, S = x.shape[:2]
    t_past = ckv_past.shape[1]
    q_lat, c_kv, k_rope, z_mla, u2, z_conv, xq, z_x, g_merge = mixer_projections(x, lp)
    q = mla_queries(q_lat, t_past + jnp.arange(S), lp)
    ckv_all = jnp.concatenate([ckv_past, c_kv], axis=1)
    kr_all = jnp.concatenate([krope_past, k_rope], axis=1)
    k_pos = jnp.arange(t_past + S)

    def stream(args):
        q_b, ckv_b, kr_b = args
        k, v = mla_keys(ckv_b[None], kr_b[None], k_pos, lp)
        return attend(q_b[None], k, v, MLA_SCALE)[0]

    o_mla = lax.map(stream, (q, ckv_all, kr_all)).reshape(B, S, MLA_WIDTH)
    o_conv, conv_new = conv_module(u2, conv_state, lp)
    o_x = cross_attend(xq, mk, mv, lp)
    y = merge_branches(x, o_mla, z_mla, o_conv, z_conv, o_x, z_x, g_merge, lp)
    return y, c_kv, k_rope, conv_new


def setup_inputs(seed: int = 0) -> dict:
    key = jax.random.key(seed)
    ks = iter(jax.random.split(key, 32))
    nrm = lambda shape, scale: jax.random.normal(next(ks), shape, jnp.float32) * scale
    gain = lambda shape: 1.0 + 0.02 * jax.random.normal(next(ks), shape, jnp.float32)
    return {
        "x_prompt": nrm((BATCH, SEQ, D_MODEL), 1.0),
        "x_sample": nrm((DEC_BATCH, DEC_SEQ, D_MODEL), 1.0),
        "mem_prompt": nrm((BATCH, N_MEM, D_MODEL), 1.0),
        "cache_ckv": nrm((DEPTH, DEC_BATCH, PAST_LEN, KV_LORA), 1.0),
        "cache_krope": nrm((DEPTH, DEC_BATCH, PAST_LEN, QK_ROPE), 1.0),
        "cache_mem_k": nrm((DEPTH, DEC_BATCH, N_MEM, X_HEADS, X_HEAD), 1.0),
        "cache_mem_v": nrm((DEPTH, DEC_BATCH, N_MEM, X_HEADS, X_HEAD), 1.0),
        "state_conv": nrm((DEPTH, DEC_BATCH, CONV_STATE, CONV_WIDTH), 0.5),
        "g_pre": gain((DEPTH, D_MODEL)),
        "w_in": nrm((DEPTH, D_MODEL, IN_COLS), D_MODEL ** -0.5),
        "g_qlat": gain((DEPTH, Q_LORA)),
        "w_uq": nrm((DEPTH, Q_LORA, N_HEADS * QK_HEAD), Q_LORA ** -0.5),
        "g_kvlat": gain((DEPTH, KV_LORA)),
        "w_ukv": nrm((DEPTH, KV_LORA, N_HEADS * (QK_NOPE + V_HEAD)), KV_LORA ** -0.5),
        "g_qnorm": gain((DEPTH, QK_HEAD)),
        "g_knorm": gain((DEPTH, QK_HEAD)),
        "conv_w": nrm((DEPTH, CONV_K, CONV_WIDTH), CONV_K ** -0.5),
        "conv_b": nrm((DEPTH, CONV_WIDTH), 0.02),
        "ln_g": gain((DEPTH, CONV_WIDTH)),
        "ln_b": nrm((DEPTH, CONV_WIDTH), 0.02),
        "w_pw2": nrm((DEPTH, CONV_WIDTH, CONV_WIDTH), CONV_WIDTH ** -0.5),
        "b_pw2": nrm((DEPTH, CONV_WIDTH), 0.02),
        "g_mem": gain((DEPTH, D_MODEL)),
        "w_mem_kv": nrm((DEPTH, D_MODEL, 2 * X_WIDTH), D_MODEL ** -0.5),
        "g_xq": gain((DEPTH, X_HEAD)),
        "g_xk": gain((DEPTH, X_HEAD)),
        "w_p_mla": nrm((DEPTH, MLA_WIDTH, D_MODEL), MLA_WIDTH ** -0.5),
        "w_p_conv": nrm((DEPTH, CONV_WIDTH, D_MODEL), CONV_WIDTH ** -0.5),
        "w_p_x": nrm((DEPTH, X_WIDTH, D_MODEL), X_WIDTH ** -0.5),
        "b_merge": nrm((DEPTH, N_BRANCH * D_MODEL), 0.02),
        "w_out": nrm((DEPTH, D_MODEL, D_MODEL), D_MODEL ** -0.5),
    }


def reference(x_prompt, x_sample, mem_prompt, cache_ckv, cache_krope, cache_mem_k, cache_mem_v, state_conv,
              g_pre, w_in, g_qlat, w_uq, g_kvlat, w_ukv, g_qnorm, g_knorm, conv_w, conv_b, ln_g, ln_b,
              w_pw2, b_pw2, g_mem, w_mem_kv, g_xq, g_xk, w_p_mla, w_p_conv, w_p_x, b_merge, w_out):
    xp, xs = x_prompt, x_sample
    p_ckv, p_kr, p_mk, p_mv, p_cv = [], [], [], [], []
    s_ckv, s_kr, s_cv = [], [], []
    for l in range(DEPTH):
        lp = dict(g_pre=g_pre[l], w_in=w_in[l], g_qlat=g_qlat[l], w_uq=w_uq[l], g_kvlat=g_kvlat[l],
                  w_ukv=w_ukv[l], g_qnorm=g_qnorm[l], g_knorm=g_knorm[l], conv_w=conv_w[l], conv_b=conv_b[l],
                  ln_g=ln_g[l], ln_b=ln_b[l], w_pw2=w_pw2[l], b_pw2=b_pw2[l], g_mem=g_mem[l],
                  w_mem_kv=w_mem_kv[l], g_xq=g_xq[l], g_xk=g_xk[l], w_p_mla=w_p_mla[l], w_p_conv=w_p_conv[l],
                  w_p_x=w_p_x[l], b_merge=b_merge[l], w_out=w_out[l])
        xp, ckv, kr, mk, mv, cv = prompt_layer(xp, mem_prompt, lp)
        p_ckv.append(ckv); p_kr.append(kr); p_mk.append(mk); p_mv.append(mv); p_cv.append(cv)
        xs, ckv, kr, cv = sample_layer(xs, cache_ckv[l], cache_krope[l], cache_mem_k[l], cache_mem_v[l],
                                       state_conv[l], lp)
        s_ckv.append(ckv); s_kr.append(kr); s_cv.append(cv)
    return (xp, xs, jnp.stack(p_ckv), jnp.stack(p_kr), jnp.stack(p_mk), jnp.stack(p_mv), jnp.stack(p_cv),
            jnp.stack(s_ckv), jnp.stack(s_kr), jnp.stack(s_cv))
```

```cpp
#include <hip/hip_runtime.h>
#include <cstdio>
#include <cstdint>

#define LAS __attribute__((address_space(3)))
#define GAS __attribute__((address_space(1)))
typedef unsigned short bf16_t;
typedef short bf16x8 __attribute__((ext_vector_type(8)));
typedef short s16x4 __attribute__((ext_vector_type(4)));
typedef float f32x2 __attribute__((ext_vector_type(2)));
typedef float f32x4 __attribute__((ext_vector_type(4)));
typedef float f32x16 __attribute__((ext_vector_type(16)));
typedef unsigned u32x2 __attribute__((ext_vector_type(2)));
typedef unsigned u32x4 __attribute__((ext_vector_type(4)));
typedef GAS unsigned gu32;

#ifndef PH_ONLY
#define PH_ONLY -1
#endif
#define PH_ON(k) (PH_ONLY < 0 || PH_ONLY == (k))
#ifndef NPH_RUN
#define NPH_RUN 18
#endif
#ifndef MK_N_LAUNCHES
#define MK_N_LAUNCHES 1
#endif

constexpr int D_MODEL = 2048, M_P = 8192, M_S = 2048, M = M_P + M_S, DEPTH = 2, NSTREAM = 32, DEC_SEQ = 64, PAST = 4096;
constexpr int NH = 16, QK_HEAD = 192, Q_LORA = 512, KV_LORA = 512;
constexpr int CONV_W = 1024, CONV_K = 31, CONV_ST = 30, N_MEM = 256, XW = 1024;
constexpr int IN_COLS = 14400, IN_PAD = 14592;
constexpr int MPAST = NSTREAM * PAST;
constexpr float EPS = 1e-6f;
constexpr float LOG2E = 1.4426950408889634f;
constexpr float C_MLA = 0.07216878364870323f * LOG2E;
constexpr float C_X = 0.0625f * LOG2E;

constexpr size_t O_YP = 0, O_YS = 16777216, O_PCKV = 20971520, O_PKR = 29360128, O_PMK = 30408704, O_PMV = 30932992,
                 O_PCONV = 31457280, O_SCKV = 31518720, O_SKR = 33615872, O_SCONV = 33878016, O_END = 35844096;

constexpr size_t al256(size_t x) { return (x + 255) / 256 * 256; }
constexpr size_t WS_CTL = 0, CTL_BYTES = 1u << 20;
constexpr size_t WS_WIN = WS_CTL + CTL_BYTES;
constexpr size_t WS_WUQ = WS_WIN + (size_t)IN_PAD * 2048 * 2;
constexpr size_t WS_WUKV = WS_WUQ + (size_t)3072 * 512 * 2;
constexpr size_t WS_WPW2 = WS_WUKV + (size_t)4096 * 512 * 2;
constexpr size_t WS_WMEM = WS_WPW2 + (size_t)1024 * 1024 * 2;
constexpr size_t WS_WPM = WS_WMEM + (size_t)2048 * 2048 * 2;
constexpr size_t WS_WPC = WS_WPM + (size_t)2048 * 2048 * 2;
constexpr size_t WS_WPX = WS_WPC + (size_t)2048 * 1024 * 2;
constexpr size_t WS_WOUT = WS_WPX + (size_t)2048 * 1024 * 2;
constexpr size_t WS_ROPE = WS_WOUT + (size_t)2048 * 2048 * 2;
constexpr size_t WS_CNP = WS_ROPE + (size_t)8192 * 64 * 4;
constexpr size_t WS_KPEP = WS_CNP + (size_t)MPAST * 512 * 2;
constexpr size_t WS_SSPEP = WS_KPEP + (size_t)MPAST * 64 * 2;
constexpr size_t WS_KP = WS_SSPEP + (size_t)MPAST * 4;
constexpr size_t WS_VP = WS_KP + (size_t)MPAST * 2048 * 2;
constexpr size_t WS_SSP = WS_VP + (size_t)MPAST * 2048 * 2;
constexpr size_t WS_HB = WS_SSP + (size_t)MPAST * 16 * 4 * 4;
constexpr size_t WS_QRAW = WS_HB;
constexpr size_t WS_QLATF = WS_HB + (size_t)M * 3072 * 2;
constexpr size_t WS_QLATN = WS_QLATF + (size_t)M * 512 * 4;
constexpr size_t WS_CKVN = WS_QLATN + (size_t)M * 512 * 2;
constexpr size_t WS_ZM = WS_CKVN + (size_t)M * 512 * 2;
constexpr size_t WS_UB = WS_ZM + (size_t)M * 2048 * 2;
constexpr size_t WS_ZC = WS_UB + (size_t)M * 1024 * 2;
constexpr size_t WS_XQ = WS_ZC + (size_t)M * 1024 * 2;
constexpr size_t WS_ZX = WS_XQ + (size_t)M * 1024 * 2;
constexpr size_t WS_GATES = WS_ZX + (size_t)M * 1024 * 2;
constexpr size_t WS_CV = WS_GATES + (size_t)M * 6144 * 2;
constexpr size_t WS_Q = WS_CV + (size_t)M * 1024 * 2;
constexpr size_t WS_KC = WS_Q + (size_t)M * 3072 * 2;
constexpr size_t WS_VC = WS_KC + (size_t)M * 2048 * 2;
constexpr size_t WS_SSC = WS_VC + (size_t)M * 2048 * 2;
constexpr size_t WS_KPEC = WS_SSC + (size_t)M * 16 * 4 * 4;
constexpr size_t WS_SSPEC = WS_KPEC + (size_t)M * 64 * 2;
constexpr size_t WS_AMLA = al256(WS_SSPEC + (size_t)M * 4);
constexpr size_t WS_ACONV = WS_AMLA + (size_t)M * 2048 * 2;
constexpr size_t WS_AX = WS_ACONV + (size_t)M * 1024 * 2;
constexpr size_t WS_X1 = WS_AX + (size_t)M * 1024 * 2;
constexpr size_t WS_MEMN = WS_X1 + (size_t)M * 2048 * 4;
constexpr size_t WS_KVRAW = WS_MEMN + (size_t)256 * 2048 * 2;
constexpr size_t WS_MKB = WS_KVRAW + (size_t)256 * 2048 * 4;
constexpr size_t WS_MVB = WS_MKB + (size_t)256 * 1024 * 2;
constexpr size_t WS_END = WS_MVB + (size_t)256 * 1024 * 2;
constexpr size_t WS_PB = WS_KP;
constexpr size_t WS_MERGED = WS_KP + 3 * (size_t)M * 2048 * 2;
static_assert(sizeof(void*) == 8, "");
static_assert(WS_END <= 2147483648ull, "workspace map exceeds 2 GiB");
static_assert(WS_MERGED + (size_t)M * 2048 * 2 <= WS_VP, "merged overlay inside KP");

constexpr int CW_BAR = 4096;
constexpr int CW_QHEAD = 16384;

constexpr int RING_BYTES = 131072, MISC_OFF = RING_BYTES + 320, LDS_BYTES = 147456;

typedef __bf16 bf16x2_t __attribute__((ext_vector_type(2)));
__device__ __forceinline__ unsigned cvt_pk_bf16(float lo, float hi) { f32x2 v = {lo, hi}; bf16x2_t b = __builtin_convertvector(v, bf16x2_t); return __builtin_bit_cast(unsigned, b); }
__device__ __forceinline__ float bf_lo(unsigned w) { return __uint_as_float(w << 16); }
__device__ __forceinline__ float bf_hi(unsigned w) { return __uint_as_float(w & 0xffff0000u); }
__device__ __forceinline__ float sigmoidf_(float x) { return __builtin_amdgcn_rcpf(1.0f + __builtin_amdgcn_exp2f(-x * LOG2E)); }
__device__ __forceinline__ float siluf_(float x) { return x * sigmoidf_(x); }
__device__ __forceinline__ float wave_sum(float v) {
#pragma unroll
    for (int o = 1; o < 64; o <<= 1) v += __shfl_xor(v, o);
    return v;
}
__device__ __forceinline__ u32x4 pack8(const f32x4 a, const f32x4 b) {
    u32x4 w; w.x = cvt_pk_bf16(a[0], a[1]); w.y = cvt_pk_bf16(a[2], a[3]); w.z = cvt_pk_bf16(b[0], b[1]); w.w = cvt_pk_bf16(b[2], b[3]); return w;
}
__device__ __forceinline__ void unpack8(const u32x4 w, f32x4& a, f32x4& b) {
    a = (f32x4){bf_lo(w.x), bf_hi(w.x), bf_lo(w.y), bf_hi(w.y)}; b = (f32x4){bf_lo(w.z), bf_hi(w.z), bf_lo(w.w), bf_hi(w.w)};
}
#define LDS_WAIT() asm volatile("s_waitcnt lgkmcnt(0)" ::: "memory")
#define VM_WAIT() asm volatile("s_waitcnt vmcnt(0)" ::: "memory")

namespace pg8 {
constexpr int BM = 256, BK = 64, HALF = 128, HTB = HALF * BK * 2, STAGE_BYTES = 8 * HTB, NXCD = 8, WGM = 8;
__host__ __device__ __forceinline__ int lds_byte(int r, int c) { const int st = (r >> 4) * 2 + (c >> 5), rr = r & 15, cc = c & 31, ob = rr * 64 + cc * 2; return st * 1024 + (ob ^ (((ob >> 9) & 1) << 5)); }
__host__ __device__ __forceinline__ void stage_rc(int b, int& R, int& C) { const int st = b / 1024, sb = b % 1024, swz = sb ^ (((sb >> 9) & 1) << 5); R = (st >> 1) * 16 + swz / 64; C = (st & 1) * 32 + (swz % 64) / 2; }
__host__ __device__ __forceinline__ int perm32(int rho) { const int n = rho >> 4, i = rho & 15; return 8 * (i >> 2) + 4 * n + (i & 3); }
struct Unit { int pm, pn; };
struct Gemm { const bf16_t* A; const bf16_t* Bt; int lda, ldb, K; };
struct StaticOrder {
    int nM, nN, nwg, G, c;
    __device__ void init(int M_, int N_, int G_, int c_) { nM = M_ / BM; nN = N_ / BM; nwg = nM * nN; G = G_; c = c_; }
    __device__ bool next(int i, Unit& u) const {
        const long L = (long)i * G + c; if (L >= nwg) return false;
        int wgid = (int)L; { const int q = nwg / NXCD, r = nwg % NXCD, xcd = wgid % NXCD, off = wgid / NXCD; wgid = (xcd < r ? xcd * (q + 1) : r * (q + 1) + (xcd - r) * q) + off; }
        const int nig = WGM * nN, gid = wgid / nig, fm = gid * WGM, gsz = (nM - fm) < WGM ? (nM - fm) : WGM;
        u.pm = fm + ((wgid % nig) % gsz); u.pn = (wgid % nig) / gsz; return true;
    }
};
template <class Epi, class Sched>
__device__ __forceinline__ void gemm_phase(LAS unsigned char* lds, const Gemm g, const Sched& S, const Epi& E) {
    int tid = threadIdx.x; asm volatile("" : "+v"(tid));
    const int wid = __builtin_amdgcn_readfirstlane(tid >> 6), lane = tid & 63, wr = wid >> 2, wc = wid & 3, fr = lane & 15, fq = lane >> 4;
    const int K = g.K, nt = K / BK;
    unsigned voffA[2], voffB[2];
#pragma unroll
    for (int i = 0; i < 2; ++i) { int R, C; stage_rc(tid * 16 + i * 8192, R, C); const int Rb = (R & ~31) + perm32(R & 31);
        voffA[i] = (unsigned)(R * g.lda + C) * 2u; voffB[i] = (unsigned)(Rb * g.ldb + C) * 2u; }
    const size_t kstep = (size_t)(BK * 2);
    const size_t hA = (size_t)HALF * g.lda * 2, hB = (size_t)HALF * g.ldb * 2;
    const size_t tA = 2 * hA, tB = 2 * hB;
    const unsigned ldsw = (unsigned)wid * 1024u;
    const int aoff = lds_byte(wr * 64 + fr, fq * 8), boff = lds_byte(wc * 32 + fr, fq * 8);
#define PG8_SA(b, h) (((b) * 2 + (h)) * HTB)
#define PG8_SB(b, h) ((4 + (b) * 2 + (h)) * HTB)
#define PG8_STAGE(bufoff, gbase, voff) do { _Pragma("unroll") for (int _i = 0; _i < 2; ++_i) \
        __builtin_amdgcn_global_load_lds((const unsigned*)((const char*)(gbase) + (voff)[_i]), (LAS unsigned*)(lds + (bufoff) + ldsw + _i * 8192), 16, 0, 0); } while (0)
#define PG8_LDA(dst, b, h) do { _Pragma("unroll") for (int m = 0; m < 4; ++m) _Pragma("unroll") for (int k = 0; k < 2; ++k) dst[m][k] = *(const LAS bf16x8*)(lds + PG8_SA(b, h) + aoff + m * 2048 + k * 1024); } while (0)
#define PG8_LDB(dst, b, h) do { _Pragma("unroll") for (int n = 0; n < 2; ++n) _Pragma("unroll") for (int k = 0; k < 2; ++k) dst[n][k] = *(const LAS bf16x8*)(lds + PG8_SB(b, h) + boff + n * 2048 + k * 1024); } while (0)
#define PG8_MMA(ai, bj, At, Bt) do { __builtin_amdgcn_s_setprio(1); _Pragma("unroll") for (int m = 0; m < 4; ++m) _Pragma("unroll") for (int n = 0; n < 2; ++n) _Pragma("unroll") for (int k = 0; k < 2; ++k) \
        acc[ai][bj][m][n] = __builtin_amdgcn_mfma_f32_16x16x32_bf16(Bt[n][k], At[m][k], acc[ai][bj][m][n], 0, 0, 0); __builtin_amdgcn_s_setprio(0); } while (0)
#define PG8_WAIT_V(n) asm volatile("s_waitcnt vmcnt(" #n ")" ::: "memory")
#define PG8_WAIT_L(n) asm volatile("s_waitcnt lgkmcnt(" #n ")" ::: "memory")
#define PG8_BAR __builtin_amdgcn_s_barrier()
#define PG8_SCHED __builtin_amdgcn_sched_barrier(0)
    Unit cur, nxt; int ui = 0;
    if (!S.next(0, cur)) return;
    f32x4 acc[2][2][4][2];
#pragma unroll
    for (int a = 0; a < 2; ++a)
#pragma unroll
        for (int b = 0; b < 2; ++b)
#pragma unroll
            for (int m = 0; m < 4; ++m)
#pragma unroll
                for (int n = 0; n < 2; ++n) acc[a][b][m][n] = (f32x4){0.f, 0.f, 0.f, 0.f};
    bf16x8 At[4][2], B0[2][2], B1[2][2];
    const char* cA = (const char*)g.A + (size_t)cur.pm * tA; const char* cB = (const char*)g.Bt + (size_t)cur.pn * tB;
    PG8_STAGE(PG8_SB(0, 0), cB, voffB); PG8_STAGE(PG8_SB(0, 1), cB + hB, voffB); PG8_STAGE(PG8_SA(0, 0), cA, voffA); PG8_STAGE(PG8_SA(0, 1), cA + hA, voffA);
    if (wr == 1) PG8_BAR;
    PG8_WAIT_V(2); PG8_BAR;
    PG8_STAGE(PG8_SB(1, 0), cB + kstep, voffB); PG8_STAGE(PG8_SA(1, 0), cA + kstep, voffA); PG8_STAGE(PG8_SB(1, 1), cB + hB + kstep, voffB);
    PG8_WAIT_V(6); PG8_BAR;
    for (;;) {
        const bool has_next = S.next(ui + 1, nxt);
        const char* nA = has_next ? (const char*)g.A + (size_t)nxt.pm * tA : cA; const char* nB = has_next ? (const char*)g.Bt + (size_t)nxt.pn * tB : cB;
        for (int t = 0; t < nt; t += 2) {
            const bool last = (t == nt - 2);
            const char* a1 = cA + (size_t)(t + 1) * kstep;
            const char* a2 = last ? nA : cA + (size_t)(t + 2) * kstep; const char* b2 = last ? nB : cB + (size_t)(t + 2) * kstep;
            const char* a3 = a2 + kstep; const char* b3 = b2 + kstep;
            PG8_LDB(B0, 0, 0); PG8_LDB(B1, 0, 1); PG8_SCHED; PG8_LDA(At, 0, 0); PG8_STAGE(PG8_SA(1, 1), a1 + hA, voffA);
            PG8_WAIT_V(8); PG8_WAIT_L(0); PG8_BAR; PG8_MMA(0, 0, At, B0); PG8_MMA(0, 1, At, B1); PG8_BAR; PG8_SCHED;
            PG8_LDA(At, 0, 1); PG8_STAGE(PG8_SB(0, 0), b2, voffB); PG8_STAGE(PG8_SB(0, 1), b2 + hB, voffB); PG8_STAGE(PG8_SA(0, 0), a2, voffA);
            PG8_WAIT_V(8); PG8_WAIT_L(0); PG8_BAR; PG8_MMA(1, 0, At, B0); PG8_MMA(1, 1, At, B1); PG8_BAR; PG8_SCHED;
            PG8_LDB(B0, 1, 0); PG8_LDB(B1, 1, 1); PG8_SCHED; PG8_LDA(At, 1, 0); PG8_STAGE(PG8_SA(0, 1), a2 + hA, voffA);
            PG8_WAIT_V(8); PG8_WAIT_L(0); PG8_BAR; PG8_MMA(0, 0, At, B0); PG8_MMA(0, 1, At, B1); PG8_BAR; PG8_SCHED;
            PG8_LDA(At, 1, 1); PG8_STAGE(PG8_SB(1, 0), b3, voffB); PG8_STAGE(PG8_SB(1, 1), b3 + hB, voffB); PG8_STAGE(PG8_SA(1, 0), a3, voffA);
            PG8_WAIT_V(8); PG8_WAIT_L(0); PG8_BAR; PG8_MMA(1, 0, At, B0); PG8_MMA(1, 1, At, B1); PG8_BAR; PG8_SCHED;
        }
        if (wr == 0) PG8_BAR;
        E(acc, cur);
        if (!has_next) break;
#pragma unroll
        for (int a = 0; a < 2; ++a)
#pragma unroll
            for (int b = 0; b < 2; ++b)
#pragma unroll
                for (int m = 0; m < 4; ++m)
#pragma unroll
                    for (int n = 0; n < 2; ++n) acc[a][b][m][n] = (f32x4){0.f, 0.f, 0.f, 0.f};
        cur = nxt; cA = nA; cB = nB; ++ui;
        if (wr == 1) PG8_BAR;
    }
    PG8_WAIT_V(0);
    PG8_BAR;
#undef PG8_SA
#undef PG8_SB
#undef PG8_STAGE
#undef PG8_LDA
#undef PG8_LDB
#undef PG8_MMA
#undef PG8_WAIT_V
#undef PG8_WAIT_L
#undef PG8_BAR
#undef PG8_SCHED
}
}
using pg8::Unit;

#define EPI_LANE int tz_ = threadIdx.x; asm volatile("" : "+v"(tz_)); const int wr = tz_ >> 8, wc = (tz_ >> 6) & 3, fr = tz_ & 15, fq = (tz_ >> 4) & 3; (void)wr; (void)wc; (void)fr; (void)fq;
#define EPI_LOOP_BEGIN \
    _Pragma("unroll") for (int ai = 0; ai < 2; ++ai) _Pragma("unroll") for (int m = 0; m < 4; ++m) { const int row = u.pm * 256 + ai * 128 + wr * 64 + m * 16 + fr; \
    _Pragma("unroll") for (int bj = 0; bj < 2; ++bj) { const int colt = bj * 128 + wc * 32 + 8 * fq; const f32x4 v0 = acc[ai][bj][m][0], v1 = acc[ai][bj][m][1]; (void)colt; (void)v0; (void)v1;
#define EPI_LOOP_END } asm volatile("" ::: "memory"); }

struct EpiBf16 {
    bf16_t* O; int ldc;
    __device__ __forceinline__ void operator()(const f32x4 (&acc)[2][2][4][2], const Unit& u) const {
        EPI_LANE
        EPI_LOOP_BEGIN
            *(u32x4*)(O + (size_t)row * ldc + u.pn * 256 + colt) = pack8(v0, v1);
        EPI_LOOP_END
    }
};
struct EpiF32 {
    float* C; int ldc;
    __device__ __forceinline__ void operator()(const f32x4 (&acc)[2][2][4][2], const Unit& u) const {
        EPI_LANE
        EPI_LOOP_BEGIN
            float* p = C + (size_t)row * ldc + u.pn * 256 + colt; *(f32x4*)p = v0; *(f32x4*)(p + 4) = v1;
        EPI_LOOP_END
    }
};
struct EpiWin {
    unsigned char* ws; float* out; const float* bmerge; int l;
    __device__ __forceinline__ void operator()(const f32x4 (&acc)[2][2][4][2], const Unit& u) const {
        EPI_LANE
        const int pn = u.pn;
        if (pn < 2) {
            float* qlat = (float*)(ws + WS_QLATF);
            EPI_LOOP_BEGIN
                float* p = qlat + (size_t)row * 512 + pn * 256 + colt; *(f32x4*)p = v0; *(f32x4*)(p + 4) = v1;
            EPI_LOOP_END
        } else if (pn < 4) {
            float* ckv_p = out + O_PCKV + (size_t)l * M_P * 512; float* ckv_s = out + O_SCKV + (size_t)l * M_S * 512;
            EPI_LOOP_BEGIN
                float* p = (row < M_P ? ckv_p + (size_t)row * 512 : ckv_s + (size_t)(row - M_P) * 512) + (pn - 2) * 256 + colt; *(f32x4*)p = v0; *(f32x4*)(p + 4) = v1;
            EPI_LOOP_END
        } else if (pn == 4) {
            float* kr_p = out + O_PKR + (size_t)l * M_P * 64; float* kr_s = out + O_SKR + (size_t)l * M_S * 64;
            EPI_LOOP_BEGIN
                if (colt < 64) { float* p = (row < M_P ? kr_p + (size_t)row * 64 : kr_s + (size_t)(row - M_P) * 64) + colt; *(f32x4*)p = v0; *(f32x4*)(p + 4) = v1; }
            EPI_LOOP_END
        } else if (pn < 13) {
            bf16_t* zm = (bf16_t*)(ws + WS_ZM);
            EPI_LOOP_BEGIN
                f32x4 a, b;
#pragma unroll
                for (int j = 0; j < 4; ++j) { a[j] = siluf_(v0[j]); b[j] = siluf_(v1[j]); }
                *(u32x4*)(zm + (size_t)row * 2048 + (pn - 5) * 256 + colt) = pack8(a, b);
            EPI_LOOP_END
        } else if (pn < 21) {
            const int t = pn - 13;
            bf16_t* ub = (bf16_t*)(ws + WS_UB);
            float* conv_p = out + O_PCONV + (size_t)l * CONV_ST * 1024; float* conv_s = out + O_SCONV + (size_t)l * NSTREAM * CONV_ST * 1024;
#pragma unroll
            for (int ai = 0; ai < 2; ++ai)
#pragma unroll
                for (int m = 0; m < 4; ++m) {
                    const int row = u.pm * 256 + ai * 128 + wr * 64 + m * 16 + fr; const int col = t * 128 + wc * 32 + 8 * fq;
                    f32x4 a, b;
#pragma unroll
                    for (int j = 0; j < 4; ++j) { a[j] = acc[ai][0][m][0][j] * sigmoidf_(acc[ai][1][m][0][j]); b[j] = acc[ai][0][m][1][j] * sigmoidf_(acc[ai][1][m][1][j]); }
                    *(u32x4*)(ub + (size_t)row * 1024 + col) = pack8(a, b);
                    if (row >= M_P - CONV_ST) {
                        if (row < M_P) { float* p = conv_p + (size_t)(row - (M_P - CONV_ST)) * 1024 + col; *(f32x4*)p = a; *(f32x4*)(p + 4) = b; }
                        else { const int rs = row - M_P, sq = rs & 63, bb = rs >> 6;
                            if (sq >= DEC_SEQ - CONV_ST) { float* p = conv_s + ((size_t)bb * CONV_ST + (sq - (DEC_SEQ - CONV_ST))) * 1024 + col; *(f32x4*)p = a; *(f32x4*)(p + 4) = b; } }
                    }
                }
        } else if (pn < 33) {
            const size_t dofs = pn < 25 ? WS_ZC : (pn < 29 ? WS_XQ : WS_ZX); const int tb = pn < 25 ? 21 : (pn < 29 ? 25 : 29); const bool act = !(pn >= 25 && pn < 29);
            bf16_t* dst = (bf16_t*)(ws + dofs);
            EPI_LOOP_BEGIN
                f32x4 a = v0, b = v1;
                if (act) {
#pragma unroll
                    for (int j = 0; j < 4; ++j) { a[j] = siluf_(v0[j]); b[j] = siluf_(v1[j]); } }
                *(u32x4*)(dst + (size_t)row * 1024 + (pn - tb) * 256 + colt) = pack8(a, b);
            EPI_LOOP_END
        } else {
            bf16_t* gates = (bf16_t*)(ws + WS_GATES);
            EPI_LOOP_BEGIN
                const int col = (pn - 33) * 256 + colt; const f32x4 b0 = *(const f32x4*)(bmerge + col), b1 = *(const f32x4*)(bmerge + col + 4);
                f32x4 a, b;
#pragma unroll
                for (int j = 0; j < 4; ++j) { a[j] = sigmoidf_(v0[j] + b0[j]); b[j] = sigmoidf_(v1[j] + b1[j]); }
                *(u32x4*)(gates + (size_t)row * 6144 + col) = pack8(a, b);
            EPI_LOOP_END
        }
    }
};
template <bool PASTROWS> struct EpiKV {
    bf16_t* Kd; bf16_t* Vd; float* SS;
    __device__ __forceinline__ void operator()(const f32x4 (&acc)[2][2][4][2], const Unit& u) const {
        EPI_LANE
        const int h = u.pn;
#pragma unroll
        for (int ai = 0; ai < 2; ++ai)
#pragma unroll
            for (int m = 0; m < 4; ++m) {
                const int row = u.pm * 256 + ai * 128 + wr * 64 + m * 16 + fr;
                const size_t R = PASTROWS ? ((size_t)((row >> 12) * 16 + h) * 4096 + (row & 4095)) : ((size_t)h * M + row);
                const int c = wc * 32 + 8 * fq;
                const f32x4 k0 = acc[ai][0][m][0], k1 = acc[ai][0][m][1];
                *(u32x4*)(Kd + R * 128 + c) = pack8(k0, k1);
                *(u32x4*)(Vd + R * 128 + c) = pack8(acc[ai][1][m][0], acc[ai][1][m][1]);
                float s = (k0[0] * k0[0] + k0[1] * k0[1]) + (k0[2] * k0[2] + k0[3] * k0[3]) + (k1[0] * k1[0] + k1[1] * k1[1]) + (k1[2] * k1[2] + k1[3] * k1[3]);
                s += __shfl_xor(s, 16); s += __shfl_xor(s, 32);
                if (fq == 0) SS[R * 4 + wc] = s;
            }
    }
};
struct EpiPw2 {
    bf16_t* O; const bf16_t* zc; const float* bias;
    __device__ __forceinline__ void operator()(const f32x4 (&acc)[2][2][4][2], const Unit& u) const {
        EPI_LANE
        EPI_LOOP_BEGIN
            const int col = u.pn * 256 + colt; const f32x4 b0 = *(const f32x4*)(bias + col), b1 = *(const f32x4*)(bias + col + 4);
            f32x4 z0, z1; unpack8(*(const u32x4*)(zc + (size_t)row * 1024 + col), z0, z1);
            *(u32x4*)(O + (size_t)row * 1024 + col) = pack8((v0 + b0) * z0, (v1 + b1) * z1);
        EPI_LOOP_END
    }
};
struct EpiGate {
    bf16_t* O; const bf16_t* gates; int goff;
    __device__ __forceinline__ void operator()(const f32x4 (&acc)[2][2][4][2], const Unit& u) const {
        EPI_LANE
        EPI_LOOP_BEGIN
            const int col = u.pn * 256 + colt;
            f32x4 g0, g1; unpack8(*(const u32x4*)(gates + (size_t)row * 6144 + goff + col), g0, g1);
            *(u32x4*)(O + (size_t)row * 2048 + col) = pack8(g0 * v0, g1 * v1);
        EPI_LOOP_END
    }
};
struct EpiOut {
    const float* src_p; const float* src_s; float* dst_p; float* dst_s;
    __device__ __forceinline__ void operator()(const f32x4 (&acc)[2][2][4][2], const Unit& u) const {
        EPI_LANE
        EPI_LOOP_BEGIN
            const int col = u.pn * 256 + colt;
            const size_t off = (row < M_P ? (size_t)row : (size_t)(row - M_P)) * 2048 + col;
            const float* s = (row < M_P ? src_p : src_s) + off; float* d = (row < M_P ? dst_p : dst_s) + off;
            *(f32x4*)d = *(const f32x4*)s + v0; *(f32x4*)(d + 4) = *(const f32x4*)(s + 4) + v1;
        EPI_LOOP_END
    }
};

namespace att {
__device__ __forceinline__ int crow(int r, int hi) { return (r & 3) + 8 * (r >> 2) + 4 * hi; }
template <int ROWB> __device__ __forceinline__ int kswz(int row, int colB) { return row * ROWB + (colB ^ ((row & 7) << 4)); }
template <int NDV> __device__ __forceinline__ int v_st(int k, int c) { const int kk = (k & ~0xC) | ((k & 4) << 1) | ((k & 8) >> 1); return ((kk >> 3) * NDV + (c >> 5)) * 512 + ((kk & 7) * 32 + (c & 31)) * 2; }
__device__ __forceinline__ int v_rd_base(int lane) { return ((lane & 3) << 3) | (((lane >> 2) & 3) << 6) | (((lane >> 4) & 1) << 5) | (((lane >> 5) & 1) << 8); }

template <int NQA, int NQB, int NDV, int NKB, bool HAS_RK, int KROWB>
__device__ __forceinline__ void tile_step(const bf16x8 (&qr)[NQA + NQB], f32x16 (&o)[NDV], float& m_reg, float& l_reg,
                                          const LAS char* Ks, const LAS char* Kp, int vb, const LAS float* rk, LAS float* al_l, int r32, int hi) {
    f32x16 p[NKB];
#pragma unroll
    for (int kb = 0; kb < NKB; ++kb)
#pragma unroll
        for (int r = 0; r < 16; ++r) p[kb][r] = 0.f;
#pragma unroll
    for (int d0 = 0; d0 < NQA; ++d0) { const int cb = (d0 * 16 + hi * 8) * 2;
#pragma unroll
        for (int kb = 0; kb < NKB; ++kb) { const bf16x8 a = *(const LAS bf16x8*)(Ks + kswz<KROWB>(kb * 32 + r32, cb)); p[kb] = __builtin_amdgcn_mfma_f32_32x32x16_bf16(a, qr[d0], p[kb], 0, 0, 0); } }
#pragma unroll
    for (int d0 = 0; d0 < NQB; ++d0) { const int cb = (d0 * 16 + hi * 8) * 2;
#pragma unroll
        for (int kb = 0; kb < NKB; ++kb) { const bf16x8 a = *(const LAS bf16x8*)(Kp + kswz<128>(kb * 32 + r32, cb)); p[kb] = __builtin_amdgcn_mfma_f32_32x32x16_bf16(a, qr[NQA + d0], p[kb], 0, 0, 0); } }
    if (HAS_RK) {
#pragma unroll
        for (int kb = 0; kb < NKB; ++kb)
#pragma unroll
            for (int i = 0; i < 4; ++i) { const f32x4 s = *(const LAS f32x4*)(rk + kb * 32 + 8 * i + 4 * hi);
#pragma unroll
                for (int j = 0; j < 4; ++j) p[kb][4 * i + j] *= s[j]; }
    }
    float pmax = p[0][0];
#pragma unroll
    for (int kb = 0; kb < NKB; ++kb)
#pragma unroll
        for (int r = 0; r < 16; ++r) pmax = fmaxf(pmax, p[kb][r]);
    { auto rr = __builtin_amdgcn_permlane32_swap(__float_as_uint(pmax), __float_as_uint(pmax), false, false); pmax = fmaxf(__uint_as_float(rr[0]), __uint_as_float(rr[1])); }
    const float mn = fmaxf(m_reg, pmax); const float alpha = __builtin_amdgcn_exp2f(m_reg - mn); m_reg = mn;
    float ps = 0.f;
#pragma unroll
    for (int kb = 0; kb < NKB; ++kb)
#pragma unroll
        for (int r = 0; r < 16; ++r) { p[kb][r] = __builtin_amdgcn_exp2f(p[kb][r] - mn); ps += p[kb][r]; }
    { auto rr = __builtin_amdgcn_permlane32_swap(__float_as_uint(ps), __float_as_uint(ps), false, false); ps = __uint_as_float(rr[0]) + __uint_as_float(rr[1]); }
    l_reg = l_reg * alpha + ps;
    if (__any(alpha < 1.f)) {
        if (hi == 0) al_l[r32] = alpha;
        LDS_WAIT();
        float al[16];
#pragma unroll
        for (int r = 0; r < 16; ++r) al[r] = al_l[crow(r, hi)];
#pragma unroll
        for (int d = 0; d < NDV; ++d)
#pragma unroll
            for (int r = 0; r < 16; ++r) o[d][r] *= al[r];
    }
    bf16x8 pa[2 * NKB];
#pragma unroll
    for (int kb = 0; kb < NKB; ++kb)
#pragma unroll
        for (int hf = 0; hf < 2; ++hf) { const int B = hf * 8;
            const unsigned a0 = cvt_pk_bf16(p[kb][B + 0], p[kb][B + 1]), a1 = cvt_pk_bf16(p[kb][B + 2], p[kb][B + 3]);
            const unsigned b0 = cvt_pk_bf16(p[kb][B + 4], p[kb][B + 5]), b1 = cvt_pk_bf16(p[kb][B + 6], p[kb][B + 7]);
            auto r0 = __builtin_amdgcn_permlane32_swap(a0, b0, false, false); auto r1 = __builtin_amdgcn_permlane32_swap(a1, b1, false, false);
            u32x4 w = {r0[0], r1[0], r0[1], r1[1]}; pa[kb * 2 + hf] = __builtin_bit_cast(bf16x8, w); }
#pragma unroll
    for (int d0 = 0; d0 < NDV; ++d0) {
        s16x4 lo[2 * NKB], hh[2 * NKB];
#pragma unroll
        for (int ks = 0; ks < 2 * NKB; ++ks) {
            asm volatile("ds_read_b64_tr_b16 %0, %1 offset:%c2" : "=&v"(lo[ks]) : "v"(vb), "i"(d0 * 512 + ks * (NDV * 1024)) : "memory");
            asm volatile("ds_read_b64_tr_b16 %0, %1 offset:%c2" : "=&v"(hh[ks]) : "v"(vb), "i"(d0 * 512 + ks * (NDV * 1024) + NDV * 512) : "memory"); }
        asm volatile("s_waitcnt lgkmcnt(0)" ::: "memory"); __builtin_amdgcn_sched_barrier(0);
#pragma unroll
        for (int ks = 0; ks < 2 * NKB; ++ks) { const bf16x8 vf = (bf16x8){lo[ks][0], lo[ks][1], lo[ks][2], lo[ks][3], hh[ks][0], hh[ks][1], hh[ks][2], hh[ks][3]};
            o[d0] = __builtin_amdgcn_mfma_f32_32x32x16_bf16(pa[ks], vf, o[d0], 0, 0, 0); }
    }
}
template <int NDV>
__device__ __forceinline__ void finish(const f32x16 (&o)[NDV], float l_reg, LAS float* al_l, bf16_t* out, const bf16_t* z, int ld, int r32, int hi) {
    if (hi == 0) al_l[r32] = l_reg;
    LDS_WAIT();
#pragma unroll
    for (int r = 0; r < 16; ++r) { const int orow = crow(r, hi); const float rl = __builtin_amdgcn_rcpf(al_l[orow]);
#pragma unroll
        for (int d0 = 0; d0 < NDV; ++d0) { const size_t idx = (size_t)orow * ld + d0 * 32 + r32; const float zz = __uint_as_float((unsigned)z[idx] << 16);
            out[idx] = (bf16_t)(cvt_pk_bf16(o[d0][r] * rl * zz, 0.f) & 0xffffu); } }
}
}

#define XB_TMO      128
#define XB_XCNT(j)  (256  + 64 * (j))
#define XB_XSUB(j)  (1280 + 64 * (j))
#define XB_XGEN(j)  (2304 + 64 * (j))
#define XB_TOP      3328
#define XB_TOPGEN   3392
#define XCD_BAR_WORDS 3456
#define XB_SPIN_CAP (1u << 18)
__device__ __forceinline__ unsigned xb_ld(unsigned* p)              { return __hip_atomic_load(p, __ATOMIC_RELAXED, __HIP_MEMORY_SCOPE_AGENT); }
__device__ __forceinline__ unsigned xb_add(unsigned* p, unsigned v) { return __hip_atomic_fetch_add(p, v, __ATOMIC_RELAXED, __HIP_MEMORY_SCOPE_AGENT); }
__device__ __forceinline__ unsigned xb_xcc_id() { return (unsigned)__builtin_amdgcn_s_getreg((3 << 11) | 20) & 0xFu; }
#define XB_SPIN(cond, bar) do { unsigned _sp = 0; while (cond) { __builtin_amdgcn_s_sleep(1); \
    if ((++_sp & 255u) == 0u) { if (xb_ld(&(bar)[XB_TMO])) break; if (_sp > XB_SPIN_CAP) { atomicAdd(&(bar)[XB_TMO], 1u); break; } } } } while (0)
struct XcdBarrier { unsigned* bar; unsigned x; volatile LAS unsigned* st; };
__device__ __forceinline__ XcdBarrier xcd_barrier_post(unsigned* bar, volatile LAS unsigned* st) {
    XcdBarrier b; b.bar = bar; b.x = xb_xcc_id(); b.st = st;
    if (threadIdx.x == 0) (void)xb_add(&bar[XB_XCNT(b.x)], 1u);
    return b;
}
__device__ __forceinline__ void xcd_barrier_complete(unsigned* bar, unsigned x, unsigned& nloc, unsigned& nx) {
    const unsigned G = gridDim.x * gridDim.y * gridDim.z;
    unsigned sum, cnt, mine, sp = 0u;
    for (;;) {
        sum = 0u; cnt = 0u; mine = 0u;
#pragma unroll
        for (unsigned j = 0; j < 16; ++j) { const unsigned c = xb_ld(&bar[XB_XCNT(j)]); sum += c; cnt += (c > 0u) ? 1u : 0u; mine = (j == x) ? c : mine; }
        if (sum == G) break;
        __builtin_amdgcn_s_sleep(1);
        if ((++sp & 255u) == 0u) { if (xb_ld(&bar[XB_TMO])) break; if (sp > XB_SPIN_CAP) { atomicAdd(&bar[XB_TMO], 1u); break; } }
    }
    nloc = mine > 0u ? mine : 1u; nx = cnt > 0u ? cnt : 1u;
}
__device__ __forceinline__ void xcd_barrier(const XcdBarrier& b) {
    asm volatile("s_waitcnt vmcnt(0)" ::: "memory");
    __syncthreads();
    if (threadIdx.x == 0) {
        unsigned* bar = b.bar;
        __builtin_amdgcn_s_waitcnt(0);
        unsigned nloc = b.st[0], nx = b.st[1];
        if (nloc == 0u) { xcd_barrier_complete(bar, b.x, nloc, nx); b.st[0] = nloc; b.st[1] = nx; }
        const unsigned old = xb_add(&bar[XB_XSUB(b.x)], 1u);
        const unsigned gen = old / nloc;
        if (old + 1u == (gen + 1u) * nloc) {
            __builtin_amdgcn_fence(__ATOMIC_RELEASE, "agent");
            asm volatile("s_waitcnt vmcnt(0)" ::: "memory");
            const unsigned og = xb_add(&bar[XB_TOP], 1u);
            const unsigned tg = og / nx;
            if (og + 1u == (tg + 1u) * nx) xb_add(&bar[XB_TOPGEN], 1u);
            else XB_SPIN(xb_ld(&bar[XB_TOPGEN]) == tg, bar);
            __builtin_amdgcn_fence(__ATOMIC_ACQUIRE, "agent");
            xb_add(&bar[XB_XGEN(b.x)], 1u);
            asm volatile("s_waitcnt vmcnt(0)" ::: "memory");
        } else {
            XB_SPIN(xb_ld(&bar[XB_XGEN(b.x)]) == gen, bar);
            __builtin_amdgcn_fence(__ATOMIC_ACQUIRE, "agent");
            asm volatile("s_waitcnt vmcnt(0)" ::: "memory");
        }
    }
    __syncthreads();
}

struct Args { const float* in[31]; float* out; unsigned char* ws; int ph_lo, ph_hi; };
typedef const float* const __attribute__((address_space(4)))* karg_in_t;
struct Ctx {
    LAS unsigned char* lds;
    karg_in_t in; float* out; unsigned char* ws;
    int tid, lane, wave, G, bid;
};
enum { I_XP = 0, I_XS, I_MEM, I_CCKV, I_CKR, I_CMK, I_CMV, I_SCONV, I_GPRE, I_WIN, I_GQLAT, I_WUQ, I_GKVLAT, I_WUKV, I_GQN, I_GKN, I_CONVW, I_CONVB, I_LNG, I_LNB,
       I_WPW2, I_BPW2, I_GMEM, I_WMEM, I_GXQ, I_GXK, I_WPM, I_WPC, I_WPX, I_BMERGE, I_WOUT };

__device__ __forceinline__ int win_src_col(int nd) {
    if (nd < 1088) return nd;
    if (nd < 1280) return -1;
    if (nd >= 3328 && nd < 5376) { const int t = (nd - 3328) >> 8, w = (nd - 3328) & 255; return w < 128 ? 3136 + t * 128 + w : 4160 + t * 128 + (w - 128); }
    return nd - 192;
}
__device__ __forceinline__ void transpose_item(const float* W, int K, int Nsrc, bf16_t* WT, const float* gain, bool winmap, LAS float* scr, int item, int nblk, int lane) {
    const int kb = item / nblk, nb = item % nblk, k0 = 64 * kb, nd0 = 32 * nb;
    const int ns0 = winmap ? win_src_col(nd0) : nd0;
#pragma unroll 8
    for (int i = 0; i < 32; ++i) { const int kk = 2 * i + (lane >> 5); float v = 0.f;
        if (ns0 >= 0) { v = W[(size_t)(k0 + kk) * Nsrc + ns0 + (lane & 31)]; if (gain) v *= gain[k0 + kk]; }
        scr[kk * 33 + (lane & 31)] = v; }
    LDS_WAIT(); asm volatile("" ::: "memory");
    const int c = lane & 7;
#pragma unroll
    for (int j = 0; j < 4; ++j) { const int n = (lane >> 3) + 8 * j; const LAS float* s = scr + (8 * c) * 33 + n;
        u32x4 o; o.x = cvt_pk_bf16(s[0 * 33], s[1 * 33]); o.y = cvt_pk_bf16(s[2 * 33], s[3 * 33]); o.z = cvt_pk_bf16(s[4 * 33], s[5 * 33]); o.w = cvt_pk_bf16(s[6 * 33], s[7 * 33]);
        *(u32x4*)(WT + (size_t)(nd0 + n) * K + k0 + 8 * c) = o; }
    LDS_WAIT(); asm volatile("" ::: "memory");
}
__device__ __forceinline__ void prep_weights(const Ctx& F, int l, int gw, int NGW) {
    LAS float* scr = (LAS float*)(F.lds + F.wave * 16384);
#pragma unroll 1
    for (int job = 0; job < 9; ++job) {
        const float* W; int K, Nsrc, Ndst; size_t dst; const float* gain = nullptr; bool winmap = false;
        switch (job) {
            case 0: W = F.in[I_WIN] + (size_t)l * 2048 * IN_COLS; K = 2048; Nsrc = IN_COLS; Ndst = IN_PAD; dst = WS_WIN; gain = F.in[I_GPRE] + l * 2048; winmap = true; break;
            case 1: W = F.in[I_WUQ] + (size_t)l * 512 * 3072; K = 512; Nsrc = 3072; Ndst = 3072; dst = WS_WUQ; gain = F.in[I_GQLAT] + l * 512; break;
            case 2: W = F.in[I_WUKV] + (size_t)l * 512 * 4096; K = 512; Nsrc = 4096; Ndst = 4096; dst = WS_WUKV; gain = F.in[I_GKVLAT] + l * 512; break;
            case 3: W = F.in[I_WPW2] + (size_t)l * 1024 * 1024; K = 1024; Nsrc = 1024; Ndst = 1024; dst = WS_WPW2; break;
            case 4: W = F.in[I_WMEM] + (size_t)l * 2048 * 2048; K = 2048; Nsrc = 2048; Ndst = 2048; dst = WS_WMEM; gain = F.in[I_GMEM] + l * 2048; break;
            case 5: W = F.in[I_WPM] + (size_t)l * 2048 * 2048; K = 2048; Nsrc = 2048; Ndst = 2048; dst = WS_WPM; break;
            case 6: W = F.in[I_WPC] + (size_t)l * 1024 * 2048; K = 1024; Nsrc = 2048; Ndst = 2048; dst = WS_WPC; break;
            case 7: W = F.in[I_WPX] + (size_t)l * 1024 * 2048; K = 1024; Nsrc = 2048; Ndst = 2048; dst = WS_WPX; break;
            default: W = F.in[I_WOUT] + (size_t)l * 2048 * 2048; K = 2048; Nsrc = 2048; Ndst = 2048; dst = WS_WOUT; break;
        }
        const int nblk = Ndst / 32, nitems = (K / 64) * nblk;
        bf16_t* WT = (bf16_t*)(F.ws + dst);
        for (int it = gw; it < nitems; it += NGW) transpose_item(W, K, Nsrc, WT, gain, winmap, scr, it, nblk, F.lane);
    }
}
__device__ __forceinline__ void rms_row_2048(const float* xrow, bf16_t* orow, int lane) {
    const f32x4* xr = (const f32x4*)xrow + lane;
    f32x4 v[8]; float s = 0.f;
#pragma unroll
    for (int j = 0; j < 8; ++j) { v[j] = xr[64 * j]; s += (v[j][0] * v[j][0] + v[j][1] * v[j][1]) + (v[j][2] * v[j][2] + v[j][3] * v[j][3]); }
    const float r = 1.0f / sqrtf(wave_sum(s) * (1.f / 2048.f) + EPS);
    u32x2* o8 = (u32x2*)orow + lane;
#pragma unroll
    for (int j = 0; j < 8; ++j) { u32x2 w; w.x = cvt_pk_bf16(v[j][0] * r, v[j][1] * r); w.y = cvt_pk_bf16(v[j][2] * r, v[j][3] * r); o8[64 * j] = w; }
}
__device__ __forceinline__ void rms_row_512(const float* xrow, bf16_t* orow, int lane) {
    const f32x4* xr = (const f32x4*)xrow + lane;
    f32x4 v[2]; float s = 0.f;
#pragma unroll
    for (int j = 0; j < 2; ++j) { v[j] = xr[64 * j]; s += (v[j][0] * v[j][0] + v[j][1] * v[j][1]) + (v[j][2] * v[j][2] + v[j][3] * v[j][3]); }
    const float r = 1.0f / sqrtf(wave_sum(s) * (1.f / 512.f) + EPS);
    u32x2* o8 = (u32x2*)orow + lane;
#pragma unroll
    for (int j = 0; j < 2; ++j) { u32x2 w; w.x = cvt_pk_bf16(v[j][0] * r, v[j][1] * r); w.y = cvt_pk_bf16(v[j][2] * r, v[j][3] * r); o8[64 * j] = w; }
}
__device__ __forceinline__ void kpe_row(const float* kr, const float* gkpe, const float* ropetab, int pos, bf16_t* kpe, float* sspe, int lane) {
    const float x = kr[lane]; const float ss = wave_sum(x * x);
    const float xg = x * gkpe[lane]; const float other = __shfl_xor(xg, 32);
    const f32x2 cs = *(const f32x2*)(ropetab + ((size_t)pos * 32 + (lane & 31)) * 2);
    const float o = lane < 32 ? xg * cs.x - other * cs.y : xg * cs.x + other * cs.y;
    kpe[lane] = (bf16_t)(cvt_pk_bf16(o, 0.f) & 0xffffu);
    if (lane == 0) *sspe = ss;
}
__device__ __forceinline__ const float* x_row(const Ctx& F, int l, int row) {
    if (l == 0) return row < M_P ? F.in[I_XP] + (size_t)row * 2048 : F.in[I_XS] + (size_t)(row - M_P) * 2048;
    return (const float*)(F.ws + WS_X1) + (size_t)row * 2048;
}
__device__ __forceinline__ void phase_prep(const Ctx& F, int l) {
    const int gw = F.bid * 8 + F.wave, NGW = F.G * 8;
    float* ropetab = (float*)(F.ws + WS_ROPE);
    if (l == 0) {
        for (int i = gw * 64 + F.lane; i < 8192 * 32; i += NGW * 64) { const int pos = i >> 5, j = i & 31;
            const float inv = powf(10000.f, -(float)j / 32.f); const float ang = (float)pos * inv;
            const double a = (double)ang; const double n = rint(a * 0.15915494309189535); const float red = (float)(a - n * 6.283185307179586);
            ropetab[2 * i] = cosf(red); ropetab[2 * i + 1] = sinf(red); }
        for (int r = gw; r < N_MEM; r += NGW) rms_row_2048(F.in[I_MEM] + (size_t)r * 2048, (bf16_t*)(F.ws + WS_MEMN) + (size_t)r * 2048, F.lane);
    }
    prep_weights(F, l, gw, NGW);
    for (int r = gw; r < M; r += NGW) rms_row_2048(x_row(F, l, r), (bf16_t*)(F.ws + WS_HB) + (size_t)r * 2048, F.lane);
    const float* cc = F.in[I_CCKV] + (size_t)l * MPAST * 512;
    for (int r = gw; r < MPAST; r += NGW) rms_row_512(cc + (size_t)r * 512, (bf16_t*)(F.ws + WS_CNP) + (size_t)r * 512, F.lane);
}
__device__ __forceinline__ void past_kpe(const Ctx& F, int l) {
    const int gw = F.bid * 8 + F.wave, NGW = F.G * 8;
    const float* ropetab = (const float*)(F.ws + WS_ROPE);
    const float* ck = F.in[I_CKR] + (size_t)l * MPAST * 64; const float* gk = F.in[I_GKN] + l * QK_HEAD + 128;
    for (int r = gw; r < MPAST; r += NGW) kpe_row(ck + (size_t)r * 64, gk, ropetab, r & (PAST - 1), (bf16_t*)(F.ws + WS_KPEP) + (size_t)r * 64, (float*)(F.ws + WS_SSPEP) + r, F.lane);
}

__device__ __forceinline__ void phase_c(const Ctx& F, int l) {
    int tid = F.tid; asm volatile("" : "+v"(tid)); const int gw = F.bid * 8 + F.wave, NGW = F.G * 8, lane = tid & 63;
    {
        const float* cw = F.in[I_CONVW] + (size_t)l * CONV_K * 1024; const float* cb = F.in[I_CONVB] + l * 1024;
        const float* lg = F.in[I_LNG] + l * 1024; const float* lb = F.in[I_LNB] + l * 1024;
        const float* st = F.in[I_SCONV] + (size_t)l * NSTREAM * CONV_ST * 1024;
        const bf16_t* ub = (const bf16_t*)(F.ws + WS_UB); bf16_t* cv = (bf16_t*)(F.ws + WS_CV);
        LAS f32x2* red = (LAS f32x2*)F.lds;
        LAS f32x2* stat = (LAS f32x2*)(F.lds + 2048);
        const int c0 = 2 * tid;
        constexpr int CR = 8, CWIN = CR + CONV_ST;
        for (int ch = F.bid; ch < M / CR; ch += F.G) {
            int seq0, r0, bb = -1;
            if (ch < M_P / CR) { seq0 = 0; r0 = ch * CR; } else { const int q = ch - M_P / CR; bb = q / (DEC_SEQ / CR); seq0 = M_P + bb * 64; r0 = (q % (DEC_SEQ / CR)) * CR; }
            float U0[CWIN], U1[CWIN];
#pragma unroll
            for (int j = 0; j < CWIN; ++j) { const int i = r0 - 30 + j;
                if (i >= 0) { const unsigned w = *(const unsigned*)(ub + (size_t)(seq0 + i) * 1024 + c0); U0[j] = bf_lo(w); U1[j] = bf_hi(w); }
                else if (bb >= 0) { const f32x2 s2 = *(const f32x2*)(st + ((size_t)bb * CONV_ST + (30 + i)) * 1024 + c0); U0[j] = s2.x; U1[j] = s2.y; }
                else { U0[j] = 0.f; U1[j] = 0.f; } }
            float y0[CR], y1[CR]; const f32x2 bia = *(const f32x2*)(cb + c0);
#pragma unroll
            for (int r = 0; r < CR; ++r) { y0[r] = bia.x; y1[r] = bia.y; }
#pragma unroll
            for (int k = 0; k < CONV_K; ++k) { const f32x2 w = *(const f32x2*)(cw + (size_t)k * 1024 + c0);
#pragma unroll
                for (int r = 0; r < CR; ++r) { y0[r] = fmaf(w.x, U0[r + k], y0[r]); y1[r] = fmaf(w.y, U1[r + k], y1[r]); }
                if ((k & 3) == 3) asm volatile("" ::: "memory"); }
#pragma unroll
            for (int r = 0; r < CR; ++r) { const float s1 = wave_sum(y0[r] + y1[r]), s2 = wave_sum(y0[r] * y0[r] + y1[r] * y1[r]); if (lane == 0) red[F.wave * CR + r] = (f32x2){s1, s2}; }
            __syncthreads();
            if (tid < CR) { float s1 = 0.f, s2 = 0.f;
#pragma unroll
                for (int w = 0; w < 8; ++w) { const f32x2 t = red[w * CR + tid]; s1 += t.x; s2 += t.y; }
                const float mean = s1 * (1.f / 1024.f); const float var = fmaxf(s2 * (1.f / 1024.f) - mean * mean, 0.f);
                stat[tid] = (f32x2){mean, 1.0f / sqrtf(var + EPS)}; }
            __syncthreads();
            const f32x2 g2 = *(const f32x2*)(lg + c0), b2 = *(const f32x2*)(lb + c0);
#pragma unroll
            for (int r = 0; r < CR; ++r) { const f32x2 ms = stat[r];
                const float a = siluf_((y0[r] - ms.x) * ms.y * g2.x + b2.x), b = siluf_((y1[r] - ms.x) * ms.y * g2.y + b2.y);
                *(unsigned*)(cv + (size_t)(seq0 + r0 + r) * 1024 + c0) = cvt_pk_bf16(a, b); }
            __syncthreads();
        }
    }
    {
        const float* ropetab = (const float*)(F.ws + WS_ROPE); const float* gk = F.in[I_GKN] + l * QK_HEAD + 128;
        for (int r = gw; r < M; r += NGW) {
            rms_row_512((const float*)(F.ws + WS_QLATF) + (size_t)r * 512, (bf16_t*)(F.ws + WS_QLATN) + (size_t)r * 512, lane);
            const float* ckv = r < M_P ? F.out + O_PCKV + ((size_t)l * M_P + r) * 512 : F.out + O_SCKV + ((size_t)l * M_S + (r - M_P)) * 512;
            rms_row_512(ckv, (bf16_t*)(F.ws + WS_CKVN) + (size_t)r * 512, lane);
            const float* kr = r < M_P ? F.out + O_PKR + ((size_t)l * M_P + r) * 64 : F.out + O_SKR + ((size_t)l * M_S + (r - M_P)) * 64;
            const int pos = r < M_P ? r : PAST + ((r - M_P) & 63);
            kpe_row(kr, gk, ropetab, pos, (bf16_t*)(F.ws + WS_KPEC) + (size_t)r * 64, (float*)(F.ws + WS_SSPEC) + r, lane);
        }
    }
    {
        const float* kvraw = (const float*)(F.ws + WS_KVRAW); const float* gx = F.in[I_GXK] + l * 256;
        for (int it = gw; it < N_MEM * 8; it += NGW) { const int t = it >> 3, hv = it & 7, isv = hv >> 2, h = hv & 3;
            const f32x4 v = *(const f32x4*)(kvraw + (size_t)t * 2048 + isv * 1024 + h * 256 + 4 * lane);
            f32x4 o = v;
            if (!isv) { const float ss = wave_sum((v[0] * v[0] + v[1] * v[1]) + (v[2] * v[2] + v[3] * v[3])); const float r = 1.0f / sqrtf(ss * (1.f / 256.f) + EPS);
                const f32x4 g = *(const f32x4*)(gx + 4 * lane); o = v * r * g; }
            float* op = F.out + (isv ? O_PMV : O_PMK) + (size_t)l * N_MEM * 1024 + (size_t)t * 1024 + h * 256 + 4 * lane;
            *(f32x4*)op = o;
            u32x2 w; w.x = cvt_pk_bf16(o[0], o[1]); w.y = cvt_pk_bf16(o[2], o[3]);
            *(u32x2*)((bf16_t*)(F.ws + (isv ? WS_MVB : WS_MKB)) + (size_t)t * 1024 + h * 256 + 4 * lane) = w;
        }
    }
}
__device__ __forceinline__ void phase_e(const Ctx& F, int l) {
    const int gw = F.bid * 8 + F.wave, NGW = F.G * 8, lane = F.lane;
    const float* ropetab = (const float*)(F.ws + WS_ROPE);
    const float* gq = F.in[I_GQN] + l * QK_HEAD; const float* gk = F.in[I_GKN] + l * QK_HEAD; const float* gxq = F.in[I_GXQ] + l * 256;
    const float gA = gq[lane] * gk[lane] * C_MLA, gB = gq[64 + lane] * gk[64 + lane] * C_MLA, gC = gq[128 + lane] * C_MLA;
    const f32x4 gx4 = *(const f32x4*)(gxq + 4 * lane) * C_X;
    const bf16_t* qraw = (const bf16_t*)(F.ws + WS_QRAW); bf16_t* Q = (bf16_t*)(F.ws + WS_Q); bf16_t* xq = (bf16_t*)(F.ws + WS_XQ);
    for (int r = gw; r < M; r += NGW) {
        const int pos = r < M_P ? r : PAST + ((r - M_P) & 63);
        const f32x2 cs = *(const f32x2*)(ropetab + ((size_t)pos * 32 + (lane & 31)) * 2);
#pragma unroll 4
        for (int h = 0; h < NH; ++h) {
            const bf16_t* src = qraw + (size_t)r * 3072 + h * 192;
            const float a = __uint_as_float((unsigned)src[lane] << 16), b = __uint_as_float((unsigned)src[64 + lane] << 16), c = __uint_as_float((unsigned)src[128 + lane] << 16);
            const float ss = wave_sum(a * a + b * b + c * c); const float rq = 1.0f / sqrtf(ss * (1.f / 192.f) + EPS);
            const float cg = c * rq * gC; const float other = __shfl_xor(cg, 32);
            const float cr = lane < 32 ? cg * cs.x - other * cs.y : cg * cs.x + other * cs.y;
            bf16_t* dst = Q + ((size_t)r * NH + h) * 192;
            dst[lane] = (bf16_t)(cvt_pk_bf16(a * rq * gA, 0.f) & 0xffffu); dst[64 + lane] = (bf16_t)(cvt_pk_bf16(b * rq * gB, 0.f) & 0xffffu); dst[128 + lane] = (bf16_t)(cvt_pk_bf16(cr, 0.f) & 0xffffu);
        }
#pragma unroll
        for (int h = 0; h < 4; ++h) {
            u32x2* p = (u32x2*)(xq + (size_t)r * 1024 + h * 256) + lane; const u32x2 w = *p;
            const f32x4 v = (f32x4){bf_lo(w.x), bf_hi(w.x), bf_lo(w.y), bf_hi(w.y)};
            const float ss = wave_sum((v[0] * v[0] + v[1] * v[1]) + (v[2] * v[2] + v[3] * v[3])); const float rr = 1.0f / sqrtf(ss * (1.f / 256.f) + EPS);
            const f32x4 o = v * rr * gx4; u32x2 ow; ow.x = cvt_pk_bf16(o[0], o[1]); ow.y = cvt_pk_bf16(o[2], o[3]); *p = ow;
        }
    }
}

constexpr int AP_KN = 0, AP_KPE = 16384, AP_V = 24576, AP_RK = 40960, AP_AL = 41216;
constexpr int AS_KN = 0, AS_KPE = 32768, AS_V = 36864, AS_RK = 69632, AS_AL = 70144;
constexpr int AX_K = 0, AX_V = 32768, AX_AL = 49152;

__device__ __forceinline__ void mla_prompt_unit(const Ctx& F, int h, int qb) {
    int tid = F.tid; asm volatile("" : "+v"(tid)); const int wid = F.wave, lane = tid & 63, r32 = lane & 31, hi = lane >> 5;
    const bf16_t* Q = (const bf16_t*)(F.ws + WS_Q); const bf16_t* KC = (const bf16_t*)(F.ws + WS_KC) + (size_t)h * M * 128; const bf16_t* VC = (const bf16_t*)(F.ws + WS_VC) + (size_t)h * M * 128;
    const float* SSC = (const float*)(F.ws + WS_SSC) + (size_t)h * M * 4; const bf16_t* KPE = (const bf16_t*)(F.ws + WS_KPEC); const float* SSPE = (const float*)(F.ws + WS_SSPEC);
    const int row0 = qb * 256 + wid * 32;
    bf16x8 qr[12];
    { const bf16_t* qp = Q + ((size_t)(row0 + r32) * NH + h) * 192 + hi * 8;
#pragma unroll
      for (int d0 = 0; d0 < 12; ++d0) qr[d0] = *(const bf16x8*)(qp + d0 * 16); }
    f32x16 o[4];
#pragma unroll
    for (int d = 0; d < 4; ++d)
#pragma unroll
        for (int r = 0; r < 16; ++r) o[d][r] = 0.f;
    float m_reg = -1e30f, l_reg = 0.f;
    const int nt_all = 4 * qb + 4, nt_w = 4 * qb + (wid >> 1) + 1;
    const int sr = tid >> 4, sc = tid & 15, pr = tid >> 3, pc = tid & 7;
    LAS char* L = (LAS char*)F.lds; LAS float* al_l = (LAS float*)(L + AP_AL) + wid * 32;
    const int vb = (int)(uintptr_t)(L + AP_V) + att::v_rd_base(lane);
    bf16x8 sk[2], sv[2], sp; f32x4 ss4 = {0.f, 0.f, 0.f, 0.f}; float sspe = 0.f;
#define MP_LOAD(t) do { const int k0 = (t) * 64; \
        _Pragma("unroll") for (int i = 0; i < 2; ++i) { sk[i] = *(const bf16x8*)(KC + (size_t)(k0 + sr + 32 * i) * 128 + sc * 8); sv[i] = *(const bf16x8*)(VC + (size_t)(k0 + sr + 32 * i) * 128 + sc * 8); } \
        sp = *(const bf16x8*)(KPE + (size_t)(k0 + pr) * 64 + pc * 8); \
        if (tid < 64) { ss4 = *(const f32x4*)(SSC + (size_t)(k0 + tid) * 4); sspe = SSPE[k0 + tid]; } } while (0)
#define MP_WRITE() do { \
        _Pragma("unroll") for (int i = 0; i < 2; ++i) { *(LAS bf16x8*)(L + AP_KN + att::kswz<256>(sr + 32 * i, sc * 16)) = sk[i]; *(LAS bf16x8*)(L + AP_V + att::v_st<4>(sr + 32 * i, sc * 8)) = sv[i]; } \
        *(LAS bf16x8*)(L + AP_KPE + att::kswz<128>(pr, pc * 16)) = sp; \
        if (tid < 64) ((LAS float*)(L + AP_RK))[tid] = 1.0f / sqrtf(((ss4[0] + ss4[1]) + (ss4[2] + ss4[3]) + sspe) * (1.f / 192.f) + EPS); } while (0)
    MP_LOAD(0);
    for (int t = 0; t < nt_all; ++t) {
        __syncthreads();
        MP_WRITE();
        __syncthreads();
        if (t + 1 < nt_all) MP_LOAD(t + 1);
        if (t < nt_w) {
            att::tile_step<8, 4, 4, 1, true, 256>(qr, o, m_reg, l_reg, L + AP_KN, L + AP_KPE, vb, (const LAS float*)(L + AP_RK), al_l, r32, hi);
            att::tile_step<8, 4, 4, 1, true, 256>(qr, o, m_reg, l_reg, L + AP_KN + 8192, L + AP_KPE + 4096, vb + 8192, (const LAS float*)(L + AP_RK) + 32, al_l, r32, hi);
        }
    }
#undef MP_LOAD
#undef MP_WRITE
    att::finish<4>(o, l_reg, al_l, (bf16_t*)(F.ws + WS_AMLA) + (size_t)row0 * 2048 + h * 128, (const bf16_t*)(F.ws + WS_ZM) + (size_t)row0 * 2048 + h * 128, 2048, r32, hi);
}
__device__ __forceinline__ void mla_sample_unit(const Ctx& F, int b, int hg) {
    int tid = F.tid; asm volatile("" : "+v"(tid)); const int wid = F.wave, lane = tid & 63, r32 = lane & 31, hi = lane >> 5;
    const int g = wid >> 1, rg = wid & 1, h = hg * 4 + g;
    const bf16_t* Q = (const bf16_t*)(F.ws + WS_Q);
    const bf16_t* KP = (const bf16_t*)(F.ws + WS_KP); const bf16_t* VP = (const bf16_t*)(F.ws + WS_VP); const float* SSP = (const float*)(F.ws + WS_SSP);
    const bf16_t* KC = (const bf16_t*)(F.ws + WS_KC); const bf16_t* VC = (const bf16_t*)(F.ws + WS_VC); const float* SSC = (const float*)(F.ws + WS_SSC);
    const bf16_t* KPEP = (const bf16_t*)(F.ws + WS_KPEP); const float* SSPEP = (const float*)(F.ws + WS_SSPEP);
    const bf16_t* KPEC = (const bf16_t*)(F.ws + WS_KPEC); const float* SSPEC = (const float*)(F.ws + WS_SSPEC);
    const int row0 = M_P + b * 64 + rg * 32;
    bf16x8 qr[12];
    { const bf16_t* qp = Q + ((size_t)(row0 + r32) * NH + h) * 192 + hi * 8;
#pragma unroll
      for (int d0 = 0; d0 < 12; ++d0) qr[d0] = *(const bf16x8*)(qp + d0 * 16); }
    f32x16 o[4];
#pragma unroll
    for (int d = 0; d < 4; ++d)
#pragma unroll
        for (int r = 0; r < 16; ++r) o[d][r] = 0.f;
    float m_reg = -1e30f, l_reg = 0.f;
    const int sr = tid >> 4, sc = tid & 15, pr = tid >> 3, pc = tid & 7, rkg = tid >> 5, rkk = tid & 31;
    LAS char* L = (LAS char*)F.lds; LAS float* al_l = (LAS float*)(L + AS_AL) + wid * 32;
    const int vb = (int)(uintptr_t)(L + AS_V + g * 8192) + att::v_rd_base(lane);
    bf16x8 sk[4], sv[4], sp = {}; f32x4 ss4 = {0.f, 0.f, 0.f, 0.f}; float sspe = 0.f;
    constexpr int NT = 130;
#define MS_LOAD(t) do { const bool past = (t) < 128; const int kk0 = past ? (t) * 32 : M_P + b * 64 + ((t) - 128) * 32; \
        _Pragma("unroll") for (int i = 0; i < 4; ++i) { const int hh = hg * 4 + i; \
            const size_t R = past ? ((size_t)(b * 16 + hh) * 4096 + kk0 + sr) : ((size_t)hh * M + kk0 + sr); \
            sk[i] = *(const bf16x8*)((past ? KP : KC) + R * 128 + sc * 8); sv[i] = *(const bf16x8*)((past ? VP : VC) + R * 128 + sc * 8); } \
        if (tid < 256) sp = *(const bf16x8*)((past ? KPEP + ((size_t)b * 4096 + kk0 + pr) * 64 : KPEC + (size_t)(kk0 + pr) * 64) + pc * 8); \
        if (tid < 128) { const int hh = hg * 4 + rkg; const size_t R = past ? ((size_t)(b * 16 + hh) * 4096 + kk0 + rkk) : ((size_t)hh * M + kk0 + rkk); \
            ss4 = *(const f32x4*)((past ? SSP : SSC) + R * 4); sspe = past ? SSPEP[(size_t)b * 4096 + kk0 + rkk] : SSPEC[kk0 + rkk]; } } while (0)
#define MS_WRITE() do { \
        _Pragma("unroll") for (int i = 0; i < 4; ++i) { *(LAS bf16x8*)(L + AS_KN + i * 8192 + att::kswz<256>(sr, sc * 16)) = sk[i]; *(LAS bf16x8*)(L + AS_V + i * 8192 + att::v_st<4>(sr, sc * 8)) = sv[i]; } \
        if (tid < 256) *(LAS bf16x8*)(L + AS_KPE + att::kswz<128>(pr, pc * 16)) = sp; \
        if (tid < 128) ((LAS float*)(L + AS_RK))[tid] = 1.0f / sqrtf(((ss4[0] + ss4[1]) + (ss4[2] + ss4[3]) + sspe) * (1.f / 192.f) + EPS); } while (0)
    MS_LOAD(0);
    for (int t = 0; t < NT; ++t) {
        __syncthreads();
        MS_WRITE();
        __syncthreads();
        if (t + 1 < NT) MS_LOAD(t + 1);
        att::tile_step<8, 4, 4, 1, true, 256>(qr, o, m_reg, l_reg, L + AS_KN + g * 8192, L + AS_KPE, vb, (const LAS float*)(L + AS_RK) + g * 32, al_l, r32, hi);
    }
#undef MS_LOAD
#undef MS_WRITE
    att::finish<4>(o, l_reg, al_l, (bf16_t*)(F.ws + WS_AMLA) + (size_t)row0 * 2048 + h * 128, (const bf16_t*)(F.ws + WS_ZM) + (size_t)row0 * 2048 + h * 128, 2048, r32, hi);
}
template <bool SAMPLE>
__device__ __forceinline__ void cross_unit(const Ctx& F, int l, int x, int h, int dvh) {
    int tid = F.tid; asm volatile("" : "+v"(tid)); const int wid = F.wave, lane = tid & 63, r32 = lane & 31, hi = lane >> 5;
    const bool active = !SAMPLE || wid < 2;
    const int row0 = SAMPLE ? M_P + x * 64 + (wid & 1) * 32 : x * 256 + wid * 32;
    const bf16_t* XQ = (const bf16_t*)(F.ws + WS_XQ);
    bf16x8 qr[16];
    { const bf16_t* qp = XQ + (size_t)(row0 + r32) * 1024 + h * 256 + hi * 8;
#pragma unroll
      for (int d0 = 0; d0 < 16; ++d0) qr[d0] = *(const bf16x8*)(qp + d0 * 16); }
    f32x16 o[4];
#pragma unroll
    for (int d = 0; d < 4; ++d)
#pragma unroll
        for (int r = 0; r < 16; ++r) o[d][r] = 0.f;
    float m_reg = -1e30f, l_reg = 0.f;
    LAS char* L = (LAS char*)F.lds; LAS float* al_l = (LAS float*)(L + AX_AL) + wid * 32;
    const int vb = (int)(uintptr_t)(L + AX_V) + att::v_rd_base(lane);
    const float* kf = F.in[I_CMK] + ((size_t)l * NSTREAM + x) * N_MEM * 1024; const float* vf = F.in[I_CMV] + ((size_t)l * NSTREAM + x) * N_MEM * 1024;
    const bf16_t* kb = (const bf16_t*)(F.ws + WS_MKB); const bf16_t* vbf = (const bf16_t*)(F.ws + WS_MVB);
    for (int t = 0; t < 4; ++t) {
        __syncthreads();
#pragma unroll
        for (int i = 0; i < 4; ++i) { const int p = tid + 512 * i, row = p >> 5, c8 = p & 31; const size_t off = (size_t)(t * 64 + row) * 1024 + h * 256 + c8 * 8;
            u32x4 w;
            if (SAMPLE) { const f32x4 a = *(const f32x4*)(kf + off), b2 = *(const f32x4*)(kf + off + 4); w = pack8(a, b2); } else w = *(const u32x4*)(kb + off);
            *(LAS u32x4*)(L + AX_K + att::kswz<512>(row, c8 * 16)) = w; }
#pragma unroll
        for (int i = 0; i < 2; ++i) { const int row = (tid >> 4) + 32 * i, c8 = tid & 15; const size_t off = (size_t)(t * 64 + row) * 1024 + h * 256 + dvh * 128 + c8 * 8;
            u32x4 w;
            if (SAMPLE) { const f32x4 a = *(const f32x4*)(vf + off), b2 = *(const f32x4*)(vf + off + 4); w = pack8(a, b2); } else w = *(const u32x4*)(vbf + off);
            *(LAS u32x4*)(L + AX_V + att::v_st<4>(row, c8 * 8)) = w; }
        __syncthreads();
        if (active) att::tile_step<16, 0, 4, 2, false, 512>(qr, o, m_reg, l_reg, L + AX_K, L + AX_K, vb, (const LAS float*)nullptr, al_l, r32, hi);
    }
    if (active) att::finish<4>(o, l_reg, al_l, (bf16_t*)(F.ws + WS_AX) + (size_t)row0 * 1024 + h * 256 + dvh * 128, (const bf16_t*)(F.ws + WS_ZX) + (size_t)row0 * 1024 + h * 256 + dvh * 128, 1024, r32, hi);
}
__device__ __forceinline__ void phase_attention(const Ctx& F, int l) {
    unsigned* head = (unsigned*)(F.ws + WS_CTL) + CW_QHEAD + 64 * l;
    volatile LAS unsigned* slot = (volatile LAS unsigned*)(F.lds + MISC_OFF);
    for (;;) {
        if (F.tid == 0) slot[0] = __hip_atomic_fetch_add(head, 1u, __ATOMIC_RELAXED, __HIP_MEMORY_SCOPE_AGENT);
        __syncthreads();
        const int u = (int)slot[0];
        __syncthreads();
        if (u >= 1152) break;
#ifndef ATT_ONLY
#define ATT_ONLY -1
#endif
#define ATT_ON(k) (ATT_ONLY < 0 || ATT_ONLY == (k))
        if (u < 128) {
#if ATT_ON(0)
            mla_sample_unit(F, u >> 2, u & 3);
#endif
        } else if (u < 640) {
#if ATT_ON(1)
            const int v = u - 128; mla_prompt_unit(F, v & 15, 31 - (v >> 4));
#endif
        } else if (u < 896) {
#if ATT_ON(2)
            const int v = u - 640; cross_unit<false>(F, l, v >> 3, (v >> 1) & 3, v & 1);
#endif
        } else {
#if ATT_ON(3)
            const int v = u - 896; cross_unit<true>(F, l, v >> 3, (v >> 1) & 3, v & 1);
#endif
        }
    }
}

__global__ void __launch_bounds__(512, 2) trunk_fwd(Args args) {
    extern __shared__ __attribute__((aligned(16))) unsigned char lds_raw[];
    for (int u = threadIdx.x; u < (LDS_BYTES - RING_BYTES) / 4; u += 512) ((LAS unsigned*)((LAS unsigned char*)lds_raw + RING_BYTES))[u] = 0u;
    __syncthreads();
    XcdBarrier bar;
    { const __attribute__((address_space(4))) char* kp0 = (const __attribute__((address_space(4))) char*)__builtin_amdgcn_kernarg_segment_ptr();
      unsigned char* ws0 = *(unsigned char* const __attribute__((address_space(4)))*)(kp0 + 256);
      bar = xcd_barrier_post((unsigned*)(ws0 + WS_CTL) + CW_BAR, (volatile LAS unsigned*)((LAS unsigned char*)lds_raw + MISC_OFF) + 8); }
    const int lo = args.ph_lo, hi = args.ph_hi;
    int ph = 0;
#define PH_BEGIN if (ph >= lo && ph < hi) { Ctx F; { const __attribute__((address_space(4))) char* kp = (const __attribute__((address_space(4))) char*)__builtin_amdgcn_kernarg_segment_ptr(); asm volatile("" : "+s"(kp)); \
        F.in = (karg_in_t)kp; F.out = *(float* const __attribute__((address_space(4)))*)(kp + 248); F.ws = *(unsigned char* const __attribute__((address_space(4)))*)(kp + 256); \
        F.lds = (LAS unsigned char*)lds_raw; int tz = threadIdx.x; asm volatile("" : "+v"(tz)); F.tid = tz; F.lane = tz & 63; F.wave = __builtin_amdgcn_readfirstlane(tz >> 6); F.G = gridDim.x; F.bid = blockIdx.x; } const int G = F.G; (void)G;
#define PH_END   if (ph + 1 < hi) xcd_barrier(bar); } ++ph;
#define rot(off) ((int)((F.bid + G - ((off) % G)) % G))

    for (int l = 0; l < DEPTH; ++l) {
        PH_BEGIN
#if PH_ON(0)
            phase_prep(F, l);
#endif
        PH_END
        PH_BEGIN
#if PH_ON(1)
            {
                pg8::Gemm g{(const bf16_t*)(F.ws + WS_HB), (const bf16_t*)(F.ws + WS_WIN), 2048, 2048, 2048};
                pg8::StaticOrder S; S.init(M, IN_PAD, G, rot(0));
                EpiWin E{F.ws, F.out, F.in[I_BMERGE] + (size_t)l * 6144, l};
                pg8::gemm_phase(F.lds, g, S, E);
            }
            {
                pg8::Gemm g{(const bf16_t*)(F.ws + WS_MEMN), (const bf16_t*)(F.ws + WS_WMEM), 2048, 2048, 2048};
                pg8::StaticOrder S; S.init(N_MEM, 2048, G, rot(232));
                EpiF32 E{(float*)(F.ws + WS_KVRAW), 2048};
                pg8::gemm_phase(F.lds, g, S, E);
            }
            {
                pg8::Gemm g{(const bf16_t*)(F.ws + WS_CNP), (const bf16_t*)(F.ws + WS_WUKV), 512, 512, 512};
                pg8::StaticOrder S; S.init(MPAST, 4096, G, rot(240));
                EpiKV<true> E{(bf16_t*)(F.ws + WS_KP), (bf16_t*)(F.ws + WS_VP), (float*)(F.ws + WS_SSP)};
                pg8::gemm_phase(F.lds, g, S, E);
            }
            past_kpe(F, l);
#endif
        PH_END
        PH_BEGIN
#if PH_ON(2)
            phase_c(F, l);
#endif
        PH_END
        PH_BEGIN
#if PH_ON(3)
            {
                pg8::Gemm g{(const bf16_t*)(F.ws + WS_QLATN), (const bf16_t*)(F.ws + WS_WUQ), 512, 512, 512};
                pg8::StaticOrder S; S.init(M, 3072, G, rot(0));
                EpiBf16 E{(bf16_t*)(F.ws + WS_QRAW), 3072};
                pg8::gemm_phase(F.lds, g, S, E);
            }
            {
                pg8::Gemm g{(const bf16_t*)(F.ws + WS_CKVN), (const bf16_t*)(F.ws + WS_WUKV), 512, 512, 512};
                pg8::StaticOrder S; S.init(M, 4096, G, rot(224));
                EpiKV<false> E{(bf16_t*)(F.ws + WS_KC), (bf16_t*)(F.ws + WS_VC), (float*)(F.ws + WS_SSC)};
                pg8::gemm_phase(F.lds, g, S, E);
            }
            {
                pg8::Gemm g{(const bf16_t*)(F.ws + WS_CV), (const bf16_t*)(F.ws + WS_WPW2), 1024, 1024, 1024};
                pg8::StaticOrder S; S.init(M, 1024, G, rot(96));
                EpiPw2 E{(bf16_t*)(F.ws + WS_ACONV), (const bf16_t*)(F.ws + WS_ZC), F.in[I_BPW2] + (size_t)l * 1024};
                pg8::gemm_phase(F.lds, g, S, E);
            }
#endif
        PH_END
        PH_BEGIN
#if PH_ON(4)
            phase_e(F, l);
#endif
        PH_END
        PH_BEGIN
#if PH_ON(5)
            phase_attention(F, l);
#endif
        PH_END
        PH_BEGIN
#if PH_ON(6)
            {
                pg8::Gemm g{(const bf16_t*)(F.ws + WS_AMLA), (const bf16_t*)(F.ws + WS_WPM), 2048, 2048, 2048};
                pg8::StaticOrder S; S.init(M, 2048, G, rot(0));
                EpiGate E{(bf16_t*)(F.ws + WS_PB), (const bf16_t*)(F.ws + WS_GATES), 0};
                pg8::gemm_phase(F.lds, g, S, E);
            }
            {
                pg8::Gemm g{(const bf16_t*)(F.ws + WS_ACONV), (const bf16_t*)(F.ws + WS_WPC), 1024, 1024, 1024};
                pg8::StaticOrder S; S.init(M, 2048, G, rot(64));
                EpiGate E{(bf16_t*)(F.ws + WS_PB) + (size_t)M * 2048, (const bf16_t*)(F.ws + WS_GATES), 2048};
                pg8::gemm_phase(F.lds, g, S, E);
            }
            {
                pg8::Gemm g{(const bf16_t*)(F.ws + WS_AX), (const bf16_t*)(F.ws + WS_WPX), 1024, 1024, 1024};
                pg8::StaticOrder S; S.init(M, 2048, G, rot(128));
                EpiGate E{(bf16_t*)(F.ws + WS_PB) + 2 * (size_t)M * 2048, (const bf16_t*)(F.ws + WS_GATES), 4096};
                pg8::gemm_phase(F.lds, g, S, E);
            }
#endif
        PH_END
        PH_BEGIN
#if PH_ON(8)
            {
                const u32x4* p0 = (const u32x4*)(F.ws + WS_PB); const u32x4* p1 = p0 + (size_t)M * 256; const u32x4* p2 = p1 + (size_t)M * 256; u32x4* mo = (u32x4*)(F.ws + WS_MERGED);
                for (size_t i = (size_t)F.bid * 512 + F.tid; i < (size_t)M * 256; i += (size_t)G * 512) {
                    f32x4 a0, a1, b0, b1, c0, c1; unpack8(p0[i], a0, a1); unpack8(p1[i], b0, b1); unpack8(p2[i], c0, c1);
                    mo[i] = pack8(a0 + b0 + c0, a1 + b1 + c1);
                }
            }
#endif
        PH_END
        PH_BEGIN
#if PH_ON(7)
            {
                pg8::Gemm g{(const bf16_t*)(F.ws + WS_MERGED), (const bf16_t*)(F.ws + WS_WOUT), 2048, 2048, 2048};
                pg8::StaticOrder S; S.init(M, 2048, G, rot(64));
                const float* sp = l == 0 ? F.in[I_XP] : (const float*)(F.ws + WS_X1); const float* ss = l == 0 ? F.in[I_XS] : (const float*)(F.ws + WS_X1) + (size_t)M_P * 2048;
                float* dp = l == DEPTH - 1 ? F.out + O_YP : (float*)(F.ws + WS_X1); float* ds = l == DEPTH - 1 ? F.out + O_YS : (float*)(F.ws + WS_X1) + (size_t)M_P * 2048;
                EpiOut E{sp, ss, dp, ds};
                pg8::gemm_phase(F.lds, g, S, E);
            }
#endif
        PH_END
    }

#ifdef DBG_DUMP
    {
        const __attribute__((address_space(4))) char* kp = (const __attribute__((address_space(4))) char*)__builtin_amdgcn_kernarg_segment_ptr();
        float* outp = *(float* const __attribute__((address_space(4)))*)(kp + 248); unsigned char* wsp = *(unsigned char* const __attribute__((address_space(4)))*)(kp + 256);
        unsigned* bins = (unsigned*)wsp + 65536;
        if (hi == 1000 || (MK_N_LAUNCHES == 1 && hi == NPH_RUN)) {
            if (hi != 1000) xcd_barrier(bar);
            const size_t lo_b = DBG_LO, hi_b = DBG_HI;
            for (size_t i = (size_t)blockIdx.x * 512 + threadIdx.x; i < O_END; i += (size_t)gridDim.x * 512) outp[i] = 0.f;
            const int gwv = blockIdx.x * 8 + (threadIdx.x >> 6), lanev = threadIdx.x & 63;
            const size_t nchunk = (hi_b - lo_b) >> 10;
            for (size_t c = gwv; c < nchunk; c += (size_t)gridDim.x * 8) {
                const u32x4 w = *(const u32x4*)(wsp + lo_b + (c << 10) + lanev * 16);
                unsigned s = (w.x * 0x9E3779B1u) ^ (w.y * 0x85EBCA77u) ^ (w.z * 0xC2B2AE3Du) ^ (w.w * 0x27D4EB2Fu); s *= (2u * lanev + 1u) * 0x165667B1u; s ^= s >> 15;
#pragma unroll
                for (int o = 1; o < 64; o <<= 1) s += __shfl_xor(s, o);
                if (lanev == 0) __hip_atomic_fetch_xor(bins + (c & 1023), s * 0x9E3779B1u, __ATOMIC_RELAXED, __HIP_MEMORY_SCOPE_AGENT);
            }
            if (hi != 1000) xcd_barrier(bar);
        }
        if (hi == 1001 || (MK_N_LAUNCHES == 1 && hi == NPH_RUN)) {
            if (blockIdx.x == 0) for (int i = threadIdx.x; i < 1024; i += 512) outp[i] = (float)(__hip_atomic_load(bins + i, __ATOMIC_RELAXED, __HIP_MEMORY_SCOPE_AGENT) & 0xffffffu) + 1.0f;
        }
    }
#endif
#undef PH_BEGIN
#undef PH_END
#undef rot
}

extern "C" void kernel_launch(void* const* d_in, const int* in_sizes, int n_in, void* d_out, int out_size, void* d_ws, size_t ws_size, hipStream_t stream) {
    static int grid = 0;
    if (grid == 0) {
        if (n_in != 31 || (size_t)out_size != O_END || ws_size < WS_END) {
            fprintf(stderr, "kernel_launch: built for 31 inputs, %zu outputs, >= %zu bytes of workspace; got n_in %d, out %d, ws %zu; nothing launched\n", (size_t)O_END, (size_t)WS_END, n_in, out_size, ws_size);
            grid = -1; return; }
        int dev = 0, cus = 0, per_cu = 0;
        if (hipGetDevice(&dev) != hipSuccess || hipDeviceGetAttribute(&cus, hipDeviceAttributeMultiprocessorCount, dev) != hipSuccess) { fprintf(stderr, "kernel_launch: device query failed\n"); grid = -1; return; }
        if (hipFuncSetAttribute((const void*)trunk_fwd, hipFuncAttributeMaxDynamicSharedMemorySize, LDS_BYTES) != hipSuccess) { fprintf(stderr, "kernel_launch: hipFuncSetAttribute failed\n"); grid = -1; return; }
        if (hipOccupancyMaxActiveBlocksPerMultiprocessor(&per_cu, (const void*)trunk_fwd, 512, LDS_BYTES) != hipSuccess || per_cu < 1)
            fprintf(stderr, "kernel_launch: note: occupancy query reports %d workgroups per CU\n", per_cu);
        (void)hipGetLastError();
        grid = cus;
    }
    if (grid < 0) return;
    if (hipMemsetAsync((char*)d_ws + WS_CTL, 0, CTL_BYTES, stream) != hipSuccess) { fprintf(stderr, "kernel_launch: memset failed\n"); return; }
    Args a{};
    for (int i = 0; i < 31; ++i) a.in[i] = (const float*)d_in[i];
    a.out = (float*)d_out; a.ws = (unsigned char*)d_ws;
    constexpr int NPH = NPH_RUN;
    if (MK_N_LAUNCHES == 1) {
        a.ph_lo = 0; a.ph_hi = NPH;
        hipLaunchKernelGGL(trunk_fwd, dim3(grid), dim3(512), LDS_BYTES, stream, a);
    } else {
        for (int p = 0; p < NPH; ++p) { a.ph_lo = p; a.ph_hi = p + 1; hipLaunchKernelGGL(trunk_fwd, dim3(grid), dim3(512), LDS_BYTES, stream, a); }
#ifdef DBG_DUMP
        a.ph_lo = 1000; a.ph_hi = 1000; hipLaunchKernelGGL(trunk_fwd, dim3(grid), dim3(512), LDS_BYTES, stream, a);
        a.ph_lo = 1001; a.ph_hi = 1001; hipLaunchKernelGGL(trunk_fwd, dim3(grid), dim3(512), LDS_BYTES, stream, a);
#endif
    }
    const hipError_t le = hipPeekAtLastError();
    if (le != hipSuccess) fprintf(stderr, "kernel_launch: launch failed: %s\n", hipGetErrorName(le));
}
```

```cpp
#include <hip/hip_runtime.h>
#include <cstdio>
#include <cstdint>

#define LAS __attribute__((address_space(3)))
#define GAS __attribute__((address_space(1)))
typedef unsigned short bf16_t;
typedef short bf16x8 __attribute__((ext_vector_type(8)));
typedef short s16x4 __attribute__((ext_vector_type(4)));
typedef float f32x2 __attribute__((ext_vector_type(2)));
typedef float f32x4 __attribute__((ext_vector_type(4)));
typedef float f32x16 __attribute__((ext_vector_type(16)));
typedef unsigned u32x2 __attribute__((ext_vector_type(2)));
typedef unsigned u32x4 __attribute__((ext_vector_type(4)));
typedef GAS unsigned gu32;

#ifndef PH_ONLY
#define PH_ONLY -1
#endif
#define PH_ON(k) (PH_ONLY < 0 || PH_ONLY == (k))
#ifndef REPEAT_MASK
#define REPEAT_MASK 0
#endif
#define REP(k) for (int rep_ = 0; rep_ < (((REPEAT_MASK) >> (k)) & 1) + 1; ++rep_)
#ifndef NPH_RUN
#define NPH_RUN 18
#endif
#ifndef MK_N_LAUNCHES
#define MK_N_LAUNCHES 1
#endif

constexpr int D_MODEL = 2048, M_P = 8192, M_S = 2048, M = M_P + M_S, DEPTH = 2, NSTREAM = 32, DEC_SEQ = 64, PAST = 4096;
constexpr int NH = 16, QK_HEAD = 192, Q_LORA = 512, KV_LORA = 512;
constexpr int CONV_W = 1024, CONV_K = 31, CONV_ST = 30, N_MEM = 256, XW = 1024;
constexpr int IN_COLS = 14400, IN_PAD = 14592;
constexpr int MPAST = NSTREAM * PAST;
constexpr float EPS = 1e-6f;
constexpr float LOG2E = 1.4426950408889634f;
constexpr float C_MLA = 0.07216878364870323f * LOG2E;
constexpr float C_X = 0.0625f * LOG2E;

constexpr size_t O_YP = 0, O_YS = 16777216, O_PCKV = 20971520, O_PKR = 29360128, O_PMK = 30408704, O_PMV = 30932992,
                 O_PCONV = 31457280, O_SCKV = 31518720, O_SKR = 33615872, O_SCONV = 33878016, O_END = 35844096;

constexpr size_t al256(size_t x) { return (x + 255) / 256 * 256; }
constexpr size_t WS_CTL = 0, CTL_BYTES = 1u << 20;
constexpr size_t WS_WIN = WS_CTL + CTL_BYTES;
constexpr size_t WS_WUQ = WS_WIN + (size_t)IN_PAD * 2048 * 2;
constexpr size_t WS_WUKV = WS_WUQ + (size_t)3072 * 512 * 2;
constexpr size_t WS_WPW2 = WS_WUKV + (size_t)4096 * 512 * 2;
constexpr size_t WS_WMEM = WS_WPW2 + (size_t)1024 * 1024 * 2;
constexpr size_t WS_WPM = WS_WMEM + (size_t)2048 * 2048 * 2;
constexpr size_t WS_WPC = WS_WPM + (size_t)2048 * 2048 * 2;
constexpr size_t WS_WPX = WS_WPC + (size_t)2048 * 1024 * 2;
constexpr size_t WS_WOUT = WS_WPX + (size_t)2048 * 1024 * 2;
constexpr size_t WS_ROPE = WS_WOUT + (size_t)2048 * 2048 * 2;
constexpr size_t WS_CNP = WS_ROPE + (size_t)8192 * 64 * 4;
constexpr size_t WS_KPEP = WS_CNP + (size_t)MPAST * 512 * 2;
constexpr size_t WS_SSPEP = WS_KPEP + (size_t)MPAST * 64 * 2;
constexpr size_t WS_KP = WS_SSPEP + (size_t)MPAST * 4;
constexpr size_t WS_VP = WS_KP + (size_t)MPAST * 2048 * 2;
constexpr size_t WS_SSP = WS_VP + (size_t)MPAST * 2048 * 2;
constexpr size_t WS_HB = WS_SSP + (size_t)MPAST * 16 * 4 * 4;
constexpr size_t WS_QRAW = WS_HB;
constexpr size_t WS_QLATF = WS_HB + (size_t)M * 3072 * 2;
constexpr size_t WS_QLATN = WS_QLATF + (size_t)M * 512 * 4;
constexpr size_t WS_CKVN = WS_QLATN + (size_t)M * 512 * 2;
constexpr size_t WS_ZM = WS_CKVN + (size_t)M * 512 * 2;
constexpr size_t WS_UB = WS_ZM + (size_t)M * 2048 * 2;
constexpr size_t WS_ZC = WS_UB + (size_t)M * 1024 * 2;
constexpr size_t WS_XQ = WS_ZC + (size_t)M * 1024 * 2;
constexpr size_t WS_ZX = WS_XQ + (size_t)M * 1024 * 2;
constexpr size_t WS_GATES = WS_ZX + (size_t)M * 1024 * 2;
constexpr size_t WS_CV = WS_GATES + (size_t)M * 6144 * 2;
constexpr size_t WS_Q = WS_CV + (size_t)M * 1024 * 2;
constexpr size_t WS_KC = WS_Q + (size_t)M * 3072 * 2;
constexpr size_t WS_VC = WS_KC + (size_t)M * 2048 * 2;
constexpr size_t WS_SSC = WS_VC + (size_t)M * 2048 * 2;
constexpr size_t WS_KPEC = WS_SSC + (size_t)M * 16 * 4 * 4;
constexpr size_t WS_SSPEC = WS_KPEC + (size_t)M * 64 * 2;
constexpr size_t WS_AMLA = al256(WS_SSPEC + (size_t)M * 4);
constexpr size_t WS_ACONV = WS_AMLA + (size_t)M * 2048 * 2;
constexpr size_t WS_AX = WS_ACONV + (size_t)M * 1024 * 2;
constexpr size_t WS_X1 = WS_AX + (size_t)M * 1024 * 2;
constexpr size_t WS_MEMN = WS_X1 + (size_t)M * 2048 * 4;
constexpr size_t WS_KVRAW = WS_MEMN + (size_t)256 * 2048 * 2;
constexpr size_t WS_MKB = WS_KVRAW + (size_t)256 * 2048 * 4;
constexpr size_t WS_MVB = WS_MKB + (size_t)256 * 1024 * 2;
constexpr size_t WS_RKC = WS_MVB + (size_t)256 * 1024 * 2;
constexpr size_t WS_RKP = WS_RKC + (size_t)16 * M * 4;
constexpr size_t WS_XQN = WS_RKP + (size_t)MPAST * 16 * 4;
constexpr size_t WS_WUK = WS_XQN + (size_t)M * 1024 * 2;
constexpr size_t WS_END = WS_WUK + (size_t)2048 * 512 * 2;
constexpr size_t WS_PB = WS_KP;
constexpr size_t WS_MERGED = WS_KP + 3 * (size_t)M * 2048 * 2;
static_assert(sizeof(void*) == 8, "");
static_assert(WS_END <= 2147483648ull, "workspace map exceeds 2 GiB");
static_assert(WS_MERGED + (size_t)M * 2048 * 2 <= WS_VP, "merged overlay inside KP");

constexpr int CW_BAR = 4096;
constexpr int CW_QHEAD = 16384;

constexpr int RING_BYTES = 131072, SCRATCH_TOP = 161536, MISC_OFF = SCRATCH_TOP + 320, LDS_BYTES = 163840;

typedef __bf16 bf16x2_t __attribute__((ext_vector_type(2)));
__device__ __forceinline__ unsigned cvt_pk_bf16(float lo, float hi) { f32x2 v = {lo, hi}; bf16x2_t b = __builtin_convertvector(v, bf16x2_t); return __builtin_bit_cast(unsigned, b); }
__device__ __forceinline__ float bf_lo(unsigned w) { return __uint_as_float(w << 16); }
__device__ __forceinline__ float bf_hi(unsigned w) { return __uint_as_float(w & 0xffff0000u); }
__device__ __forceinline__ float sigmoidf_(float x) { return __builtin_amdgcn_rcpf(1.0f + __builtin_amdgcn_exp2f(-x * LOG2E)); }
__device__ __forceinline__ float siluf_(float x) { return x * sigmoidf_(x); }
__device__ __forceinline__ float wave_sum(float v) {
#pragma unroll
    for (int o = 1; o < 64; o <<= 1) v += __shfl_xor(v, o);
    return v;
}
__device__ __forceinline__ u32x4 pack8(const f32x4 a, const f32x4 b) {
    u32x4 w; w.x = cvt_pk_bf16(a[0], a[1]); w.y = cvt_pk_bf16(a[2], a[3]); w.z = cvt_pk_bf16(b[0], b[1]); w.w = cvt_pk_bf16(b[2], b[3]); return w;
}
__device__ __forceinline__ void unpack8(const u32x4 w, f32x4& a, f32x4& b) {
    a = (f32x4){bf_lo(w.x), bf_hi(w.x), bf_lo(w.y), bf_hi(w.y)}; b = (f32x4){bf_lo(w.z), bf_hi(w.z), bf_lo(w.w), bf_hi(w.w)};
}
#define LDS_WAIT() asm volatile("s_waitcnt lgkmcnt(0)" ::: "memory")
#define VM_WAIT() asm volatile("s_waitcnt vmcnt(0)" ::: "memory")

namespace pg8 {
constexpr int BM = 256, BK = 64, HALF = 128, HTB = HALF * BK * 2, STAGE_BYTES = 8 * HTB, NXCD = 8, WGM = 8;
__host__ __device__ __forceinline__ int lds_byte(int r, int c) { const int st = (r >> 4) * 2 + (c >> 5), rr = r & 15, cc = c & 31, ob = rr * 64 + cc * 2; return st * 1024 + (ob ^ (((ob >> 9) & 1) << 5)); }
__host__ __device__ __forceinline__ void stage_rc(int b, int& R, int& C) { const int st = b / 1024, sb = b % 1024, swz = sb ^ (((sb >> 9) & 1) << 5); R = (st >> 1) * 16 + swz / 64; C = (st & 1) * 32 + (swz % 64) / 2; }
__host__ __device__ __forceinline__ int perm32(int rho) { const int n = rho >> 4, i = rho & 15; return 8 * (i >> 2) + 4 * n + (i & 3); }
struct Unit { int pm, pn; };
struct Gemm { const bf16_t* A; const bf16_t* Bt; int lda, ldb, K; };
struct StaticOrder {
    int nM, nN, nwg, G, c;
    __device__ void init(int M_, int N_, int G_, int c_) { nM = M_ / BM; nN = N_ / BM; nwg = nM * nN; G = G_; c = c_; }
    __device__ bool next(int i, Unit& u) const {
        const long L = (long)i * G + c; if (L >= nwg) return false;
        int wgid = (int)L; { const int q = nwg / NXCD, r = nwg % NXCD, xcd = wgid % NXCD, off = wgid / NXCD; wgid = (xcd < r ? xcd * (q + 1) : r * (q + 1) + (xcd - r) * q) + off; }
        const int nig = WGM * nN, gid = wgid / nig, fm = gid * WGM, gsz = (nM - fm) < WGM ? (nM - fm) : WGM;
        u.pm = fm + ((wgid % nig) % gsz); u.pn = (wgid % nig) / gsz; return true;
    }
};
struct ListOrder {
    int nM, nN, nwg, L0, n, stride;
    __device__ void init(int M_, int N_, int L0_, int n_, int stride_) { nM = M_ / BM; nN = N_ / BM; nwg = nM * nN; L0 = L0_; n = n_; stride = stride_; }
    __device__ bool next(int i, Unit& u) const {
        if (i >= n) return false;
        int wgid = L0 + i * stride; { const int q = nwg / NXCD, r = nwg % NXCD, xcd = wgid % NXCD, off = wgid / NXCD; wgid = (xcd < r ? xcd * (q + 1) : r * (q + 1) + (xcd - r) * q) + off; }
        const int nig = WGM * nN, gid = wgid / nig, fm = gid * WGM, gsz = (nM - fm) < WGM ? (nM - fm) : WGM;
        u.pm = fm + ((wgid % nig) % gsz); u.pn = (wgid % nig) / gsz; return true;
    }
};
template <class Epi, class Sched>
__device__ __forceinline__ void gemm_phase(LAS unsigned char* lds, const Gemm g, const Sched& S, const Epi& E) {
    int tid = threadIdx.x; asm volatile("" : "+v"(tid));
    const int wid = __builtin_amdgcn_readfirstlane(tid >> 6), lane = tid & 63, wr = wid >> 2, wc = wid & 3, fr = lane & 15, fq = lane >> 4;
    const int K = g.K, nt = K / BK;
    unsigned voffA[2], voffB[2];
#pragma unroll
    for (int i = 0; i < 2; ++i) { int R, C; stage_rc(tid * 16 + i * 8192, R, C); const int Rb = (R & ~31) + perm32(R & 31);
        voffA[i] = (unsigned)(R * g.lda + C) * 2u; voffB[i] = (unsigned)(Rb * g.ldb + C) * 2u; }
    const size_t kstep = (size_t)(BK * 2);
    const size_t hA = (size_t)HALF * g.lda * 2, hB = (size_t)HALF * g.ldb * 2;
    const size_t tA = 2 * hA, tB = 2 * hB;
    const unsigned ldsw = (unsigned)wid * 1024u;
    const int aoff = lds_byte(wr * 64 + fr, fq * 8), boff = lds_byte(wc * 32 + fr, fq * 8);
#define PG8_SA(b, h) (((b) * 2 + (h)) * HTB)
#define PG8_SB(b, h) ((4 + (b) * 2 + (h)) * HTB)
#define PG8_STAGE(bufoff, gbase, voff) do { _Pragma("unroll") for (int _i = 0; _i < 2; ++_i) \
        __builtin_amdgcn_global_load_lds((const unsigned*)((const char*)(gbase) + (voff)[_i]), (LAS unsigned*)(lds + (bufoff) + ldsw + _i * 8192), 16, 0, 0); } while (0)
#define PG8_LDA(dst, b, h) do { _Pragma("unroll") for (int m = 0; m < 4; ++m) _Pragma("unroll") for (int k = 0; k < 2; ++k) dst[m][k] = *(const LAS bf16x8*)(lds + PG8_SA(b, h) + aoff + m * 2048 + k * 1024); } while (0)
#define PG8_LDB(dst, b, h) do { _Pragma("unroll") for (int n = 0; n < 2; ++n) _Pragma("unroll") for (int k = 0; k < 2; ++k) dst[n][k] = *(const LAS bf16x8*)(lds + PG8_SB(b, h) + boff + n * 2048 + k * 1024); } while (0)
#define PG8_MMA(ai, bj, At, Bt) do { __builtin_amdgcn_s_setprio(1); _Pragma("unroll") for (int m = 0; m < 4; ++m) _Pragma("unroll") for (int n = 0; n < 2; ++n) _Pragma("unroll") for (int k = 0; k < 2; ++k) \
        acc[ai][bj][m][n] = __builtin_amdgcn_mfma_f32_16x16x32_bf16(Bt[n][k], At[m][k], acc[ai][bj][m][n], 0, 0, 0); __builtin_amdgcn_s_setprio(0); } while (0)
#define PG8_WAIT_V(n) asm volatile("s_waitcnt vmcnt(" #n ")" ::: "memory")
#define PG8_WAIT_L(n) asm volatile("s_waitcnt lgkmcnt(" #n ")" ::: "memory")
#define PG8_BAR __builtin_amdgcn_s_barrier()
#define PG8_SCHED __builtin_amdgcn_sched_barrier(0)
    Unit cur, nxt; int ui = 0;
    if (!S.next(0, cur)) return;
    f32x4 acc[2][2][4][2];
#pragma unroll
    for (int a = 0; a < 2; ++a)
#pragma unroll
        for (int b = 0; b < 2; ++b)
#pragma unroll
            for (int m = 0; m < 4; ++m)
#pragma unroll
                for (int n = 0; n < 2; ++n) acc[a][b][m][n] = (f32x4){0.f, 0.f, 0.f, 0.f};
    bf16x8 At[4][2], B0[2][2], B1[2][2];
    const char* cA = (const char*)g.A + (size_t)cur.pm * tA; const char* cB = (const char*)g.Bt + (size_t)cur.pn * tB;
    PG8_STAGE(PG8_SB(0, 0), cB, voffB); PG8_STAGE(PG8_SB(0, 1), cB + hB, voffB); PG8_STAGE(PG8_SA(0, 0), cA, voffA); PG8_STAGE(PG8_SA(0, 1), cA + hA, voffA);
    if (wr == 1) PG8_BAR;
    PG8_WAIT_V(2); PG8_BAR;
    PG8_STAGE(PG8_SB(1, 0), cB + kstep, voffB); PG8_STAGE(PG8_SA(1, 0), cA + kstep, voffA); PG8_STAGE(PG8_SB(1, 1), cB + hB + kstep, voffB);
    PG8_WAIT_V(6); PG8_BAR;
    for (;;) {
        const bool has_next = S.next(ui + 1, nxt);
        const char* nA = has_next ? (const char*)g.A + (size_t)nxt.pm * tA : cA; const char* nB = has_next ? (const char*)g.Bt + (size_t)nxt.pn * tB : cB;
        for (int t = 0; t < nt; t += 2) {
            const bool last = (t == nt - 2);
            const char* a1 = cA + (size_t)(t + 1) * kstep;
            const char* a2 = last ? nA : cA + (size_t)(t + 2) * kstep; const char* b2 = last ? nB : cB + (size_t)(t + 2) * kstep;
            const char* a3 = a2 + kstep; const char* b3 = b2 + kstep;
            PG8_LDB(B0, 0, 0); PG8_LDB(B1, 0, 1); PG8_SCHED; PG8_LDA(At, 0, 0); PG8_STAGE(PG8_SA(1, 1), a1 + hA, voffA);
            PG8_WAIT_V(8); PG8_WAIT_L(0); PG8_BAR; PG8_MMA(0, 0, At, B0); PG8_MMA(0, 1, At, B1); PG8_BAR; PG8_SCHED;
            PG8_LDA(At, 0, 1); PG8_STAGE(PG8_SB(0, 0), b2, voffB); PG8_STAGE(PG8_SB(0, 1), b2 + hB, voffB); PG8_STAGE(PG8_SA(0, 0), a2, voffA);
            PG8_WAIT_V(8); PG8_WAIT_L(0); PG8_BAR; PG8_MMA(1, 0, At, B0); PG8_MMA(1, 1, At, B1); PG8_BAR; PG8_SCHED;
            PG8_LDB(B0, 1, 0); PG8_LDB(B1, 1, 1); PG8_SCHED; PG8_LDA(At, 1, 0); PG8_STAGE(PG8_SA(0, 1), a2 + hA, voffA);
            PG8_WAIT_V(8); PG8_WAIT_L(0); PG8_BAR; PG8_MMA(0, 0, At, B0); PG8_MMA(0, 1, At, B1); PG8_BAR; PG8_SCHED;
            PG8_LDA(At, 1, 1); PG8_STAGE(PG8_SB(1, 0), b3, voffB); PG8_STAGE(PG8_SB(1, 1), b3 + hB, voffB); PG8_STAGE(PG8_SA(1, 0), a3, voffA);
            PG8_WAIT_V(8); PG8_WAIT_L(0); PG8_BAR; PG8_MMA(1, 0, At, B0); PG8_MMA(1, 1, At, B1); PG8_BAR; PG8_SCHED;
        }
        if (wr == 0) PG8_BAR;
        E(acc, cur);
        if (!has_next) break;
#pragma unroll
        for (int a = 0; a < 2; ++a)
#pragma unroll
            for (int b = 0; b < 2; ++b)
#pragma unroll
                for (int m = 0; m < 4; ++m)
#pragma unroll
                    for (int n = 0; n < 2; ++n) acc[a][b][m][n] = (f32x4){0.f, 0.f, 0.f, 0.f};
        cur = nxt; cA = nA; cB = nB; ++ui;
        if (wr == 1) PG8_BAR;
    }
    PG8_WAIT_V(0);
    PG8_BAR;
#undef PG8_SA
#undef PG8_SB
#undef PG8_STAGE
#undef PG8_LDA
#undef PG8_LDB
#undef PG8_MMA
#undef PG8_WAIT_V
#undef PG8_WAIT_L
#undef PG8_BAR
#undef PG8_SCHED
}
}
using pg8::Unit;

#define EPI_LANE int tz_ = threadIdx.x; asm volatile("" : "+v"(tz_)); const int wr = tz_ >> 8, wc = (tz_ >> 6) & 3, fr = tz_ & 15, fq = (tz_ >> 4) & 3; (void)wr; (void)wc; (void)fr; (void)fq;
#define EPI_LOOP_BEGIN \
    _Pragma("unroll") for (int ai = 0; ai < 2; ++ai) _Pragma("unroll") for (int m = 0; m < 4; ++m) { const int row = u.pm * 256 + ai * 128 + wr * 64 + m * 16 + fr; \
    _Pragma("unroll") for (int bj = 0; bj < 2; ++bj) { const int colt = bj * 128 + wc * 32 + 8 * fq; const f32x4 v0 = acc[ai][bj][m][0], v1 = acc[ai][bj][m][1]; (void)colt; (void)v0; (void)v1;
#define EPI_LOOP_END } }

struct EpiBf16 {
    bf16_t* O; int ldc;
    __device__ __forceinline__ void operator()(const f32x4 (&acc)[2][2][4][2], const Unit& u) const {
        EPI_LANE
        EPI_LOOP_BEGIN
            *(u32x4*)(O + (size_t)row * ldc + u.pn * 256 + colt) = pack8(v0, v1);
        EPI_LOOP_END
    }
};
struct EpiNone { __device__ __forceinline__ void operator()(const f32x4 (&acc)[2][2][4][2], const Unit& u) const { (void)u;
#pragma unroll
    for (int a = 0; a < 2; ++a)
#pragma unroll
        for (int b = 0; b < 2; ++b)
#pragma unroll
            for (int m = 0; m < 4; ++m) asm volatile("" :: "v"(acc[a][b][m][0]), "v"(acc[a][b][m][1])); } };
struct EpiF32 {
    float* C; int ldc;
    __device__ __forceinline__ void operator()(const f32x4 (&acc)[2][2][4][2], const Unit& u) const {
        EPI_LANE
        EPI_LOOP_BEGIN
            float* p = C + (size_t)row * ldc + u.pn * 256 + colt; *(f32x4*)p = v0; *(f32x4*)(p + 4) = v1;
        EPI_LOOP_END
    }
};
struct EpiWin {
    unsigned char* ws; float* out; const float* bmerge; int l;
    __device__ __forceinline__ void operator()(const f32x4 (&acc)[2][2][4][2], const Unit& u) const {
        EPI_LANE
        const int pn = u.pn;
        if (pn < 2) {
            float* qlat = (float*)(ws + WS_QLATF);
            EPI_LOOP_BEGIN
                float* p = qlat + (size_t)row * 512 + pn * 256 + colt; *(f32x4*)p = v0; *(f32x4*)(p + 4) = v1;
            EPI_LOOP_END
        } else if (pn < 4) {
            float* ckv_p = out + O_PCKV + (size_t)l * M_P * 512; float* ckv_s = out + O_SCKV + (size_t)l * M_S * 512;
            EPI_LOOP_BEGIN
                float* p = (row < M_P ? ckv_p + (size_t)row * 512 : ckv_s + (size_t)(row - M_P) * 512) + (pn - 2) * 256 + colt; *(f32x4*)p = v0; *(f32x4*)(p + 4) = v1;
            EPI_LOOP_END
        } else if (pn == 4) {
            float* kr_p = out + O_PKR + (size_t)l * M_P * 64; float* kr_s = out + O_SKR + (size_t)l * M_S * 64;
            EPI_LOOP_BEGIN
                if (colt < 64) { float* p = (row < M_P ? kr_p + (size_t)row * 64 : kr_s + (size_t)(row - M_P) * 64) + colt; *(f32x4*)p = v0; *(f32x4*)(p + 4) = v1; }
            EPI_LOOP_END
        } else if (pn < 13) {
            bf16_t* zm = (bf16_t*)(ws + WS_ZM);
            EPI_LOOP_BEGIN
                f32x4 a, b;
#pragma unroll
                for (int j = 0; j < 4; ++j) { a[j] = siluf_(v0[j]); b[j] = siluf_(v1[j]); }
                *(u32x4*)(zm + (size_t)row * 2048 + (pn - 5) * 256 + colt) = pack8(a, b);
            EPI_LOOP_END
        } else if (pn < 21) {
            const int t = pn - 13;
            bf16_t* ub = (bf16_t*)(ws + WS_UB);
            float* conv_p = out + O_PCONV + (size_t)l * CONV_ST * 1024; float* conv_s = out + O_SCONV + (size_t)l * NSTREAM * CONV_ST * 1024;
#pragma unroll
            for (int ai = 0; ai < 2; ++ai)
#pragma unroll
                for (int m = 0; m < 4; ++m) {
                    const int row = u.pm * 256 + ai * 128 + wr * 64 + m * 16 + fr; const int col = t * 128 + wc * 32 + 8 * fq;
                    f32x4 a, b;
#pragma unroll
                    for (int j = 0; j < 4; ++j) { a[j] = acc[ai][0][m][0][j] * sigmoidf_(acc[ai][1][m][0][j]); b[j] = acc[ai][0][m][1][j] * sigmoidf_(acc[ai][1][m][1][j]); }
                    *(u32x4*)(ub + (size_t)row * 1024 + col) = pack8(a, b);
                    if (row >= M_P - CONV_ST) {
                        if (row < M_P) { float* p = conv_p + (size_t)(row - (M_P - CONV_ST)) * 1024 + col; *(f32x4*)p = a; *(f32x4*)(p + 4) = b; }
                        else { const int rs = row - M_P, sq = rs & 63, bb = rs >> 6;
                            if (sq >= DEC_SEQ - CONV_ST) { float* p = conv_s + ((size_t)bb * CONV_ST + (sq - (DEC_SEQ - CONV_ST))) * 1024 + col; *(f32x4*)p = a; *(f32x4*)(p + 4) = b; } }
                    }
                }
        } else if (pn < 33) {
            const size_t dofs = pn < 25 ? WS_ZC : (pn < 29 ? WS_XQ : WS_ZX); const int tb = pn < 25 ? 21 : (pn < 29 ? 25 : 29); const bool act = !(pn >= 25 && pn < 29);
            bf16_t* dst = (bf16_t*)(ws + dofs);
            EPI_LOOP_BEGIN
                f32x4 a = v0, b = v1;
                if (act) {
#pragma unroll
                    for (int j = 0; j < 4; ++j) { a[j] = siluf_(v0[j]); b[j] = siluf_(v1[j]); } }
                *(u32x4*)(dst + (size_t)row * 1024 + (pn - tb) * 256 + colt) = pack8(a, b);
            EPI_LOOP_END
        } else {
            bf16_t* gates = (bf16_t*)(ws + WS_GATES);
            f32x4 bb[2][2];
#pragma unroll
            for (int bj = 0; bj < 2; ++bj) { const float* bp = bmerge + (pn - 33) * 256 + bj * 128 + wc * 32 + 8 * fq; bb[bj][0] = *(const f32x4*)bp; bb[bj][1] = *(const f32x4*)(bp + 4); }
            EPI_LOOP_BEGIN
                const int col = (pn - 33) * 256 + colt;
                f32x4 a, b;
#pragma unroll
                for (int j = 0; j < 4; ++j) { a[j] = sigmoidf_(v0[j] + bb[bj][0][j]); b[j] = sigmoidf_(v1[j] + bb[bj][1][j]); }
                *(u32x4*)(gates + (size_t)row * 6144 + col) = pack8(a, b);
            EPI_LOOP_END
        }
    }
};
template <bool PASTROWS> struct EpiKV {
    bf16_t* Kd; bf16_t* Vd; float* SS;
    __device__ __forceinline__ void operator()(const f32x4 (&acc)[2][2][4][2], const Unit& u) const {
        EPI_LANE
        const int h = u.pn;
#pragma unroll
        for (int ai = 0; ai < 2; ++ai)
#pragma unroll
            for (int m = 0; m < 4; ++m) {
                const int row = u.pm * 256 + ai * 128 + wr * 64 + m * 16 + fr;
                const size_t R = PASTROWS ? ((size_t)((row >> 12) * 16 + h) * 4096 + (row & 4095)) : ((size_t)h * M + row);
                const int c = wc * 32 + 8 * fq;
                const f32x4 k0 = acc[ai][0][m][0], k1 = acc[ai][0][m][1];
                *(u32x4*)(Kd + R * 128 + c) = pack8(k0, k1);
                *(u32x4*)(Vd + R * 128 + c) = pack8(acc[ai][1][m][0], acc[ai][1][m][1]);
                float s = (k0[0] * k0[0] + k0[1] * k0[1]) + (k0[2] * k0[2] + k0[3] * k0[3]) + (k1[0] * k1[0] + k1[1] * k1[1]) + (k1[2] * k1[2] + k1[3] * k1[3]);
                s += __shfl_xor(s, 16); s += __shfl_xor(s, 32);
                if (fq == 0) SS[R * 4 + wc] = s;
            }
    }
};
template <bool DOK = true, bool DOSS = true, bool TILED = true> struct EpiK {
    bf16_t* Kd; float* SS;
    __device__ __forceinline__ void operator()(const f32x4 (&acc)[2][2][4][2], const Unit& u) const {
        EPI_LANE
        float sq[2][4][2];
#pragma unroll
        for (int ai = 0; ai < 2; ++ai)
#pragma unroll
            for (int m = 0; m < 4; ++m)
#pragma unroll
                for (int bj = 0; bj < 2; ++bj) {
                    const f32x4 k0 = acc[ai][bj][m][0], k1 = acc[ai][bj][m][1];
                    if (DOK) *(u32x4*)(Kd + ((((((((size_t)u.pm * 8 + u.pn) * 2 + ai) * 2 + wr) * 4 + m) * 2 + bj) * 4 + wc) * 64 + (fq * 16 + fr)) * 8) = pack8(k0, k1);
                    sq[ai][m][bj] = (k0[0] * k0[0] + k0[1] * k0[1]) + (k0[2] * k0[2] + k0[3] * k0[3]) + (k1[0] * k1[0] + k1[1] * k1[1]) + (k1[2] * k1[2] + k1[3] * k1[3]);
                }
#pragma unroll
        for (int ai = 0; ai < 2; ++ai)
#pragma unroll
            for (int m = 0; m < 4; ++m)
#pragma unroll
                for (int bj = 0; bj < 2; ++bj) sq[ai][m][bj] += __shfl_xor(sq[ai][m][bj], 16);
#pragma unroll
        for (int ai = 0; ai < 2; ++ai)
#pragma unroll
            for (int m = 0; m < 4; ++m)
#pragma unroll
                for (int bj = 0; bj < 2; ++bj) sq[ai][m][bj] += __shfl_xor(sq[ai][m][bj], 32);
        if (DOSS) {
#pragma unroll
            for (int ai = 0; ai < 2; ++ai)
#pragma unroll
                for (int bj = 0; bj < 2; ++bj) {
                    const float v = fq == 0 ? sq[ai][0][bj] : (fq == 1 ? sq[ai][1][bj] : (fq == 2 ? sq[ai][2][bj] : sq[ai][3][bj]));
                    const int row = u.pm * 256 + ai * 128 + wr * 64 + fq * 16 + fr; const int h = u.pn * 2 + bj;
                    SS[(size_t)wc * ((size_t)MPAST * 16) + (size_t)((row >> 12) * 16 + h) * 4096 + (row & 4095)] = v;
                }
        }
        (void)TILED;
    }
};
struct EpiPw2 {
    bf16_t* O; const bf16_t* zc; const float* bias;
    __device__ __forceinline__ void operator()(const f32x4 (&acc)[2][2][4][2], const Unit& u) const {
        EPI_LANE
        f32x4 bb[2][2];
#pragma unroll
        for (int bj = 0; bj < 2; ++bj) { const float* bp = bias + u.pn * 256 + bj * 128 + wc * 32 + 8 * fq; bb[bj][0] = *(const f32x4*)bp; bb[bj][1] = *(const f32x4*)(bp + 4); }
#pragma unroll
        for (int ai = 0; ai < 2; ++ai) {
            u32x4 z[4][2];
#pragma unroll
            for (int m = 0; m < 4; ++m)
#pragma unroll
                for (int bj = 0; bj < 2; ++bj) { const int row = u.pm * 256 + ai * 128 + wr * 64 + m * 16 + fr; z[m][bj] = *(const u32x4*)(zc + (size_t)row * 1024 + u.pn * 256 + bj * 128 + wc * 32 + 8 * fq); }
#pragma unroll
            for (int m = 0; m < 4; ++m)
#pragma unroll
                for (int bj = 0; bj < 2; ++bj) { const int row = u.pm * 256 + ai * 128 + wr * 64 + m * 16 + fr; const int col = u.pn * 256 + bj * 128 + wc * 32 + 8 * fq;
                    f32x4 z0, z1; unpack8(z[m][bj], z0, z1);
                    *(u32x4*)(O + (size_t)row * 1024 + col) = pack8((acc[ai][bj][m][0] + bb[bj][0]) * z0, (acc[ai][bj][m][1] + bb[bj][1]) * z1); }
            asm volatile("" ::: "memory");
        }
    }
};
struct EpiGate {
    bf16_t* O; const bf16_t* gates; int goff;
    __device__ __forceinline__ void operator()(const f32x4 (&acc)[2][2][4][2], const Unit& u) const {
        EPI_LANE
#pragma unroll
        for (int ai = 0; ai < 2; ++ai) {
            u32x4 gg[4][2];
#pragma unroll
            for (int m = 0; m < 4; ++m)
#pragma unroll
                for (int bj = 0; bj < 2; ++bj) { const int row = u.pm * 256 + ai * 128 + wr * 64 + m * 16 + fr; gg[m][bj] = *(const u32x4*)(gates + (size_t)row * 6144 + goff + u.pn * 256 + bj * 128 + wc * 32 + 8 * fq); }
#pragma unroll
            for (int m = 0; m < 4; ++m)
#pragma unroll
                for (int bj = 0; bj < 2; ++bj) { const int row = u.pm * 256 + ai * 128 + wr * 64 + m * 16 + fr; const int col = u.pn * 256 + bj * 128 + wc * 32 + 8 * fq;
                    f32x4 g0, g1; unpack8(gg[m][bj], g0, g1);
                    *(u32x4*)(O + (size_t)row * 2048 + col) = pack8(g0 * acc[ai][bj][m][0], g1 * acc[ai][bj][m][1]); }
            asm volatile("" ::: "memory");
        }
    }
};
struct EpiOut {
    const float* src_p; const float* src_s; float* dst_p; float* dst_s;
    __device__ __forceinline__ void operator()(const f32x4 (&acc)[2][2][4][2], const Unit& u) const {
        EPI_LANE
        const bool pr = u.pm * 256 < M_P;
        const float* src = pr ? src_p : src_s; float* dst = pr ? dst_p : dst_s; const int rbase = u.pm * 256 - (pr ? 0 : M_P);
#pragma unroll
        for (int ai = 0; ai < 2; ++ai)
#pragma unroll
            for (int mh = 0; mh < 2; ++mh) {
                f32x4 xx[2][2][2];
#pragma unroll
                for (int mm = 0; mm < 2; ++mm)
#pragma unroll
                    for (int bj = 0; bj < 2; ++bj) { const int m = mh * 2 + mm; const size_t off = (size_t)(rbase + ai * 128 + wr * 64 + m * 16 + fr) * 2048 + u.pn * 256 + bj * 128 + wc * 32 + 8 * fq;
                        xx[mm][bj][0] = *(const f32x4*)(src + off); xx[mm][bj][1] = *(const f32x4*)(src + off + 4); }
#pragma unroll
                for (int mm = 0; mm < 2; ++mm)
#pragma unroll
                    for (int bj = 0; bj < 2; ++bj) { const int m = mh * 2 + mm; const size_t off = (size_t)(rbase + ai * 128 + wr * 64 + m * 16 + fr) * 2048 + u.pn * 256 + bj * 128 + wc * 32 + 8 * fq;
                        *(f32x4*)(dst + off) = xx[mm][bj][0] + acc[ai][bj][m][0]; *(f32x4*)(dst + off + 4) = xx[mm][bj][1] + acc[ai][bj][m][1]; }
                asm volatile("" ::: "memory");
            }
    }
};

namespace att {
__device__ __forceinline__ int crow(int r, int hi) { return (r & 3) + 8 * (r >> 2) + 4 * hi; }
template <int ROWB> __device__ __forceinline__ int kswz(int row, int colB) { return row * ROWB + (colB ^ ((row & 7) << 4)); }
template <int NDV> __device__ __forceinline__ int v_st(int k, int c) { const int kk = (k & ~0xC) | ((k & 4) << 1) | ((k & 8) >> 1); return ((kk >> 3) * NDV + (c >> 5)) * 512 + ((kk & 7) * 32 + (c & 31)) * 2; }
__device__ __forceinline__ int v_rd_base(int lane) { return ((lane & 3) << 3) | (((lane >> 2) & 3) << 6) | (((lane >> 4) & 1) << 5) | (((lane >> 5) & 1) << 8); }

template <int NQA, int NQB, int NDV, int NKB, bool HAS_RK, int KROWB, int KR = 3>
__device__ __forceinline__ void tile_step(const bf16x8 (&qr)[NQA + NQB], f32x16 (&o)[NDV], float& m_reg, float& l_reg,
                                          const LAS char* Ks, const LAS char* Kp, int vb, const LAS float* rk, LAS float* al_l, int r32, int hi) {
    f32x16 p[NKB];
#pragma unroll
    for (int kb = 0; kb < NKB; ++kb)
#pragma unroll
        for (int r = 0; r < 16; ++r) p[kb][r] = 0.f;
    {
        auto kfrag = [&](int kb, int d) -> bf16x8 { return d < NQA ? *(const LAS bf16x8*)(Ks + kswz<KROWB>(kb * 32 + r32, (d * 16 + hi * 8) * 2)) : *(const LAS bf16x8*)(Kp + kswz<128>(kb * 32 + r32, ((d - NQA) * 16 + hi * 8) * 2)); };
        bf16x8 kf[KR][NKB];
#pragma unroll
        for (int a = 0; a < KR - 1; ++a)
#pragma unroll
            for (int kb = 0; kb < NKB; ++kb) kf[a][kb] = kfrag(kb, a);
#pragma unroll
        for (int d0 = 0; d0 < NQA + NQB; ++d0) {
            if (d0 + KR - 1 < NQA + NQB) {
#pragma unroll
                for (int kb = 0; kb < NKB; ++kb) kf[(d0 + KR - 1) % KR][kb] = kfrag(kb, d0 + KR - 1); }
#pragma unroll
            for (int kb = 0; kb < NKB; ++kb) p[kb] = __builtin_amdgcn_mfma_f32_32x32x16_bf16(kf[d0 % KR][kb], qr[d0], p[kb], 0, 0, 0);
        }
    }
    if (HAS_RK) {
#pragma unroll
        for (int kb = 0; kb < NKB; ++kb)
#pragma unroll
            for (int i = 0; i < 4; ++i) { const f32x4 s = *(const LAS f32x4*)(rk + kb * 32 + 8 * i + 4 * hi);
#pragma unroll
                for (int j = 0; j < 4; ++j) p[kb][4 * i + j] *= s[j]; }
    }
    float pmax = p[0][0];
#pragma unroll
    for (int kb = 0; kb < NKB; ++kb)
#pragma unroll
        for (int r = 0; r < 16; ++r) pmax = fmaxf(pmax, p[kb][r]);
    { auto rr = __builtin_amdgcn_permlane32_swap(__float_as_uint(pmax), __float_as_uint(pmax), false, false); pmax = fmaxf(__uint_as_float(rr[0]), __uint_as_float(rr[1])); }
    const float mn = fmaxf(m_reg, pmax); const float alpha = __builtin_amdgcn_exp2f(m_reg - mn); m_reg = mn;
    float ps = 0.f;
#pragma unroll
    for (int kb = 0; kb < NKB; ++kb)
#pragma unroll
        for (int r = 0; r < 16; ++r) { p[kb][r] = __builtin_amdgcn_exp2f(p[kb][r] - mn); ps += p[kb][r]; }
    { auto rr = __builtin_amdgcn_permlane32_swap(__float_as_uint(ps), __float_as_uint(ps), false, false); ps = __uint_as_float(rr[0]) + __uint_as_float(rr[1]); }
    l_reg = l_reg * alpha + ps;
    if (__any(alpha < 1.f)) {
        if (hi == 0) al_l[r32] = alpha;
        LDS_WAIT();
        float al[16];
#pragma unroll
        for (int r = 0; r < 16; ++r) al[r] = al_l[crow(r, hi)];
#pragma unroll
        for (int d = 0; d < NDV; ++d)
#pragma unroll
            for (int r = 0; r < 16; ++r) o[d][r] *= al[r];
    }
    bf16x8 pa[2 * NKB];
#pragma unroll
    for (int kb = 0; kb < NKB; ++kb)
#pragma unroll
        for (int hf = 0; hf < 2; ++hf) { const int B = hf * 8;
            const unsigned a0 = cvt_pk_bf16(p[kb][B + 0], p[kb][B + 1]), a1 = cvt_pk_bf16(p[kb][B + 2], p[kb][B + 3]);
            const unsigned b0 = cvt_pk_bf16(p[kb][B + 4], p[kb][B + 5]), b1 = cvt_pk_bf16(p[kb][B + 6], p[kb][B + 7]);
            auto r0 = __builtin_amdgcn_permlane32_swap(a0, b0, false, false); auto r1 = __builtin_amdgcn_permlane32_swap(a1, b1, false, false);
            u32x4 w = {r0[0], r1[0], r0[1], r1[1]}; pa[kb * 2 + hf] = __builtin_bit_cast(bf16x8, w); }
#pragma unroll
    for (int d0 = 0; d0 < NDV; ++d0) {
        s16x4 lo[2 * NKB], hh[2 * NKB];
#pragma unroll
        for (int ks = 0; ks < 2 * NKB; ++ks) {
            asm volatile("ds_read_b64_tr_b16 %0, %1 offset:%c2" : "=&v"(lo[ks]) : "v"(vb), "i"(d0 * 512 + ks * (NDV * 1024)) : "memory");
            asm volatile("ds_read_b64_tr_b16 %0, %1 offset:%c2" : "=&v"(hh[ks]) : "v"(vb), "i"(d0 * 512 + ks * (NDV * 1024) + NDV * 512) : "memory"); }
        asm volatile("s_waitcnt lgkmcnt(0)" ::: "memory"); __builtin_amdgcn_sched_barrier(0);
#pragma unroll
        for (int ks = 0; ks < 2 * NKB; ++ks) { const bf16x8 vf = (bf16x8){lo[ks][0], lo[ks][1], lo[ks][2], lo[ks][3], hh[ks][0], hh[ks][1], hh[ks][2], hh[ks][3]};
            o[d0] = __builtin_amdgcn_mfma_f32_32x32x16_bf16(pa[ks], vf, o[d0], 0, 0, 0); }
    }
}
typedef short v4i16_t __attribute__((ext_vector_type(4)));
__device__ __forceinline__ s16x4 vtr(const LAS char* p) { return __builtin_bit_cast(s16x4, __builtin_amdgcn_ds_read_tr16_b64_v4i16((LAS v4i16_t*)p)); }
template <int NQA, int NQB, int NDV, int NKB, int KROWB, int NDVT = NDV>
__device__ __forceinline__ void tile_step_fs(const bf16x8 (&qr)[NQA + NQB], f32x16 (&o)[NDV], float& l_part,
                                             const LAS char* Ks, const LAS char* Kp, const LAS char* vbp, const LAS float* rk, float negB2, int r32, int hi) {
    f32x16 p[NKB];
#pragma unroll
    for (int kb = 0; kb < NKB; ++kb)
#pragma unroll
        for (int r = 0; r < 16; ++r) p[kb][r] = 0.f;
    bf16x8 ka[NKB], kn[NKB];
#pragma unroll
    for (int kb = 0; kb < NKB; ++kb) ka[kb] = *(const LAS bf16x8*)(Ks + kswz<KROWB>(kb * 32 + r32, hi * 16));
#pragma unroll
    for (int d0 = 0; d0 < NQA + NQB; ++d0) {
        if (d0 + 1 < NQA + NQB) {
#pragma unroll
            for (int kb = 0; kb < NKB; ++kb) { const int d1 = d0 + 1;
                kn[kb] = d1 < NQA ? *(const LAS bf16x8*)(Ks + kswz<KROWB>(kb * 32 + r32, (d1 * 16 + hi * 8) * 2)) : *(const LAS bf16x8*)(Kp + kswz<128>(kb * 32 + r32, ((d1 - NQA) * 16 + hi * 8) * 2)); } }
#pragma unroll
        for (int kb = 0; kb < NKB; ++kb) p[kb] = __builtin_amdgcn_mfma_f32_32x32x16_bf16(ka[kb], qr[d0], p[kb], 0, 0, 0);
#pragma unroll
        for (int kb = 0; kb < NKB; ++kb) ka[kb] = kn[kb];
    }
#pragma unroll
    for (int kb = 0; kb < NKB; ++kb) {
        float ps = 0.f;
#pragma unroll
        for (int i = 0; i < 4; ++i) { const f32x4 s = *(const LAS f32x4*)(rk + kb * 32 + 8 * i + 4 * hi);
#pragma unroll
            for (int j = 0; j < 4; ++j) { const float e = __builtin_amdgcn_exp2f(fmaf(p[kb][4 * i + j], s[j], negB2)); p[kb][4 * i + j] = e; ps += e; } }
        l_part += ps;
        bf16x8 pa[2];
#pragma unroll
        for (int hf = 0; hf < 2; ++hf) { const int B = hf * 8;
            const unsigned a0 = cvt_pk_bf16(p[kb][B + 0], p[kb][B + 1]), a1 = cvt_pk_bf16(p[kb][B + 2], p[kb][B + 3]);
            const unsigned b0 = cvt_pk_bf16(p[kb][B + 4], p[kb][B + 5]), b1 = cvt_pk_bf16(p[kb][B + 6], p[kb][B + 7]);
            auto r0 = __builtin_amdgcn_permlane32_swap(a0, b0, false, false); auto r1 = __builtin_amdgcn_permlane32_swap(a1, b1, false, false);
            u32x4 w = {r0[0], r1[0], r0[1], r1[1]}; pa[hf] = __builtin_bit_cast(bf16x8, w); }
#pragma unroll
        for (int hf = 0; hf < 2; ++hf) { const int ks = kb * 2 + hf;
            bf16x8 vf[NDV];
#pragma unroll
            for (int d0 = 0; d0 < NDV; ++d0) { const s16x4 lo = vtr(vbp + d0 * 512 + ks * (NDVT * 1024)), hh = vtr(vbp + d0 * 512 + ks * (NDVT * 1024) + NDVT * 512);
                vf[d0] = (bf16x8){lo[0], lo[1], lo[2], lo[3], hh[0], hh[1], hh[2], hh[3]}; }
#pragma unroll
            for (int d0 = 0; d0 < NDV; ++d0) o[d0] = __builtin_amdgcn_mfma_f32_32x32x16_bf16(pa[hf], vf[d0], o[d0], 0, 0, 0); }
    }
}
template <int NQA, int NQB, int NKB, int KROWB>
__device__ __forceinline__ void qk_sm(const bf16x8 (&qr)[NQA + NQB], float& l_part, const LAS char* Ks, const LAS char* Kp, const LAS float* rk, float negB2, int r32, int hi, bf16x8 (&pa)[2 * NKB]) {
    f32x16 p[NKB];
#pragma unroll
    for (int kb = 0; kb < NKB; ++kb)
#pragma unroll
        for (int r = 0; r < 16; ++r) p[kb][r] = 0.f;
    auto kfrag = [&](int kb, int d) -> bf16x8 { return d < NQA ? *(const LAS bf16x8*)(Ks + kswz<KROWB>(kb * 32 + r32, (d * 16 + hi * 8) * 2)) : *(const LAS bf16x8*)(Kp + kswz<128>(kb * 32 + r32, ((d - NQA) * 16 + hi * 8) * 2)); };
    bf16x8 kf[3][NKB];
#pragma unroll
    for (int kb = 0; kb < NKB; ++kb) { kf[0][kb] = kfrag(kb, 0); kf[1][kb] = kfrag(kb, 1); }
#pragma unroll
    for (int d0 = 0; d0 < NQA + NQB; ++d0) {
        if (d0 + 2 < NQA + NQB) {
#pragma unroll
            for (int kb = 0; kb < NKB; ++kb) kf[(d0 + 2) % 3][kb] = kfrag(kb, d0 + 2); }
#pragma unroll
        for (int kb = 0; kb < NKB; ++kb) p[kb] = __builtin_amdgcn_mfma_f32_32x32x16_bf16(kf[d0 % 3][kb], qr[d0], p[kb], 0, 0, 0);
    }
    f32x4 sc[NKB][4];
#pragma unroll
    for (int kb = 0; kb < NKB; ++kb)
#pragma unroll
        for (int i = 0; i < 4; ++i) sc[kb][i] = *(const LAS f32x4*)(rk + kb * 32 + 8 * i + 4 * hi);
#pragma unroll
    for (int kb = 0; kb < NKB; ++kb) {
        float ps = 0.f;
#pragma unroll
        for (int i = 0; i < 4; ++i) {
#pragma unroll
            for (int j = 0; j < 4; ++j) { const float e = __builtin_amdgcn_exp2f(fmaf(p[kb][4 * i + j], sc[kb][i][j], negB2)); p[kb][4 * i + j] = e; ps += e; } }
        l_part += ps;
#pragma unroll
        for (int hf = 0; hf < 2; ++hf) { const int B = hf * 8;
            const unsigned a0 = cvt_pk_bf16(p[kb][B + 0], p[kb][B + 1]), a1 = cvt_pk_bf16(p[kb][B + 2], p[kb][B + 3]);
            const unsigned b0 = cvt_pk_bf16(p[kb][B + 4], p[kb][B + 5]), b1 = cvt_pk_bf16(p[kb][B + 6], p[kb][B + 7]);
            auto r0 = __builtin_amdgcn_permlane32_swap(a0, b0, false, false); auto r1 = __builtin_amdgcn_permlane32_swap(a1, b1, false, false);
            u32x4 w = {r0[0], r1[0], r0[1], r1[1]}; pa[kb * 2 + hf] = __builtin_bit_cast(bf16x8, w); }
    }
}
template <int NDV, int NKB>
__device__ __forceinline__ void pv_fs(f32x16 (&o)[NDV], const LAS char* vbp, const bf16x8 (&pa)[2 * NKB]) {
    const int vb = (int)(uintptr_t)vbp;
    s16x4 lo[2][NDV], hh[2][NDV];
    __builtin_amdgcn_sched_barrier(0);
#pragma unroll
    for (int d0 = 0; d0 < NDV; ++d0) {
        asm volatile("ds_read_b64_tr_b16 %0, %1 offset:%c2" : "=&v"(lo[0][d0]) : "v"(vb), "i"(d0 * 512) : "memory");
        asm volatile("ds_read_b64_tr_b16 %0, %1 offset:%c2" : "=&v"(hh[0][d0]) : "v"(vb), "i"(d0 * 512 + NDV * 512) : "memory"); }
#pragma unroll
    for (int ks = 0; ks < 2 * NKB; ++ks) {
        if (ks + 1 < 2 * NKB) {
#pragma unroll
            for (int d0 = 0; d0 < NDV; ++d0) {
                asm volatile("ds_read_b64_tr_b16 %0, %1 offset:%c2" : "=&v"(lo[(ks + 1) & 1][d0]) : "v"(vb), "i"(d0 * 512 + (ks + 1) * (NDV * 1024)) : "memory");
                asm volatile("ds_read_b64_tr_b16 %0, %1 offset:%c2" : "=&v"(hh[(ks + 1) & 1][d0]) : "v"(vb), "i"(d0 * 512 + (ks + 1) * (NDV * 1024) + NDV * 512) : "memory"); }
            asm volatile("s_waitcnt lgkmcnt(%0)" :: "n"(2 * NDV) : "memory");
        } else asm volatile("s_waitcnt lgkmcnt(0)" ::: "memory");
        __builtin_amdgcn_sched_barrier(0);
#pragma unroll
        for (int d0 = 0; d0 < NDV; ++d0) { const s16x4 l_ = lo[ks & 1][d0], h_ = hh[ks & 1][d0];
            const bf16x8 vf = (bf16x8){l_[0], l_[1], l_[2], l_[3], h_[0], h_[1], h_[2], h_[3]};
            o[d0] = __builtin_amdgcn_mfma_f32_32x32x16_bf16(pa[ks], vf, o[d0], 0, 0, 0); }
        __builtin_amdgcn_sched_barrier(0);
    }
}
__device__ __forceinline__ float lane_pair_sum(float x) { auto rr = __builtin_amdgcn_permlane32_swap(__float_as_uint(x), __float_as_uint(x), false, false); return __uint_as_float(rr[0]) + __uint_as_float(rr[1]); }
template <int NDV>
__device__ __forceinline__ void finish(const f32x16 (&o)[NDV], float l_reg, LAS float* al_l, bf16_t* out, const bf16_t* z, int ld, int r32, int hi) {
    if (hi == 0) al_l[r32] = l_reg;
    LDS_WAIT();
    const bool odd = r32 & 1;
#pragma unroll
    for (int r = 0; r < 16; r += 2) { const int orow = crow(r, hi);
        const float rl0 = __builtin_amdgcn_rcpf(al_l[orow]), rl1 = __builtin_amdgcn_rcpf(al_l[orow + 1]);
#pragma unroll
        for (int d0 = 0; d0 < NDV; ++d0) {
            const float a = o[d0][r] * rl0, b = o[d0][r + 1] * rl1;
            const float recv = __shfl_xor(odd ? a : b, 1);
            const float v0 = odd ? recv : a, v1 = odd ? b : recv;
            const size_t idx = (size_t)(orow + (odd ? 1 : 0)) * ld + d0 * 32 + (r32 & ~1);
            const unsigned zw = *(const unsigned*)(z + idx);
            *(unsigned*)(out + idx) = cvt_pk_bf16(v0 * bf_lo(zw), v1 * bf_hi(zw)); } }
}
}

#define XB_TMO      128
#define XB_XCNT(j)  (256  + 64 * (j))
#define XB_XSUB(j)  (1280 + 64 * (j))
#define XB_XGEN(j)  (2304 + 64 * (j))
#define XB_TOP      3328
#define XB_TOPGEN   3392
#define XCD_BAR_WORDS 3456
#define XB_SPIN_CAP (1u << 18)
__device__ __forceinline__ unsigned xb_ld(unsigned* p)              { return __hip_atomic_load(p, __ATOMIC_RELAXED, __HIP_MEMORY_SCOPE_AGENT); }
__device__ __forceinline__ unsigned xb_add(unsigned* p, unsigned v) { return __hip_atomic_fetch_add(p, v, __ATOMIC_RELAXED, __HIP_MEMORY_SCOPE_AGENT); }
__device__ __forceinline__ unsigned xb_xcc_id() { return (unsigned)__builtin_amdgcn_s_getreg((3 << 11) | 20) & 0xFu; }
#define XB_SPIN(cond, bar) do { unsigned _sp = 0; while (cond) { __builtin_amdgcn_s_sleep(1); \
    if ((++_sp & 255u) == 0u) { if (xb_ld(&(bar)[XB_TMO])) break; if (_sp > XB_SPIN_CAP) { atomicAdd(&(bar)[XB_TMO], 1u); break; } } } } while (0)
struct XcdBarrier { unsigned* bar; unsigned x; volatile LAS unsigned* st; };
__device__ __forceinline__ XcdBarrier xcd_barrier_post(unsigned* bar, volatile LAS unsigned* st) {
    XcdBarrier b; b.bar = bar; b.x = xb_xcc_id(); b.st = st;
    if (threadIdx.x == 0) (void)xb_add(&bar[XB_XCNT(b.x)], 1u);
    return b;
}
__device__ __forceinline__ void xcd_barrier_complete(unsigned* bar, unsigned x, unsigned& nloc, unsigned& nx) {
    const unsigned G = gridDim.x * gridDim.y * gridDim.z;
    unsigned sum, cnt, mine, sp = 0u;
    for (;;) {
        sum = 0u; cnt = 0u; mine = 0u;
#pragma unroll
        for (unsigned j = 0; j < 16; ++j) { const unsigned c = xb_ld(&bar[XB_XCNT(j)]); sum += c; cnt += (c > 0u) ? 1u : 0u; mine = (j == x) ? c : mine; }
        if (sum == G) break;
        __builtin_amdgcn_s_sleep(1);
        if ((++sp & 255u) == 0u) { if (xb_ld(&bar[XB_TMO])) break; if (sp > XB_SPIN_CAP) { atomicAdd(&bar[XB_TMO], 1u); break; } }
    }
    nloc = mine > 0u ? mine : 1u; nx = cnt > 0u ? cnt : 1u;
}
__device__ __forceinline__ void xcd_barrier(const XcdBarrier& b) {
    asm volatile("s_waitcnt vmcnt(0)" ::: "memory");
    __syncthreads();
    if (threadIdx.x == 0) {
        unsigned* bar = b.bar; asm volatile("" : "+s"(bar));
        __builtin_amdgcn_s_waitcnt(0);
        unsigned nloc = b.st[0], nx = b.st[1];
        if (nloc == 0u) { xcd_barrier_complete(bar, b.x, nloc, nx); b.st[0] = nloc; b.st[1] = nx; }
        const unsigned old = xb_add(&bar[XB_XSUB(b.x)], 1u);
        const unsigned gen = old / nloc;
        if (old + 1u == (gen + 1u) * nloc) {
            __builtin_amdgcn_fence(__ATOMIC_RELEASE, "agent");
            asm volatile("s_waitcnt vmcnt(0)" ::: "memory");
            const unsigned og = xb_add(&bar[XB_TOP], 1u);
            const unsigned tg = og / nx;
            if (og + 1u == (tg + 1u) * nx) xb_add(&bar[XB_TOPGEN], 1u);
            else XB_SPIN(xb_ld(&bar[XB_TOPGEN]) == tg, bar);
            __builtin_amdgcn_fence(__ATOMIC_ACQUIRE, "agent");
            xb_add(&bar[XB_XGEN(b.x)], 1u);
            asm volatile("s_waitcnt vmcnt(0)" ::: "memory");
        } else {
            XB_SPIN(xb_ld(&bar[XB_XGEN(b.x)]) == gen, bar);
            __builtin_amdgcn_fence(__ATOMIC_ACQUIRE, "agent");
            asm volatile("s_waitcnt vmcnt(0)" ::: "memory");
        }
    }
    __syncthreads();
}

struct Args { const float* in[31]; float* out; unsigned char* ws; int ph_lo, ph_hi; };
typedef const float* const __attribute__((address_space(4)))* karg_in_t;
struct Ctx {
    LAS unsigned char* lds;
    karg_in_t in; float* out; unsigned char* ws;
    int tid, lane, wave, G, bid;
};
enum { I_XP = 0, I_XS, I_MEM, I_CCKV, I_CKR, I_CMK, I_CMV, I_SCONV, I_GPRE, I_WIN, I_GQLAT, I_WUQ, I_GKVLAT, I_WUKV, I_GQN, I_GKN, I_CONVW, I_CONVB, I_LNG, I_LNB,
       I_WPW2, I_BPW2, I_GMEM, I_WMEM, I_GXQ, I_GXK, I_WPM, I_WPC, I_WPX, I_BMERGE, I_WOUT };

__device__ __forceinline__ int win_src_col(int nd) {
    if (nd < 1088) return nd;
    if (nd < 1280) return -1;
    if (nd >= 3328 && nd < 5376) { const int t = (nd - 3328) >> 8, w = (nd - 3328) & 255; return w < 128 ? 3136 + t * 128 + w : 4160 + t * 128 + (w - 128); }
    return nd - 192;
}
__device__ __forceinline__ void transpose_item(const float* W, int K, int Nsrc, bf16_t* WT, const float* gain, int mapmode, LAS float* scr, int item, int nblk, int lane) {
    const int kb = item / nblk, nb = item % nblk, k0 = 64 * kb, nd0 = 64 * nb;
    const int ns0 = mapmode == 1 ? win_src_col(nd0) : (mapmode == 2 ? (nd0 >> 7) * 256 + (nd0 & 127) : nd0);
    const int lk = lane >> 4, ln4 = (lane & 15) * 4;
    f32x4 v[16];
#pragma unroll
    for (int i = 0; i < 16; ++i) v[i] = ns0 >= 0 ? *(const f32x4*)(W + (size_t)(k0 + lk + 4 * i) * Nsrc + ns0 + ln4) : (f32x4){0.f, 0.f, 0.f, 0.f};
#pragma unroll
    for (int i = 0; i < 16; ++i) { LAS float* p = scr + (lk + 4 * i) * 65 + ln4; p[0] = v[i][0]; p[1] = v[i][1]; p[2] = v[i][2]; p[3] = v[i][3]; }
    LDS_WAIT(); asm volatile("" ::: "memory");
    const int c = lane & 7;
    f32x4 g0 = {1.f, 1.f, 1.f, 1.f}, g1 = {1.f, 1.f, 1.f, 1.f};
    if (gain) { g0 = *(const f32x4*)(gain + k0 + 8 * c); g1 = *(const f32x4*)(gain + k0 + 8 * c + 4); }
#pragma unroll
    for (int j = 0; j < 8; ++j) { const int n = (lane >> 3) + 8 * j; const LAS float* sp = scr + (8 * c) * 65 + n;
        u32x4 o; o.x = cvt_pk_bf16(sp[0 * 65] * g0[0], sp[1 * 65] * g0[1]); o.y = cvt_pk_bf16(sp[2 * 65] * g0[2], sp[3 * 65] * g0[3]);
        o.z = cvt_pk_bf16(sp[4 * 65] * g1[0], sp[5 * 65] * g1[1]); o.w = cvt_pk_bf16(sp[6 * 65] * g1[2], sp[7 * 65] * g1[3]);
        *(u32x4*)(WT + (size_t)(nd0 + n) * K + k0 + 8 * c) = o; }
    LDS_WAIT(); asm volatile("" ::: "memory");
}
__device__ __forceinline__ bool h_early_ok(int G) { const int n2 = (M / 256) * (2048 / 256) - G; return n2 > 0 && n2 < G; }
constexpr unsigned PW_ALL = 0x3ffu, PW_EARLY = PW_ALL & ~(1u << 8);
__device__ __forceinline__ void prep_weights(const Ctx& F, int l, int gw, int NGW, unsigned jobs) {
    LAS float* scr = (LAS float*)(F.lds + F.wave * 16640);
    int base = 0;
#pragma unroll 1
    for (int job = 0; job < 10; ++job) {
        if (!((jobs >> job) & 1u)) continue;
        const float* W; int K, Nsrc, Ndst; size_t dst; const float* gain = nullptr; int winmap = 0;
        switch (job) {
            case 0: W = F.in[I_WIN] + (size_t)l * 2048 * IN_COLS; K = 2048; Nsrc = IN_COLS; Ndst = IN_PAD; dst = WS_WIN; gain = F.in[I_GPRE] + l * 2048; winmap = 1; break;
            case 1: W = F.in[I_WUQ] + (size_t)l * 512 * 3072; K = 512; Nsrc = 3072; Ndst = 3072; dst = WS_WUQ; gain = F.in[I_GQLAT] + l * 512; break;
            case 2: W = F.in[I_WUKV] + (size_t)l * 512 * 4096; K = 512; Nsrc = 4096; Ndst = 4096; dst = WS_WUKV; gain = F.in[I_GKVLAT] + l * 512; break;
            case 3: W = F.in[I_WPW2] + (size_t)l * 1024 * 1024; K = 1024; Nsrc = 1024; Ndst = 1024; dst = WS_WPW2; break;
            case 4: W = F.in[I_WMEM] + (size_t)l * 2048 * 2048; K = 2048; Nsrc = 2048; Ndst = 2048; dst = WS_WMEM; gain = F.in[I_GMEM] + l * 2048; break;
            case 5: W = F.in[I_WPM] + (size_t)l * 2048 * 2048; K = 2048; Nsrc = 2048; Ndst = 2048; dst = WS_WPM; break;
            case 6: W = F.in[I_WPC] + (size_t)l * 1024 * 2048; K = 1024; Nsrc = 2048; Ndst = 2048; dst = WS_WPC; break;
            case 7: W = F.in[I_WPX] + (size_t)l * 1024 * 2048; K = 1024; Nsrc = 2048; Ndst = 2048; dst = WS_WPX; break;
            case 8: W = F.in[I_WOUT] + (size_t)l * 2048 * 2048; K = 2048; Nsrc = 2048; Ndst = 2048; dst = WS_WOUT; break;
            default: W = F.in[I_WUKV] + (size_t)l * 512 * 4096; K = 512; Nsrc = 4096; Ndst = 2048; dst = WS_WUK; gain = F.in[I_GKVLAT] + l * 512; winmap = 2; break;
        }
        const int nblk = Ndst / 64, nitems = (K / 64) * nblk;
        bf16_t* WT = (bf16_t*)(F.ws + dst);
        int first = (gw - base) % NGW; if (first < 0) first += NGW;
        for (int it = first; it < nitems; it += NGW) transpose_item(W, K, Nsrc, WT, gain, winmap, scr, it, nblk, F.lane);
        base += nitems;
    }
}
__device__ __forceinline__ void rms_row_2048(const float* xrow, bf16_t* orow, int lane) {
    const f32x4* xr = (const f32x4*)xrow + lane;
    f32x4 v[8]; float s = 0.f;
#pragma unroll
    for (int j = 0; j < 8; ++j) { v[j] = xr[64 * j]; s += (v[j][0] * v[j][0] + v[j][1] * v[j][1]) + (v[j][2] * v[j][2] + v[j][3] * v[j][3]); }
    const float r = 1.0f / sqrtf(wave_sum(s) * (1.f / 2048.f) + EPS);
    u32x2* o8 = (u32x2*)orow + lane;
#pragma unroll
    for (int j = 0; j < 8; ++j) { u32x2 w; w.x = cvt_pk_bf16(v[j][0] * r, v[j][1] * r); w.y = cvt_pk_bf16(v[j][2] * r, v[j][3] * r); o8[64 * j] = w; }
}
__device__ __forceinline__ void rms_row_512(const float* xrow, bf16_t* orow, int lane) {
    const f32x4* xr = (const f32x4*)xrow + lane;
    f32x4 v[2]; float s = 0.f;
#pragma unroll
    for (int j = 0; j < 2; ++j) { v[j] = xr[64 * j]; s += (v[j][0] * v[j][0] + v[j][1] * v[j][1]) + (v[j][2] * v[j][2] + v[j][3] * v[j][3]); }
    const float r = 1.0f / sqrtf(wave_sum(s) * (1.f / 512.f) + EPS);
    u32x2* o8 = (u32x2*)orow + lane;
#pragma unroll
    for (int j = 0; j < 2; ++j) { u32x2 w; w.x = cvt_pk_bf16(v[j][0] * r, v[j][1] * r); w.y = cvt_pk_bf16(v[j][2] * r, v[j][3] * r); o8[64 * j] = w; }
}
__device__ __forceinline__ void kpe_row(const float* kr, const float* gkpe, const float* ropetab, int pos, bf16_t* kpe, float* sspe, int lane) {
    const float x = kr[lane]; const float ss = wave_sum(x * x);
    const float xg = x * gkpe[lane]; const float other = __shfl_xor(xg, 32);
    const f32x2 cs = *(const f32x2*)(ropetab + ((size_t)pos * 32 + (lane & 31)) * 2);
    const float o = lane < 32 ? xg * cs.x - other * cs.y : xg * cs.x + other * cs.y;
    kpe[lane] = (bf16_t)(cvt_pk_bf16(o, 0.f) & 0xffffu);
    if (lane == 0) *sspe = ss;
}
template <int R>
__device__ __forceinline__ void rms_rows_512(const float* x0, bf16_t* o0, int lane) {
    f32x4 v[R][2]; float s[R];
#pragma unroll
    for (int r = 0; r < R; ++r) { const f32x4* xr = (const f32x4*)(x0 + (size_t)r * 512) + lane;
#pragma unroll
        for (int j = 0; j < 2; ++j) v[r][j] = xr[64 * j]; }
#pragma unroll
    for (int r = 0; r < R; ++r) { s[r] = 0.f;
#pragma unroll
        for (int j = 0; j < 2; ++j) s[r] += (v[r][j][0] * v[r][j][0] + v[r][j][1] * v[r][j][1]) + (v[r][j][2] * v[r][j][2] + v[r][j][3] * v[r][j][3]); }
#pragma unroll
    for (int o = 1; o < 64; o <<= 1)
#pragma unroll
        for (int r = 0; r < R; ++r) s[r] += __shfl_xor(s[r], o);
#pragma unroll
    for (int r = 0; r < R; ++r) { const float rr = 1.0f / sqrtf(s[r] * (1.f / 512.f) + EPS); u32x2* o8 = (u32x2*)(o0 + (size_t)r * 512) + lane;
#pragma unroll
        for (int j = 0; j < 2; ++j) { u32x2 w; w.x = cvt_pk_bf16(v[r][j][0] * rr, v[r][j][1] * rr); w.y = cvt_pk_bf16(v[r][j][2] * rr, v[r][j][3] * rr); o8[64 * j] = w; } }
}
template <int R>
__device__ __forceinline__ void kpe_rows(const float* kr0, float gk, const float* ropetab, int pos0, bf16_t* kpe0, float* sspe0, int lane) {
    float x[R], ss[R]; f32x2 cs[R];
#pragma unroll
    for (int r = 0; r < R; ++r) { x[r] = kr0[(size_t)r * 64 + lane]; cs[r] = *(const f32x2*)(ropetab + ((size_t)(pos0 + r) * 32 + (lane & 31)) * 2); }
#pragma unroll
    for (int r = 0; r < R; ++r) ss[r] = x[r] * x[r];
#pragma unroll
    for (int o = 1; o < 64; o <<= 1)
#pragma unroll
        for (int r = 0; r < R; ++r) ss[r] += __shfl_xor(ss[r], o);
#pragma unroll
    for (int r = 0; r < R; ++r) { const float xg = x[r] * gk; const float other = __shfl_xor(xg, 32);
        const float o = lane < 32 ? xg * cs[r].x - other * cs[r].y : xg * cs[r].x + other * cs[r].y;
        kpe0[(size_t)r * 64 + lane] = (bf16_t)(cvt_pk_bf16(o, 0.f) & 0xffffu);
        if (lane == 0) sspe0[r] = ss[r]; }
}
__device__ __forceinline__ const float* x_row(const Ctx& F, int l, int row) {
    if (l == 0) return row < M_P ? F.in[I_XP] + (size_t)row * 2048 : F.in[I_XS] + (size_t)(row - M_P) * 2048;
    return (const float*)(F.ws + WS_X1) + (size_t)row * 2048;
}
__device__ __forceinline__ void phase_prep(const Ctx& F, int l) {
    const int gw = F.bid * 8 + F.wave, NGW = F.G * 8;
    float* ropetab = (float*)(F.ws + WS_ROPE);
    if (l == 0) {
        for (int i = gw * 64 + F.lane; i < 8192 * 32; i += NGW * 64) { const int pos = i >> 5, j = i & 31;
            const float inv = powf(10000.f, -(float)j / 32.f); const float ang = (float)pos * inv;
            const double a = (double)ang; const double n = rint(a * 0.15915494309189535); const float red = (float)(a - n * 6.283185307179586);
            ropetab[2 * i] = cosf(red); ropetab[2 * i + 1] = sinf(red); }
        for (int r = gw; r < N_MEM; r += NGW) rms_row_2048(F.in[I_MEM] + (size_t)r * 2048, (bf16_t*)(F.ws + WS_MEMN) + (size_t)r * 2048, F.lane);
    }
    prep_weights(F, l, gw, NGW, (l == 1 && h_early_ok(F.G)) ? (PW_ALL & ~PW_EARLY) : PW_ALL);
    for (int r = gw; r < M; r += NGW) rms_row_2048(x_row(F, l, r), (bf16_t*)(F.ws + WS_HB) + (size_t)r * 2048, F.lane);
#ifdef DUP_P2
    for (int r = gw; r < M; r += NGW) rms_row_2048(x_row(F, l, r), (bf16_t*)(F.ws + WS_HB) + (size_t)r * 2048, F.lane);
#endif
    const float* cc = F.in[I_CCKV] + (size_t)l * MPAST * 512;
    for (int r = gw * 4; r < MPAST; r += NGW * 4) rms_rows_512<4>(cc + (size_t)r * 512, (bf16_t*)(F.ws + WS_CNP) + (size_t)r * 512, F.lane);
#ifdef DUP_P3
    for (int r = gw * 4; r < MPAST; r += NGW * 4) rms_rows_512<4>(cc + (size_t)r * 512, (bf16_t*)(F.ws + WS_CNP) + (size_t)r * 512, F.lane);
#endif
}
__device__ __forceinline__ void past_kpe(const Ctx& F, int l) {
    const int gw = F.bid * 8 + F.wave, NGW = F.G * 8;
    const float* ropetab = (const float*)(F.ws + WS_ROPE);
    const float* ck = F.in[I_CKR] + (size_t)l * MPAST * 64; const float* gk = F.in[I_GKN] + l * QK_HEAD + 128;
    const float gkl = gk[F.lane];
    for (int r = gw * 4; r < MPAST; r += NGW * 4) kpe_rows<4>(ck + (size_t)r * 64, gkl, ropetab, r & (PAST - 1), (bf16_t*)(F.ws + WS_KPEP) + (size_t)r * 64, (float*)(F.ws + WS_SSPEP) + r, F.lane);
}

__device__ __forceinline__ void glds16(const void* g, LAS void* l) { unsigned keep; const unsigned dst = (unsigned)(uintptr_t)l;
    asm volatile("s_mov_b32 %0, m0\n\ts_mov_b32 m0, %2\n\ts_nop 0\n\tglobal_load_lds_dwordx4 %1, off\n\ts_mov_b32 m0, %0" : "=&s"(keep) : "v"(g), "s"(dst) : "memory"); }
__device__ __forceinline__ void glds16s(const void* sbase, unsigned voff, LAS void* l) { const unsigned dst = (unsigned)(uintptr_t)l;
    asm volatile("s_mov_b32 m0, %2\n\ts_nop 0\n\tglobal_load_lds_dwordx4 %0, %1" :: "v"(voff), "s"(sbase), "s"(dst) : "memory", "m0"); }
__device__ __forceinline__ void glds4s(const void* sbase, unsigned voff, LAS void* l) { const unsigned dst = (unsigned)(uintptr_t)l;
    asm volatile("s_mov_b32 m0, %2\n\ts_nop 0\n\tglobal_load_lds_dword %0, %1" :: "v"(voff), "s"(sbase), "s"(dst) : "memory", "m0"); }
__device__ __forceinline__ void glds4(const void* g, LAS void* l) { unsigned keep; const unsigned dst = (unsigned)(uintptr_t)l;
    asm volatile("s_mov_b32 %0, m0\n\ts_mov_b32 m0, %2\n\ts_nop 0\n\tglobal_load_lds_dword %1, off\n\ts_mov_b32 m0, %0" : "=&s"(keep) : "v"(g), "s"(dst) : "memory"); }
template <int CR, int SB>
__device__ __forceinline__ void conv_chunk(const Ctx& F, int l, int tid, int seq0, int r0, int seqlen, int bb) {
    constexpr int CWIN = CR + CONV_ST;
    const int lane = tid & 63, wv = __builtin_amdgcn_readfirstlane(tid >> 6);
    asm volatile("" : "+s"(l));
    const float* cw = F.in[I_CONVW] + (size_t)l * CONV_K * 1024; const float* cb = F.in[I_CONVB] + l * 1024;
    const float* lg = F.in[I_LNG] + l * 1024; const float* lb = F.in[I_LNB] + l * 1024;
    const float* st = F.in[I_SCONV] + (size_t)l * NSTREAM * CONV_ST * 1024;
    const bf16_t* ub = (const bf16_t*)(F.ws + WS_UB); bf16_t* cv = (bf16_t*)(F.ws + WS_CV);
    LAS unsigned char* win = F.lds;
    LAS f32x2* red = (LAS f32x2*)(F.lds + CWIN * 2048);
    LAS f32x2* stat = red + 8 * SB;
    const int nh = r0 < CONV_ST ? CONV_ST - r0 : 0;
    for (int hr = 2 * nh + wv; hr < 2 * CWIN; hr += 8)
#ifdef CONV_NODMA
        *(LAS u32x4*)(win + hr * 1024 + lane * 16) = *(const u32x4*)(ub + (size_t)(seq0 + r0 - CONV_ST + (hr >> 1)) * 1024 + (hr & 1) * 512 + lane * 8);
#else
        glds16(ub + (size_t)(seq0 + r0 - CONV_ST + (hr >> 1)) * 1024 + (hr & 1) * 512 + lane * 8, win + hr * 1024);
#endif
    if (bb >= 0) {
        for (int hr0 = wv; hr0 < 2 * nh; hr0 += 32) { f32x4 a[4], b[4];
#pragma unroll
            for (int q = 0; q < 4; ++q) { const int hr = min(hr0 + 8 * q, 2 * nh - 1); const float* sp = st + ((size_t)bb * CONV_ST + r0 + (hr >> 1)) * 1024 + (hr & 1) * 512 + lane * 8; a[q] = *(const f32x4*)sp; b[q] = *(const f32x4*)(sp + 4); }
#pragma unroll
            for (int q = 0; q < 4; ++q) if (hr0 + 8 * q < 2 * nh) *(LAS u32x4*)(win + (hr0 + 8 * q) * 1024 + lane * 16) = pack8(a[q], b[q]); }
    } else for (int hr = wv; hr < 2 * nh; hr += 8) *(LAS u32x4*)(win + hr * 1024 + lane * 16) = (u32x4){0u, 0u, 0u, 0u};
    asm volatile("" ::: "memory");
    const int c0 = 2 * tid;
    f32x2 w[CONV_K];
#pragma unroll
    for (int k = 0; k < CONV_K; ++k) w[k] = *(const f32x2*)(cw + (size_t)k * 1024 + c0);
    const f32x2 bia = *(const f32x2*)(cb + c0);
    const f32x2 g2 = *(const f32x2*)(lg + c0), b2 = *(const f32x2*)(lb + c0);
    asm volatile("s_waitcnt vmcnt(0)" ::: "memory");
    __syncthreads();
#pragma unroll 1
    for (int sb = 0; sb < CR / SB; ++sb) {
        LAS const unsigned char* wp = win + sb * SB * 2048 + c0 * 2;
        f32x2 y[SB];
#pragma unroll
        for (int r = 0; r < SB; ++r) y[r] = bia;
#pragma unroll
        for (int jj = 0; jj < SB + CONV_ST; ++jj) { const unsigned uu = *(const LAS unsigned*)(wp + jj * 2048); const f32x2 u = {bf_lo(uu), bf_hi(uu)};
#pragma unroll
            for (int r = 0; r < SB; ++r) { const int k = jj - r; if (k >= 0 && k < CONV_K) y[r] = w[k] * u + y[r]; } }
#pragma unroll
        for (int r = 0; r < SB; ++r) { const float s1 = wave_sum(y[r].x + y[r].y), s2 = wave_sum(y[r].x * y[r].x + y[r].y * y[r].y); if (lane == 0) red[wv * SB + r] = (f32x2){s1, s2}; }
        __syncthreads();
        if (tid < SB) { float s1 = 0.f, s2 = 0.f;
#pragma unroll
            for (int q = 0; q < 8; ++q) { const f32x2 t = red[q * SB + tid]; s1 += t.x; s2 += t.y; }
            const float mean = s1 * (1.f / 1024.f); const float var = fmaxf(s2 * (1.f / 1024.f) - mean * mean, 0.f);
            stat[tid] = (f32x2){mean, 1.0f / sqrtf(var + EPS)}; }
        __syncthreads();
        const int rb = r0 + sb * SB;
#pragma unroll
        for (int r = 0; r < SB; ++r) { const f32x2 ms = stat[r];
            const float a = siluf_((y[r].x - ms.x) * ms.y * g2.x + b2.x), b = siluf_((y[r].y - ms.x) * ms.y * g2.y + b2.y);
            if (rb + r < seqlen) *(unsigned*)(cv + (size_t)(seq0 + rb + r) * 1024 + c0) = cvt_pk_bf16(a, b); }
    }
    __syncthreads();
}
__device__ __forceinline__ void phase_c(const Ctx& F, int l) {
    int tid = F.tid; asm volatile("" : "+v"(tid)); const int gw = F.bid * 8 + F.wave, NGW = F.G * 8, lane = tid & 63;
    for (int c = F.bid; c < 187 + 64; c += F.G) {
        if (c < 187) conv_chunk<44, 11>(F, l, tid, 0, c * 44, M_P, -1);
        else { const int q = c - 187; conv_chunk<32, 8>(F, l, tid, M_P + (q >> 1) * 64, (q & 1) * 32, DEC_SEQ, q >> 1); }
    }
    {
        const float* ropetab = (const float*)(F.ws + WS_ROPE); const float gkl = (F.in[I_GKN] + l * QK_HEAD + 128)[lane];
        constexpr int RB = 5;
        for (int r0 = gw * RB; r0 < M; r0 += NGW * RB) {
            f32x4 a[RB][2], c[RB][2]; float kx[RB], s[3 * RB]; f32x2 cs[RB];
#pragma unroll
            for (int i = 0; i < RB; ++i) { const int r = r0 + i;
                const f32x4* ap = (const f32x4*)((const float*)(F.ws + WS_QLATF) + (size_t)r * 512) + lane;
                const float* ckv = r < M_P ? F.out + O_PCKV + ((size_t)l * M_P + r) * 512 : F.out + O_SCKV + ((size_t)l * M_S + (r - M_P)) * 512;
                const float* kr = r < M_P ? F.out + O_PKR + ((size_t)l * M_P + r) * 64 : F.out + O_SKR + ((size_t)l * M_S + (r - M_P)) * 64;
                const int pos = r < M_P ? r : PAST + ((r - M_P) & 63);
                a[i][0] = ap[0]; a[i][1] = ap[64]; c[i][0] = ((const f32x4*)ckv)[lane]; c[i][1] = ((const f32x4*)ckv)[lane + 64];
                kx[i] = kr[lane]; cs[i] = *(const f32x2*)(ropetab + ((size_t)pos * 32 + (lane & 31)) * 2); }
#pragma unroll
            for (int i = 0; i < RB; ++i) { s[3 * i] = 0.f; s[3 * i + 1] = 0.f;
#pragma unroll
                for (int j = 0; j < 2; ++j) { s[3 * i] += (a[i][j][0] * a[i][j][0] + a[i][j][1] * a[i][j][1]) + (a[i][j][2] * a[i][j][2] + a[i][j][3] * a[i][j][3]);
                    s[3 * i + 1] += (c[i][j][0] * c[i][j][0] + c[i][j][1] * c[i][j][1]) + (c[i][j][2] * c[i][j][2] + c[i][j][3] * c[i][j][3]); }
                s[3 * i + 2] = kx[i] * kx[i]; }
#pragma unroll
            for (int o = 1; o < 64; o <<= 1)
#pragma unroll
                for (int i = 0; i < 3 * RB; ++i) s[i] += __shfl_xor(s[i], o);
#pragma unroll
            for (int i = 0; i < RB; ++i) { const int r = r0 + i;
                const float ra = 1.0f / sqrtf(s[3 * i] * (1.f / 512.f) + EPS), rc = 1.0f / sqrtf(s[3 * i + 1] * (1.f / 512.f) + EPS);
                u32x2* oa = (u32x2*)((bf16_t*)(F.ws + WS_QLATN) + (size_t)r * 512) + lane; u32x2* oc = (u32x2*)((bf16_t*)(F.ws + WS_CKVN) + (size_t)r * 512) + lane;
#pragma unroll
                for (int j = 0; j < 2; ++j) { u32x2 w; w.x = cvt_pk_bf16(a[i][j][0] * ra, a[i][j][1] * ra); w.y = cvt_pk_bf16(a[i][j][2] * ra, a[i][j][3] * ra); oa[64 * j] = w;
                    w.x = cvt_pk_bf16(c[i][j][0] * rc, c[i][j][1] * rc); w.y = cvt_pk_bf16(c[i][j][2] * rc, c[i][j][3] * rc); oc[64 * j] = w; }
                const float xg = kx[i] * gkl; const float other = __shfl_xor(xg, 32);
                const float o = lane < 32 ? xg * cs[i].x - other * cs[i].y : xg * cs[i].x + other * cs[i].y;
                ((bf16_t*)(F.ws + WS_KPEC))[(size_t)r * 64 + lane] = (bf16_t)(cvt_pk_bf16(o, 0.f) & 0xffffu);
                if (lane == 0) ((float*)(F.ws + WS_SSPEC))[r] = s[3 * i + 2]; }
        }
    }
    {
        const float* kvraw = (const float*)(F.ws + WS_KVRAW); const float* gx = F.in[I_GXK] + l * 256;
        for (int it = gw; it < N_MEM * 8; it += NGW) { const int t = it >> 3, hv = it & 7, isv = hv >> 2, h = hv & 3;
            const f32x4 v = *(const f32x4*)(kvraw + (size_t)t * 2048 + isv * 1024 + h * 256 + 4 * lane);
            f32x4 o = v;
            if (!isv) { const float ss = wave_sum((v[0] * v[0] + v[1] * v[1]) + (v[2] * v[2] + v[3] * v[3])); const float r = 1.0f / sqrtf(ss * (1.f / 256.f) + EPS);
                const f32x4 g = *(const f32x4*)(gx + 4 * lane); o = v * r * g; }
            float* op = F.out + (isv ? O_PMV : O_PMK) + (size_t)l * N_MEM * 1024 + (size_t)t * 1024 + h * 256 + 4 * lane;
            *(f32x4*)op = o;
            u32x2 w; w.x = cvt_pk_bf16(o[0], o[1]); w.y = cvt_pk_bf16(o[2], o[3]);
            *(u32x2*)((bf16_t*)(F.ws + (isv ? WS_MVB : WS_MKB)) + (size_t)t * 1024 + h * 256 + 4 * lane) = w;
        }
    }
}
__device__ __forceinline__ void phase_e(const Ctx& F, int l) {
    const int gw = F.bid * 8 + F.wave, NGW = F.G * 8, lane = F.lane;
    const float* ropetab = (const float*)(F.ws + WS_ROPE);
    const float* gq = F.in[I_GQN] + l * QK_HEAD; const float* gk = F.in[I_GKN] + l * QK_HEAD; const float* gxq = F.in[I_GXQ] + l * 256;
    const f32x4 gx4 = *(const f32x4*)(gxq + 4 * lane) * C_X;
    const bf16_t* qraw = (const bf16_t*)(F.ws + WS_QRAW); bf16_t* Q = (bf16_t*)(F.ws + WS_Q); bf16_t* xq = (bf16_t*)(F.ws + WS_XQ);
    {
        const size_t gt = (size_t)F.bid * 512 + F.tid, GT = (size_t)F.G * 512;
        const float* SSC = (const float*)(F.ws + WS_SSC); const float* SSPEC = (const float*)(F.ws + WS_SSPEC); float* RKC = (float*)(F.ws + WS_RKC);
        for (size_t i = gt; i < (size_t)16 * M; i += GT) { const f32x4 s4 = *(const f32x4*)(SSC + i * 4); const int row = (int)(i % M);
            RKC[i] = 1.0f / sqrtf(((s4[0] + s4[1]) + (s4[2] + s4[3]) + SSPEC[row]) * (1.f / 192.f) + EPS); }
        const float* SSP = (const float*)(F.ws + WS_SSP); const float* SSPEP = (const float*)(F.ws + WS_SSPEP); float* RKP = (float*)(F.ws + WS_RKP);
        for (size_t i4 = gt; i4 < (size_t)MPAST * 4; i4 += GT) { const size_t PL = (size_t)MPAST * 16, i = i4 * 4; const size_t bb = i >> 16, t = i & 4095;
            const f32x4 s = (*(const f32x4*)(SSP + i) + *(const f32x4*)(SSP + PL + i)) + (*(const f32x4*)(SSP + 2 * PL + i) + *(const f32x4*)(SSP + 3 * PL + i)) + *(const f32x4*)(SSPEP + bb * 4096 + t);
            f32x4 o; o[0] = 1.0f / sqrtf(s[0] * (1.f / 192.f) + EPS); o[1] = 1.0f / sqrtf(s[1] * (1.f / 192.f) + EPS); o[2] = 1.0f / sqrtf(s[2] * (1.f / 192.f) + EPS); o[3] = 1.0f / sqrtf(s[3] * (1.f / 192.f) + EPS);
            *(f32x4*)(RKP + i) = o; }
    }
    f32x4 gsc;
    { const int e0 = lane < 32 ? 4 * lane : 128 + 4 * (lane & 15);
      const f32x4 q4 = *(const f32x4*)(gq + e0); gsc = q4 * C_MLA; if (lane < 32) gsc = gsc * *(const f32x4*)(gk + e0); }
    for (int r = gw; r < M; r += NGW) {
        const int pos = r < M_P ? r : PAST + ((r - M_P) & 63);
        const float* ct = ropetab + ((size_t)pos * 32 + 4 * (lane & 7)) * 2;
        const f32x4 c01 = *(const f32x4*)ct, c23 = *(const f32x4*)(ct + 4);
        u32x2 xw[4];
#pragma unroll
        for (int h = 0; h < 4; ++h) xw[h] = ((const u32x2*)(xq + (size_t)r * 1024 + h * 256))[lane];
        for (int h0 = 0; h0 < NH; h0 += 8) {
            f32x4 v[8]; float ss[8];
#pragma unroll
            for (int j = 0; j < 8; ++j) { u32x2 w = {0u, 0u}; if (lane < 48) w = *(const u32x2*)(qraw + (size_t)r * 3072 + (h0 + j) * 192 + 4 * lane);
                v[j] = (f32x4){bf_lo(w.x), bf_hi(w.x), bf_lo(w.y), bf_hi(w.y)}; ss[j] = (v[j][0] * v[j][0] + v[j][1] * v[j][1]) + (v[j][2] * v[j][2] + v[j][3] * v[j][3]); }
#pragma unroll
            for (int o = 1; o < 64; o <<= 1)
#pragma unroll
                for (int j = 0; j < 8; ++j) ss[j] += __shfl_xor(ss[j], o);
#pragma unroll
            for (int j = 0; j < 8; ++j) { const float rq = 1.0f / sqrtf(ss[j] * (1.f / 192.f) + EPS);
                f32x4 x = v[j] * rq * gsc;
                f32x4 ot; ot[0] = __shfl_xor(x[0], 8); ot[1] = __shfl_xor(x[1], 8); ot[2] = __shfl_xor(x[2], 8); ot[3] = __shfl_xor(x[3], 8);
                if (lane >= 32) { const float sg = lane < 40 ? -1.f : 1.f;
                    x = (f32x4){x[0] * c01[0] + sg * ot[0] * c01[1], x[1] * c01[2] + sg * ot[1] * c01[3], x[2] * c23[0] + sg * ot[2] * c23[1], x[3] * c23[2] + sg * ot[3] * c23[3]}; }
                if (lane < 48) { u32x2 ow; ow.x = cvt_pk_bf16(x[0], x[1]); ow.y = cvt_pk_bf16(x[2], x[3]); *(u32x2*)(Q + ((size_t)r * NH + h0 + j) * 192 + 4 * lane) = ow; } }
        }
#pragma unroll
        for (int h = 0; h < 4; ++h) {
            const u32x2 w = xw[h]; u32x2* po = (u32x2*)((bf16_t*)(F.ws + WS_XQN) + (size_t)r * 1024 + h * 256) + lane;
            const f32x4 v = (f32x4){bf_lo(w.x), bf_hi(w.x), bf_lo(w.y), bf_hi(w.y)};
            const float ss = wave_sum((v[0] * v[0] + v[1] * v[1]) + (v[2] * v[2] + v[3] * v[3])); const float rr = 1.0f / sqrtf(ss * (1.f / 256.f) + EPS);
            const f32x4 o = v * rr * gx4; u32x2 ow; ow.x = cvt_pk_bf16(o[0], o[1]); ow.y = cvt_pk_bf16(o[2], o[3]); *po = ow;
        }
    }
}

constexpr int AP_KN = 0, AP_KPE = 16384, AP_V = 24576, AP_RK = 40960;
constexpr int AX_K = 0, AX_V = 32768, AX_AL = 49152;

__device__ __forceinline__ int swap23(int k) { return (k & ~0xC) | ((k & 4) << 1) | ((k & 8) >> 1); }
__device__ __forceinline__ int src_kn(int o) { const int row = o >> 8, colB = (o & 255) ^ ((row & 7) << 4); return row * 128 + (colB >> 1); }
__device__ __forceinline__ int src_kpe(int o) { const int row = o >> 7, colB = (o & 127) ^ ((row & 7) << 4); return row * 64 + (colB >> 1); }
__device__ __forceinline__ int src_v1024(int o) { const int sub = o >> 9, kk = (sub >> 2) * 8 + ((o & 511) >> 6), c = (sub & 3) * 32 + ((o & 63) >> 1); return swap23(kk) * 1024 + c; }
__device__ __forceinline__ int src_v(int o) { const int sub = o >> 9, kk = (sub >> 2) * 8 + ((o & 511) >> 6), c = (sub & 3) * 32 + ((o & 63) >> 1); return swap23(kk) * 128 + c; }

constexpr int AQ_KBUF = 24832, AQ_KPE = 16384, AQ_RK = 24576, AQ_V0 = 3 * AQ_KBUF, AQ_VBUF = 16384, AQ_AL = AQ_V0 + 4 * AQ_VBUF;
__device__ __forceinline__ void mla_prompt_unit(const Ctx& F, int h, int qb, float negB2) {
    int tid = F.tid; asm volatile("" : "+v"(tid)); const int wid = F.wave, lane = tid & 63, r32 = lane & 31, hi = lane >> 5;
    const bf16_t* Q = (const bf16_t*)(F.ws + WS_Q); const bf16_t* KC = (const bf16_t*)(F.ws + WS_KC) + (size_t)h * M * 128; const bf16_t* VC = (const bf16_t*)(F.ws + WS_VC) + (size_t)h * M * 128;
    const float* RK = (const float*)(F.ws + WS_RKC) + (size_t)h * M; const bf16_t* KPE = (const bf16_t*)(F.ws + WS_KPEC);
    const int row0 = qb * 256 + wid * 32;
    f32x16 o[4];
#pragma unroll
    for (int d = 0; d < 4; ++d)
#pragma unroll
        for (int r = 0; r < 16; ++r) o[d][r] = 0.f;
    float l_part = 0.f;
    const int nt_all = 4 * qb + 4, nt_w = 4 * qb + (wid >> 1) + 1;
    const bool late = false;
    LAS char* L = (LAS char*)F.lds; LAS float* al_l = (LAS float*)(L + AQ_AL) + wid * 32;
    const LAS char* vb0 = L + AQ_V0 + att::v_rd_base(lane);
    unsigned okn[2], ov[2];
#pragma unroll
    for (int i = 0; i < 2; ++i) { const int o16 = ((wid * 2 + i) * 64 + lane) * 16; okn[i] = (unsigned)src_kn(o16) * 2u; ov[i] = (unsigned)src_v(o16) * 2u; }
    const unsigned okp = (unsigned)src_kpe((wid * 64 + lane) * 16) * 2u, ork = (unsigned)lane * 4u;
#define MP_ISSUE(t) do { LAS char* Lk = L + ((t) % 3) * AQ_KBUF; LAS char* Lv = L + AQ_V0 + ((t) & 3) * AQ_VBUF; const size_t kb_ = (size_t)(t) * 64; \
        glds16s(KC + kb_ * 128, okn[0], Lk + (wid * 2) * 1024); glds16s(KC + kb_ * 128, okn[1], Lk + (wid * 2 + 1) * 1024); \
        glds16s(VC + kb_ * 128, ov[0], Lv + (wid * 2) * 1024); glds16s(VC + kb_ * 128, ov[1], Lv + (wid * 2 + 1) * 1024); \
        glds16s(KPE + kb_ * 64, okp, Lk + AQ_KPE + wid * 1024); \
        if (wid == 0) glds4s(RK + kb_, ork, Lk + AQ_RK); } while (0)
    __builtin_amdgcn_s_barrier();
    MP_ISSUE(0); MP_ISSUE(1);
    bf16x8 qr[12];
    { const bf16_t* qp = Q + ((size_t)(row0 + r32) * NH + h) * 192 + hi * 8;
#pragma unroll
      for (int d0 = 0; d0 < 12; ++d0) qr[d0] = *(const bf16x8*)(qp + d0 * 16);
#pragma unroll
      for (int d0 = 0; d0 < 12; ++d0) asm volatile("" :: "v"(qr[d0])); }
    bf16x8 pa[4] = {};
    for (int t = 0; t < nt_all; ++t) {
        if (t + 1 < nt_all) { if (wid == 0) asm volatile("s_waitcnt vmcnt(6)" ::: "memory"); else asm volatile("s_waitcnt vmcnt(5)" ::: "memory"); }
        else asm volatile("s_waitcnt vmcnt(0)" ::: "memory");
        __builtin_amdgcn_s_barrier();
        asm volatile("" ::: "memory");
        if (t + 2 < nt_all) MP_ISSUE(t + 2);
        if (late && t >= 1 && t - 1 < nt_w) att::pv_fs<4, 2>(o, vb0 + ((t - 1) & 3) * AQ_VBUF, pa);
        if (t < nt_w) {
            const LAS char* Lk = L + (t % 3) * AQ_KBUF;
            att::qk_sm<8, 4, 2, 256>(qr, l_part, Lk, Lk + AQ_KPE, (const LAS float*)(Lk + AQ_RK), negB2, r32, hi, pa);
#ifdef PROBE_QK2
            { bf16x8 pa2[4]; float l2 = 0.f; int r32b = r32; asm volatile("" : "+v"(r32b)); att::qk_sm<8, 4, 2, 256>(qr, l2, Lk, Lk + AQ_KPE, (const LAS float*)(Lk + AQ_RK), negB2, r32b, hi, pa2);
              asm volatile("" :: "v"(pa2[0]), "v"(pa2[1]), "v"(pa2[2]), "v"(pa2[3]), "v"(l2)); }
#endif
#ifdef PROBE_PV2
            { f32x16 o2[4];
#pragma unroll
              for (int d = 0; d < 4; ++d)
#pragma unroll
                  for (int r = 0; r < 16; ++r) o2[d][r] = 0.f;
              att::pv_fs<4, 2>(o2, vb0 + (t & 3) * AQ_VBUF, pa);
              asm volatile("" :: "v"(o2[0]), "v"(o2[1]), "v"(o2[2]), "v"(o2[3])); }
#endif
            if (!late) att::pv_fs<4, 2>(o, vb0 + (t & 3) * AQ_VBUF, pa);
        }
    }
    if (late && nt_all - 1 < nt_w) att::pv_fs<4, 2>(o, vb0 + ((nt_all - 1) & 3) * AQ_VBUF, pa);
#undef MP_ISSUE
    att::finish<4>(o, att::lane_pair_sum(l_part), al_l, (bf16_t*)(F.ws + WS_AMLA) + (size_t)row0 * 2048 + h * 128, (const bf16_t*)(F.ws + WS_ZM) + (size_t)row0 * 2048 + h * 128, 2048, r32, hi);
}
constexpr int AC_KN = 0, AC_KPE = 8192, AC_CN = 10240, AC_RK = 26624, AC_BUF = 26752, AC_NB = 6, AC_AL = AC_NB * AC_BUF;
static_assert(AC_AL + 1024 <= SCRATCH_TOP, "sample attention ring + row-sum scratch inside the phase scratch");
__device__ __forceinline__ int src_cn(int o) { const int sub = o >> 9, kk = (sub >> 4) * 8 + ((o & 511) >> 6), c = (sub & 15) * 32 + ((o & 63) >> 1); return swap23(kk) * 512 + c; }
#ifndef PROBE_HOT
#define PROBE_HOT 0
#endif
__device__ __forceinline__ void mla_sample_unit(const Ctx& F, int b, int hp, float negB2, bool rep2 = false) {
    int tid = F.tid; asm volatile("" : "+v"(tid)); const int wid = F.wave, lane = tid & 63, r32 = lane & 31, hi = lane >> 5;
    const int g = wid >> 2, rg = (wid >> 1) & 1, lh = wid & 1, h = hp * 2 + g;
    const bf16_t* Q = (const bf16_t*)(F.ws + WS_Q);
    const int row0 = M_P + b * 64 + rg * 32;
    f32x16 o[8];
#pragma unroll
    for (int d = 0; d < 8; ++d)
#pragma unroll
        for (int r = 0; r < 16; ++r) o[d][r] = 0.f;
    float l_part = 0.f;
    constexpr int SC_CS = 16384, SC_NC = 5, SC_K0 = SC_CS * SC_NC, SC_KS = 10368, SC_NK = 6, SK_KPE = 8192, SK_RK = 10240, SC_P0 = SC_K0 + SC_KS * SC_NK, SC_AL = SC_P0 + 4 * 2048;
    static_assert(SC_AL + 1024 <= SCRATCH_TOP && SC_AL >= 131072, "sample attention LDS map");
    LAS char* L = (LAS char*)F.lds; LAS float* al_l = (LAS float*)(L + SC_AL) + wid * 32; LAS float* al_p = (LAS float*)(L + SC_AL) + (wid ^ 1) * 32;
    LAS char* Pb = L + SC_P0 + (wid >> 1) * 2048 + lane * 32;
    const int dg = wid >> 2, dh = hp * 2 + dg;
    const bf16_t* KPt = (const bf16_t*)(F.ws + WS_KP); const bf16_t* KCh = (const bf16_t*)(F.ws + WS_KC) + ((size_t)dh * M + M_P + b * 64) * 128;
    const bf16_t* CNP = (const bf16_t*)(F.ws + WS_CNP) + (size_t)b * 4096 * 512; const bf16_t* CNC = (const bf16_t*)(F.ws + WS_CKVN) + (size_t)(M_P + b * 64) * 512;
    const bf16_t* KPEP = (const bf16_t*)(F.ws + WS_KPEP) + (size_t)b * 4096 * 64; const bf16_t* KPEC = (const bf16_t*)(F.ws + WS_KPEC) + (size_t)(M_P + b * 64) * 64;
    const float* RKPb = (const float*)(F.ws + WS_RKP) + (size_t)(b * 16 + hp * 2) * 4096; const float* RKCb = (const float*)(F.ws + WS_RKC) + (size_t)(hp * 2) * M + M_P + b * 64;
    constexpr int NT = 260, NS = NT / 2;
    unsigned voffKp, voffKc, voffC0, voffC1, voffX;
    { const int o16 = ((wid & 3) * 64 + lane) * 16, r = o16 >> 8, cB = (o16 & 255) ^ ((r & 7) << 4), cc = cB >> 4;
      voffKp = (unsigned)((((dg * 4 + (cc >> 2)) * 64) + (cc & 3) * 16 + r) * 8) * 2u; voffKc = (unsigned)(r * 128 + (cB >> 1)) * 2u;
      voffC0 = (unsigned)src_cn(((wid * 2) * 64 + lane) * 16) * 2u; voffC1 = (unsigned)src_cn(((wid * 2 + 1) * 64 + lane) * 16) * 2u;
      voffX = wid < 2 ? (unsigned)src_kpe(((wid & 1) * 64 + lane) * 16) * 2u : (unsigned)((((lane >> 4) & 1) * 4096 + (lane & 15)) * 4); }
#define MS_ISSUE_C(tt) do { const int t_ = (tt) < NT ? (tt) : NT - 1; LAS char* Lc = L + ((tt) % SC_NC) * SC_CS; \
        if (t_ < 256) { const bf16_t* cs_ = CNP + (size_t)t_ * 16 * 512; glds16s(cs_, voffC0, Lc + (wid * 2) * 1024); glds16s(cs_, voffC1, Lc + (wid * 2 + 1) * 1024); } \
        else { const bf16_t* cs_ = CNC + (size_t)(t_ - 256) * 16 * 512; glds16s(cs_, voffC0, Lc + (wid * 2) * 1024); glds16s(cs_, voffC1, Lc + (wid * 2 + 1) * 1024); } } while (0)
#define MS_ISSUE_K(tt) do { const int t_ = (tt) < NT ? (tt) : NT - 1; LAS char* Lk = L + SC_K0 + ((tt) % SC_NK) * SC_KS; \
        if (t_ < 256) { const size_t kb_ = (size_t)t_ * 16, grow = (size_t)b * 4096 + kb_; const size_t blk = ((((grow >> 8) * 8 + hp) * 2 + ((grow >> 7) & 1)) * 2 + ((grow >> 6) & 1)) * 4 + ((grow >> 4) & 3); \
            glds16s(KPt + blk * 4096, voffKp, Lk + wid * 1024); \
            if (wid < 2) glds16s(KPEP + kb_ * 64, voffX, Lk + SK_KPE + wid * 1024); \
            if (wid == 2) { if (lane < 32) glds4s(RKPb + kb_, voffX, Lk + SK_RK); } } \
        else { const size_t kb_ = (size_t)(t_ - 256) * 16; \
            glds16s(KCh + kb_ * 128, voffKc, Lk + wid * 1024); \
            if (wid < 2) glds16s(KPEC + kb_ * 64, voffX, Lk + SK_KPE + wid * 1024); \
            if (wid == 2) { if (lane < 32) glds4s(RKCb + kb_, (unsigned)((((lane >> 4) & 1) * M + (lane & 15)) * 4), Lk + SK_RK); } } } while (0)
    __builtin_amdgcn_s_barrier();
    MS_ISSUE_K(0); MS_ISSUE_K(1); MS_ISSUE_K(2); MS_ISSUE_K(3); MS_ISSUE_C(0);
    bf16x8 qr[12];
    { const bf16_t* qp = Q + ((size_t)(row0 + r32) * NH + h) * 192 + hi * 8;
#pragma unroll
      for (int d0 = 0; d0 < 12; ++d0) qr[d0] = *(const bf16x8*)(qp + d0 * 16);
#pragma unroll
      for (int d0 = 0; d0 < 12; ++d0) asm volatile("" :: "v"(qr[d0])); }
    const int vrb = lh * 8 * 512 + att::v_rd_base(lane);
    bf16x8 pk[2] = {};
    for (int s = -1; s < NS; ++s) {
        if (s < 0) asm volatile("s_waitcnt vmcnt(0)" ::: "memory"); else if (wid < 3) asm volatile("s_waitcnt vmcnt(6)" ::: "memory"); else asm volatile("s_waitcnt vmcnt(4)" ::: "memory");
        __builtin_amdgcn_s_barrier();
        asm volatile("" ::: "memory");
        const bool mine = (lh == ((s + g) & 1));
        if (!mine && s >= 0) { pk[0] = *(const LAS bf16x8*)Pb; pk[1] = *(const LAS bf16x8*)(Pb + 16); }
        MS_ISSUE_C(2 * s + 3); MS_ISSUE_C(2 * s + 4); MS_ISSUE_K(2 * s + 6); MS_ISSUE_K(2 * s + 7);
        if (s >= 0) {
            asm volatile("" : "+v"(pk[0]), "+v"(pk[1]));
            const int vA = (int)(uintptr_t)(L + ((2 * s) % SC_NC) * SC_CS + vrb), vB = (int)(uintptr_t)(L + ((2 * s + 1) % SC_NC) * SC_CS + vrb);
            s16x4 lo[4], hh[4];
#define MS_TR(i) do { asm volatile("ds_read_b64_tr_b16 %0, %1 offset:%c2" : "=&v"(lo[(i) & 3]) : "v"((i) < 8 ? vA : vB), "i"(((i) & 7) * 512) : "memory"); \
                      asm volatile("ds_read_b64_tr_b16 %0, %1 offset:%c2" : "=&v"(hh[(i) & 3]) : "v"((i) < 8 ? vA : vB), "i"(((i) & 7) * 512 + 16 * 512) : "memory"); } while (0)
            __builtin_amdgcn_sched_barrier(0);
            MS_TR(0); MS_TR(1); MS_TR(2);
            __builtin_amdgcn_s_setprio(1);
#pragma unroll
            for (int i = 0; i < 16; ++i) {
                if (i + 3 < 16) { MS_TR(i + 3); asm volatile("s_waitcnt lgkmcnt(6)" ::: "memory"); }
                else if (i + 2 < 16) asm volatile("s_waitcnt lgkmcnt(4)" ::: "memory");
                else if (i + 1 < 16) asm volatile("s_waitcnt lgkmcnt(2)" ::: "memory");
                else asm volatile("s_waitcnt lgkmcnt(0)" ::: "memory");
                __builtin_amdgcn_sched_barrier(0);
                { const s16x4 l_ = lo[i & 3], h_ = hh[i & 3]; const bf16x8 vf = (bf16x8){l_[0], l_[1], l_[2], l_[3], h_[0], h_[1], h_[2], h_[3]};
                  o[i & 7] = __builtin_amdgcn_mfma_f32_32x32x16_bf16(pk[i >> 3], vf, o[i & 7], 0, 0, 0); }
                __builtin_amdgcn_sched_barrier(0);
            }
            __builtin_amdgcn_s_setprio(0);
#undef MS_TR
        }
        if (!mine && s + 1 < NS) {
            const LAS char* KA = L + SC_K0 + ((2 * s + 2) % SC_NK) * SC_KS; const LAS char* KB = L + SC_K0 + ((2 * s + 3) % SC_NK) * SC_KS;
            const LAS char* Lm = r32 < 16 ? KA : KB;
            const LAS char* Ks = Lm + g * 4096; const LAS char* Kp = Lm + SK_KPE; const int kr = r32 & 15;
            f32x16 p;
#pragma unroll
            for (int r = 0; r < 16; ++r) p[r] = 0.f;
            auto kfrag = [&](int d) -> bf16x8 { return d < 8 ? *(const LAS bf16x8*)(Ks + att::kswz<256>(kr, (d * 16 + hi * 8) * 2)) : *(const LAS bf16x8*)(Kp + att::kswz<128>(kr, ((d - 8) * 16 + hi * 8) * 2)); };
            bf16x8 kf[3];
            kf[0] = kfrag(0); kf[1] = kfrag(1);
            __builtin_amdgcn_s_setprio(1);
#pragma unroll
            for (int d0 = 0; d0 < 12; ++d0) {
                if (d0 + 2 < 12) kf[(d0 + 2) % 3] = kfrag(d0 + 2);
                p = __builtin_amdgcn_mfma_f32_32x32x16_bf16(kf[d0 % 3], qr[d0], p, 0, 0, 0);
            }
            __builtin_amdgcn_s_setprio(0);
            float ps = 0.f;
#pragma unroll
            for (int hf2 = 0; hf2 < 2; ++hf2) {
                f32x4 sc[2];
#pragma unroll
                for (int i2 = 0; i2 < 2; ++i2) { const LAS float* rk = (const LAS float*)((hf2 == 0 ? KA : KB) + SK_RK) + g * 16; sc[i2] = *(const LAS f32x4*)(rk + 8 * i2 + 4 * hi); }
#pragma unroll
                for (int i2 = 0; i2 < 2; ++i2)
#pragma unroll
                    for (int j = 0; j < 4; ++j) { const int i = hf2 * 2 + i2; const float e = __builtin_amdgcn_exp2f(fmaf(p[4 * i + j], sc[i2][j], negB2)); p[4 * i + j] = e; ps += e; }
                asm volatile("" ::: "memory");
            }
            l_part += ps;
#pragma unroll
            for (int hf = 0; hf < 2; ++hf) { const int B = hf * 8;
                const unsigned a0 = cvt_pk_bf16(p[B + 0], p[B + 1]), a1 = cvt_pk_bf16(p[B + 2], p[B + 3]), b0 = cvt_pk_bf16(p[B + 4], p[B + 5]), b1 = cvt_pk_bf16(p[B + 6], p[B + 7]);
                auto r0 = __builtin_amdgcn_permlane32_swap(a0, b0, false, false); auto r1 = __builtin_amdgcn_permlane32_swap(a1, b1, false, false);
                u32x4 w = {r0[0], r1[0], r0[1], r1[1]}; pk[hf] = __builtin_bit_cast(bf16x8, w); }
            *(LAS bf16x8*)Pb = pk[0]; *(LAS bf16x8*)(Pb + 16) = pk[1];
            LDS_WAIT();
        }
    }
#undef MS_ISSUE_C
#undef MS_ISSUE_K
    asm volatile("s_waitcnt vmcnt(0)" ::: "memory");
    const float lsum = att::lane_pair_sum(l_part);
    if (hi == 0) al_l[r32] = lsum;
    LDS_WAIT();
    __builtin_amdgcn_s_barrier();
    asm volatile("" ::: "memory");
    {
        const bool oddl = r32 & 1;
#pragma unroll
        for (int r = 0; r < 16; r += 2) { const int q = att::crow(r, hi); const float rl0 = __builtin_amdgcn_rcpf(al_l[q] + al_p[q]), rl1 = __builtin_amdgcn_rcpf(al_l[q + 1] + al_p[q + 1]);
            const int qrow = rg * 32 + q + (oddl ? 1 : 0);
#pragma unroll
            for (int d0 = 0; d0 < 8; ++d0) { const float va = o[d0][r] * rl0, vb2 = o[d0][r + 1] * rl1; const float recv = __shfl_xor(oddl ? va : vb2, 1);
                const int colB = ((lh * 8 + d0) * 32 + (r32 & ~1)) * 2;
                *(LAS unsigned*)(L + g * 65536 + att::kswz<1024>(qrow, colB)) = oddl ? cvt_pk_bf16(recv, vb2) : cvt_pk_bf16(va, recv); } }
    }
    LDS_WAIT();
    __builtin_amdgcn_s_barrier();
    asm volatile("" ::: "memory");
    {
        const int g2 = wid >> 2, rg2 = (wid >> 1) & 1, dvh = wid & 1, h2 = hp * 2 + g2;
        const bf16_t* Wuv = (const bf16_t*)(F.ws + WS_WUKV) + ((size_t)(h2 * 256 + 128 + dvh * 64 + r32)) * 512 + hi * 8;
        const int orow0 = M_P + b * 64 + rg2 * 32;
        bf16_t* out = (bf16_t*)(F.ws + ((PROBE_HOT != 0 && rep2) ? WS_VP : WS_AMLA)) + (size_t)orow0 * 2048 + h2 * 128 + dvh * 64; const bf16_t* z = (const bf16_t*)(F.ws + WS_ZM) + (size_t)orow0 * 2048 + h2 * 128 + dvh * 64;
        const bool odd = r32 & 1;
        unsigned zw[2][8];
#pragma unroll
        for (int k2 = 0; k2 < 2; ++k2)
#pragma unroll
            for (int r = 0; r < 16; r += 2) zw[k2][r >> 1] = *(const unsigned*)(z + (size_t)(att::crow(r, hi) + (odd ? 1 : 0)) * 2048 + k2 * 32 + (r32 & ~1));
        f32x16 acc[2];
#pragma unroll
        for (int k2 = 0; k2 < 2; ++k2)
#pragma unroll
            for (int r = 0; r < 16; ++r) acc[k2][r] = 0.f;
#pragma unroll 16
        for (int ks = 0; ks < 32; ++ks) {
            const bf16x8 a = *(const LAS bf16x8*)(L + g2 * 65536 + att::kswz<1024>(rg2 * 32 + r32, (ks * 16 + hi * 8) * 2));
            const bf16x8 bw0 = *(const bf16x8*)(Wuv + ks * 16), bw1 = *(const bf16x8*)(Wuv + (size_t)32 * 512 + ks * 16);
            acc[0] = __builtin_amdgcn_mfma_f32_32x32x16_bf16(a, bw0, acc[0], 0, 0, 0); acc[1] = __builtin_amdgcn_mfma_f32_32x32x16_bf16(a, bw1, acc[1], 0, 0, 0);
        }
#pragma unroll
        for (int k2 = 0; k2 < 2; ++k2)
#pragma unroll
            for (int r = 0; r < 16; r += 2) { const float va = acc[k2][r], vb2 = acc[k2][r + 1];
                const float recv = __shfl_xor(odd ? va : vb2, 1); const float v0 = odd ? recv : va, v1 = odd ? vb2 : recv; const unsigned w = zw[k2][r >> 1];
                *(unsigned*)(out + (size_t)(att::crow(r, hi) + (odd ? 1 : 0)) * 2048 + k2 * 32 + (r32 & ~1)) = cvt_pk_bf16(v0 * bf_lo(w), v1 * bf_hi(w)); }
    }
    __builtin_amdgcn_s_barrier();
}
template <bool SAMPLE>
__device__ __forceinline__ void cross_unit(const Ctx& F, int l, int x, int h, int dvh) {
    int tid = F.tid; asm volatile("" : "+v"(tid)); const int wid = F.wave, lane = tid & 63, r32 = lane & 31, hi = lane >> 5;
    if (SAMPLE) {
        LAS char* L = (LAS char*)F.lds; constexpr int XB = 49152; LAS float* al_l = (LAS float*)(L + 2 * XB) + wid * 32;
        const float* kf = F.in[I_CMK] + ((size_t)l * NSTREAM + x) * N_MEM * 1024 + h * 256; const float* vf = F.in[I_CMV] + ((size_t)l * NSTREAM + x) * N_MEM * 1024 + h * 256 + dvh * 128;
        __syncthreads();
        if (wid < 2) {
            const int row0 = M_P + x * 64 + wid * 32;
            bf16x8 qr[16];
            { const bf16_t* qp = (const bf16_t*)(F.ws + WS_XQN) + (size_t)(row0 + r32) * 1024 + h * 256 + hi * 8;
#pragma unroll
              for (int d0 = 0; d0 < 16; ++d0) qr[d0] = *(const bf16x8*)(qp + d0 * 16); }
            f32x16 o[4];
#pragma unroll
            for (int d = 0; d < 4; ++d)
#pragma unroll
                for (int r = 0; r < 16; ++r) o[d][r] = 0.f;
            float m_reg = -1e30f, l_reg = 0.f;
            const int vb = (int)(uintptr_t)(L + AX_V) + att::v_rd_base(lane);
            __builtin_amdgcn_s_setprio(1);
            for (int t = 0; t < 4; ++t) {
                __builtin_amdgcn_s_barrier();
                asm volatile("" ::: "memory");
                att::tile_step<16, 0, 4, 2, false, 512>(qr, o, m_reg, l_reg, L + (t & 1) * XB + AX_K, L + (t & 1) * XB + AX_K, vb + (t & 1) * XB, (const LAS float*)nullptr, al_l, r32, hi);
            }
            __builtin_amdgcn_s_setprio(0);
            att::finish<4>(o, l_reg, al_l, (bf16_t*)(F.ws + WS_AX) + (size_t)row0 * 1024 + h * 256 + dvh * 128, (const bf16_t*)(F.ws + WS_ZX) + (size_t)row0 * 1024 + h * 256 + dvh * 128, 1024, r32, hi);
        } else {
            const int lt = tid - 128;
            f32x4 ra[8][2], rb[8][2];
#define XS_LOAD(t, R) do { _Pragma("unroll") for (int i = 0; i < 8; ++i) { const int c = lt + 384 * i; const bool isk = c < 2048; const int cv = c - 2048; \
                const float* sp = isk ? kf + (size_t)((t) * 64 + (c >> 5)) * 1024 + (c & 31) * 8 : vf + (size_t)((t) * 64 + (cv >> 4)) * 1024 + (cv & 15) * 8; \
                R[i][0] = *(const f32x4*)sp; R[i][1] = *(const f32x4*)(sp + 4); } } while (0)
#define XS_STORE(t, R) do { LAS char* Lb = L + ((t) & 1) * XB; _Pragma("unroll") for (int i = 0; i < 8; ++i) { const int c = lt + 384 * i; const bool isk = c < 2048; const int cv = c - 2048; \
                const int dst = isk ? AX_K + att::kswz<512>(c >> 5, (c & 31) * 16) : AX_V + att::v_st<4>(cv >> 4, (cv & 15) * 8); \
                *(LAS u32x4*)(Lb + dst) = pack8(R[i][0], R[i][1]); } \
                LDS_WAIT(); __builtin_amdgcn_s_barrier(); asm volatile("" ::: "memory"); } while (0)
            XS_LOAD(0, ra);
            XS_LOAD(1, rb); XS_STORE(0, ra);
            XS_LOAD(2, ra); XS_STORE(1, rb);
            XS_LOAD(3, rb); XS_STORE(2, ra);
            XS_STORE(3, rb);
#undef XS_LOAD
#undef XS_STORE
        }
        return;
    }
    const int row0 = x * 256 + wid * 32;
    bf16x8 qr[16];
    { const bf16_t* qp = (const bf16_t*)(F.ws + WS_XQN) + (size_t)(row0 + r32) * 1024 + h * 256 + hi * 8;
#pragma unroll
      for (int d0 = 0; d0 < 16; ++d0) qr[d0] = *(const bf16x8*)(qp + d0 * 16);
#pragma unroll
      for (int d0 = 0; d0 < 16; ++d0) asm volatile("" :: "v"(qr[d0])); }
    f32x16 o[4];
#pragma unroll
    for (int d = 0; d < 4; ++d)
#pragma unroll
        for (int r = 0; r < 16; ++r) o[d][r] = 0.f;
    float m_reg = -1e30f, l_reg = 0.f;
    constexpr int XB = 49152;
    LAS char* L = (LAS char*)F.lds; LAS float* al_l = (LAS float*)(L + 3 * XB) + wid * 32;
    const int vb = (int)(uintptr_t)(L + AX_V) + att::v_rd_base(lane);
    const bf16_t* kb = (const bf16_t*)(F.ws + WS_MKB) + h * 256; const bf16_t* vbf = (const bf16_t*)(F.ws + WS_MVB) + h * 256 + dvh * 128;
#define XP_ISSUE(t) do { LAS char* Lb = L + ((t) % 3) * XB; const bf16_t* ks_ = kb + (size_t)(t) * 64 * 1024; const bf16_t* vs_ = vbf + (size_t)(t) * 64 * 1024; int ln_ = lane; asm volatile("" : "+v"(ln_)); \
        _Pragma("unroll") for (int j = 0; j < 4; ++j) { const int o16 = ((wid * 4 + j) * 64 + ln_) * 16, row = o16 >> 9, colB = (o16 & 511) ^ ((row & 7) << 4); glds16s(ks_, (unsigned)(row * 1024 + (colB >> 1)) * 2u, Lb + AX_K + (wid * 4 + j) * 1024); } \
        _Pragma("unroll") for (int j = 0; j < 2; ++j) glds16s(vs_, (unsigned)src_v1024(((wid * 2 + j) * 64 + ln_) * 16) * 2u, Lb + AX_V + (wid * 2 + j) * 1024); } while (0)
    __syncthreads();
    XP_ISSUE(0); XP_ISSUE(1); XP_ISSUE(2);
#pragma unroll 1
    for (int t = 0; t < 4; ++t) {
        if (t == 0) asm volatile("s_waitcnt vmcnt(12)" ::: "memory"); else if (t < 3) asm volatile("s_waitcnt vmcnt(6)" ::: "memory"); else asm volatile("s_waitcnt vmcnt(0)" ::: "memory");
        __builtin_amdgcn_s_barrier();
        asm volatile("" ::: "memory");
        if (t == 1) XP_ISSUE(3);
        att::tile_step<16, 0, 4, 2, false, 512, 2>(qr, o, m_reg, l_reg, L + (t % 3) * XB + AX_K, L + (t % 3) * XB + AX_K, vb + (t % 3) * XB, (const LAS float*)nullptr, al_l, r32, hi);
    }
#undef XP_ISSUE
    att::finish<4>(o, l_reg, al_l, (bf16_t*)(F.ws + WS_AX) + (size_t)row0 * 1024 + h * 256 + dvh * 128, (const bf16_t*)(F.ws + WS_ZX) + (size_t)row0 * 1024 + h * 256 + dvh * 128, 1024, r32, hi);
}
#ifndef ATT_ONLY
#define ATT_ONLY -1
#endif
#define ATT_ON(k) (ATT_ONLY < 0 || ATT_ONLY == (k))
constexpr int QN = 160;
__device__ __forceinline__ void phase_attention(const Ctx& F, int l, int rep) {
    (void)rep;
    unsigned* heads = (unsigned*)(F.ws + WS_CTL) + CW_QHEAD + 64 * 8 * l + 64 * 16 * rep;
    volatile LAS unsigned* slot = (volatile LAS unsigned*)(F.lds + MISC_OFF);
    float negB2;
    { const float* gq = F.in[I_GQN] + l * QK_HEAD; const float* gk = F.in[I_GKN] + l * QK_HEAD; const int ln = F.lane;
      float m1 = fmaxf(fabsf(gq[ln] * gk[ln]), fabsf(gq[64 + ln] * gk[64 + ln])), mq = fabsf(gq[128 + ln]), mk = fabsf(gk[128 + ln]);
#pragma unroll
      for (int o = 1; o < 64; o <<= 1) { m1 = fmaxf(m1, __shfl_xor(m1, o)); mq = fmaxf(mq, __shfl_xor(mq, o)); mk = fmaxf(mk, __shfl_xor(mk, o)); }
      negB2 = -(19.99f * 1.01f * fmaxf(m1, mq * mk) + 0.1f); }
    const int x0 = (int)(xb_xcc_id() & 7u);
    for (int step = 0; step < 8; ++step) {
        const int x = (x0 + step) & 7;
        for (;;) {
            if (F.tid == 0) slot[0] = __hip_atomic_fetch_add(heads + 64 * x, 1u, __ATOMIC_RELAXED, __HIP_MEMORY_SCOPE_AGENT);
            __syncthreads();
            int u = __builtin_amdgcn_readfirstlane((int)slot[0]);
            __syncthreads();
#ifdef QREP_TYPE
            if (u >= 2 * QN) break;
            bool rep2 = false;
            if (u >= QN) { u -= QN; rep2 = true; const int ty = u < 96 ? (u < 32 ? 0 : 1) : (u < 128 ? 2 : 3); if (QREP_TYPE != 9 && ty != QREP_TYPE) continue; }
#else
            const bool rep2 = false;
            if (u >= QN) break;
#endif
            if (u < 96) {
                if (u < 32) {
#if ATT_ON(0)
                    mla_sample_unit(F, 4 * x + (u >> 3), u & 7, negB2, rep2);
#endif
                } else {
#if ATT_ON(1)
                    const int j = u - 32; mla_prompt_unit(F, 2 * x + (j & 1), 31 - (j >> 1), negB2);
#endif
                }
            } else if (u < 128) {
#if ATT_ON(2)
                const int v = x * 32 + (u - 96); cross_unit<false>(F, l, v >> 3, (v >> 1) & 3, v & 1);
#endif
            } else {
#if ATT_ON(3)
                const int v = x * 32 + (u - 128); cross_unit<true>(F, l, v >> 3, (v >> 1) & 3, v & 1);
#endif
            }
        }
    }
}
#define rot(off) ((int)((F.bid + G - ((off) % G)) % G))
__device__ __forceinline__ void phase_b(const Ctx& F, int l) {
    const int G = F.G; (void)G;
            {
                pg8::Gemm g{(const bf16_t*)(F.ws + WS_HB), (const bf16_t*)(F.ws + WS_WIN), 2048, 2048, 2048};
                pg8::StaticOrder S; S.init(M, IN_PAD, G, rot(0));
                EpiWin E{F.ws, F.out, F.in[I_BMERGE] + (size_t)l * 6144, l};
                pg8::gemm_phase(F.lds, g, S, E);
            }
#ifdef DUP_B1
            {
                pg8::Gemm g{(const bf16_t*)(F.ws + WS_HB), (const bf16_t*)(F.ws + WS_WIN), 2048, 2048, 2048};
                pg8::StaticOrder S; S.init(M, IN_PAD, G, rot(0));
                EpiWin E{F.ws, F.out, F.in[I_BMERGE] + (size_t)l * 6144, l};
                pg8::gemm_phase(F.lds, g, S, E);
            }
#endif
#ifdef DUP_B1N
            {
                pg8::Gemm g{(const bf16_t*)(F.ws + WS_HB), (const bf16_t*)(F.ws + WS_WIN), 2048, 2048, 2048};
                pg8::StaticOrder S; S.init(M, IN_PAD, G, rot(0));
                EpiNone E{};
                pg8::gemm_phase(F.lds, g, S, E);
            }
#endif
            {
                pg8::Gemm g{(const bf16_t*)(F.ws + WS_MEMN), (const bf16_t*)(F.ws + WS_WMEM), 2048, 2048, 2048};
                pg8::StaticOrder S; S.init(N_MEM, 2048, G, rot(232));
                EpiF32 E{(float*)(F.ws + WS_KVRAW), 2048};
                pg8::gemm_phase(F.lds, g, S, E);
            }
            {
                pg8::Gemm g{(const bf16_t*)(F.ws + WS_CNP), (const bf16_t*)(F.ws + WS_WUK), 512, 512, 512};
                pg8::StaticOrder S; S.init(MPAST, 2048, G, rot(240));
                EpiK<> E{(bf16_t*)(F.ws + WS_KP), (float*)(F.ws + WS_SSP)};
                pg8::gemm_phase(F.lds, g, S, E);
            }
#ifdef DUP_B3
            {
                pg8::Gemm g{(const bf16_t*)(F.ws + WS_CNP), (const bf16_t*)(F.ws + WS_WUK), 512, 512, 512};
                pg8::StaticOrder S; S.init(MPAST, 2048, G, rot(240));
                EpiK<> E{(bf16_t*)(F.ws + WS_KP), (float*)(F.ws + WS_SSP)};
                pg8::gemm_phase(F.lds, g, S, E);
            }
#endif
#ifdef DUP_B3N
            {
                pg8::Gemm g{(const bf16_t*)(F.ws + WS_CNP), (const bf16_t*)(F.ws + WS_WUK), 512, 512, 512};
                pg8::StaticOrder S; S.init(MPAST, 2048, G, rot(240));
#ifndef DUP_B3N_K
#define DUP_B3N_K false
#endif
#ifndef DUP_B3N_S
#define DUP_B3N_S false
#endif
#ifndef DUP_B3N_T
#define DUP_B3N_T false
#endif
                EpiK<DUP_B3N_K, DUP_B3N_S, DUP_B3N_T> E{(bf16_t*)(F.ws + WS_VP), (float*)(F.ws + WS_VP) + (size_t)64 * 1024 * 1024};
                pg8::gemm_phase(F.lds, g, S, E);
            }
#endif
            past_kpe(F, l);
#ifdef DUP_B4
            past_kpe(F, l);
#endif
}
__device__ __forceinline__ void phase_d(const Ctx& F, int l) {
    const int G = F.G; (void)G;
            {
                pg8::Gemm g{(const bf16_t*)(F.ws + WS_QLATN), (const bf16_t*)(F.ws + WS_WUQ), 512, 512, 512};
                pg8::StaticOrder S; S.init(M, 3072, G, rot(0));
                EpiBf16 E{(bf16_t*)(F.ws + WS_QRAW), 3072};
                pg8::gemm_phase(F.lds, g, S, E);
            }
            {
                pg8::Gemm g{(const bf16_t*)(F.ws + WS_CKVN), (const bf16_t*)(F.ws + WS_WUKV), 512, 512, 512};
                pg8::StaticOrder S; S.init(M, 4096, G, rot(224));
                EpiKV<false> E{(bf16_t*)(F.ws + WS_KC), (bf16_t*)(F.ws + WS_VC), (float*)(F.ws + WS_SSC)};
                pg8::gemm_phase(F.lds, g, S, E);
            }
            {
                pg8::Gemm g{(const bf16_t*)(F.ws + WS_CV), (const bf16_t*)(F.ws + WS_WPW2), 1024, 1024, 1024};
                pg8::StaticOrder S; S.init(M, 1024, G, rot(96));
                EpiPw2 E{(bf16_t*)(F.ws + WS_ACONV), (const bf16_t*)(F.ws + WS_ZC), F.in[I_BPW2] + (size_t)l * 1024};
                pg8::gemm_phase(F.lds, g, S, E);
            }
}
__device__ __forceinline__ void phase_g(const Ctx& F, int l) {
    const int G = F.G; (void)G;
    const bool bal = (G == 256); const int cls = F.bid >> 6, j = F.bid & 63;
            {
                pg8::Gemm g{(const bf16_t*)(F.ws + WS_AMLA), (const bf16_t*)(F.ws + WS_WPM), 2048, 2048, 2048};
                EpiGate E{(bf16_t*)(F.ws + WS_PB), (const bf16_t*)(F.ws + WS_GATES), 0};
                pg8::ListOrder S; if (bal) S.init(M, 2048, (cls == 0 ? 0 : (cls == 1 ? 128 : 256)) + j, cls < 2 ? 2 : (cls == 2 ? 1 : 0), 64); else S.init(M, 2048, rot(0), (320 - rot(0) + G - 1) / G, G);
                pg8::gemm_phase(F.lds, g, S, E);
            }
            {
                pg8::Gemm g{(const bf16_t*)(F.ws + WS_ACONV), (const bf16_t*)(F.ws + WS_WPC), 1024, 1024, 1024};
                EpiGate E{(bf16_t*)(F.ws + WS_PB) + (size_t)M * 2048, (const bf16_t*)(F.ws + WS_GATES), 2048};
                pg8::ListOrder S; if (bal) S.init(M, 2048, (cls == 0 ? 0 : (cls == 2 ? 64 : 192)) + j, cls == 0 ? 1 : (cls == 1 ? 0 : 2), 64); else S.init(M, 2048, rot(64), (320 - rot(64) + G - 1) / G, G);
                pg8::gemm_phase(F.lds, g, S, E);
            }
            {
                pg8::Gemm g{(const bf16_t*)(F.ws + WS_AX), (const bf16_t*)(F.ws + WS_WPX), 1024, 1024, 1024};
                EpiGate E{(bf16_t*)(F.ws + WS_PB) + 2 * (size_t)M * 2048, (const bf16_t*)(F.ws + WS_GATES), 4096};
                pg8::ListOrder S; if (bal) S.init(M, 2048, (cls == 1 ? 0 : (cls == 2 ? 64 : 128)) + j, cls == 0 ? 0 : (cls == 3 ? 3 : 1), 64); else S.init(M, 2048, rot(128), (320 - rot(128) + G - 1) / G, G);
                pg8::gemm_phase(F.lds, g, S, E);
            }
}
__device__ __forceinline__ void phase_g2(const Ctx& F, int l) {
    const int G = F.G; (void)G;
            {
                const u32x4* p0 = (const u32x4*)(F.ws + WS_PB); const u32x4* p1 = p0 + (size_t)M * 256; const u32x4* p2 = p1 + (size_t)M * 256; u32x4* mo = (u32x4*)(F.ws + WS_MERGED);
                for (size_t i = (size_t)F.bid * 512 + F.tid; i < (size_t)M * 256; i += (size_t)G * 512) {
                    f32x4 a0, a1, b0, b1, c0, c1; unpack8(p0[i], a0, a1); unpack8(p1[i], b0, b1); unpack8(p2[i], c0, c1);
                    mo[i] = pack8(a0 + b0 + c0, a1 + b1 + c1);
                }
            }
}
__device__ __forceinline__ void phase_h(const Ctx& F, int l) {
    const int G = F.G; (void)G;
            {
                pg8::Gemm g{(const bf16_t*)(F.ws + WS_MERGED), (const bf16_t*)(F.ws + WS_WOUT), 2048, 2048, 2048};
                pg8::StaticOrder S; S.init(M, 2048, G, rot(64));
                const float* sp = l == 0 ? F.in[I_XP] : (const float*)(F.ws + WS_X1); const float* ss = l == 0 ? F.in[I_XS] : (const float*)(F.ws + WS_X1) + (size_t)M_P * 2048;
                float* dp = l == DEPTH - 1 ? F.out + O_YP : (float*)(F.ws + WS_X1); float* ds = l == DEPTH - 1 ? F.out + O_YS : (float*)(F.ws + WS_X1) + (size_t)M_P * 2048;
                EpiOut E{sp, ss, dp, ds};
                pg8::gemm_phase(F.lds, g, S, E);
            }
            if (l + 1 < DEPTH && h_early_ok(G)) { const int n2 = (M / 256) * (2048 / 256) - G, c = rot(64);
                if (c >= n2) prep_weights(F, l + 1, (c - n2) * 8 + F.wave, (G - n2) * 8, PW_EARLY); }
}
__global__ void __launch_bounds__(512, 2) trunk_fwd(Args args) {
    extern __shared__ __attribute__((aligned(16))) unsigned char lds_raw[];
    for (int u = threadIdx.x; u < (LDS_BYTES - SCRATCH_TOP) / 4; u += 512) ((LAS unsigned*)((LAS unsigned char*)lds_raw + SCRATCH_TOP))[u] = 0u;
    __syncthreads();
    XcdBarrier bar;
    { const __attribute__((address_space(4))) char* kp0 = (const __attribute__((address_space(4))) char*)__builtin_amdgcn_kernarg_segment_ptr();
      unsigned char* ws0 = *(unsigned char* const __attribute__((address_space(4)))*)(kp0 + 256);
      bar = xcd_barrier_post((unsigned*)(ws0 + WS_CTL) + CW_BAR, (volatile LAS unsigned*)((LAS unsigned char*)lds_raw + MISC_OFF) + 8); }
    const int lo = args.ph_lo, hi = args.ph_hi;
    int ph = 0;
#ifdef DBG_TIME
    if (blockIdx.x == 0 && threadIdx.x == 0) ((LAS unsigned long long*)((LAS unsigned char*)lds_raw + MISC_OFF + 256))[0] = __builtin_amdgcn_s_memrealtime();
#endif
#define PH_BEGIN if (ph >= lo && ph < hi) { Ctx F; { const __attribute__((address_space(4))) char* kp = (const __attribute__((address_space(4))) char*)__builtin_amdgcn_kernarg_segment_ptr(); asm volatile("" : "+s"(kp)); \
        F.in = (karg_in_t)kp; F.out = *(float* const __attribute__((address_space(4)))*)(kp + 248); F.ws = *(unsigned char* const __attribute__((address_space(4)))*)(kp + 256); \
        F.lds = (LAS unsigned char*)lds_raw; int tz = threadIdx.x; asm volatile("" : "+v"(tz)); F.tid = tz; F.lane = tz & 63; F.wave = __builtin_amdgcn_readfirstlane(tz >> 6); F.G = gridDim.x; F.bid = blockIdx.x; } const int G = F.G; (void)G;
#ifdef DBG_TIME
#define PH_END   if (ph + 1 < hi) xcd_barrier(bar); } ++ph; if (blockIdx.x == 0 && threadIdx.x == 0 && ph < 24) ((LAS unsigned long long*)((LAS unsigned char*)lds_raw + MISC_OFF + 256))[ph] = __builtin_amdgcn_s_memrealtime();
#else
#define PH_END   if (ph + 1 < hi) xcd_barrier(bar); } ++ph;
#endif

    for (int l = 0; l < DEPTH; ++l) {
        PH_BEGIN
#if PH_ON(0)
            REP(0) {
            phase_prep(F, l);
            }
#endif
        PH_END
        PH_BEGIN
#if PH_ON(1)
            phase_b(F, l);
#ifdef DUP_1
            phase_b(F, l);
#endif
#endif
        PH_END
        PH_BEGIN
#if PH_ON(2)
            REP(2) {
            phase_c(F, l);
#ifdef DUP_2
            phase_c(F, l);
#endif
            }
#endif
        PH_END
        PH_BEGIN
#if PH_ON(3)
            phase_d(F, l);
#ifdef DUP_3
            phase_d(F, l);
#endif
#endif
        PH_END
        PH_BEGIN
#if PH_ON(4)
            REP(4) {
            phase_e(F, l);
#ifdef DUP_4
            phase_e(F, l);
#endif
            }
#endif
        PH_END
        PH_BEGIN
#if PH_ON(5)
            REP(5) {
            phase_attention(F, l, 0);
#ifdef DUP_5
            phase_attention(F, l, 1);
#endif
            }
#endif
        PH_END
        PH_BEGIN
#if PH_ON(6)
            phase_g(F, l);
#ifdef DUP_6
            phase_g(F, l);
#endif
#endif
        PH_END
        PH_BEGIN
#if PH_ON(8)
            phase_g2(F, l);
#ifdef DUP_8
            phase_g2(F, l);
#endif
#endif
        PH_END
        PH_BEGIN
#if PH_ON(7)
            phase_h(F, l);
#ifdef DUP_7
            phase_h(F, l);
#endif
#endif
        PH_END
    }


#ifdef DBG_TIME
    {
        xcd_barrier(bar);
        if (blockIdx.x == 0) {
            const __attribute__((address_space(4))) char* kp = (const __attribute__((address_space(4))) char*)__builtin_amdgcn_kernarg_segment_ptr();
            float* outp = *(float* const __attribute__((address_space(4)))*)(kp + 248);
            const LAS unsigned long long* st = (const LAS unsigned long long*)((LAS unsigned char*)lds_raw + MISC_OFF + 256);
            __syncthreads();
            const size_t offs[10] = {O_YP, O_YS, O_PCKV, O_PKR, O_PMK, O_PMV, O_PCONV, O_SCKV, O_SKR, O_SCONV};
#pragma unroll
            for (int k = 0; k < 10; ++k) {
                const int a = DBG_TIME + k, b = (k == 9 ? 18 : DBG_TIME + k + 1);
                unsigned us = (unsigned)((st[b] - st[a]) / 100ull) + 1u; if (us > 60000u) us = 60000u;
                for (unsigned i = threadIdx.x; i < us; i += 512) outp[offs[k] + i] = __uint_as_float(0xAAAAAAAAu);
            }
        }
    }
#endif
#ifdef DBG_DUMP
    {
        const __attribute__((address_space(4))) char* kp = (const __attribute__((address_space(4))) char*)__builtin_amdgcn_kernarg_segment_ptr();
        float* outp = *(float* const __attribute__((address_space(4)))*)(kp + 248); unsigned char* wsp = *(unsigned char* const __attribute__((address_space(4)))*)(kp + 256);
        unsigned* bins = (unsigned*)wsp + 65536;
        if (hi == 1000 || (MK_N_LAUNCHES == 1 && hi == NPH_RUN)) {
            if (hi != 1000) xcd_barrier(bar);
            const size_t lo_b = DBG_LO, hi_b = DBG_HI;
            for (size_t i = (size_t)blockIdx.x * 512 + threadIdx.x; i < O_END; i += (size_t)gridDim.x * 512) outp[i] = 0.f;
            const int gwv = blockIdx.x * 8 + (threadIdx.x >> 6), lanev = threadIdx.x & 63;
            const size_t nchunk = (hi_b - lo_b) >> 10;
            for (size_t c = gwv; c < nchunk; c += (size_t)gridDim.x * 8) {
                const u32x4 w = *(const u32x4*)(wsp + lo_b + (c << 10) + lanev * 16);
                unsigned s = (w.x * 0x9E3779B1u) ^ (w.y * 0x85EBCA77u) ^ (w.z * 0xC2B2AE3Du) ^ (w.w * 0x27D4EB2Fu); s *= (2u * lanev + 1u) * 0x165667B1u; s ^= s >> 15;
#pragma unroll
                for (int o = 1; o < 64; o <<= 1) s += __shfl_xor(s, o);
                if (lanev == 0) __hip_atomic_fetch_xor(bins + (c & 1023), s * 0x9E3779B1u, __ATOMIC_RELAXED, __HIP_MEMORY_SCOPE_AGENT);
            }
            if (hi != 1000) xcd_barrier(bar);
        }
        if (hi == 1001 || (MK_N_LAUNCHES == 1 && hi == NPH_RUN)) {
            if (blockIdx.x == 0) for (int i = threadIdx.x; i < 1024; i += 512) outp[i] = (float)(__hip_atomic_load(bins + i, __ATOMIC_RELAXED, __HIP_MEMORY_SCOPE_AGENT) & 0xffffffu) + 1.0f;
        }
    }
#endif
#undef PH_BEGIN
#undef PH_END
}

extern "C" void kernel_launch(void* const* d_in, const int* in_sizes, int n_in, void* d_out, int out_size, void* d_ws, size_t ws_size, hipStream_t stream) {
    static int grid = 0;
    if (grid == 0) {
        if (n_in != 31 || (size_t)out_size != O_END || ws_size < WS_END) {
            fprintf(stderr, "kernel_launch: built for 31 inputs, %zu outputs, >= %zu bytes of workspace; got n_in %d, out %d, ws %zu; nothing launched\n", (size_t)O_END, (size_t)WS_END, n_in, out_size, ws_size);
            grid = -1; return; }
        int dev = 0, cus = 0, per_cu = 0;
        if (hipGetDevice(&dev) != hipSuccess || hipDeviceGetAttribute(&cus, hipDeviceAttributeMultiprocessorCount, dev) != hipSuccess) { fprintf(stderr, "kernel_launch: device query failed\n"); grid = -1; return; }
        if (hipFuncSetAttribute((const void*)trunk_fwd, hipFuncAttributeMaxDynamicSharedMemorySize, LDS_BYTES) != hipSuccess) { fprintf(stderr, "kernel_launch: hipFuncSetAttribute failed\n"); grid = -1; return; }
        if (hipOccupancyMaxActiveBlocksPerMultiprocessor(&per_cu, (const void*)trunk_fwd, 512, LDS_BYTES) != hipSuccess || per_cu < 1)
            fprintf(stderr, "kernel_launch: note: occupancy query reports %d workgroups per CU\n", per_cu);
        (void)hipGetLastError();
        grid = cus;
    }
    if (grid < 0) return;
    if (hipMemsetAsync((char*)d_ws + WS_CTL, 0, CTL_BYTES, stream) != hipSuccess) { fprintf(stderr, "kernel_launch: memset failed\n"); return; }
    Args a{};
    for (int i = 0; i < 31; ++i) a.in[i] = (const float*)d_in[i];
    a.out = (float*)d_out; a.ws = (unsigned char*)d_ws;
    constexpr int NPH = NPH_RUN;
    if (MK_N_LAUNCHES == 1) {
        a.ph_lo = 0; a.ph_hi = NPH;
        hipLaunchKernelGGL(trunk_fwd, dim3(grid), dim3(512), LDS_BYTES, stream, a);
    } else {
        for (int p = 0; p < NPH; ++p) { a.ph_lo = p; a.ph_hi = p + 1; hipLaunchKernelGGL(trunk_fwd, dim3(grid), dim3(512), LDS_BYTES, stream, a); }
#ifdef DBG_DUMP
        a.ph_lo = 1000; a.ph_hi = 1000; hipLaunchKernelGGL(trunk_fwd, dim3(grid), dim3(512), LDS_BYTES, stream, a);
        a.ph_lo = 1001; a.ph_hi = 1001; hipLaunchKernelGGL(trunk_fwd, dim3(grid), dim3(512), LDS_BYTES, stream, a);
#endif
    }
    const hipError_t le = hipPeekAtLastError();
    if (le != hipSuccess) fprintf(stderr, "kernel_launch: launch failed: %s\n", hipGetErrorName(le));
}
```

```cpp
#include <hip/hip_runtime.h>
#include <cstdio>
#include <cstdint>

#define LAS __attribute__((address_space(3)))
#define GAS __attribute__((address_space(1)))
typedef unsigned short bf16_t;
typedef short bf16x8 __attribute__((ext_vector_type(8)));
typedef short s16x4 __attribute__((ext_vector_type(4)));
typedef float f32x2 __attribute__((ext_vector_type(2)));
typedef float f32x4 __attribute__((ext_vector_type(4)));
typedef float f32x16 __attribute__((ext_vector_type(16)));
typedef unsigned u32x2 __attribute__((ext_vector_type(2)));
typedef unsigned u32x4 __attribute__((ext_vector_type(4)));
typedef GAS unsigned gu32;

#ifndef PH_ONLY
#define PH_ONLY -1
#endif
#define PH_ON(k) (PH_ONLY < 0 || PH_ONLY == (k))
#ifndef REPEAT_MASK
#define REPEAT_MASK 0
#endif
#define REP(k) for (int rep_ = 0; rep_ < (((REPEAT_MASK) >> (k)) & 1) + 1; ++rep_)
#ifndef NPH_RUN
#define NPH_RUN 18
#endif
#ifndef MK_N_LAUNCHES
#define MK_N_LAUNCHES 1
#endif

constexpr int D_MODEL = 2048, M_P = 8192, M_S = 2048, M = M_P + M_S, DEPTH = 2, NSTREAM = 32, DEC_SEQ = 64, PAST = 4096;
constexpr int NH = 16, QK_HEAD = 192, Q_LORA = 512, KV_LORA = 512;
constexpr int CONV_W = 1024, CONV_K = 31, CONV_ST = 30, N_MEM = 256, XW = 1024;
constexpr int IN_COLS = 14400, IN_PAD = 14592;
constexpr int MPAST = NSTREAM * PAST;
constexpr float EPS = 1e-6f;
constexpr float LOG2E = 1.4426950408889634f;
constexpr float C_MLA = 0.07216878364870323f * LOG2E;
constexpr float C_X = 0.0625f * LOG2E;

constexpr size_t O_YP = 0, O_YS = 16777216, O_PCKV = 20971520, O_PKR = 29360128, O_PMK = 30408704, O_PMV = 30932992,
                 O_PCONV = 31457280, O_SCKV = 31518720, O_SKR = 33615872, O_SCONV = 33878016, O_END = 35844096;

constexpr size_t al256(size_t x) { return (x + 255) / 256 * 256; }
constexpr size_t WS_CTL = 0, CTL_BYTES = 1u << 20;
constexpr size_t WS_WIN = WS_CTL + CTL_BYTES;
constexpr size_t WS_WUQ = WS_WIN + (size_t)IN_PAD * 2048 * 2;
constexpr size_t WS_WUKV = WS_WUQ + (size_t)3072 * 512 * 2;
constexpr size_t WS_WPW2 = WS_WUKV + (size_t)4096 * 512 * 2;
constexpr size_t WS_WMEM = WS_WPW2 + (size_t)1024 * 1024 * 2;
constexpr size_t WS_WPM = WS_WMEM + (size_t)2048 * 2048 * 2;
constexpr size_t WS_WPC = WS_WPM + (size_t)2048 * 2048 * 2;
constexpr size_t WS_WPX = WS_WPC + (size_t)2048 * 1024 * 2;
constexpr size_t WS_WOUT = WS_WPX + (size_t)2048 * 1024 * 2;
constexpr size_t WS_ROPE = WS_WOUT + (size_t)2048 * 2048 * 2;
constexpr size_t WS_CNP = WS_ROPE + (size_t)8192 * 64 * 4;
constexpr size_t WS_KPEP = WS_CNP + (size_t)MPAST * 512 * 2;
constexpr size_t WS_SSPEP = WS_KPEP + (size_t)MPAST * 64 * 2;
constexpr size_t WS_KP = WS_SSPEP + (size_t)MPAST * 4;
constexpr size_t WS_VP = WS_KP + (size_t)MPAST * 2048 * 2;
constexpr size_t WS_SSP = WS_VP + (size_t)MPAST * 2048 * 2;
constexpr size_t WS_HB = WS_SSP + (size_t)MPAST * 16 * 4 * 4;
constexpr size_t WS_QRAW = WS_HB;
constexpr size_t WS_QLATF = WS_HB + (size_t)M * 3072 * 2;
constexpr size_t WS_QLATN = WS_QLATF + (size_t)M * 512 * 4;
constexpr size_t WS_CKVN = WS_QLATN + (size_t)M * 512 * 2;
constexpr size_t WS_ZM = WS_CKVN + (size_t)M * 512 * 2;
constexpr size_t WS_UB = WS_ZM + (size_t)M * 2048 * 2;
constexpr size_t WS_ZC = WS_UB + (size_t)M * 1024 * 2;
constexpr size_t WS_XQ = WS_ZC + (size_t)M * 1024 * 2;
constexpr size_t WS_ZX = WS_XQ + (size_t)M * 1024 * 2;
constexpr size_t WS_GATES = WS_ZX + (size_t)M * 1024 * 2;
constexpr size_t WS_CV = WS_GATES + (size_t)M * 6144 * 2;
constexpr size_t WS_Q = WS_CV + (size_t)M * 1024 * 2;
constexpr size_t WS_KC = WS_Q + (size_t)M * 3072 * 2;
constexpr size_t WS_VC = WS_KC + (size_t)M * 2048 * 2;
constexpr size_t WS_SSC = WS_VC + (size_t)M * 2048 * 2;
constexpr size_t WS_KPEC = WS_SSC + (size_t)M * 16 * 4 * 4;
constexpr size_t WS_SSPEC = WS_KPEC + (size_t)M * 64 * 2;
constexpr size_t WS_AMLA = al256(WS_SSPEC + (size_t)M * 4);
constexpr size_t WS_ACONV = WS_AMLA + (size_t)M * 2048 * 2;
constexpr size_t WS_AX = WS_ACONV + (size_t)M * 1024 * 2;
constexpr size_t WS_X1 = WS_AX + (size_t)M * 1024 * 2;
constexpr size_t WS_MEMN = WS_X1 + (size_t)M * 2048 * 4;
constexpr size_t WS_KVRAW = WS_MEMN + (size_t)256 * 2048 * 2;
constexpr size_t WS_MKB = WS_KVRAW + (size_t)256 * 2048 * 4;
constexpr size_t WS_MVB = WS_MKB + (size_t)256 * 1024 * 2;
constexpr size_t WS_RKC = WS_MVB + (size_t)256 * 1024 * 2;
constexpr size_t WS_RKP = WS_RKC + (size_t)16 * M * 4;
constexpr size_t WS_XQN = WS_RKP + (size_t)MPAST * 16 * 4;
constexpr size_t WS_WUK = WS_XQN + (size_t)M * 1024 * 2;
constexpr size_t WS_END = WS_WUK + (size_t)2048 * 512 * 2;
constexpr size_t WS_PB = WS_KP;
constexpr size_t WS_MERGED = WS_KP + 3 * (size_t)M * 2048 * 2;
static_assert(sizeof(void*) == 8, "");
static_assert(WS_END <= 2147483648ull, "workspace map exceeds 2 GiB");
static_assert(WS_MERGED + (size_t)M * 2048 * 2 <= WS_VP, "merged overlay inside KP");

constexpr int CW_BAR = 4096;
constexpr int CW_QHEAD = 16384;

constexpr int RING_BYTES = 131072, SCRATCH_TOP = 161536, MISC_OFF = SCRATCH_TOP + 320, LDS_BYTES = 163840;

typedef __bf16 bf16x2_t __attribute__((ext_vector_type(2)));
__device__ __forceinline__ unsigned cvt_pk_bf16(float lo, float hi) { f32x2 v = {lo, hi}; bf16x2_t b = __builtin_convertvector(v, bf16x2_t); return __builtin_bit_cast(unsigned, b); }
__device__ __forceinline__ float bf_lo(unsigned w) { return __uint_as_float(w << 16); }
__device__ __forceinline__ float bf_hi(unsigned w) { return __uint_as_float(w & 0xffff0000u); }
__device__ __forceinline__ float sigmoidf_(float x) { return __builtin_amdgcn_rcpf(1.0f + __builtin_amdgcn_exp2f(-x * LOG2E)); }
__device__ __forceinline__ float siluf_(float x) { return x * sigmoidf_(x); }
__device__ __forceinline__ float wave_sum(float v) {
#pragma unroll
    for (int o = 1; o < 64; o <<= 1) v += __shfl_xor(v, o);
    return v;
}
__device__ __forceinline__ u32x4 pack8(const f32x4 a, const f32x4 b) {
    u32x4 w; w.x = cvt_pk_bf16(a[0], a[1]); w.y = cvt_pk_bf16(a[2], a[3]); w.z = cvt_pk_bf16(b[0], b[1]); w.w = cvt_pk_bf16(b[2], b[3]); return w;
}
__device__ __forceinline__ void unpack8(const u32x4 w, f32x4& a, f32x4& b) {
    a = (f32x4){bf_lo(w.x), bf_hi(w.x), bf_lo(w.y), bf_hi(w.y)}; b = (f32x4){bf_lo(w.z), bf_hi(w.z), bf_lo(w.w), bf_hi(w.w)};
}
#define LDS_WAIT() asm volatile("s_waitcnt lgkmcnt(0)" ::: "memory")
#define VM_WAIT() asm volatile("s_waitcnt vmcnt(0)" ::: "memory")

namespace pg8 {
constexpr int BM = 256, BK = 64, HALF = 128, HTB = HALF * BK * 2, STAGE_BYTES = 8 * HTB, NXCD = 8, WGM = 8;
__host__ __device__ __forceinline__ int lds_byte(int r, int c) { const int st = (r >> 4) * 2 + (c >> 5), rr = r & 15, cc = c & 31, ob = rr * 64 + cc * 2; return st * 1024 + (ob ^ (((ob >> 9) & 1) << 5)); }
__host__ __device__ __forceinline__ void stage_rc(int b, int& R, int& C) { const int st = b / 1024, sb = b % 1024, swz = sb ^ (((sb >> 9) & 1) << 5); R = (st >> 1) * 16 + swz / 64; C = (st & 1) * 32 + (swz % 64) / 2; }
__host__ __device__ __forceinline__ int perm32(int rho) { const int n = rho >> 4, i = rho & 15; return 8 * (i >> 2) + 4 * n + (i & 3); }
struct Unit { int pm, pn; };
struct Gemm { const bf16_t* A; const bf16_t* Bt; int lda, ldb, K; };
struct StaticOrder {
    int nM, nN, nwg, G, c;
    __device__ void init(int M_, int N_, int G_, int c_) { nM = M_ / BM; nN = N_ / BM; nwg = nM * nN; G = G_; c = c_; }
    __device__ bool next(int i, Unit& u) const {
        const long L = (long)i * G + c; if (L >= nwg) return false;
        int wgid = (int)L; { const int q = nwg / NXCD, r = nwg % NXCD, xcd = wgid % NXCD, off = wgid / NXCD; wgid = (xcd < r ? xcd * (q + 1) : r * (q + 1) + (xcd - r) * q) + off; }
        const int nig = WGM * nN, gid = wgid / nig, fm = gid * WGM, gsz = (nM - fm) < WGM ? (nM - fm) : WGM;
        u.pm = fm + ((wgid % nig) % gsz); u.pn = (wgid % nig) / gsz; return true;
    }
};
struct ListOrder {
    int nM, nN, nwg, L0, n, stride;
    __device__ void init(int M_, int N_, int L0_, int n_, int stride_) { nM = M_ / BM; nN = N_ / BM; nwg = nM * nN; L0 = L0_; n = n_; stride = stride_; }
    __device__ bool next(int i, Unit& u) const {
        if (i >= n) return false;
        int wgid = L0 + i * stride; { const int q = nwg / NXCD, r = nwg % NXCD, xcd = wgid % NXCD, off = wgid / NXCD; wgid = (xcd < r ? xcd * (q + 1) : r * (q + 1) + (xcd - r) * q) + off; }
        const int nig = WGM * nN, gid = wgid / nig, fm = gid * WGM, gsz = (nM - fm) < WGM ? (nM - fm) : WGM;
        u.pm = fm + ((wgid % nig) % gsz); u.pn = (wgid % nig) / gsz; return true;
    }
};
template <class Epi, class Sched>
__device__ __forceinline__ void gemm_phase(LAS unsigned char* lds, const Gemm g, const Sched& S, const Epi& E) {
    int tid = threadIdx.x; asm volatile("" : "+v"(tid));
    const int wid = __builtin_amdgcn_readfirstlane(tid >> 6), lane = tid & 63, wr = wid >> 2, wc = wid & 3, fr = lane & 15, fq = lane >> 4;
    const int K = g.K, nt = K / BK;
    unsigned voffA[2], voffB[2];
#pragma unroll
    for (int i = 0; i < 2; ++i) { int R, C; stage_rc(tid * 16 + i * 8192, R, C); const int Rb = (R & ~31) + perm32(R & 31);
        voffA[i] = (unsigned)(R * g.lda + C) * 2u; voffB[i] = (unsigned)(Rb * g.ldb + C) * 2u; }
    const size_t kstep = (size_t)(BK * 2);
    const size_t hA = (size_t)HALF * g.lda * 2, hB = (size_t)HALF * g.ldb * 2;
    const size_t tA = 2 * hA, tB = 2 * hB;
    const unsigned ldsw = (unsigned)wid * 1024u;
    const int aoff = lds_byte(wr * 64 + fr, fq * 8), boff = lds_byte(wc * 32 + fr, fq * 8);
#define PG8_SA(b, h) (((b) * 2 + (h)) * HTB)
#define PG8_SB(b, h) ((4 + (b) * 2 + (h)) * HTB)
#define PG8_STAGE(bufoff, gbase, voff) do { _Pragma("unroll") for (int _i = 0; _i < 2; ++_i) \
        __builtin_amdgcn_global_load_lds((const unsigned*)((const char*)(gbase) + (voff)[_i]), (LAS unsigned*)(lds + (bufoff) + ldsw + _i * 8192), 16, 0, 0); } while (0)
#define PG8_LDA(dst, b, h) do { _Pragma("unroll") for (int m = 0; m < 4; ++m) _Pragma("unroll") for (int k = 0; k < 2; ++k) dst[m][k] = *(const LAS bf16x8*)(lds + PG8_SA(b, h) + aoff + m * 2048 + k * 1024); } while (0)
#define PG8_LDB(dst, b, h) do { _Pragma("unroll") for (int n = 0; n < 2; ++n) _Pragma("unroll") for (int k = 0; k < 2; ++k) dst[n][k] = *(const LAS bf16x8*)(lds + PG8_SB(b, h) + boff + n * 2048 + k * 1024); } while (0)
#define PG8_MMA(ai, bj, At, Bt) do { __builtin_amdgcn_s_setprio(1); _Pragma("unroll") for (int m = 0; m < 4; ++m) _Pragma("unroll") for (int n = 0; n < 2; ++n) _Pragma("unroll") for (int k = 0; k < 2; ++k) \
        acc[ai][bj][m][n] = __builtin_amdgcn_mfma_f32_16x16x32_bf16(Bt[n][k], At[m][k], acc[ai][bj][m][n], 0, 0, 0); __builtin_amdgcn_s_setprio(0); } while (0)
#define PG8_WAIT_V(n) asm volatile("s_waitcnt vmcnt(" #n ")" ::: "memory")
#define PG8_WAIT_L(n) asm volatile("s_waitcnt lgkmcnt(" #n ")" ::: "memory")
#define PG8_BAR __builtin_amdgcn_s_barrier()
#define PG8_SCHED __builtin_amdgcn_sched_barrier(0)
    Unit cur, nxt; int ui = 0;
    if (!S.next(0, cur)) return;
    f32x4 acc[2][2][4][2];
#pragma unroll
    for (int a = 0; a < 2; ++a)
#pragma unroll
        for (int b = 0; b < 2; ++b)
#pragma unroll
            for (int m = 0; m < 4; ++m)
#pragma unroll
                for (int n = 0; n < 2; ++n) acc[a][b][m][n] = (f32x4){0.f, 0.f, 0.f, 0.f};
    bf16x8 At[4][2], B0[2][2], B1[2][2];
    const char* cA = (const char*)g.A + (size_t)cur.pm * tA; const char* cB = (const char*)g.Bt + (size_t)cur.pn * tB;
    PG8_STAGE(PG8_SB(0, 0), cB, voffB); PG8_STAGE(PG8_SB(0, 1), cB + hB, voffB); PG8_STAGE(PG8_SA(0, 0), cA, voffA); PG8_STAGE(PG8_SA(0, 1), cA + hA, voffA);
    if (wr == 1) PG8_BAR;
    PG8_WAIT_V(2); PG8_BAR;
    PG8_STAGE(PG8_SB(1, 0), cB + kstep, voffB); PG8_STAGE(PG8_SA(1, 0), cA + kstep, voffA); PG8_STAGE(PG8_SB(1, 1), cB + hB + kstep, voffB);
    PG8_WAIT_V(6); PG8_BAR;
    for (;;) {
        const bool has_next = S.next(ui + 1, nxt);
        const char* nA = has_next ? (const char*)g.A + (size_t)nxt.pm * tA : cA; const char* nB = has_next ? (const char*)g.Bt + (size_t)nxt.pn * tB : cB;
        for (int t = 0; t < nt; t += 2) {
            const bool last = (t == nt - 2);
            const char* a1 = cA + (size_t)(t + 1) * kstep;
            const char* a2 = last ? nA : cA + (size_t)(t + 2) * kstep; const char* b2 = last ? nB : cB + (size_t)(t + 2) * kstep;
            const char* a3 = a2 + kstep; const char* b3 = b2 + kstep;
            PG8_LDB(B0, 0, 0); PG8_LDB(B1, 0, 1); PG8_SCHED; PG8_LDA(At, 0, 0); PG8_STAGE(PG8_SA(1, 1), a1 + hA, voffA);
            PG8_WAIT_V(8); PG8_WAIT_L(0); PG8_BAR; PG8_MMA(0, 0, At, B0); PG8_MMA(0, 1, At, B1); PG8_BAR; PG8_SCHED;
            PG8_LDA(At, 0, 1); PG8_STAGE(PG8_SB(0, 0), b2, voffB); PG8_STAGE(PG8_SB(0, 1), b2 + hB, voffB); PG8_STAGE(PG8_SA(0, 0), a2, voffA);
            PG8_WAIT_V(8); PG8_WAIT_L(0); PG8_BAR; PG8_MMA(1, 0, At, B0); PG8_MMA(1, 1, At, B1); PG8_BAR; PG8_SCHED;
            PG8_LDB(B0, 1, 0); PG8_LDB(B1, 1, 1); PG8_SCHED; PG8_LDA(At, 1, 0); PG8_STAGE(PG8_SA(0, 1), a2 + hA, voffA);
            PG8_WAIT_V(8); PG8_WAIT_L(0); PG8_BAR; PG8_MMA(0, 0, At, B0); PG8_MMA(0, 1, At, B1); PG8_BAR; PG8_SCHED;
            PG8_LDA(At, 1, 1); PG8_STAGE(PG8_SB(1, 0), b3, voffB); PG8_STAGE(PG8_SB(1, 1), b3 + hB, voffB); PG8_STAGE(PG8_SA(1, 0), a3, voffA);
            PG8_WAIT_V(8); PG8_WAIT_L(0); PG8_BAR; PG8_MMA(1, 0, At, B0); PG8_MMA(1, 1, At, B1); PG8_BAR; PG8_SCHED;
        }
        if (wr == 0) PG8_BAR;
        E(acc, cur);
        if (!has_next) break;
#pragma unroll
        for (int a = 0; a < 2; ++a)
#pragma unroll
            for (int b = 0; b < 2; ++b)
#pragma unroll
                for (int m = 0; m < 4; ++m)
#pragma unroll
                    for (int n = 0; n < 2; ++n) acc[a][b][m][n] = (f32x4){0.f, 0.f, 0.f, 0.f};
        cur = nxt; cA = nA; cB = nB; ++ui;
        if (wr == 1) PG8_BAR;
    }
    PG8_WAIT_V(0);
    PG8_BAR;
#undef PG8_SA
#undef PG8_SB
#undef PG8_STAGE
#undef PG8_LDA
#undef PG8_LDB
#undef PG8_MMA
#undef PG8_WAIT_V
#undef PG8_WAIT_L
#undef PG8_BAR
#undef PG8_SCHED
}
}
using pg8::Unit;

#define EPI_LANE int tz_ = threadIdx.x; asm volatile("" : "+v"(tz_)); const int wr = tz_ >> 8, wc = (tz_ >> 6) & 3, fr = tz_ & 15, fq = (tz_ >> 4) & 3; (void)wr; (void)wc; (void)fr; (void)fq;
#define EPI_LOOP_BEGIN \
    _Pragma("unroll") for (int ai = 0; ai < 2; ++ai) _Pragma("unroll") for (int m = 0; m < 4; ++m) { const int row = u.pm * 256 + ai * 128 + wr * 64 + m * 16 + fr; \
    _Pragma("unroll") for (int bj = 0; bj < 2; ++bj) { const int colt = bj * 128 + wc * 32 + 8 * fq; const f32x4 v0 = acc[ai][bj][m][0], v1 = acc[ai][bj][m][1]; (void)colt; (void)v0; (void)v1;
#define EPI_LOOP_END } }

struct EpiBf16 {
    bf16_t* O; int ldc;
    __device__ __forceinline__ void operator()(const f32x4 (&acc)[2][2][4][2], const Unit& u) const {
        EPI_LANE
        EPI_LOOP_BEGIN
            *(u32x4*)(O + (size_t)row * ldc + u.pn * 256 + colt) = pack8(v0, v1);
        EPI_LOOP_END
    }
};
struct EpiNone { __device__ __forceinline__ void operator()(const f32x4 (&acc)[2][2][4][2], const Unit& u) const { (void)u;
#pragma unroll
    for (int a = 0; a < 2; ++a)
#pragma unroll
        for (int b = 0; b < 2; ++b)
#pragma unroll
            for (int m = 0; m < 4; ++m) asm volatile("" :: "v"(acc[a][b][m][0]), "v"(acc[a][b][m][1])); } };
struct EpiF32 {
    float* C; int ldc;
    __device__ __forceinline__ void operator()(const f32x4 (&acc)[2][2][4][2], const Unit& u) const {
        EPI_LANE
        EPI_LOOP_BEGIN
            float* p = C + (size_t)row * ldc + u.pn * 256 + colt; *(f32x4*)p = v0; *(f32x4*)(p + 4) = v1;
        EPI_LOOP_END
    }
};
struct EpiWin {
    unsigned char* ws; float* out; const float* bmerge; int l;
    __device__ __forceinline__ void operator()(const f32x4 (&acc)[2][2][4][2], const Unit& u) const {
        EPI_LANE
        const int pn = u.pn;
        if (pn < 2) {
            float* qlat = (float*)(ws + WS_QLATF);
            EPI_LOOP_BEGIN
                float* p = qlat + (size_t)row * 512 + pn * 256 + colt; *(f32x4*)p = v0; *(f32x4*)(p + 4) = v1;
            EPI_LOOP_END
        } else if (pn < 4) {
            float* ckv_p = out + O_PCKV + (size_t)l * M_P * 512; float* ckv_s = out + O_SCKV + (size_t)l * M_S * 512;
            EPI_LOOP_BEGIN
                float* p = (row < M_P ? ckv_p + (size_t)row * 512 : ckv_s + (size_t)(row - M_P) * 512) + (pn - 2) * 256 + colt; *(f32x4*)p = v0; *(f32x4*)(p + 4) = v1;
            EPI_LOOP_END
        } else if (pn == 4) {
            float* kr_p = out + O_PKR + (size_t)l * M_P * 64; float* kr_s = out + O_SKR + (size_t)l * M_S * 64;
            EPI_LOOP_BEGIN
                if (colt < 64) { float* p = (row < M_P ? kr_p + (size_t)row * 64 : kr_s + (size_t)(row - M_P) * 64) + colt; *(f32x4*)p = v0; *(f32x4*)(p + 4) = v1; }
            EPI_LOOP_END
        } else if (pn < 13) {
            bf16_t* zm = (bf16_t*)(ws + WS_ZM);
            EPI_LOOP_BEGIN
                f32x4 a, b;
#pragma unroll
                for (int j = 0; j < 4; ++j) { a[j] = siluf_(v0[j]); b[j] = siluf_(v1[j]); }
                *(u32x4*)(zm + (size_t)row * 2048 + (pn - 5) * 256 + colt) = pack8(a, b);
            EPI_LOOP_END
        } else if (pn < 21) {
            const int t = pn - 13;
            bf16_t* ub = (bf16_t*)(ws + WS_UB);
            float* conv_p = out + O_PCONV + (size_t)l * CONV_ST * 1024; float* conv_s = out + O_SCONV + (size_t)l * NSTREAM * CONV_ST * 1024;
#pragma unroll
            for (int ai = 0; ai < 2; ++ai)
#pragma unroll
                for (int m = 0; m < 4; ++m) {
                    const int row = u.pm * 256 + ai * 128 + wr * 64 + m * 16 + fr; const int col = t * 128 + wc * 32 + 8 * fq;
                    f32x4 a, b;
#pragma unroll
                    for (int j = 0; j < 4; ++j) { a[j] = acc[ai][0][m][0][j] * sigmoidf_(acc[ai][1][m][0][j]); b[j] = acc[ai][0][m][1][j] * sigmoidf_(acc[ai][1][m][1][j]); }
                    *(u32x4*)(ub + (size_t)row * 1024 + col) = pack8(a, b);
                    if (row >= M_P - CONV_ST) {
                        if (row < M_P) { float* p = conv_p + (size_t)(row - (M_P - CONV_ST)) * 1024 + col; *(f32x4*)p = a; *(f32x4*)(p + 4) = b; }
                        else { const int rs = row - M_P, sq = rs & 63, bb = rs >> 6;
                            if (sq >= DEC_SEQ - CONV_ST) { float* p = conv_s + ((size_t)bb * CONV_ST + (sq - (DEC_SEQ - CONV_ST))) * 1024 + col; *(f32x4*)p = a; *(f32x4*)(p + 4) = b; } }
                    }
                }
        } else if (pn < 33) {
            const size_t dofs = pn < 25 ? WS_ZC : (pn < 29 ? WS_XQ : WS_ZX); const int tb = pn < 25 ? 21 : (pn < 29 ? 25 : 29); const bool act = !(pn >= 25 && pn < 29);
            bf16_t* dst = (bf16_t*)(ws + dofs);
            EPI_LOOP_BEGIN
                f32x4 a = v0, b = v1;
                if (act) {
#pragma unroll
                    for (int j = 0; j < 4; ++j) { a[j] = siluf_(v0[j]); b[j] = siluf_(v1[j]); } }
                *(u32x4*)(dst + (size_t)row * 1024 + (pn - tb) * 256 + colt) = pack8(a, b);
            EPI_LOOP_END
        } else {
            bf16_t* gates = (bf16_t*)(ws + WS_GATES);
            f32x4 bb[2][2];
#pragma unroll
            for (int bj = 0; bj < 2; ++bj) { const float* bp = bmerge + (pn - 33) * 256 + bj * 128 + wc * 32 + 8 * fq; bb[bj][0] = *(const f32x4*)bp; bb[bj][1] = *(const f32x4*)(bp + 4); }
            EPI_LOOP_BEGIN
                const int col = (pn - 33) * 256 + colt;
                f32x4 a, b;
#pragma unroll
                for (int j = 0; j < 4; ++j) { a[j] = sigmoidf_(v0[j] + bb[bj][0][j]); b[j] = sigmoidf_(v1[j] + bb[bj][1][j]); }
                *(u32x4*)(gates + (size_t)row * 6144 + col) = pack8(a, b);
            EPI_LOOP_END
        }
    }
};
template <bool PASTROWS> struct EpiKV {
    bf16_t* Kd; bf16_t* Vd; float* SS;
    __device__ __forceinline__ void operator()(const f32x4 (&acc)[2][2][4][2], const Unit& u) const {
        EPI_LANE
        const int h = u.pn;
#pragma unroll
        for (int ai = 0; ai < 2; ++ai)
#pragma unroll
            for (int m = 0; m < 4; ++m) {
                const int row = u.pm * 256 + ai * 128 + wr * 64 + m * 16 + fr;
                const size_t R = PASTROWS ? ((size_t)((row >> 12) * 16 + h) * 4096 + (row & 4095)) : ((size_t)h * M + row);
                const int c = wc * 32 + 8 * fq;
                const f32x4 k0 = acc[ai][0][m][0], k1 = acc[ai][0][m][1];
                *(u32x4*)(Kd + R * 128 + c) = pack8(k0, k1);
                *(u32x4*)(Vd + R * 128 + c) = pack8(acc[ai][1][m][0], acc[ai][1][m][1]);
                float s = (k0[0] * k0[0] + k0[1] * k0[1]) + (k0[2] * k0[2] + k0[3] * k0[3]) + (k1[0] * k1[0] + k1[1] * k1[1]) + (k1[2] * k1[2] + k1[3] * k1[3]);
                s += __shfl_xor(s, 16); s += __shfl_xor(s, 32);
                if (fq == 0) SS[R * 4 + wc] = s;
            }
    }
};
template <bool DOK = true, bool DOSS = true, bool TILED = true> struct EpiK {
    bf16_t* Kd; float* SS;
    __device__ __forceinline__ void operator()(const f32x4 (&acc)[2][2][4][2], const Unit& u) const {
        EPI_LANE
        float sq[2][4][2];
#pragma unroll
        for (int ai = 0; ai < 2; ++ai)
#pragma unroll
            for (int m = 0; m < 4; ++m)
#pragma unroll
                for (int bj = 0; bj < 2; ++bj) {
                    const f32x4 k0 = acc[ai][bj][m][0], k1 = acc[ai][bj][m][1];
                    if (DOK) *(u32x4*)(Kd + ((((((((size_t)u.pm * 8 + u.pn) * 2 + ai) * 2 + wr) * 4 + m) * 2 + bj) * 4 + wc) * 64 + (fq * 16 + fr)) * 8) = pack8(k0, k1);
                    sq[ai][m][bj] = (k0[0] * k0[0] + k0[1] * k0[1]) + (k0[2] * k0[2] + k0[3] * k0[3]) + (k1[0] * k1[0] + k1[1] * k1[1]) + (k1[2] * k1[2] + k1[3] * k1[3]);
                }
#pragma unroll
        for (int ai = 0; ai < 2; ++ai)
#pragma unroll
            for (int m = 0; m < 4; ++m)
#pragma unroll
                for (int bj = 0; bj < 2; ++bj) sq[ai][m][bj] += __shfl_xor(sq[ai][m][bj], 16);
#pragma unroll
        for (int ai = 0; ai < 2; ++ai)
#pragma unroll
            for (int m = 0; m < 4; ++m)
#pragma unroll
                for (int bj = 0; bj < 2; ++bj) sq[ai][m][bj] += __shfl_xor(sq[ai][m][bj], 32);
        if (DOSS) {
#pragma unroll
            for (int ai = 0; ai < 2; ++ai)
#pragma unroll
                for (int bj = 0; bj < 2; ++bj) {
                    const float v = fq == 0 ? sq[ai][0][bj] : (fq == 1 ? sq[ai][1][bj] : (fq == 2 ? sq[ai][2][bj] : sq[ai][3][bj]));
                    const int row = u.pm * 256 + ai * 128 + wr * 64 + fq * 16 + fr; const int h = u.pn * 2 + bj;
                    SS[(size_t)wc * ((size_t)MPAST * 16) + (size_t)((row >> 12) * 16 + h) * 4096 + (row & 4095)] = v;
                }
        }
        (void)TILED;
    }
};
struct EpiPw2 {
    bf16_t* O; const bf16_t* zc; const float* bias;
    __device__ __forceinline__ void operator()(const f32x4 (&acc)[2][2][4][2], const Unit& u) const {
        EPI_LANE
        f32x4 bb[2][2];
#pragma unroll
        for (int bj = 0; bj < 2; ++bj) { const float* bp = bias + u.pn * 256 + bj * 128 + wc * 32 + 8 * fq; bb[bj][0] = *(const f32x4*)bp; bb[bj][1] = *(const f32x4*)(bp + 4); }
#pragma unroll
        for (int ai = 0; ai < 2; ++ai) {
            u32x4 z[4][2];
#pragma unroll
            for (int m = 0; m < 4; ++m)
#pragma unroll
                for (int bj = 0; bj < 2; ++bj) { const int row = u.pm * 256 + ai * 128 + wr * 64 + m * 16 + fr; z[m][bj] = *(const u32x4*)(zc + (size_t)row * 1024 + u.pn * 256 + bj * 128 + wc * 32 + 8 * fq); }
#pragma unroll
            for (int m = 0; m < 4; ++m)
#pragma unroll
                for (int bj = 0; bj < 2; ++bj) { const int row = u.pm * 256 + ai * 128 + wr * 64 + m * 16 + fr; const int col = u.pn * 256 + bj * 128 + wc * 32 + 8 * fq;
                    f32x4 z0, z1; unpack8(z[m][bj], z0, z1);
                    *(u32x4*)(O + (size_t)row * 1024 + col) = pack8((acc[ai][bj][m][0] + bb[bj][0]) * z0, (acc[ai][bj][m][1] + bb[bj][1]) * z1); }
            asm volatile("" ::: "memory");
        }
    }
};
struct EpiGate {
    bf16_t* O; const bf16_t* gates; int goff;
    __device__ __forceinline__ void operator()(const f32x4 (&acc)[2][2][4][2], const Unit& u) const {
        EPI_LANE
#pragma unroll
        for (int ai = 0; ai < 2; ++ai) {
            u32x4 gg[4][2];
#pragma unroll
            for (int m = 0; m < 4; ++m)
#pragma unroll
                for (int bj = 0; bj < 2; ++bj) { const int row = u.pm * 256 + ai * 128 + wr * 64 + m * 16 + fr; gg[m][bj] = *(const u32x4*)(gates + (size_t)row * 6144 + goff + u.pn * 256 + bj * 128 + wc * 32 + 8 * fq); }
#pragma unroll
            for (int m = 0; m < 4; ++m)
#pragma unroll
                for (int bj = 0; bj < 2; ++bj) { const int row = u.pm * 256 + ai * 128 + wr * 64 + m * 16 + fr; const int col = u.pn * 256 + bj * 128 + wc * 32 + 8 * fq;
                    f32x4 g0, g1; unpack8(gg[m][bj], g0, g1);
                    *(u32x4*)(O + (size_t)row * 2048 + col) = pack8(g0 * acc[ai][bj][m][0], g1 * acc[ai][bj][m][1]); }
            asm volatile("" ::: "memory");
        }
    }
};
struct EpiOut {
    const float* src_p; const float* src_s; float* dst_p; float* dst_s;
    __device__ __forceinline__ void operator()(const f32x4 (&acc)[2][2][4][2], const Unit& u) const {
        EPI_LANE
        const bool pr = u.pm * 256 < M_P;
        const float* src = pr ? src_p : src_s; float* dst = pr ? dst_p : dst_s; const int rbase = u.pm * 256 - (pr ? 0 : M_P);
#pragma unroll
        for (int ai = 0; ai < 2; ++ai)
#pragma unroll
            for (int mh = 0; mh < 2; ++mh) {
                f32x4 xx[2][2][2];
#pragma unroll
                for (int mm = 0; mm < 2; ++mm)
#pragma unroll
                    for (int bj = 0; bj < 2; ++bj) { const int m = mh * 2 + mm; const size_t off = (size_t)(rbase + ai * 128 + wr * 64 + m * 16 + fr) * 2048 + u.pn * 256 + bj * 128 + wc * 32 + 8 * fq;
                        xx[mm][bj][0] = *(const f32x4*)(src + off); xx[mm][bj][1] = *(const f32x4*)(src + off + 4); }
#pragma unroll
                for (int mm = 0; mm < 2; ++mm)
#pragma unroll
                    for (int bj = 0; bj < 2; ++bj) { const int m = mh * 2 + mm; const size_t off = (size_t)(rbase + ai * 128 + wr * 64 + m * 16 + fr) * 2048 + u.pn * 256 + bj * 128 + wc * 32 + 8 * fq;
                        *(f32x4*)(dst + off) = xx[mm][bj][0] + acc[ai][bj][m][0]; *(f32x4*)(dst + off + 4) = xx[mm][bj][1] + acc[ai][bj][m][1]; }
                asm volatile("" ::: "memory");
            }
    }
};

namespace att {
__device__ __forceinline__ int crow(int r, int hi) { return (r & 3) + 8 * (r >> 2) + 4 * hi; }
template <int ROWB> __device__ __forceinline__ int kswz(int row, int colB) { return row * ROWB + (colB ^ ((row & 7) << 4)); }
template <int NDV> __device__ __forceinline__ int v_st(int k, int c) { const int kk = (k & ~0xC) | ((k & 4) << 1) | ((k & 8) >> 1); return ((kk >> 3) * NDV + (c >> 5)) * 512 + ((kk & 7) * 32 + (c & 31)) * 2; }
__device__ __forceinline__ int v_rd_base(int lane) { return ((lane & 3) << 3) | (((lane >> 2) & 3) << 6) | (((lane >> 4) & 1) << 5) | (((lane >> 5) & 1) << 8); }

template <int NQA, int NQB, int NDV, int NKB, bool HAS_RK, int KROWB, int KR = 3>
__device__ __forceinline__ void tile_step(const bf16x8 (&qr)[NQA + NQB], f32x16 (&o)[NDV], float& m_reg, float& l_reg,
                                          const LAS char* Ks, const LAS char* Kp, int vb, const LAS float* rk, LAS float* al_l, int r32, int hi) {
    f32x16 p[NKB];
#pragma unroll
    for (int kb = 0; kb < NKB; ++kb)
#pragma unroll
        for (int r = 0; r < 16; ++r) p[kb][r] = 0.f;
    {
        auto kfrag = [&](int kb, int d) -> bf16x8 { return d < NQA ? *(const LAS bf16x8*)(Ks + kswz<KROWB>(kb * 32 + r32, (d * 16 + hi * 8) * 2)) : *(const LAS bf16x8*)(Kp + kswz<128>(kb * 32 + r32, ((d - NQA) * 16 + hi * 8) * 2)); };
        bf16x8 kf[KR][NKB];
#pragma unroll
        for (int a = 0; a < KR - 1; ++a)
#pragma unroll
            for (int kb = 0; kb < NKB; ++kb) kf[a][kb] = kfrag(kb, a);
#pragma unroll
        for (int d0 = 0; d0 < NQA + NQB; ++d0) {
            if (d0 + KR - 1 < NQA + NQB) {
#pragma unroll
                for (int kb = 0; kb < NKB; ++kb) kf[(d0 + KR - 1) % KR][kb] = kfrag(kb, d0 + KR - 1); }
#pragma unroll
            for (int kb = 0; kb < NKB; ++kb) p[kb] = __builtin_amdgcn_mfma_f32_32x32x16_bf16(kf[d0 % KR][kb], qr[d0], p[kb], 0, 0, 0);
        }
    }
    if (HAS_RK) {
#pragma unroll
        for (int kb = 0; kb < NKB; ++kb)
#pragma unroll
            for (int i = 0; i < 4; ++i) { const f32x4 s = *(const LAS f32x4*)(rk + kb * 32 + 8 * i + 4 * hi);
#pragma unroll
                for (int j = 0; j < 4; ++j) p[kb][4 * i + j] *= s[j]; }
    }
    float pmax = p[0][0];
#pragma unroll
    for (int kb = 0; kb < NKB; ++kb)
#pragma unroll
        for (int r = 0; r < 16; ++r) pmax = fmaxf(pmax, p[kb][r]);
    { auto rr = __builtin_amdgcn_permlane32_swap(__float_as_uint(pmax), __float_as_uint(pmax), false, false); pmax = fmaxf(__uint_as_float(rr[0]), __uint_as_float(rr[1])); }
    const float mn = fmaxf(m_reg, pmax); const float alpha = __builtin_amdgcn_exp2f(m_reg - mn); m_reg = mn;
    float ps = 0.f;
#pragma unroll
    for (int kb = 0; kb < NKB; ++kb)
#pragma unroll
        for (int r = 0; r < 16; ++r) { p[kb][r] = __builtin_amdgcn_exp2f(p[kb][r] - mn); ps += p[kb][r]; }
    { auto rr = __builtin_amdgcn_permlane32_swap(__float_as_uint(ps), __float_as_uint(ps), false, false); ps = __uint_as_float(rr[0]) + __uint_as_float(rr[1]); }
    l_reg = l_reg * alpha + ps;
    if (__any(alpha < 1.f)) {
        if (hi == 0) al_l[r32] = alpha;
        LDS_WAIT();
        float al[16];
#pragma unroll
        for (int r = 0; r < 16; ++r) al[r] = al_l[crow(r, hi)];
#pragma unroll
        for (int d = 0; d < NDV; ++d)
#pragma unroll
            for (int r = 0; r < 16; ++r) o[d][r] *= al[r];
    }
    bf16x8 pa[2 * NKB];
#pragma unroll
    for (int kb = 0; kb < NKB; ++kb)
#pragma unroll
        for (int hf = 0; hf < 2; ++hf) { const int B = hf * 8;
            const unsigned a0 = cvt_pk_bf16(p[kb][B + 0], p[kb][B + 1]), a1 = cvt_pk_bf16(p[kb][B + 2], p[kb][B + 3]);
            const unsigned b0 = cvt_pk_bf16(p[kb][B + 4], p[kb][B + 5]), b1 = cvt_pk_bf16(p[kb][B + 6], p[kb][B + 7]);
            auto r0 = __builtin_amdgcn_permlane32_swap(a0, b0, false, false); auto r1 = __builtin_amdgcn_permlane32_swap(a1, b1, false, false);
            u32x4 w = {r0[0], r1[0], r0[1], r1[1]}; pa[kb * 2 + hf] = __builtin_bit_cast(bf16x8, w); }
#pragma unroll
    for (int d0 = 0; d0 < NDV; ++d0) {
        s16x4 lo[2 * NKB], hh[2 * NKB];
#pragma unroll
        for (int ks = 0; ks < 2 * NKB; ++ks) {
            asm volatile("ds_read_b64_tr_b16 %0, %1 offset:%c2" : "=&v"(lo[ks]) : "v"(vb), "i"(d0 * 512 + ks * (NDV * 1024)) : "memory");
            asm volatile("ds_read_b64_tr_b16 %0, %1 offset:%c2" : "=&v"(hh[ks]) : "v"(vb), "i"(d0 * 512 + ks * (NDV * 1024) + NDV * 512) : "memory"); }
        asm volatile("s_waitcnt lgkmcnt(0)" ::: "memory"); __builtin_amdgcn_sched_barrier(0);
#pragma unroll
        for (int ks = 0; ks < 2 * NKB; ++ks) { const bf16x8 vf = (bf16x8){lo[ks][0], lo[ks][1], lo[ks][2], lo[ks][3], hh[ks][0], hh[ks][1], hh[ks][2], hh[ks][3]};
            o[d0] = __builtin_amdgcn_mfma_f32_32x32x16_bf16(pa[ks], vf, o[d0], 0, 0, 0); }
    }
}
typedef short v4i16_t __attribute__((ext_vector_type(4)));
__device__ __forceinline__ s16x4 vtr(const LAS char* p) { return __builtin_bit_cast(s16x4, __builtin_amdgcn_ds_read_tr16_b64_v4i16((LAS v4i16_t*)p)); }
template <int NQA, int NQB, int NDV, int NKB, int KROWB, int NDVT = NDV>
__device__ __forceinline__ void tile_step_fs(const bf16x8 (&qr)[NQA + NQB], f32x16 (&o)[NDV], float& l_part,
                                             const LAS char* Ks, const LAS char* Kp, const LAS char* vbp, const LAS float* rk, float negB2, int r32, int hi) {
    f32x16 p[NKB];
#pragma unroll
    for (int kb = 0; kb < NKB; ++kb)
#pragma unroll
        for (int r = 0; r < 16; ++r) p[kb][r] = 0.f;
    bf16x8 ka[NKB], kn[NKB];
#pragma unroll
    for (int kb = 0; kb < NKB; ++kb) ka[kb] = *(const LAS bf16x8*)(Ks + kswz<KROWB>(kb * 32 + r32, hi * 16));
#pragma unroll
    for (int d0 = 0; d0 < NQA + NQB; ++d0) {
        if (d0 + 1 < NQA + NQB) {
#pragma unroll
            for (int kb = 0; kb < NKB; ++kb) { const int d1 = d0 + 1;
                kn[kb] = d1 < NQA ? *(const LAS bf16x8*)(Ks + kswz<KROWB>(kb * 32 + r32, (d1 * 16 + hi * 8) * 2)) : *(const LAS bf16x8*)(Kp + kswz<128>(kb * 32 + r32, ((d1 - NQA) * 16 + hi * 8) * 2)); } }
#pragma unroll
        for (int kb = 0; kb < NKB; ++kb) p[kb] = __builtin_amdgcn_mfma_f32_32x32x16_bf16(ka[kb], qr[d0], p[kb], 0, 0, 0);
#pragma unroll
        for (int kb = 0; kb < NKB; ++kb) ka[kb] = kn[kb];
    }
#pragma unroll
    for (int kb = 0; kb < NKB; ++kb) {
        float ps = 0.f;
#pragma unroll
        for (int i = 0; i < 4; ++i) { const f32x4 s = *(const LAS f32x4*)(rk + kb * 32 + 8 * i + 4 * hi);
#pragma unroll
            for (int j = 0; j < 4; ++j) { const float e = __builtin_amdgcn_exp2f(fmaf(p[kb][4 * i + j], s[j], negB2)); p[kb][4 * i + j] = e; ps += e; } }
        l_part += ps;
        bf16x8 pa[2];
#pragma unroll
        for (int hf = 0; hf < 2; ++hf) { const int B = hf * 8;
            const unsigned a0 = cvt_pk_bf16(p[kb][B + 0], p[kb][B + 1]), a1 = cvt_pk_bf16(p[kb][B + 2], p[kb][B + 3]);
            const unsigned b0 = cvt_pk_bf16(p[kb][B + 4], p[kb][B + 5]), b1 = cvt_pk_bf16(p[kb][B + 6], p[kb][B + 7]);
            auto r0 = __builtin_amdgcn_permlane32_swap(a0, b0, false, false); auto r1 = __builtin_amdgcn_permlane32_swap(a1, b1, false, false);
            u32x4 w = {r0[0], r1[0], r0[1], r1[1]}; pa[hf] = __builtin_bit_cast(bf16x8, w); }
#pragma unroll
        for (int hf = 0; hf < 2; ++hf) { const int ks = kb * 2 + hf;
            bf16x8 vf[NDV];
#pragma unroll
            for (int d0 = 0; d0 < NDV; ++d0) { const s16x4 lo = vtr(vbp + d0 * 512 + ks * (NDVT * 1024)), hh = vtr(vbp + d0 * 512 + ks * (NDVT * 1024) + NDVT * 512);
                vf[d0] = (bf16x8){lo[0], lo[1], lo[2], lo[3], hh[0], hh[1], hh[2], hh[3]}; }
#pragma unroll
            for (int d0 = 0; d0 < NDV; ++d0) o[d0] = __builtin_amdgcn_mfma_f32_32x32x16_bf16(pa[hf], vf[d0], o[d0], 0, 0, 0); }
    }
}
template <int NQA, int NQB, int NKB, int KROWB>
__device__ __forceinline__ void qk_sm(const bf16x8 (&qr)[NQA + NQB], float& l_part, const LAS char* Ks, const LAS char* Kp, const LAS float* rk, float negB2, int r32, int hi, bf16x8 (&pa)[2 * NKB]) {
    f32x16 p[NKB];
#pragma unroll
    for (int kb = 0; kb < NKB; ++kb)
#pragma unroll
        for (int r = 0; r < 16; ++r) p[kb][r] = 0.f;
    auto kfrag = [&](int kb, int d) -> bf16x8 { return d < NQA ? *(const LAS bf16x8*)(Ks + kswz<KROWB>(kb * 32 + r32, (d * 16 + hi * 8) * 2)) : *(const LAS bf16x8*)(Kp + kswz<128>(kb * 32 + r32, ((d - NQA) * 16 + hi * 8) * 2)); };
    bf16x8 kf[3][NKB];
#pragma unroll
    for (int kb = 0; kb < NKB; ++kb) { kf[0][kb] = kfrag(kb, 0); kf[1][kb] = kfrag(kb, 1); }
#pragma unroll
    for (int d0 = 0; d0 < NQA + NQB; ++d0) {
        if (d0 + 2 < NQA + NQB) {
#pragma unroll
            for (int kb = 0; kb < NKB; ++kb) kf[(d0 + 2) % 3][kb] = kfrag(kb, d0 + 2); }
#pragma unroll
        for (int kb = 0; kb < NKB; ++kb) p[kb] = __builtin_amdgcn_mfma_f32_32x32x16_bf16(kf[d0 % 3][kb], qr[d0], p[kb], 0, 0, 0);
    }
    f32x4 sc[NKB][4];
#pragma unroll
    for (int kb = 0; kb < NKB; ++kb)
#pragma unroll
        for (int i = 0; i < 4; ++i) sc[kb][i] = *(const LAS f32x4*)(rk + kb * 32 + 8 * i + 4 * hi);
#pragma unroll
    for (int kb = 0; kb < NKB; ++kb) {
        float ps = 0.f;
#pragma unroll
        for (int i = 0; i < 4; ++i) {
#pragma unroll
            for (int j = 0; j < 4; ++j) { const float e = __builtin_amdgcn_exp2f(fmaf(p[kb][4 * i + j], sc[kb][i][j], negB2)); p[kb][4 * i + j] = e; ps += e; } }
        l_part += ps;
#pragma unroll
        for (int hf = 0; hf < 2; ++hf) { const int B = hf * 8;
            const unsigned a0 = cvt_pk_bf16(p[kb][B + 0], p[kb][B + 1]), a1 = cvt_pk_bf16(p[kb][B + 2], p[kb][B + 3]);
            const unsigned b0 = cvt_pk_bf16(p[kb][B + 4], p[kb][B + 5]), b1 = cvt_pk_bf16(p[kb][B + 6], p[kb][B + 7]);
            auto r0 = __builtin_amdgcn_permlane32_swap(a0, b0, false, false); auto r1 = __builtin_amdgcn_permlane32_swap(a1, b1, false, false);
            u32x4 w = {r0[0], r1[0], r0[1], r1[1]}; pa[kb * 2 + hf] = __builtin_bit_cast(bf16x8, w); }
    }
}
template <int NDV, int NKB>
__device__ __forceinline__ void pv_fs(f32x16 (&o)[NDV], const LAS char* vbp, const bf16x8 (&pa)[2 * NKB]) {
    const int vb = (int)(uintptr_t)vbp;
    s16x4 lo[2][NDV], hh[2][NDV];
    __builtin_amdgcn_sched_barrier(0);
#pragma unroll
    for (int d0 = 0; d0 < NDV; ++d0) {
        asm volatile("ds_read_b64_tr_b16 %0, %1 offset:%c2" : "=&v"(lo[0][d0]) : "v"(vb), "i"(d0 * 512) : "memory");
        asm volatile("ds_read_b64_tr_b16 %0, %1 offset:%c2" : "=&v"(hh[0][d0]) : "v"(vb), "i"(d0 * 512 + NDV * 512) : "memory"); }
#pragma unroll
    for (int ks = 0; ks < 2 * NKB; ++ks) {
        if (ks + 1 < 2 * NKB) {
#pragma unroll
            for (int d0 = 0; d0 < NDV; ++d0) {
                asm volatile("ds_read_b64_tr_b16 %0, %1 offset:%c2" : "=&v"(lo[(ks + 1) & 1][d0]) : "v"(vb), "i"(d0 * 512 + (ks + 1) * (NDV * 1024)) : "memory");
                asm volatile("ds_read_b64_tr_b16 %0, %1 offset:%c2" : "=&v"(hh[(ks + 1) & 1][d0]) : "v"(vb), "i"(d0 * 512 + (ks + 1) * (NDV * 1024) + NDV * 512) : "memory"); }
            asm volatile("s_waitcnt lgkmcnt(%0)" :: "n"(2 * NDV) : "memory");
        } else asm volatile("s_waitcnt lgkmcnt(0)" ::: "memory");
        __builtin_amdgcn_sched_barrier(0);
#pragma unroll
        for (int d0 = 0; d0 < NDV; ++d0) { const s16x4 l_ = lo[ks & 1][d0], h_ = hh[ks & 1][d0];
            const bf16x8 vf = (bf16x8){l_[0], l_[1], l_[2], l_[3], h_[0], h_[1], h_[2], h_[3]};
            o[d0] = __builtin_amdgcn_mfma_f32_32x32x16_bf16(pa[ks], vf, o[d0], 0, 0, 0); }
        __builtin_amdgcn_sched_barrier(0);
    }
}
__device__ __forceinline__ float lane_pair_sum(float x) { auto rr = __builtin_amdgcn_permlane32_swap(__float_as_uint(x), __float_as_uint(x), false, false); return __uint_as_float(rr[0]) + __uint_as_float(rr[1]); }
template <int NDV>
__device__ __forceinline__ void finish(const f32x16 (&o)[NDV], float l_reg, LAS float* al_l, bf16_t* out, const bf16_t* z, int ld, int r32, int hi) {
    if (hi == 0) al_l[r32] = l_reg;
    LDS_WAIT();
    const bool odd = r32 & 1;
#pragma unroll
    for (int r = 0; r < 16; r += 2) { const int orow = crow(r, hi);
        const float rl0 = __builtin_amdgcn_rcpf(al_l[orow]), rl1 = __builtin_amdgcn_rcpf(al_l[orow + 1]);
#pragma unroll
        for (int d0 = 0; d0 < NDV; ++d0) {
            const float a = o[d0][r] * rl0, b = o[d0][r + 1] * rl1;
            const float recv = __shfl_xor(odd ? a : b, 1);
            const float v0 = odd ? recv : a, v1 = odd ? b : recv;
            const size_t idx = (size_t)(orow + (odd ? 1 : 0)) * ld + d0 * 32 + (r32 & ~1);
            const unsigned zw = *(const unsigned*)(z + idx);
            *(unsigned*)(out + idx) = cvt_pk_bf16(v0 * bf_lo(zw), v1 * bf_hi(zw)); } }
}
}

#define XB_TMO      128
#define XB_XCNT(j)  (256  + 64 * (j))
#define XB_XSUB(j)  (1280 + 64 * (j))
#define XB_XGEN(j)  (2304 + 64 * (j))
#define XB_TOP      3328
#define XB_TOPGEN   3392
#define XCD_BAR_WORDS 3456
#define XB_SPIN_CAP (1u << 18)
__device__ __forceinline__ unsigned xb_ld(unsigned* p)              { return __hip_atomic_load(p, __ATOMIC_RELAXED, __HIP_MEMORY_SCOPE_AGENT); }
__device__ __forceinline__ unsigned xb_add(unsigned* p, unsigned v) { return __hip_atomic_fetch_add(p, v, __ATOMIC_RELAXED, __HIP_MEMORY_SCOPE_AGENT); }
__device__ __forceinline__ unsigned xb_xcc_id() { return (unsigned)__builtin_amdgcn_s_getreg((3 << 11) | 20) & 0xFu; }
#define XB_SPIN(cond, bar) do { unsigned _sp = 0; while (cond) { __builtin_amdgcn_s_sleep(1); \
    if ((++_sp & 255u) == 0u) { if (xb_ld(&(bar)[XB_TMO])) break; if (_sp > XB_SPIN_CAP) { atomicAdd(&(bar)[XB_TMO], 1u); break; } } } } while (0)
struct XcdBarrier { unsigned* bar; unsigned x; volatile LAS unsigned* st; };
__device__ __forceinline__ XcdBarrier xcd_barrier_post(unsigned* bar, volatile LAS unsigned* st) {
    XcdBarrier b; b.bar = bar; b.x = xb_xcc_id(); b.st = st;
    if (threadIdx.x == 0) (void)xb_add(&bar[XB_XCNT(b.x)], 1u);
    return b;
}
__device__ __forceinline__ void xcd_barrier_complete(unsigned* bar, unsigned x, unsigned& nloc, unsigned& nx) {
    const unsigned G = gridDim.x * gridDim.y * gridDim.z;
    unsigned sum, cnt, mine, sp = 0u;
    for (;;) {
        sum = 0u; cnt = 0u; mine = 0u;
#pragma unroll
        for (unsigned j = 0; j < 16; ++j) { const unsigned c = xb_ld(&bar[XB_XCNT(j)]); sum += c; cnt += (c > 0u) ? 1u : 0u; mine = (j == x) ? c : mine; }
        if (sum == G) break;
        __builtin_amdgcn_s_sleep(1);
        if ((++sp & 255u) == 0u) { if (xb_ld(&bar[XB_TMO])) break; if (sp > XB_SPIN_CAP) { atomicAdd(&bar[XB_TMO], 1u); break; } }
    }
    nloc = mine > 0u ? mine : 1u; nx = cnt > 0u ? cnt : 1u;
}
__device__ __forceinline__ void xcd_barrier(const XcdBarrier& b) {
    asm volatile("s_waitcnt vmcnt(0)" ::: "memory");
    __syncthreads();
    if (threadIdx.x == 0) {
        unsigned* bar = b.bar; asm volatile("" : "+s"(bar));
        __builtin_amdgcn_s_waitcnt(0);
        unsigned nloc = b.st[0], nx = b.st[1];
        if (nloc == 0u) { xcd_barrier_complete(bar, b.x, nloc, nx); b.st[0] = nloc; b.st[1] = nx; }
        const unsigned old = xb_add(&bar[XB_XSUB(b.x)], 1u);
        const unsigned gen = old / nloc;
        if (old + 1u == (gen + 1u) * nloc) {
            __builtin_amdgcn_fence(__ATOMIC_RELEASE, "agent");
            asm volatile("s_waitcnt vmcnt(0)" ::: "memory");
            const unsigned og = xb_add(&bar[XB_TOP], 1u);
            const unsigned tg = og / nx;
            if (og + 1u == (tg + 1u) * nx) xb_add(&bar[XB_TOPGEN], 1u);
            else XB_SPIN(xb_ld(&bar[XB_TOPGEN]) == tg, bar);
            __builtin_amdgcn_fence(__ATOMIC_ACQUIRE, "agent");
            xb_add(&bar[XB_XGEN(b.x)], 1u);
            asm volatile("s_waitcnt vmcnt(0)" ::: "memory");
        } else {
            XB_SPIN(xb_ld(&bar[XB_XGEN(b.x)]) == gen, bar);
            __builtin_amdgcn_fence(__ATOMIC_ACQUIRE, "agent");
            asm volatile("s_waitcnt vmcnt(0)" ::: "memory");
        }
    }
    __syncthreads();
}

struct Args { const float* in[31]; float* out; unsigned char* ws; int ph_lo, ph_hi; };
typedef const float* const __attribute__((address_space(4)))* karg_in_t;
struct Ctx {
    LAS unsigned char* lds;
    karg_in_t in; float* out; unsigned char* ws;
    int tid, lane, wave, G, bid;
};
enum { I_XP = 0, I_XS, I_MEM, I_CCKV, I_CKR, I_CMK, I_CMV, I_SCONV, I_GPRE, I_WIN, I_GQLAT, I_WUQ, I_GKVLAT, I_WUKV, I_GQN, I_GKN, I_CONVW, I_CONVB, I_LNG, I_LNB,
       I_WPW2, I_BPW2, I_GMEM, I_WMEM, I_GXQ, I_GXK, I_WPM, I_WPC, I_WPX, I_BMERGE, I_WOUT };

__device__ __forceinline__ int win_src_col(int nd) {
    if (nd < 1088) return nd;
    if (nd < 1280) return -1;
    if (nd >= 3328 && nd < 5376) { const int t = (nd - 3328) >> 8, w = (nd - 3328) & 255; return w < 128 ? 3136 + t * 128 + w : 4160 + t * 128 + (w - 128); }
    return nd - 192;
}
__device__ __forceinline__ void transpose_item(const float* W, int K, int Nsrc, bf16_t* WT, const float* gain, int mapmode, LAS float* scr, int item, int nblk, int lane) {
    const int kb = item / nblk, nb = item % nblk, k0 = 64 * kb, nd0 = 64 * nb;
    const int ns0 = mapmode == 1 ? win_src_col(nd0) : (mapmode == 2 ? (nd0 >> 7) * 256 + (nd0 & 127) : nd0);
    const int lk = lane >> 4, ln4 = (lane & 15) * 4;
    f32x4 v[16];
#pragma unroll
    for (int i = 0; i < 16; ++i) v[i] = ns0 >= 0 ? *(const f32x4*)(W + (size_t)(k0 + lk + 4 * i) * Nsrc + ns0 + ln4) : (f32x4){0.f, 0.f, 0.f, 0.f};
#pragma unroll
    for (int i = 0; i < 16; ++i) { LAS float* p = scr + (lk + 4 * i) * 65 + ln4; p[0] = v[i][0]; p[1] = v[i][1]; p[2] = v[i][2]; p[3] = v[i][3]; }
    LDS_WAIT(); asm volatile("" ::: "memory");
    const int c = lane & 7;
    f32x4 g0 = {1.f, 1.f, 1.f, 1.f}, g1 = {1.f, 1.f, 1.f, 1.f};
    if (gain) { g0 = *(const f32x4*)(gain + k0 + 8 * c); g1 = *(const f32x4*)(gain + k0 + 8 * c + 4); }
#pragma unroll
    for (int j = 0; j < 8; ++j) { const int n = (lane >> 3) + 8 * j; const LAS float* sp = scr + (8 * c) * 65 + n;
        u32x4 o; o.x = cvt_pk_bf16(sp[0 * 65] * g0[0], sp[1 * 65] * g0[1]); o.y = cvt_pk_bf16(sp[2 * 65] * g0[2], sp[3 * 65] * g0[3]);
        o.z = cvt_pk_bf16(sp[4 * 65] * g1[0], sp[5 * 65] * g1[1]); o.w = cvt_pk_bf16(sp[6 * 65] * g1[2], sp[7 * 65] * g1[3]);
        *(u32x4*)(WT + (size_t)(nd0 + n) * K + k0 + 8 * c) = o; }
    LDS_WAIT(); asm volatile("" ::: "memory");
}
__device__ __forceinline__ bool h_early_ok(int G) { const int n2 = (M / 256) * (2048 / 256) - G; return n2 > 0 && n2 < G; }
constexpr unsigned PW_ALL = 0x3ffu, PW_EARLY = PW_ALL & ~(1u << 8);
__device__ __forceinline__ void prep_weights(const Ctx& F, int l, int gw, int NGW, unsigned jobs) {
    LAS float* scr = (LAS float*)(F.lds + F.wave * 16640);
    int base = 0;
#pragma unroll 1
    for (int job = 0; job < 10; ++job) {
        if (!((jobs >> job) & 1u)) continue;
        const float* W; int K, Nsrc, Ndst; size_t dst; const float* gain = nullptr; int winmap = 0;
        switch (job) {
            case 0: W = F.in[I_WIN] + (size_t)l * 2048 * IN_COLS; K = 2048; Nsrc = IN_COLS; Ndst = IN_PAD; dst = WS_WIN; gain = F.in[I_GPRE] + l * 2048; winmap = 1; break;
            case 1: W = F.in[I_WUQ] + (size_t)l * 512 * 3072; K = 512; Nsrc = 3072; Ndst = 3072; dst = WS_WUQ; gain = F.in[I_GQLAT] + l * 512; break;
            case 2: W = F.in[I_WUKV] + (size_t)l * 512 * 4096; K = 512; Nsrc = 4096; Ndst = 4096; dst = WS_WUKV; gain = F.in[I_GKVLAT] + l * 512; break;
            case 3: W = F.in[I_WPW2] + (size_t)l * 1024 * 1024; K = 1024; Nsrc = 1024; Ndst = 1024; dst = WS_WPW2; break;
            case 4: W = F.in[I_WMEM] + (size_t)l * 2048 * 2048; K = 2048; Nsrc = 2048; Ndst = 2048; dst = WS_WMEM; gain = F.in[I_GMEM] + l * 2048; break;
            case 5: W = F.in[I_WPM] + (size_t)l * 2048 * 2048; K = 2048; Nsrc = 2048; Ndst = 2048; dst = WS_WPM; break;
            case 6: W = F.in[I_WPC] + (size_t)l * 1024 * 2048; K = 1024; Nsrc = 2048; Ndst = 2048; dst = WS_WPC; break;
            case 7: W = F.in[I_WPX] + (size_t)l * 1024 * 2048; K = 1024; Nsrc = 2048; Ndst = 2048; dst = WS_WPX; break;
            case 8: W = F.in[I_WOUT] + (size_t)l * 2048 * 2048; K = 2048; Nsrc = 2048; Ndst = 2048; dst = WS_WOUT; break;
            default: W = F.in[I_WUKV] + (size_t)l * 512 * 4096; K = 512; Nsrc = 4096; Ndst = 2048; dst = WS_WUK; gain = F.in[I_GKVLAT] + l * 512; winmap = 2; break;
        }
        const int nblk = Ndst / 64, nitems = (K / 64) * nblk;
        bf16_t* WT = (bf16_t*)(F.ws + dst);
        int first = (gw - base) % NGW; if (first < 0) first += NGW;
        for (int it = first; it < nitems; it += NGW) transpose_item(W, K, Nsrc, WT, gain, winmap, scr, it, nblk, F.lane);
        base += nitems;
    }
}
__device__ __forceinline__ void rms_row_2048(const float* xrow, bf16_t* orow, int lane) {
    const f32x4* xr = (const f32x4*)xrow + lane;
    f32x4 v[8]; float s = 0.f;
#pragma unroll
    for (int j = 0; j < 8; ++j) { v[j] = xr[64 * j]; s += (v[j][0] * v[j][0] + v[j][1] * v[j][1]) + (v[j][2] * v[j][2] + v[j][3] * v[j][3]); }
    const float r = 1.0f / sqrtf(wave_sum(s) * (1.f / 2048.f) + EPS);
    u32x2* o8 = (u32x2*)orow + lane;
#pragma unroll
    for (int j = 0; j < 8; ++j) { u32x2 w; w.x = cvt_pk_bf16(v[j][0] * r, v[j][1] * r); w.y = cvt_pk_bf16(v[j][2] * r, v[j][3] * r); o8[64 * j] = w; }
}
__device__ __forceinline__ void rms_row_512(const float* xrow, bf16_t* orow, int lane) {
    const f32x4* xr = (const f32x4*)xrow + lane;
    f32x4 v[2]; float s = 0.f;
#pragma unroll
    for (int j = 0; j < 2; ++j) { v[j] = xr[64 * j]; s += (v[j][0] * v[j][0] + v[j][1] * v[j][1]) + (v[j][2] * v[j][2] + v[j][3] * v[j][3]); }
    const float r = 1.0f / sqrtf(wave_sum(s) * (1.f / 512.f) + EPS);
    u32x2* o8 = (u32x2*)orow + lane;
#pragma unroll
    for (int j = 0; j < 2; ++j) { u32x2 w; w.x = cvt_pk_bf16(v[j][0] * r, v[j][1] * r); w.y = cvt_pk_bf16(v[j][2] * r, v[j][3] * r); o8[64 * j] = w; }
}
__device__ __forceinline__ void kpe_row(const float* kr, const float* gkpe, const float* ropetab, int pos, bf16_t* kpe, float* sspe, int lane) {
    const float x = kr[lane]; const float ss = wave_sum(x * x);
    const float xg = x * gkpe[lane]; const float other = __shfl_xor(xg, 32);
    const f32x2 cs = *(const f32x2*)(ropetab + ((size_t)pos * 32 + (lane & 31)) * 2);
    const float o = lane < 32 ? xg * cs.x - other * cs.y : xg * cs.x + other * cs.y;
    kpe[lane] = (bf16_t)(cvt_pk_bf16(o, 0.f) & 0xffffu);
    if (lane == 0) *sspe = ss;
}
template <int R>
__device__ __forceinline__ void rms_rows_512(const float* x0, bf16_t* o0, int lane) {
    f32x4 v[R][2]; float s[R];
#pragma unroll
    for (int r = 0; r < R; ++r) { const f32x4* xr = (const f32x4*)(x0 + (size_t)r * 512) + lane;
#pragma unroll
        for (int j = 0; j < 2; ++j) v[r][j] = xr[64 * j]; }
#pragma unroll
    for (int r = 0; r < R; ++r) { s[r] = 0.f;
#pragma unroll
        for (int j = 0; j < 2; ++j) s[r] += (v[r][j][0] * v[r][j][0] + v[r][j][1] * v[r][j][1]) + (v[r][j][2] * v[r][j][2] + v[r][j][3] * v[r][j][3]); }
#pragma unroll
    for (int o = 1; o < 64; o <<= 1)
#pragma unroll
        for (int r = 0; r < R; ++r) s[r] += __shfl_xor(s[r], o);
#pragma unroll
    for (int r = 0; r < R; ++r) { const float rr = 1.0f / sqrtf(s[r] * (1.f / 512.f) + EPS); u32x2* o8 = (u32x2*)(o0 + (size_t)r * 512) + lane;
#pragma unroll
        for (int j = 0; j < 2; ++j) { u32x2 w; w.x = cvt_pk_bf16(v[r][j][0] * rr, v[r][j][1] * rr); w.y = cvt_pk_bf16(v[r][j][2] * rr, v[r][j][3] * rr); o8[64 * j] = w; } }
}
template <int R>
__device__ __forceinline__ void kpe_rows(const float* kr0, float gk, const float* ropetab, int pos0, bf16_t* kpe0, float* sspe0, int lane) {
    float x[R], ss[R]; f32x2 cs[R];
#pragma unroll
    for (int r = 0; r < R; ++r) { x[r] = kr0[(size_t)r * 64 + lane]; cs[r] = *(const f32x2*)(ropetab + ((size_t)(pos0 + r) * 32 + (lane & 31)) * 2); }
#pragma unroll
    for (int r = 0; r < R; ++r) ss[r] = x[r] * x[r];
#pragma unroll
    for (int o = 1; o < 64; o <<= 1)
#pragma unroll
        for (int r = 0; r < R; ++r) ss[r] += __shfl_xor(ss[r], o);
#pragma unroll
    for (int r = 0; r < R; ++r) { const float xg = x[r] * gk; const float other = __shfl_xor(xg, 32);
        const float o = lane < 32 ? xg * cs[r].x - other * cs[r].y : xg * cs[r].x + other * cs[r].y;
        kpe0[(size_t)r * 64 + lane] = (bf16_t)(cvt_pk_bf16(o, 0.f) & 0xffffu);
        if (lane == 0) sspe0[r] = ss[r]; }
}
__device__ __forceinline__ const float* x_row(const Ctx& F, int l, int row) {
    if (l == 0) return row < M_P ? F.in[I_XP] + (size_t)row * 2048 : F.in[I_XS] + (size_t)(row - M_P) * 2048;
    return (const float*)(F.ws + WS_X1) + (size_t)row * 2048;
}
__device__ __forceinline__ void past_kpe(const Ctx& F, int l);
__device__ __forceinline__ void phase_prep(const Ctx& F, int l) {
    const int gw = F.bid * 8 + F.wave, NGW = F.G * 8;
    float* ropetab = (float*)(F.ws + WS_ROPE);
    if (l == 0) {
        for (int i = gw * 64 + F.lane; i < 8192 * 32; i += NGW * 64) { const int pos = i >> 5, j = i & 31;
            const float inv = powf(10000.f, -(float)j / 32.f); const float ang = (float)pos * inv;
            const double a = (double)ang; const double n = rint(a * 0.15915494309189535); const float red = (float)(a - n * 6.283185307179586);
            ropetab[2 * i] = cosf(red); ropetab[2 * i + 1] = sinf(red); }
        for (int r = gw; r < N_MEM; r += NGW) rms_row_2048(F.in[I_MEM] + (size_t)r * 2048, (bf16_t*)(F.ws + WS_MEMN) + (size_t)r * 2048, F.lane);
    }
    prep_weights(F, l, gw, NGW, (l == 1 && h_early_ok(F.G)) ? (PW_ALL & ~PW_EARLY) : PW_ALL);
    for (int r = gw; r < M; r += NGW) rms_row_2048(x_row(F, l, r), (bf16_t*)(F.ws + WS_HB) + (size_t)r * 2048, F.lane);
#ifdef DUP_P2
    for (int r = gw; r < M; r += NGW) rms_row_2048(x_row(F, l, r), (bf16_t*)(F.ws + WS_HB) + (size_t)r * 2048, F.lane);
#endif
    const float* cc = F.in[I_CCKV] + (size_t)l * MPAST * 512;
    for (int r = gw * 4; r < MPAST; r += NGW * 4) rms_rows_512<4>(cc + (size_t)r * 512, (bf16_t*)(F.ws + WS_CNP) + (size_t)r * 512, F.lane);
    if (l > 0) past_kpe(F, l);
#ifdef DUP_P3
    for (int r = gw * 4; r < MPAST; r += NGW * 4) rms_rows_512<4>(cc + (size_t)r * 512, (bf16_t*)(F.ws + WS_CNP) + (size_t)r * 512, F.lane);
#endif
}
__device__ __forceinline__ void past_kpe(const Ctx& F, int l) {
    const int gw = F.bid * 8 + F.wave, NGW = F.G * 8;
    const float* ropetab = (const float*)(F.ws + WS_ROPE);
    const float* ck = F.in[I_CKR] + (size_t)l * MPAST * 64; const float* gk = F.in[I_GKN] + l * QK_HEAD + 128;
    const float gkl = gk[F.lane];
    for (int r = gw * 4; r < MPAST; r += NGW * 4) kpe_rows<4>(ck + (size_t)r * 64, gkl, ropetab, r & (PAST - 1), (bf16_t*)(F.ws + WS_KPEP) + (size_t)r * 64, (float*)(F.ws + WS_SSPEP) + r, F.lane);
}

__device__ __forceinline__ void glds16(const void* g, LAS void* l) { unsigned keep; const unsigned dst = (unsigned)(uintptr_t)l;
    asm volatile("s_mov_b32 %0, m0\n\ts_mov_b32 m0, %2\n\ts_nop 0\n\tglobal_load_lds_dwordx4 %1, off\n\ts_mov_b32 m0, %0" : "=&s"(keep) : "v"(g), "s"(dst) : "memory"); }
__device__ __forceinline__ void glds16s(const void* sbase, unsigned voff, LAS void* l) { const unsigned dst = (unsigned)(uintptr_t)l;
    asm volatile("s_mov_b32 m0, %2\n\ts_nop 0\n\tglobal_load_lds_dwordx4 %0, %1" :: "v"(voff), "s"(sbase), "s"(dst) : "memory", "m0"); }
__device__ __forceinline__ void glds4s(const void* sbase, unsigned voff, LAS void* l) { const unsigned dst = (unsigned)(uintptr_t)l;
    asm volatile("s_mov_b32 m0, %2\n\ts_nop 0\n\tglobal_load_lds_dword %0, %1" :: "v"(voff), "s"(sbase), "s"(dst) : "memory", "m0"); }
__device__ __forceinline__ void glds4(const void* g, LAS void* l) { unsigned keep; const unsigned dst = (unsigned)(uintptr_t)l;
    asm volatile("s_mov_b32 %0, m0\n\ts_mov_b32 m0, %2\n\ts_nop 0\n\tglobal_load_lds_dword %1, off\n\ts_mov_b32 m0, %0" : "=&s"(keep) : "v"(g), "s"(dst) : "memory"); }
template <int CR, int SB>
__device__ __forceinline__ void conv_chunk(const Ctx& F, int l, int tid, int seq0, int r0, int seqlen, int bb) {
    constexpr int CWIN = CR + CONV_ST;
    const int lane = tid & 63, wv = __builtin_amdgcn_readfirstlane(tid >> 6);
    asm volatile("" : "+s"(l));
    const float* cw = F.in[I_CONVW] + (size_t)l * CONV_K * 1024; const float* cb = F.in[I_CONVB] + l * 1024;
    const float* lg = F.in[I_LNG] + l * 1024; const float* lb = F.in[I_LNB] + l * 1024;
    const float* st = F.in[I_SCONV] + (size_t)l * NSTREAM * CONV_ST * 1024;
    const bf16_t* ub = (const bf16_t*)(F.ws + WS_UB); bf16_t* cv = (bf16_t*)(F.ws + WS_CV);
    LAS unsigned char* win = F.lds;
    LAS f32x2* red = (LAS f32x2*)(F.lds + CWIN * 2048);
    LAS f32x2* stat = red + 8 * SB;
    const int nh = r0 < CONV_ST ? CONV_ST - r0 : 0;
    for (int hr = 2 * nh + wv; hr < 2 * CWIN; hr += 8)
#ifdef CONV_NODMA
        *(LAS u32x4*)(win + hr * 1024 + lane * 16) = *(const u32x4*)(ub + (size_t)(seq0 + r0 - CONV_ST + (hr >> 1)) * 1024 + (hr & 1) * 512 + lane * 8);
#else
        glds16(ub + (size_t)(seq0 + r0 - CONV_ST + (hr >> 1)) * 1024 + (hr & 1) * 512 + lane * 8, win + hr * 1024);
#endif
    if (bb >= 0) {
        for (int hr0 = wv; hr0 < 2 * nh; hr0 += 32) { f32x4 a[4], b[4];
#pragma unroll
            for (int q = 0; q < 4; ++q) { const int hr = min(hr0 + 8 * q, 2 * nh - 1); const float* sp = st + ((size_t)bb * CONV_ST + r0 + (hr >> 1)) * 1024 + (hr & 1) * 512 + lane * 8; a[q] = *(const f32x4*)sp; b[q] = *(const f32x4*)(sp + 4); }
#pragma unroll
            for (int q = 0; q < 4; ++q) if (hr0 + 8 * q < 2 * nh) *(LAS u32x4*)(win + (hr0 + 8 * q) * 1024 + lane * 16) = pack8(a[q], b[q]); }
    } else for (int hr = wv; hr < 2 * nh; hr += 8) *(LAS u32x4*)(win + hr * 1024 + lane * 16) = (u32x4){0u, 0u, 0u, 0u};
    asm volatile("" ::: "memory");
    const int c0 = 2 * tid;
    f32x2 w[CONV_K];
#pragma unroll
    for (int k = 0; k < CONV_K; ++k) w[k] = *(const f32x2*)(cw + (size_t)k * 1024 + c0);
    const f32x2 bia = *(const f32x2*)(cb + c0);
    const f32x2 g2 = *(const f32x2*)(lg + c0), b2 = *(const f32x2*)(lb + c0);
    asm volatile("s_waitcnt vmcnt(0)" ::: "memory");
    __syncthreads();
#pragma unroll 1
    for (int sb = 0; sb < CR / SB; ++sb) {
        LAS const unsigned char* wp = win + sb * SB * 2048 + c0 * 2;
        f32x2 y[SB];
#pragma unroll
        for (int r = 0; r < SB; ++r) y[r] = bia;
#pragma unroll
        for (int jj = 0; jj < SB + CONV_ST; ++jj) { const unsigned uu = *(const LAS unsigned*)(wp + jj * 2048); const f32x2 u = {bf_lo(uu), bf_hi(uu)};
#pragma unroll
            for (int r = 0; r < SB; ++r) { const int k = jj - r; if (k >= 0 && k < CONV_K) y[r] = w[k] * u + y[r]; } }
#pragma unroll
        for (int r = 0; r < SB; ++r) { const float s1 = wave_sum(y[r].x + y[r].y), s2 = wave_sum(y[r].x * y[r].x + y[r].y * y[r].y); if (lane == 0) red[wv * SB + r] = (f32x2){s1, s2}; }
        __syncthreads();
        if (tid < SB) { float s1 = 0.f, s2 = 0.f;
#pragma unroll
            for (int q = 0; q < 8; ++q) { const f32x2 t = red[q * SB + tid]; s1 += t.x; s2 += t.y; }
            const float mean = s1 * (1.f / 1024.f); const float var = fmaxf(s2 * (1.f / 1024.f) - mean * mean, 0.f);
            stat[tid] = (f32x2){mean, 1.0f / sqrtf(var + EPS)}; }
        __syncthreads();
        const int rb = r0 + sb * SB;
#pragma unroll
        for (int r = 0; r < SB; ++r) { const f32x2 ms = stat[r];
            const float a = siluf_((y[r].x - ms.x) * ms.y * g2.x + b2.x), b = siluf_((y[r].y - ms.x) * ms.y * g2.y + b2.y);
            if (rb + r < seqlen) *(unsigned*)(cv + (size_t)(seq0 + rb + r) * 1024 + c0) = cvt_pk_bf16(a, b); }
    }
    __syncthreads();
}
__device__ __forceinline__ void phase_c(const Ctx& F, int l) {
    int tid = F.tid; asm volatile("" : "+v"(tid)); const int gw = F.bid * 8 + F.wave, NGW = F.G * 8, lane = tid & 63;
    for (int c = F.bid; c < 187 + 64; c += F.G) {
        if (c < 187) conv_chunk<44, 11>(F, l, tid, 0, c * 44, M_P, -1);
        else { const int q = c - 187; conv_chunk<32, 8>(F, l, tid, M_P + (q >> 1) * 64, (q & 1) * 32, DEC_SEQ, q >> 1); }
    }
    {
        const float* ropetab = (const float*)(F.ws + WS_ROPE); const float gkl = (F.in[I_GKN] + l * QK_HEAD + 128)[lane];
        constexpr int RB = 5;
        for (int r0 = gw * RB; r0 < M; r0 += NGW * RB) {
            f32x4 a[RB][2], c[RB][2]; float kx[RB], s[3 * RB]; f32x2 cs[RB];
#pragma unroll
            for (int i = 0; i < RB; ++i) { const int r = r0 + i;
                const f32x4* ap = (const f32x4*)((const float*)(F.ws + WS_QLATF) + (size_t)r * 512) + lane;
                const float* ckv = r < M_P ? F.out + O_PCKV + ((size_t)l * M_P + r) * 512 : F.out + O_SCKV + ((size_t)l * M_S + (r - M_P)) * 512;
                const float* kr = r < M_P ? F.out + O_PKR + ((size_t)l * M_P + r) * 64 : F.out + O_SKR + ((size_t)l * M_S + (r - M_P)) * 64;
                const int pos = r < M_P ? r : PAST + ((r - M_P) & 63);
                a[i][0] = ap[0]; a[i][1] = ap[64]; c[i][0] = ((const f32x4*)ckv)[lane]; c[i][1] = ((const f32x4*)ckv)[lane + 64];
                kx[i] = kr[lane]; cs[i] = *(const f32x2*)(ropetab + ((size_t)pos * 32 + (lane & 31)) * 2); }
#pragma unroll
            for (int i = 0; i < RB; ++i) { s[3 * i] = 0.f; s[3 * i + 1] = 0.f;
#pragma unroll
                for (int j = 0; j < 2; ++j) { s[3 * i] += (a[i][j][0] * a[i][j][0] + a[i][j][1] * a[i][j][1]) + (a[i][j][2] * a[i][j][2] + a[i][j][3] * a[i][j][3]);
                    s[3 * i + 1] += (c[i][j][0] * c[i][j][0] + c[i][j][1] * c[i][j][1]) + (c[i][j][2] * c[i][j][2] + c[i][j][3] * c[i][j][3]); }
                s[3 * i + 2] = kx[i] * kx[i]; }
#pragma unroll
            for (int o = 1; o < 64; o <<= 1)
#pragma unroll
                for (int i = 0; i < 3 * RB; ++i) s[i] += __shfl_xor(s[i], o);
#pragma unroll
            for (int i = 0; i < RB; ++i) { const int r = r0 + i;
                const float ra = 1.0f / sqrtf(s[3 * i] * (1.f / 512.f) + EPS), rc = 1.0f / sqrtf(s[3 * i + 1] * (1.f / 512.f) + EPS);
                u32x2* oa = (u32x2*)((bf16_t*)(F.ws + WS_QLATN) + (size_t)r * 512) + lane; u32x2* oc = (u32x2*)((bf16_t*)(F.ws + WS_CKVN) + (size_t)r * 512) + lane;
#pragma unroll
                for (int j = 0; j < 2; ++j) { u32x2 w; w.x = cvt_pk_bf16(a[i][j][0] * ra, a[i][j][1] * ra); w.y = cvt_pk_bf16(a[i][j][2] * ra, a[i][j][3] * ra); oa[64 * j] = w;
                    w.x = cvt_pk_bf16(c[i][j][0] * rc, c[i][j][1] * rc); w.y = cvt_pk_bf16(c[i][j][2] * rc, c[i][j][3] * rc); oc[64 * j] = w; }
                const float xg = kx[i] * gkl; const float other = __shfl_xor(xg, 32);
                const float o = lane < 32 ? xg * cs[i].x - other * cs[i].y : xg * cs[i].x + other * cs[i].y;
                ((bf16_t*)(F.ws + WS_KPEC))[(size_t)r * 64 + lane] = (bf16_t)(cvt_pk_bf16(o, 0.f) & 0xffffu);
                if (lane == 0) ((float*)(F.ws + WS_SSPEC))[r] = s[3 * i + 2]; }
        }
    }
    {
        const float* kvraw = (const float*)(F.ws + WS_KVRAW); const float* gx = F.in[I_GXK] + l * 256;
        for (int it = gw; it < N_MEM * 8; it += NGW) { const int t = it >> 3, hv = it & 7, isv = hv >> 2, h = hv & 3;
            const f32x4 v = *(const f32x4*)(kvraw + (size_t)t * 2048 + isv * 1024 + h * 256 + 4 * lane);
            f32x4 o = v;
            if (!isv) { const float ss = wave_sum((v[0] * v[0] + v[1] * v[1]) + (v[2] * v[2] + v[3] * v[3])); const float r = 1.0f / sqrtf(ss * (1.f / 256.f) + EPS);
                const f32x4 g = *(const f32x4*)(gx + 4 * lane); o = v * r * g; }
            float* op = F.out + (isv ? O_PMV : O_PMK) + (size_t)l * N_MEM * 1024 + (size_t)t * 1024 + h * 256 + 4 * lane;
            *(f32x4*)op = o;
            u32x2 w; w.x = cvt_pk_bf16(o[0], o[1]); w.y = cvt_pk_bf16(o[2], o[3]);
            *(u32x2*)((bf16_t*)(F.ws + (isv ? WS_MVB : WS_MKB)) + (size_t)t * 1024 + h * 256 + 4 * lane) = w;
        }
    }
}
__device__ __forceinline__ void phase_e(const Ctx& F, int l) {
    const int gw = F.bid * 8 + F.wave, NGW = F.G * 8, lane = F.lane;
    const float* ropetab = (const float*)(F.ws + WS_ROPE);
    const float* gq = F.in[I_GQN] + l * QK_HEAD; const float* gk = F.in[I_GKN] + l * QK_HEAD; const float* gxq = F.in[I_GXQ] + l * 256;
    const f32x4 gx4 = *(const f32x4*)(gxq + 4 * lane) * C_X;
    const bf16_t* qraw = (const bf16_t*)(F.ws + WS_QRAW); bf16_t* Q = (bf16_t*)(F.ws + WS_Q); bf16_t* xq = (bf16_t*)(F.ws + WS_XQ);
    {
        const size_t gt = (size_t)F.bid * 512 + F.tid, GT = (size_t)F.G * 512;
        const float* SSC = (const float*)(F.ws + WS_SSC); const float* SSPEC = (const float*)(F.ws + WS_SSPEC); float* RKC = (float*)(F.ws + WS_RKC);
        for (size_t i = gt; i < (size_t)16 * M; i += GT) { const f32x4 s4 = *(const f32x4*)(SSC + i * 4); const int row = (int)(i % M);
            RKC[i] = 1.0f / sqrtf(((s4[0] + s4[1]) + (s4[2] + s4[3]) + SSPEC[row]) * (1.f / 192.f) + EPS); }
        const float* SSP = (const float*)(F.ws + WS_SSP); const float* SSPEP = (const float*)(F.ws + WS_SSPEP); float* RKP = (float*)(F.ws + WS_RKP);
        for (size_t i4 = gt; i4 < (size_t)MPAST * 4; i4 += GT) { const size_t PL = (size_t)MPAST * 16, i = i4 * 4; const size_t bb = i >> 16, t = i & 4095;
            const f32x4 s = (*(const f32x4*)(SSP + i) + *(const f32x4*)(SSP + PL + i)) + (*(const f32x4*)(SSP + 2 * PL + i) + *(const f32x4*)(SSP + 3 * PL + i)) + *(const f32x4*)(SSPEP + bb * 4096 + t);
            f32x4 o; o[0] = 1.0f / sqrtf(s[0] * (1.f / 192.f) + EPS); o[1] = 1.0f / sqrtf(s[1] * (1.f / 192.f) + EPS); o[2] = 1.0f / sqrtf(s[2] * (1.f / 192.f) + EPS); o[3] = 1.0f / sqrtf(s[3] * (1.f / 192.f) + EPS);
            *(f32x4*)(RKP + i) = o; }
    }
    f32x4 gsc;
    { const int e0 = lane < 32 ? 4 * lane : 128 + 4 * (lane & 15);
      const f32x4 q4 = *(const f32x4*)(gq + e0); gsc = q4 * C_MLA; if (lane < 32) gsc = gsc * *(const f32x4*)(gk + e0); }
    for (int r = gw; r < M; r += NGW) {
        const int pos = r < M_P ? r : PAST + ((r - M_P) & 63);
        const float* ct = ropetab + ((size_t)pos * 32 + 4 * (lane & 7)) * 2;
        const f32x4 c01 = *(const f32x4*)ct, c23 = *(const f32x4*)(ct + 4);
        u32x2 xw[4];
#pragma unroll
        for (int h = 0; h < 4; ++h) xw[h] = ((const u32x2*)(xq + (size_t)r * 1024 + h * 256))[lane];
        for (int h0 = 0; h0 < NH; h0 += 8) {
            f32x4 v[8]; float ss[8];
#pragma unroll
            for (int j = 0; j < 8; ++j) { u32x2 w = {0u, 0u}; if (lane < 48) w = *(const u32x2*)(qraw + (size_t)r * 3072 + (h0 + j) * 192 + 4 * lane);
                v[j] = (f32x4){bf_lo(w.x), bf_hi(w.x), bf_lo(w.y), bf_hi(w.y)}; ss[j] = (v[j][0] * v[j][0] + v[j][1] * v[j][1]) + (v[j][2] * v[j][2] + v[j][3] * v[j][3]); }
#pragma unroll
            for (int o = 1; o < 64; o <<= 1)
#pragma unroll
                for (int j = 0; j < 8; ++j) ss[j] += __shfl_xor(ss[j], o);
#pragma unroll
            for (int j = 0; j < 8; ++j) { const float rq = 1.0f / sqrtf(ss[j] * (1.f / 192.f) + EPS);
                f32x4 x = v[j] * rq * gsc;
                f32x4 ot; ot[0] = __shfl_xor(x[0], 8); ot[1] = __shfl_xor(x[1], 8); ot[2] = __shfl_xor(x[2], 8); ot[3] = __shfl_xor(x[3], 8);
                if (lane >= 32) { const float sg = lane < 40 ? -1.f : 1.f;
                    x = (f32x4){x[0] * c01[0] + sg * ot[0] * c01[1], x[1] * c01[2] + sg * ot[1] * c01[3], x[2] * c23[0] + sg * ot[2] * c23[1], x[3] * c23[2] + sg * ot[3] * c23[3]}; }
                if (lane < 48) { u32x2 ow; ow.x = cvt_pk_bf16(x[0], x[1]); ow.y = cvt_pk_bf16(x[2], x[3]); *(u32x2*)(Q + ((size_t)r * NH + h0 + j) * 192 + 4 * lane) = ow; } }
        }
#pragma unroll
        for (int h = 0; h < 4; ++h) {
            const u32x2 w = xw[h]; u32x2* po = (u32x2*)((bf16_t*)(F.ws + WS_XQN) + (size_t)r * 1024 + h * 256) + lane;
            const f32x4 v = (f32x4){bf_lo(w.x), bf_hi(w.x), bf_lo(w.y), bf_hi(w.y)};
            const float ss = wave_sum((v[0] * v[0] + v[1] * v[1]) + (v[2] * v[2] + v[3] * v[3])); const float rr = 1.0f / sqrtf(ss * (1.f / 256.f) + EPS);
            const f32x4 o = v * rr * gx4; u32x2 ow; ow.x = cvt_pk_bf16(o[0], o[1]); ow.y = cvt_pk_bf16(o[2], o[3]); *po = ow;
        }
    }
}

constexpr int AP_KN = 0, AP_KPE = 16384, AP_V = 24576, AP_RK = 40960;
constexpr int AX_K = 0, AX_V = 32768, AX_AL = 49152;

__device__ __forceinline__ int swap23(int k) { return (k & ~0xC) | ((k & 4) << 1) | ((k & 8) >> 1); }
__device__ __forceinline__ int src_kn(int o) { const int row = o >> 8, colB = (o & 255) ^ ((row & 7) << 4); return row * 128 + (colB >> 1); }
__device__ __forceinline__ int src_kpe(int o) { const int row = o >> 7, colB = (o & 127) ^ ((row & 7) << 4); return row * 64 + (colB >> 1); }
__device__ __forceinline__ int src_v1024(int o) { const int sub = o >> 9, kk = (sub >> 2) * 8 + ((o & 511) >> 6), c = (sub & 3) * 32 + ((o & 63) >> 1); return swap23(kk) * 1024 + c; }
__device__ __forceinline__ int src_v(int o) { const int sub = o >> 9, kk = (sub >> 2) * 8 + ((o & 511) >> 6), c = (sub & 3) * 32 + ((o & 63) >> 1); return swap23(kk) * 128 + c; }

constexpr int AQ_KBUF = 24832, AQ_KPE = 16384, AQ_RK = 24576, AQ_V0 = 3 * AQ_KBUF, AQ_VBUF = 16384, AQ_AL = AQ_V0 + 4 * AQ_VBUF;
__device__ __forceinline__ void mla_prompt_unit(const Ctx& F, int h, int qb, float negB2) {
    int tid = F.tid; asm volatile("" : "+v"(tid)); const int wid = F.wave, lane = tid & 63, r32 = lane & 31, hi = lane >> 5;
    const bf16_t* Q = (const bf16_t*)(F.ws + WS_Q); const bf16_t* KC = (const bf16_t*)(F.ws + WS_KC) + (size_t)h * M * 128; const bf16_t* VC = (const bf16_t*)(F.ws + WS_VC) + (size_t)h * M * 128;
    const float* RK = (const float*)(F.ws + WS_RKC) + (size_t)h * M; const bf16_t* KPE = (const bf16_t*)(F.ws + WS_KPEC);
    const int row0 = qb * 256 + wid * 32;
    f32x16 o[4];
#pragma unroll
    for (int d = 0; d < 4; ++d)
#pragma unroll
        for (int r = 0; r < 16; ++r) o[d][r] = 0.f;
    float l_part = 0.f;
    const int nt_all = 4 * qb + 4, nt_w = 4 * qb + (wid >> 1) + 1;
    const bool late = false;
    LAS char* L = (LAS char*)F.lds; LAS float* al_l = (LAS float*)(L + AQ_AL) + wid * 32;
    const LAS char* vb0 = L + AQ_V0 + att::v_rd_base(lane);
    unsigned okn[2], ov[2];
#pragma unroll
    for (int i = 0; i < 2; ++i) { const int o16 = ((wid * 2 + i) * 64 + lane) * 16; okn[i] = (unsigned)src_kn(o16) * 2u; ov[i] = (unsigned)src_v(o16) * 2u; }
    const unsigned okp = (unsigned)src_kpe((wid * 64 + lane) * 16) * 2u, ork = (unsigned)lane * 4u;
#define MP_ISSUE(t) do { LAS char* Lk = L + ((t) % 3) * AQ_KBUF; LAS char* Lv = L + AQ_V0 + ((t) & 3) * AQ_VBUF; const size_t kb_ = (size_t)(t) * 64; \
        glds16s(KC + kb_ * 128, okn[0], Lk + (wid * 2) * 1024); glds16s(KC + kb_ * 128, okn[1], Lk + (wid * 2 + 1) * 1024); \
        glds16s(VC + kb_ * 128, ov[0], Lv + (wid * 2) * 1024); glds16s(VC + kb_ * 128, ov[1], Lv + (wid * 2 + 1) * 1024); \
        glds16s(KPE + kb_ * 64, okp, Lk + AQ_KPE + wid * 1024); \
        if (wid == 0) glds4s(RK + kb_, ork, Lk + AQ_RK); } while (0)
    __builtin_amdgcn_s_barrier();
    MP_ISSUE(0); MP_ISSUE(1);
    bf16x8 qr[12];
    { const bf16_t* qp = Q + ((size_t)(row0 + r32) * NH + h) * 192 + hi * 8;
#pragma unroll
      for (int d0 = 0; d0 < 12; ++d0) qr[d0] = *(const bf16x8*)(qp + d0 * 16);
#pragma unroll
      for (int d0 = 0; d0 < 12; ++d0) asm volatile("" :: "v"(qr[d0])); }
    bf16x8 pa[4] = {};
    for (int t = 0; t < nt_all; ++t) {
        if (t + 1 < nt_all) { if (wid == 0) asm volatile("s_waitcnt vmcnt(6)" ::: "memory"); else asm volatile("s_waitcnt vmcnt(5)" ::: "memory"); }
        else asm volatile("s_waitcnt vmcnt(0)" ::: "memory");
        __builtin_amdgcn_s_barrier();
        asm volatile("" ::: "memory");
        if (t + 2 < nt_all) MP_ISSUE(t + 2);
        if (late && t >= 1 && t - 1 < nt_w) att::pv_fs<4, 2>(o, vb0 + ((t - 1) & 3) * AQ_VBUF, pa);
        if (t < nt_w) {
            const LAS char* Lk = L + (t % 3) * AQ_KBUF;
            att::qk_sm<8, 4, 2, 256>(qr, l_part, Lk, Lk + AQ_KPE, (const LAS float*)(Lk + AQ_RK), negB2, r32, hi, pa);
#ifdef PROBE_QK2
            { bf16x8 pa2[4]; float l2 = 0.f; int r32b = r32; asm volatile("" : "+v"(r32b)); att::qk_sm<8, 4, 2, 256>(qr, l2, Lk, Lk + AQ_KPE, (const LAS float*)(Lk + AQ_RK), negB2, r32b, hi, pa2);
              asm volatile("" :: "v"(pa2[0]), "v"(pa2[1]), "v"(pa2[2]), "v"(pa2[3]), "v"(l2)); }
#endif
#ifdef PROBE_PV2
            { f32x16 o2[4];
#pragma unroll
              for (int d = 0; d < 4; ++d)
#pragma unroll
                  for (int r = 0; r < 16; ++r) o2[d][r] = 0.f;
              att::pv_fs<4, 2>(o2, vb0 + (t & 3) * AQ_VBUF, pa);
              asm volatile("" :: "v"(o2[0]), "v"(o2[1]), "v"(o2[2]), "v"(o2[3])); }
#endif
            if (!late) att::pv_fs<4, 2>(o, vb0 + (t & 3) * AQ_VBUF, pa);
        }
    }
    if (late && nt_all - 1 < nt_w) att::pv_fs<4, 2>(o, vb0 + ((nt_all - 1) & 3) * AQ_VBUF, pa);
#undef MP_ISSUE
    att::finish<4>(o, att::lane_pair_sum(l_part), al_l, (bf16_t*)(F.ws + WS_AMLA) + (size_t)row0 * 2048 + h * 128, (const bf16_t*)(F.ws + WS_ZM) + (size_t)row0 * 2048 + h * 128, 2048, r32, hi);
}
constexpr int AC_KN = 0, AC_KPE = 8192, AC_CN = 10240, AC_RK = 26624, AC_BUF = 26752, AC_NB = 6, AC_AL = AC_NB * AC_BUF;
static_assert(AC_AL + 1024 <= SCRATCH_TOP, "sample attention ring + row-sum scratch inside the phase scratch");
__device__ __forceinline__ int src_cn(int o) { const int sub = o >> 9, kk = (sub >> 4) * 8 + ((o & 511) >> 6), c = (sub & 15) * 32 + ((o & 63) >> 1); return swap23(kk) * 512 + c; }
#ifndef PROBE_HOT
#define PROBE_HOT 0
#endif
__device__ __forceinline__ void mla_sample_unit(const Ctx& F, int b, int hp, float negB2, bool rep2 = false) {
    int tid = F.tid; asm volatile("" : "+v"(tid)); const int wid = F.wave, lane = tid & 63, r32 = lane & 31, hi = lane >> 5;
    const int g = wid >> 2, rg = (wid >> 1) & 1, lh = wid & 1, h = hp * 2 + g;
    const bf16_t* Q = (const bf16_t*)(F.ws + WS_Q);
    const int row0 = M_P + b * 64 + rg * 32;
    f32x16 o[8];
#pragma unroll
    for (int d = 0; d < 8; ++d)
#pragma unroll
        for (int r = 0; r < 16; ++r) o[d][r] = 0.f;
    float l_part = 0.f;
    constexpr int SC_CS = 16384, SC_NC = 5, SC_K0 = SC_CS * SC_NC, SC_KS = 10368, SC_NK = 6, SK_KPE = 8192, SK_RK = 10240, SC_P0 = SC_K0 + SC_KS * SC_NK, SC_AL = SC_P0 + 4 * 2048;
    static_assert(SC_AL + 1024 <= SCRATCH_TOP && SC_AL >= 131072, "sample attention LDS map");
    LAS char* L = (LAS char*)F.lds; LAS float* al_l = (LAS float*)(L + SC_AL) + wid * 32; LAS float* al_p = (LAS float*)(L + SC_AL) + (wid ^ 1) * 32;
    LAS char* Pb = L + SC_P0 + (wid >> 1) * 2048 + lane * 32;
    const int dg = wid >> 2, dh = hp * 2 + dg;
    const bf16_t* KPt = (const bf16_t*)(F.ws + WS_KP); const bf16_t* KCh = (const bf16_t*)(F.ws + WS_KC) + ((size_t)dh * M + M_P + b * 64) * 128;
    const bf16_t* CNP = (const bf16_t*)(F.ws + WS_CNP) + (size_t)b * 4096 * 512; const bf16_t* CNC = (const bf16_t*)(F.ws + WS_CKVN) + (size_t)(M_P + b * 64) * 512;
    const bf16_t* KPEP = (const bf16_t*)(F.ws + WS_KPEP) + (size_t)b * 4096 * 64; const bf16_t* KPEC = (const bf16_t*)(F.ws + WS_KPEC) + (size_t)(M_P + b * 64) * 64;
    const float* RKPb = (const float*)(F.ws + WS_RKP) + (size_t)(b * 16 + hp * 2) * 4096; const float* RKCb = (const float*)(F.ws + WS_RKC) + (size_t)(hp * 2) * M + M_P + b * 64;
    constexpr int NT = 260, NS = NT / 2;
    unsigned voffKp, voffKc, voffC0, voffC1, voffX;
    { const int o16 = ((wid & 3) * 64 + lane) * 16, r = o16 >> 8, cB = (o16 & 255) ^ ((r & 7) << 4), cc = cB >> 4;
      voffKp = (unsigned)((((dg * 4 + (cc >> 2)) * 64) + (cc & 3) * 16 + r) * 8) * 2u; voffKc = (unsigned)(r * 128 + (cB >> 1)) * 2u;
      voffC0 = (unsigned)src_cn(((wid * 2) * 64 + lane) * 16) * 2u; voffC1 = (unsigned)src_cn(((wid * 2 + 1) * 64 + lane) * 16) * 2u;
      voffX = wid < 2 ? (unsigned)src_kpe(((wid & 1) * 64 + lane) * 16) * 2u : (unsigned)((((lane >> 4) & 1) * 4096 + (lane & 15)) * 4); }
#define MS_ISSUE_C(tt) do { const int t_ = (tt) < NT ? (tt) : NT - 1; LAS char* Lc = L + ((tt) % SC_NC) * SC_CS; \
        if (t_ < 256) { const bf16_t* cs_ = CNP + (size_t)t_ * 16 * 512; glds16s(cs_, voffC0, Lc + (wid * 2) * 1024); glds16s(cs_, voffC1, Lc + (wid * 2 + 1) * 1024); } \
        else { const bf16_t* cs_ = CNC + (size_t)(t_ - 256) * 16 * 512; glds16s(cs_, voffC0, Lc + (wid * 2) * 1024); glds16s(cs_, voffC1, Lc + (wid * 2 + 1) * 1024); } } while (0)
#define MS_ISSUE_K(tt) do { const int t_ = (tt) < NT ? (tt) : NT - 1; LAS char* Lk = L + SC_K0 + ((tt) % SC_NK) * SC_KS; \
        if (t_ < 256) { const size_t kb_ = (size_t)t_ * 16, grow = (size_t)b * 4096 + kb_; const size_t blk = ((((grow >> 8) * 8 + hp) * 2 + ((grow >> 7) & 1)) * 2 + ((grow >> 6) & 1)) * 4 + ((grow >> 4) & 3); \
            glds16s(KPt + blk * 4096, voffKp, Lk + wid * 1024); \
            if (wid < 2) glds16s(KPEP + kb_ * 64, voffX, Lk + SK_KPE + wid * 1024); \
            if (wid == 2) { if (lane < 32) glds4s(RKPb + kb_, voffX, Lk + SK_RK); } } \
        else { const size_t kb_ = (size_t)(t_ - 256) * 16; \
            glds16s(KCh + kb_ * 128, voffKc, Lk + wid * 1024); \
            if (wid < 2) glds16s(KPEC + kb_ * 64, voffX, Lk + SK_KPE + wid * 1024); \
            if (wid == 2) { if (lane < 32) glds4s(RKCb + kb_, (unsigned)((((lane >> 4) & 1) * M + (lane & 15)) * 4), Lk + SK_RK); } } } while (0)
    __builtin_amdgcn_s_barrier();
    MS_ISSUE_K(0); MS_ISSUE_K(1); MS_ISSUE_K(2); MS_ISSUE_K(3); MS_ISSUE_C(0);
    bf16x8 qr[12];
    { const bf16_t* qp = Q + ((size_t)(row0 + r32) * NH + h) * 192 + hi * 8;
#pragma unroll
      for (int d0 = 0; d0 < 12; ++d0) qr[d0] = *(const bf16x8*)(qp + d0 * 16);
#pragma unroll
      for (int d0 = 0; d0 < 12; ++d0) asm volatile("" :: "v"(qr[d0])); }
    const int vrb = lh * 8 * 512 + att::v_rd_base(lane);
    bf16x8 pk[2] = {};
    for (int s = -1; s < NS; ++s) {
        if (s < 0) asm volatile("s_waitcnt vmcnt(0)" ::: "memory"); else if (wid < 3) asm volatile("s_waitcnt vmcnt(6)" ::: "memory"); else asm volatile("s_waitcnt vmcnt(4)" ::: "memory");
        __builtin_amdgcn_s_barrier();
        asm volatile("" ::: "memory");
        const bool mine = (lh == ((s + g) & 1));
        if (!mine && s >= 0) { pk[0] = *(const LAS bf16x8*)Pb; pk[1] = *(const LAS bf16x8*)(Pb + 16); }
        MS_ISSUE_C(2 * s + 3); MS_ISSUE_C(2 * s + 4); MS_ISSUE_K(2 * s + 6); MS_ISSUE_K(2 * s + 7);
        if (s >= 0) {
            asm volatile("" : "+v"(pk[0]), "+v"(pk[1]));
            const int vA = (int)(uintptr_t)(L + ((2 * s) % SC_NC) * SC_CS + vrb), vB = (int)(uintptr_t)(L + ((2 * s + 1) % SC_NC) * SC_CS + vrb);
            s16x4 lo[4], hh[4];
#define MS_TR(i) do { asm volatile("ds_read_b64_tr_b16 %0, %1 offset:%c2" : "=&v"(lo[(i) & 3]) : "v"((i) < 8 ? vA : vB), "i"(((i) & 7) * 512) : "memory"); \
                      asm volatile("ds_read_b64_tr_b16 %0, %1 offset:%c2" : "=&v"(hh[(i) & 3]) : "v"((i) < 8 ? vA : vB), "i"(((i) & 7) * 512 + 16 * 512) : "memory"); } while (0)
            __builtin_amdgcn_sched_barrier(0);
            MS_TR(0); MS_TR(1); MS_TR(2);
            __builtin_amdgcn_s_setprio(1);
#pragma unroll
            for (int i = 0; i < 16; ++i) {
                if (i + 3 < 16) { MS_TR(i + 3); asm volatile("s_waitcnt lgkmcnt(6)" ::: "memory"); }
                else if (i + 2 < 16) asm volatile("s_waitcnt lgkmcnt(4)" ::: "memory");
                else if (i + 1 < 16) asm volatile("s_waitcnt lgkmcnt(2)" ::: "memory");
                else asm volatile("s_waitcnt lgkmcnt(0)" ::: "memory");
                __builtin_amdgcn_sched_barrier(0);
                { const s16x4 l_ = lo[i & 3], h_ = hh[i & 3]; const bf16x8 vf = (bf16x8){l_[0], l_[1], l_[2], l_[3], h_[0], h_[1], h_[2], h_[3]};
                  o[i & 7] = __builtin_amdgcn_mfma_f32_32x32x16_bf16(pk[i >> 3], vf, o[i & 7], 0, 0, 0); }
                __builtin_amdgcn_sched_barrier(0);
            }
            __builtin_amdgcn_s_setprio(0);
#undef MS_TR
        }
        if (!mine && s + 1 < NS) {
            const LAS char* KA = L + SC_K0 + ((2 * s + 2) % SC_NK) * SC_KS; const LAS char* KB = L + SC_K0 + ((2 * s + 3) % SC_NK) * SC_KS;
            const LAS char* Lm = r32 < 16 ? KA : KB;
            const LAS char* Ks = Lm + g * 4096; const LAS char* Kp = Lm + SK_KPE; const int kr = r32 & 15;
            f32x16 p;
#pragma unroll
            for (int r = 0; r < 16; ++r) p[r] = 0.f;
            auto kfrag = [&](int d) -> bf16x8 { return d < 8 ? *(const LAS bf16x8*)(Ks + att::kswz<256>(kr, (d * 16 + hi * 8) * 2)) : *(const LAS bf16x8*)(Kp + att::kswz<128>(kr, ((d - 8) * 16 + hi * 8) * 2)); };
            bf16x8 kf[3];
            kf[0] = kfrag(0); kf[1] = kfrag(1);
            __builtin_amdgcn_s_setprio(1);
#pragma unroll
            for (int d0 = 0; d0 < 12; ++d0) {
                if (d0 + 2 < 12) kf[(d0 + 2) % 3] = kfrag(d0 + 2);
                p = __builtin_amdgcn_mfma_f32_32x32x16_bf16(kf[d0 % 3], qr[d0], p, 0, 0, 0);
            }
            __builtin_amdgcn_s_setprio(0);
            float ps = 0.f;
#pragma unroll
            for (int hf2 = 0; hf2 < 2; ++hf2) {
                f32x4 sc[2];
#pragma unroll
                for (int i2 = 0; i2 < 2; ++i2) { const LAS float* rk = (const LAS float*)((hf2 == 0 ? KA : KB) + SK_RK) + g * 16; sc[i2] = *(const LAS f32x4*)(rk + 8 * i2 + 4 * hi); }
#pragma unroll
                for (int i2 = 0; i2 < 2; ++i2)
#pragma unroll
                    for (int j = 0; j < 4; ++j) { const int i = hf2 * 2 + i2; const float e = __builtin_amdgcn_exp2f(fmaf(p[4 * i + j], sc[i2][j], negB2)); p[4 * i + j] = e; ps += e; }
                asm volatile("" ::: "memory");
            }
            l_part += ps;
#pragma unroll
            for (int hf = 0; hf < 2; ++hf) { const int B = hf * 8;
                const unsigned a0 = cvt_pk_bf16(p[B + 0], p[B + 1]), a1 = cvt_pk_bf16(p[B + 2], p[B + 3]), b0 = cvt_pk_bf16(p[B + 4], p[B + 5]), b1 = cvt_pk_bf16(p[B + 6], p[B + 7]);
                auto r0 = __builtin_amdgcn_permlane32_swap(a0, b0, false, false); auto r1 = __builtin_amdgcn_permlane32_swap(a1, b1, false, false);
                u32x4 w = {r0[0], r1[0], r0[1], r1[1]}; pk[hf] = __builtin_bit_cast(bf16x8, w); }
            *(LAS bf16x8*)Pb = pk[0]; *(LAS bf16x8*)(Pb + 16) = pk[1];
            LDS_WAIT();
        }
    }
#undef MS_ISSUE_C
#undef MS_ISSUE_K
    asm volatile("s_waitcnt vmcnt(0)" ::: "memory");
    const float lsum = att::lane_pair_sum(l_part);
    if (hi == 0) al_l[r32] = lsum;
    LDS_WAIT();
    __builtin_amdgcn_s_barrier();
    asm volatile("" ::: "memory");
#pragma unroll
    for (int r = 0; r < 16; ++r) { const int q = att::crow(r, hi); const float rl = __builtin_amdgcn_rcpf(al_l[q] + al_p[q]); const int qrow = rg * 32 + q;
#pragma unroll
        for (int d0 = 0; d0 < 8; ++d0) { const int colB = ((lh * 8 + d0) * 32 + r32) * 2;
            *(LAS bf16_t*)(L + g * 65536 + att::kswz<1024>(qrow, colB)) = (bf16_t)(cvt_pk_bf16(o[d0][r] * rl, 0.f) & 0xffffu); } }
    LDS_WAIT();
    __builtin_amdgcn_s_barrier();
    asm volatile("" ::: "memory");
    {
        const int g2 = wid >> 2, rg2 = (wid >> 1) & 1, dvh = wid & 1, h2 = hp * 2 + g2;
        const bf16_t* Wuv = (const bf16_t*)(F.ws + WS_WUKV) + ((size_t)(h2 * 256 + 128 + dvh * 64 + r32)) * 512 + hi * 8;
        const int orow0 = M_P + b * 64 + rg2 * 32;
        bf16_t* out = (bf16_t*)(F.ws + ((PROBE_HOT != 0 && rep2) ? WS_VP : WS_AMLA)) + (size_t)orow0 * 2048 + h2 * 128 + dvh * 64; const bf16_t* z = (const bf16_t*)(F.ws + WS_ZM) + (size_t)orow0 * 2048 + h2 * 128 + dvh * 64;
        const bool odd = r32 & 1;
        unsigned zw[2][8];
#pragma unroll
        for (int k2 = 0; k2 < 2; ++k2)
#pragma unroll
            for (int r = 0; r < 16; r += 2) zw[k2][r >> 1] = *(const unsigned*)(z + (size_t)(att::crow(r, hi) + (odd ? 1 : 0)) * 2048 + k2 * 32 + (r32 & ~1));
        f32x16 acc[2];
#pragma unroll
        for (int k2 = 0; k2 < 2; ++k2)
#pragma unroll
            for (int r = 0; r < 16; ++r) acc[k2][r] = 0.f;
#pragma unroll 16
        for (int ks = 0; ks < 32; ++ks) {
            const bf16x8 a = *(const LAS bf16x8*)(L + g2 * 65536 + att::kswz<1024>(rg2 * 32 + r32, (ks * 16 + hi * 8) * 2));
            const bf16x8 bw0 = *(const bf16x8*)(Wuv + ks * 16), bw1 = *(const bf16x8*)(Wuv + (size_t)32 * 512 + ks * 16);
            acc[0] = __builtin_amdgcn_mfma_f32_32x32x16_bf16(a, bw0, acc[0], 0, 0, 0); acc[1] = __builtin_amdgcn_mfma_f32_32x32x16_bf16(a, bw1, acc[1], 0, 0, 0);
        }
#pragma unroll
        for (int k2 = 0; k2 < 2; ++k2)
#pragma unroll
            for (int r = 0; r < 16; r += 2) { const float va = acc[k2][r], vb2 = acc[k2][r + 1];
                const float recv = __shfl_xor(odd ? va : vb2, 1); const float v0 = odd ? recv : va, v1 = odd ? vb2 : recv; const unsigned w = zw[k2][r >> 1];
                *(unsigned*)(out + (size_t)(att::crow(r, hi) + (odd ? 1 : 0)) * 2048 + k2 * 32 + (r32 & ~1)) = cvt_pk_bf16(v0 * bf_lo(w), v1 * bf_hi(w)); }
    }
    __builtin_amdgcn_s_barrier();
}
template <bool SAMPLE>
__device__ __forceinline__ void cross_unit(const Ctx& F, int l, int x, int h, int dvh) {
    int tid = F.tid; asm volatile("" : "+v"(tid)); const int wid = F.wave, lane = tid & 63, r32 = lane & 31, hi = lane >> 5;
    if (SAMPLE) {
        LAS char* L = (LAS char*)F.lds; constexpr int XB = 49152; LAS float* al_l = (LAS float*)(L + 2 * XB) + wid * 32;
        const float* kf = F.in[I_CMK] + ((size_t)l * NSTREAM + x) * N_MEM * 1024 + h * 256; const float* vf = F.in[I_CMV] + ((size_t)l * NSTREAM + x) * N_MEM * 1024 + h * 256 + dvh * 128;
        __syncthreads();
        if (wid < 2) {
            const int row0 = M_P + x * 64 + wid * 32;
            bf16x8 qr[16];
            { const bf16_t* qp = (const bf16_t*)(F.ws + WS_XQN) + (size_t)(row0 + r32) * 1024 + h * 256 + hi * 8;
#pragma unroll
              for (int d0 = 0; d0 < 16; ++d0) qr[d0] = *(const bf16x8*)(qp + d0 * 16); }
            f32x16 o[4];
#pragma unroll
            for (int d = 0; d < 4; ++d)
#pragma unroll
                for (int r = 0; r < 16; ++r) o[d][r] = 0.f;
            float m_reg = -1e30f, l_reg = 0.f;
            const int vb = (int)(uintptr_t)(L + AX_V) + att::v_rd_base(lane);
            for (int t = 0; t < 4; ++t) {
                __builtin_amdgcn_s_barrier();
                asm volatile("" ::: "memory");
                att::tile_step<16, 0, 4, 2, false, 512>(qr, o, m_reg, l_reg, L + (t & 1) * XB + AX_K, L + (t & 1) * XB + AX_K, vb + (t & 1) * XB, (const LAS float*)nullptr, al_l, r32, hi);
            }
            att::finish<4>(o, l_reg, al_l, (bf16_t*)(F.ws + WS_AX) + (size_t)row0 * 1024 + h * 256 + dvh * 128, (const bf16_t*)(F.ws + WS_ZX) + (size_t)row0 * 1024 + h * 256 + dvh * 128, 1024, r32, hi);
        } else {
            const int lt = tid - 128;
            f32x4 ra[8][2], rb[8][2];
#define XS_LOAD(t, R) do { _Pragma("unroll") for (int i = 0; i < 8; ++i) { const int c = lt + 384 * i; const bool isk = c < 2048; const int cv = c - 2048; \
                const float* sp = isk ? kf + (size_t)((t) * 64 + (c >> 5)) * 1024 + (c & 31) * 8 : vf + (size_t)((t) * 64 + (cv >> 4)) * 1024 + (cv & 15) * 8; \
                R[i][0] = *(const f32x4*)sp; R[i][1] = *(const f32x4*)(sp + 4); } } while (0)
#define XS_STORE(t, R) do { LAS char* Lb = L + ((t) & 1) * XB; _Pragma("unroll") for (int i = 0; i < 8; ++i) { const int c = lt + 384 * i; const bool isk = c < 2048; const int cv = c - 2048; \
                const int dst = isk ? AX_K + att::kswz<512>(c >> 5, (c & 31) * 16) : AX_V + att::v_st<4>(cv >> 4, (cv & 15) * 8); \
                *(LAS u32x4*)(Lb + dst) = pack8(R[i][0], R[i][1]); } \
                LDS_WAIT(); __builtin_amdgcn_s_barrier(); asm volatile("" ::: "memory"); } while (0)
            XS_LOAD(0, ra);
            XS_LOAD(1, rb); XS_STORE(0, ra);
            XS_LOAD(2, ra); XS_STORE(1, rb);
            XS_LOAD(3, rb); XS_STORE(2, ra);
            XS_STORE(3, rb);
#undef XS_LOAD
#undef XS_STORE
        }
        return;
    }
    const int row0 = x * 256 + wid * 32;
    bf16x8 qr[16];
    { const bf16_t* qp = (const bf16_t*)(F.ws + WS_XQN) + (size_t)(row0 + r32) * 1024 + h * 256 + hi * 8;
#pragma unroll
      for (int d0 = 0; d0 < 16; ++d0) qr[d0] = *(const bf16x8*)(qp + d0 * 16);
#pragma unroll
      for (int d0 = 0; d0 < 16; ++d0) asm volatile("" :: "v"(qr[d0])); }
    f32x16 o[4];
#pragma unroll
    for (int d = 0; d < 4; ++d)
#pragma unroll
        for (int r = 0; r < 16; ++r) o[d][r] = 0.f;
    float m_reg = -1e30f, l_reg = 0.f;
    constexpr int XB = 49152;
    LAS char* L = (LAS char*)F.lds; LAS float* al_l = (LAS float*)(L + 3 * XB) + wid * 32;
    const int vb = (int)(uintptr_t)(L + AX_V) + att::v_rd_base(lane);
    const bf16_t* kb = (const bf16_t*)(F.ws + WS_MKB) + h * 256; const bf16_t* vbf = (const bf16_t*)(F.ws + WS_MVB) + h * 256 + dvh * 128;
#define XP_ISSUE(t) do { LAS char* Lb = L + ((t) % 3) * XB; const bf16_t* ks_ = kb + (size_t)(t) * 64 * 1024; const bf16_t* vs_ = vbf + (size_t)(t) * 64 * 1024; int ln_ = lane; asm volatile("" : "+v"(ln_)); \
        _Pragma("unroll") for (int j = 0; j < 4; ++j) { const int o16 = ((wid * 4 + j) * 64 + ln_) * 16, row = o16 >> 9, colB = (o16 & 511) ^ ((row & 7) << 4); glds16s(ks_, (unsigned)(row * 1024 + (colB >> 1)) * 2u, Lb + AX_K + (wid * 4 + j) * 1024); } \
        _Pragma("unroll") for (int j = 0; j < 2; ++j) glds16s(vs_, (unsigned)src_v1024(((wid * 2 + j) * 64 + ln_) * 16) * 2u, Lb + AX_V + (wid * 2 + j) * 1024); } while (0)
    __syncthreads();
    XP_ISSUE(0); XP_ISSUE(1); XP_ISSUE(2);
#pragma unroll 1
    for (int t = 0; t < 4; ++t) {
        if (t == 0) asm volatile("s_waitcnt vmcnt(12)" ::: "memory"); else if (t < 3) asm volatile("s_waitcnt vmcnt(6)" ::: "memory"); else asm volatile("s_waitcnt vmcnt(0)" ::: "memory");
        __builtin_amdgcn_s_barrier();
        asm volatile("" ::: "memory");
        if (t == 1) XP_ISSUE(3);
        att::tile_step<16, 0, 4, 2, false, 512, 2>(qr, o, m_reg, l_reg, L + (t % 3) * XB + AX_K, L + (t % 3) * XB + AX_K, vb + (t % 3) * XB, (const LAS float*)nullptr, al_l, r32, hi);
    }
#undef XP_ISSUE
    att::finish<4>(o, l_reg, al_l, (bf16_t*)(F.ws + WS_AX) + (size_t)row0 * 1024 + h * 256 + dvh * 128, (const bf16_t*)(F.ws + WS_ZX) + (size_t)row0 * 1024 + h * 256 + dvh * 128, 1024, r32, hi);
}
#ifndef ATT_ONLY
#define ATT_ONLY -1
#endif
#define ATT_ON(k) (ATT_ONLY < 0 || ATT_ONLY == (k))
constexpr int QN = 160;
__device__ __forceinline__ void phase_attention(const Ctx& F, int l, int rep) {
    (void)rep;
    unsigned* heads = (unsigned*)(F.ws + WS_CTL) + CW_QHEAD + 64 * 8 * l + 64 * 16 * rep;
    volatile LAS unsigned* slot = (volatile LAS unsigned*)(F.lds + MISC_OFF);
    float negB2;
    { const float* gq = F.in[I_GQN] + l * QK_HEAD; const float* gk = F.in[I_GKN] + l * QK_HEAD; const int ln = F.lane;
      float m1 = fmaxf(fabsf(gq[ln] * gk[ln]), fabsf(gq[64 + ln] * gk[64 + ln])), mq = fabsf(gq[128 + ln]), mk = fabsf(gk[128 + ln]);
#pragma unroll
      for (int o = 1; o < 64; o <<= 1) { m1 = fmaxf(m1, __shfl_xor(m1, o)); mq = fmaxf(mq, __shfl_xor(mq, o)); mk = fmaxf(mk, __shfl_xor(mk, o)); }
      negB2 = -(19.99f * 1.01f * fmaxf(m1, mq * mk) + 0.1f); }
    const int x0 = (int)(xb_xcc_id() & 7u);
    for (int step = 0; step < 8; ++step) {
        const int x = (x0 + step) & 7;
        for (;;) {
            if (F.tid == 0) slot[0] = __hip_atomic_fetch_add(heads + 64 * x, 1u, __ATOMIC_RELAXED, __HIP_MEMORY_SCOPE_AGENT);
            __syncthreads();
            int u = __builtin_amdgcn_readfirstlane((int)slot[0]);
            __syncthreads();
#ifdef QREP_TYPE
            if (u >= 2 * QN) break;
            bool rep2 = false;
            if (u >= QN) { u -= QN; rep2 = true; const int ty = u < 96 ? (u < 32 ? 0 : 1) : (u < 128 ? 2 : 3); if (QREP_TYPE != 9 && ty != QREP_TYPE) continue; }
#else
            const bool rep2 = false;
            if (u >= QN) break;
#endif
            if (u < 96) {
                if (u < 32) {
#if ATT_ON(0)
                    mla_sample_unit(F, 4 * x + (u >> 3), u & 7, negB2, rep2);
#endif
                } else {
#if ATT_ON(1)
                    const int j = u - 32; mla_prompt_unit(F, 2 * x + (j & 1), 31 - (j >> 1), negB2);
#endif
                }
            } else if (u < 128) {
#if ATT_ON(2)
                const int v = x * 32 + (u - 96); cross_unit<false>(F, l, v >> 3, (v >> 1) & 3, v & 1);
#endif
            } else {
#if ATT_ON(3)
                const int v = x * 32 + (u - 128); cross_unit<true>(F, l, v >> 3, (v >> 1) & 3, v & 1);
#endif
            }
        }
    }
}
#define rot(off) ((int)((F.bid + G - ((off) % G)) % G))
__device__ __forceinline__ void phase_b(const Ctx& F, int l) {
    const int G = F.G; (void)G;
            {
                pg8::Gemm g{(const bf16_t*)(F.ws + WS_HB), (const bf16_t*)(F.ws + WS_WIN), 2048, 2048, 2048};
                pg8::StaticOrder S; S.init(M, IN_PAD, G, rot(0));
                EpiWin E{F.ws, F.out, F.in[I_BMERGE] + (size_t)l * 6144, l};
                pg8::gemm_phase(F.lds, g, S, E);
            }
#ifdef DUP_B1
            {
                pg8::Gemm g{(const bf16_t*)(F.ws + WS_HB), (const bf16_t*)(F.ws + WS_WIN), 2048, 2048, 2048};
                pg8::StaticOrder S; S.init(M, IN_PAD, G, rot(0));
                EpiWin E{F.ws, F.out, F.in[I_BMERGE] + (size_t)l * 6144, l};
                pg8::gemm_phase(F.lds, g, S, E);
            }
#endif
#ifdef DUP_B1N
            {
                pg8::Gemm g{(const bf16_t*)(F.ws + WS_HB), (const bf16_t*)(F.ws + WS_WIN), 2048, 2048, 2048};
                pg8::StaticOrder S; S.init(M, IN_PAD, G, rot(0));
                EpiNone E{};
                pg8::gemm_phase(F.lds, g, S, E);
            }
#endif
            {
                pg8::Gemm g{(const bf16_t*)(F.ws + WS_MEMN), (const bf16_t*)(F.ws + WS_WMEM), 2048, 2048, 2048};
                pg8::StaticOrder S; S.init(N_MEM, 2048, G, rot(232));
                EpiF32 E{(float*)(F.ws + WS_KVRAW), 2048};
                pg8::gemm_phase(F.lds, g, S, E);
            }
            {
                pg8::Gemm g{(const bf16_t*)(F.ws + WS_CNP), (const bf16_t*)(F.ws + WS_WUK), 512, 512, 512};
                pg8::StaticOrder S; S.init(MPAST, 2048, G, rot(240));
                EpiK<> E{(bf16_t*)(F.ws + WS_KP), (float*)(F.ws + WS_SSP)};
                pg8::gemm_phase(F.lds, g, S, E);
            }
#ifdef DUP_B3
            {
                pg8::Gemm g{(const bf16_t*)(F.ws + WS_CNP), (const bf16_t*)(F.ws + WS_WUK), 512, 512, 512};
                pg8::StaticOrder S; S.init(MPAST, 2048, G, rot(240));
                EpiK<> E{(bf16_t*)(F.ws + WS_KP), (float*)(F.ws + WS_SSP)};
                pg8::gemm_phase(F.lds, g, S, E);
            }
#endif
#ifdef DUP_B3N
            {
                pg8::Gemm g{(const bf16_t*)(F.ws + WS_CNP), (const bf16_t*)(F.ws + WS_WUK), 512, 512, 512};
                pg8::StaticOrder S; S.init(MPAST, 2048, G, rot(240));
#ifndef DUP_B3N_K
#define DUP_B3N_K false
#endif
#ifndef DUP_B3N_S
#define DUP_B3N_S false
#endif
#ifndef DUP_B3N_T
#define DUP_B3N_T false
#endif
                EpiK<DUP_B3N_K, DUP_B3N_S, DUP_B3N_T> E{(bf16_t*)(F.ws + WS_VP), (float*)(F.ws + WS_VP) + (size_t)64 * 1024 * 1024};
                pg8::gemm_phase(F.lds, g, S, E);
            }
#endif
            if (l == 0) past_kpe(F, l);
#ifdef DUP_B4
            past_kpe(F, l);
#endif
}
__device__ __forceinline__ void phase_d(const Ctx& F, int l) {
    const int G = F.G; (void)G;
            {
                pg8::Gemm g{(const bf16_t*)(F.ws + WS_QLATN), (const bf16_t*)(F.ws + WS_WUQ), 512, 512, 512};
                pg8::StaticOrder S; S.init(M, 3072, G, rot(0));
                EpiBf16 E{(bf16_t*)(F.ws + WS_QRAW), 3072};
                pg8::gemm_phase(F.lds, g, S, E);
            }
            {
                pg8::Gemm g{(const bf16_t*)(F.ws + WS_CKVN), (const bf16_t*)(F.ws + WS_WUKV), 512, 512, 512};
                pg8::StaticOrder S; S.init(M, 4096, G, rot(224));
                EpiKV<false> E{(bf16_t*)(F.ws + WS_KC), (bf16_t*)(F.ws + WS_VC), (float*)(F.ws + WS_SSC)};
                pg8::gemm_phase(F.lds, g, S, E);
            }
            {
                pg8::Gemm g{(const bf16_t*)(F.ws + WS_CV), (const bf16_t*)(F.ws + WS_WPW2), 1024, 1024, 1024};
                pg8::StaticOrder S; S.init(M, 1024, G, rot(96));
                EpiPw2 E{(bf16_t*)(F.ws + WS_ACONV), (const bf16_t*)(F.ws + WS_ZC), F.in[I_BPW2] + (size_t)l * 1024};
                pg8::gemm_phase(F.lds, g, S, E);
            }
}
__device__ __forceinline__ void phase_g(const Ctx& F, int l) {
    const int G = F.G; (void)G;
    const bool bal = (G == 256); const int cls = F.bid >> 6, j = F.bid & 63;
            {
                pg8::Gemm g{(const bf16_t*)(F.ws + WS_AMLA), (const bf16_t*)(F.ws + WS_WPM), 2048, 2048, 2048};
                EpiGate E{(bf16_t*)(F.ws + WS_PB), (const bf16_t*)(F.ws + WS_GATES), 0};
                pg8::ListOrder S; if (bal) S.init(M, 2048, (cls == 0 ? 0 : (cls == 1 ? 128 : 256)) + j, cls < 2 ? 2 : (cls == 2 ? 1 : 0), 64); else S.init(M, 2048, rot(0), (320 - rot(0) + G - 1) / G, G);
                pg8::gemm_phase(F.lds, g, S, E);
            }
            {
                pg8::Gemm g{(const bf16_t*)(F.ws + WS_ACONV), (const bf16_t*)(F.ws + WS_WPC), 1024, 1024, 1024};
                EpiGate E{(bf16_t*)(F.ws + WS_PB) + (size_t)M * 2048, (const bf16_t*)(F.ws + WS_GATES), 2048};
                pg8::ListOrder S; if (bal) S.init(M, 2048, (cls == 0 ? 0 : (cls == 2 ? 64 : 192)) + j, cls == 0 ? 1 : (cls == 1 ? 0 : 2), 64); else S.init(M, 2048, rot(64), (320 - rot(64) + G - 1) / G, G);
                pg8::gemm_phase(F.lds, g, S, E);
            }
            {
                pg8::Gemm g{(const bf16_t*)(F.ws + WS_AX), (const bf16_t*)(F.ws + WS_WPX), 1024, 1024, 1024};
                EpiGate E{(bf16_t*)(F.ws + WS_PB) + 2 * (size_t)M * 2048, (const bf16_t*)(F.ws + WS_GATES), 4096};
                pg8::ListOrder S; if (bal) S.init(M, 2048, (cls == 1 ? 0 : (cls == 2 ? 64 : 128)) + j, cls == 0 ? 0 : (cls == 3 ? 3 : 1), 64); else S.init(M, 2048, rot(128), (320 - rot(128) + G - 1) / G, G);
                pg8::gemm_phase(F.lds, g, S, E);
            }
}
__device__ __forceinline__ void phase_g2(const Ctx& F, int l) {
    const int G = F.G; (void)G;
            {
                const u32x4* p0 = (const u32x4*)(F.ws + WS_PB); const u32x4* p1 = p0 + (size_t)M * 256; const u32x4* p2 = p1 + (size_t)M * 256; u32x4* mo = (u32x4*)(F.ws + WS_MERGED);
                for (size_t i = (size_t)F.bid * 512 + F.tid; i < (size_t)M * 256; i += (size_t)G * 512) {
                    f32x4 a0, a1, b0, b1, c0, c1; unpack8(p0[i], a0, a1); unpack8(p1[i], b0, b1); unpack8(p2[i], c0, c1);
                    mo[i] = pack8(a0 + b0 + c0, a1 + b1 + c1);
                }
            }
}
__device__ __forceinline__ void phase_h(const Ctx& F, int l) {
    const int G = F.G; (void)G;
            {
                pg8::Gemm g{(const bf16_t*)(F.ws + WS_MERGED), (const bf16_t*)(F.ws + WS_WOUT), 2048, 2048, 2048};
                pg8::StaticOrder S; S.init(M, 2048, G, rot(64));
                const float* sp = l == 0 ? F.in[I_XP] : (const float*)(F.ws + WS_X1); const float* ss = l == 0 ? F.in[I_XS] : (const float*)(F.ws + WS_X1) + (size_t)M_P * 2048;
                float* dp = l == DEPTH - 1 ? F.out + O_YP : (float*)(F.ws + WS_X1); float* ds = l == DEPTH - 1 ? F.out + O_YS : (float*)(F.ws + WS_X1) + (size_t)M_P * 2048;
                EpiOut E{sp, ss, dp, ds};
                pg8::gemm_phase(F.lds, g, S, E);
            }
            if (l + 1 < DEPTH && h_early_ok(G)) { const int n2 = (M / 256) * (2048 / 256) - G, c = rot(64);
                if (c >= n2) prep_weights(F, l + 1, (c - n2) * 8 + F.wave, (G - n2) * 8, PW_EARLY); }
}
__global__ void __launch_bounds__(512, 2) trunk_fwd(Args args) {
    extern __shared__ __attribute__((aligned(16))) unsigned char lds_raw[];
    for (int u = threadIdx.x; u < (LDS_BYTES - SCRATCH_TOP) / 4; u += 512) ((LAS unsigned*)((LAS unsigned char*)lds_raw + SCRATCH_TOP))[u] = 0u;
    __syncthreads();
    XcdBarrier bar;
    { const __attribute__((address_space(4))) char* kp0 = (const __attribute__((address_space(4))) char*)__builtin_amdgcn_kernarg_segment_ptr();
      unsigned char* ws0 = *(unsigned char* const __attribute__((address_space(4)))*)(kp0 + 256);
      bar = xcd_barrier_post((unsigned*)(ws0 + WS_CTL) + CW_BAR, (volatile LAS unsigned*)((LAS unsigned char*)lds_raw + MISC_OFF) + 8); }
    const int lo = args.ph_lo, hi = args.ph_hi;
    int ph = 0;
#ifdef DBG_TIME
    if (blockIdx.x == 0 && threadIdx.x == 0) ((LAS unsigned long long*)((LAS unsigned char*)lds_raw + MISC_OFF + 256))[0] = __builtin_amdgcn_s_memrealtime();
#endif
#define PH_BEGIN if (ph >= lo && ph < hi) { Ctx F; { const __attribute__((address_space(4))) char* kp = (const __attribute__((address_space(4))) char*)__builtin_amdgcn_kernarg_segment_ptr(); asm volatile("" : "+s"(kp)); \
        F.in = (karg_in_t)kp; F.out = *(float* const __attribute__((address_space(4)))*)(kp + 248); F.ws = *(unsigned char* const __attribute__((address_space(4)))*)(kp + 256); \
        F.lds = (LAS unsigned char*)lds_raw; int tz = threadIdx.x; asm volatile("" : "+v"(tz)); F.tid = tz; F.lane = tz & 63; F.wave = __builtin_amdgcn_readfirstlane(tz >> 6); F.G = gridDim.x; F.bid = blockIdx.x; } const int G = F.G; (void)G;
#ifdef DBG_TIME
#define PH_END   if (ph + 1 < hi) xcd_barrier(bar); } ++ph; if (blockIdx.x == 0 && threadIdx.x == 0 && ph < 24) ((LAS unsigned long long*)((LAS unsigned char*)lds_raw + MISC_OFF + 256))[ph] = __builtin_amdgcn_s_memrealtime();
#else
#define PH_END   if (ph + 1 < hi) xcd_barrier(bar); } ++ph;
#endif

    for (int l = 0; l < DEPTH; ++l) {
        PH_BEGIN
#if PH_ON(0)
            REP(0) {
            phase_prep(F, l);
            }
#endif
        PH_END
        PH_BEGIN
#if PH_ON(1)
            phase_b(F, l);
#ifdef DUP_1
            phase_b(F, l);
#endif
#endif
        PH_END
        PH_BEGIN
#if PH_ON(2)
            REP(2) {
            phase_c(F, l);
#ifdef DUP_2
            phase_c(F, l);
#endif
            }
#endif
        PH_END
        PH_BEGIN
#if PH_ON(3)
            phase_d(F, l);
#ifdef DUP_3
            phase_d(F, l);
#endif
#endif
        PH_END
        PH_BEGIN
#if PH_ON(4)
            REP(4) {
            phase_e(F, l);
#ifdef DUP_4
            phase_e(F, l);
#endif
            }
#endif
        PH_END
        PH_BEGIN
#if PH_ON(5)
            REP(5) {
            phase_attention(F, l, 0);
#ifdef DUP_5
            phase_attention(F, l, 1);
#endif
            }
#endif
        PH_END
        PH_BEGIN
#if PH_ON(6)
            phase_g(F, l);
#ifdef DUP_6
            phase_g(F, l);
#endif
#endif
        PH_END
        PH_BEGIN
#if PH_ON(8)
            phase_g2(F, l);
#ifdef DUP_8
            phase_g2(F, l);
#endif
#endif
        PH_END
        PH_BEGIN
#if PH_ON(7)
            phase_h(F, l);
#ifdef DUP_7
            phase_h(F, l);
#endif
#endif
        PH_END
    }


#ifdef DBG_TIME
    {
        xcd_barrier(bar);
        if (blockIdx.x == 0) {
            const __attribute__((address_space(4))) char* kp = (const __attribute__((address_space(4))) char*)__builtin_amdgcn_kernarg_segment_ptr();
            float* outp = *(float* const __attribute__((address_space(4)))*)(kp + 248);
            const LAS unsigned long long* st = (const LAS unsigned long long*)((LAS unsigned char*)lds_raw + MISC_OFF + 256);
            __syncthreads();
            const size_t offs[10] = {O_YP, O_YS, O_PCKV, O_PKR, O_PMK, O_PMV, O_PCONV, O_SCKV, O_SKR, O_SCONV};
#pragma unroll
            for (int k = 0; k < 10; ++k) {
                const int a = DBG_TIME + k, b = (k == 9 ? 18 : DBG_TIME + k + 1);
                unsigned us = (unsigned)((st[b] - st[a]) / 100ull) + 1u; if (us > 60000u) us = 60000u;
                for (unsigned i = threadIdx.x; i < us; i += 512) outp[offs[k] + i] = __uint_as_float(0xAAAAAAAAu);
            }
        }
    }
#endif
#ifdef DBG_DUMP
    {
        const __attribute__((address_space(4))) char* kp = (const __attribute__((address_space(4))) char*)__builtin_amdgcn_kernarg_segment_ptr();
        float* outp = *(float* const __attribute__((address_space(4)))*)(kp + 248); unsigned char* wsp = *(unsigned char* const __attribute__((address_space(4)))*)(kp + 256);
        unsigned* bins = (unsigned*)wsp + 65536;
        if (hi == 1000 || (MK_N_LAUNCHES == 1 && hi == NPH_RUN)) {
            if (hi != 1000) xcd_barrier(bar);
            const size_t lo_b = DBG_LO, hi_b = DBG_HI;
            for (size_t i = (size_t)blockIdx.x * 512 + threadIdx.x; i < O_END; i += (size_t)gridDim.x * 512) outp[i] = 0.f;
            const int gwv = blockIdx.x * 8 + (threadIdx.x >> 6), lanev = threadIdx.x & 63;
            const size_t nchunk = (hi_b - lo_b) >> 10;
            for (size_t c = gwv; c < nchunk; c += (size_t)gridDim.x * 8) {
                const u32x4 w = *(const u32x4*)(wsp + lo_b + (c << 10) + lanev * 16);
                unsigned s = (w.x * 0x9E3779B1u) ^ (w.y * 0x85EBCA77u) ^ (w.z * 0xC2B2AE3Du) ^ (w.w * 0x27D4EB2Fu); s *= (2u * lanev + 1u) * 0x165667B1u; s ^= s >> 15;
#pragma unroll
                for (int o = 1; o < 64; o <<= 1) s += __shfl_xor(s, o);
                if (lanev == 0) __hip_atomic_fetch_xor(bins + (c & 1023), s * 0x9E3779B1u, __ATOMIC_RELAXED, __HIP_MEMORY_SCOPE_AGENT);
            }
            if (hi != 1000) xcd_barrier(bar);
        }
        if (hi == 1001 || (MK_N_LAUNCHES == 1 && hi == NPH_RUN)) {
            if (blockIdx.x == 0) for (int i = threadIdx.x; i < 1024; i += 512) outp[i] = (float)(__hip_atomic_load(bins + i, __ATOMIC_RELAXED, __HIP_MEMORY_SCOPE_AGENT) & 0xffffffu) + 1.0f;
        }
    }
#endif
#undef PH_BEGIN
#undef PH_END
}

extern "C" void kernel_launch(void* const* d_in, const int* in_sizes, int n_in, void* d_out, int out_size, void* d_ws, size_t ws_size, hipStream_t stream) {
    static int grid = 0;
    if (grid == 0) {
        if (n_in != 31 || (size_t)out_size != O_END || ws_size < WS_END) {
            fprintf(stderr, "kernel_launch: built for 31 inputs, %zu outputs, >= %zu bytes of workspace; got n_in %d, out %d, ws %zu; nothing launched\n", (size_t)O_END, (size_t)WS_END, n_in, out_size, ws_size);
            grid = -1; return; }
        int dev = 0, cus = 0, per_cu = 0;
        if (hipGetDevice(&dev) != hipSuccess || hipDeviceGetAttribute(&cus, hipDeviceAttributeMultiprocessorCount, dev) != hipSuccess) { fprintf(stderr, "kernel_launch: device query failed\n"); grid = -1; return; }
        if (hipFuncSetAttribute((const void*)trunk_fwd, hipFuncAttributeMaxDynamicSharedMemorySize, LDS_BYTES) != hipSuccess) { fprintf(stderr, "kernel_launch: hipFuncSetAttribute failed\n"); grid = -1; return; }
        if (hipOccupancyMaxActiveBlocksPerMultiprocessor(&per_cu, (const void*)trunk_fwd, 512, LDS_BYTES) != hipSuccess || per_cu < 1)
            fprintf(stderr, "kernel_launch: note: occupancy query reports %d workgroups per CU\n", per_cu);
        (void)hipGetLastError();
        grid = cus;
    }
    if (grid < 0) return;
    if (hipMemsetAsync((char*)d_ws + WS_CTL, 0, CTL_BYTES, stream) != hipSuccess) { fprintf(stderr, "kernel_launch: memset failed\n"); return; }
    Args a{};
    for (int i = 0; i < 31; ++i) a.in[i] = (const float*)d_in[i];
    a.out = (float*)d_out; a.ws = (unsigned char*)d_ws;
    constexpr int NPH = NPH_RUN;
    if (MK_N_LAUNCHES == 1) {
        a.ph_lo = 0; a.ph_hi = NPH;
        hipLaunchKernelGGL(trunk_fwd, dim3(grid), dim3(512), LDS_BYTES, stream, a);
    } else {
        for (int p = 0; p < NPH; ++p) { a.ph_lo = p; a.ph_hi = p + 1; hipLaunchKernelGGL(trunk_fwd, dim3(grid), dim3(512), LDS_BYTES, stream, a); }
#ifdef DBG_DUMP
        a.ph_lo = 1000; a.ph_hi = 1000; hipLaunchKernelGGL(trunk_fwd, dim3(grid), dim3(512), LDS_BYTES, stream, a);
        a.ph_lo = 1001; a.ph_hi = 1001; hipLaunchKernelGGL(trunk_fwd, dim3(grid), dim3(512), LDS_BYTES, stream, a);
#endif
    }
    const hipError_t le = hipPeekAtLastError();
    if (le != hipSuccess) fprintf(stderr, "kernel_launch: launch failed: %s\n", hipGetErrorName(le));
}
```

```cpp
#include <hip/hip_runtime.h>
#include <cstdio>
#include <cstdint>

#define LAS __attribute__((address_space(3)))
#define GAS __attribute__((address_space(1)))
typedef unsigned short bf16_t;
typedef short bf16x8 __attribute__((ext_vector_type(8)));
typedef short s16x4 __attribute__((ext_vector_type(4)));
typedef float f32x2 __attribute__((ext_vector_type(2)));
typedef float f32x4 __attribute__((ext_vector_type(4)));
typedef float f32x16 __attribute__((ext_vector_type(16)));
typedef unsigned u32x2 __attribute__((ext_vector_type(2)));
typedef unsigned u32x4 __attribute__((ext_vector_type(4)));
typedef GAS unsigned gu32;

#ifndef PH_ONLY
#define PH_ONLY -1
#endif
#define PH_ON(k) (PH_ONLY < 0 || PH_ONLY == (k))
#ifndef REPEAT_MASK
#define REPEAT_MASK 0
#endif
#define REP(k) for (int rep_ = 0; rep_ < (((REPEAT_MASK) >> (k)) & 1) + 1; ++rep_)
#ifndef NPH_RUN
#define NPH_RUN 18
#endif
#ifndef MK_N_LAUNCHES
#define MK_N_LAUNCHES 1
#endif

constexpr int D_MODEL = 2048, M_P = 8192, M_S = 2048, M = M_P + M_S, DEPTH = 2, NSTREAM = 32, DEC_SEQ = 64, PAST = 4096;
constexpr int NH = 16, QK_HEAD = 192, Q_LORA = 512, KV_LORA = 512;
constexpr int CONV_W = 1024, CONV_K = 31, CONV_ST = 30, N_MEM = 256, XW = 1024;
constexpr int IN_COLS = 14400, IN_PAD = 14592;
constexpr int MPAST = NSTREAM * PAST;
constexpr float EPS = 1e-6f;
constexpr float LOG2E = 1.4426950408889634f;
constexpr float C_MLA = 0.07216878364870323f * LOG2E;
constexpr float C_X = 0.0625f * LOG2E;

constexpr size_t O_YP = 0, O_YS = 16777216, O_PCKV = 20971520, O_PKR = 29360128, O_PMK = 30408704, O_PMV = 30932992,
                 O_PCONV = 31457280, O_SCKV = 31518720, O_SKR = 33615872, O_SCONV = 33878016, O_END = 35844096;

constexpr size_t al256(size_t x) { return (x + 255) / 256 * 256; }
constexpr size_t WS_CTL = 0, CTL_BYTES = 1u << 20;
constexpr size_t WS_WIN = WS_CTL + CTL_BYTES;
constexpr size_t WS_WUQ = WS_WIN + (size_t)IN_PAD * 2048 * 2;
constexpr size_t WS_WUKV = WS_WUQ + (size_t)3072 * 512 * 2;
constexpr size_t WS_WPW2 = WS_WUKV + (size_t)4096 * 512 * 2;
constexpr size_t WS_WMEM = WS_WPW2 + (size_t)1024 * 1024 * 2;
constexpr size_t WS_WPM = WS_WMEM + (size_t)2048 * 2048 * 2;
constexpr size_t WS_WPC = WS_WPM + (size_t)2048 * 2048 * 2;
constexpr size_t WS_WPX = WS_WPC + (size_t)2048 * 1024 * 2;
constexpr size_t WS_WOUT = WS_WPX + (size_t)2048 * 1024 * 2;
constexpr size_t WS_ROPE = WS_WOUT + (size_t)2048 * 2048 * 2;
constexpr size_t WS_CNP = WS_ROPE + (size_t)8192 * 64 * 4;
constexpr size_t WS_KPEP = WS_CNP + (size_t)MPAST * 512 * 2;
constexpr size_t WS_SSPEP = WS_KPEP + (size_t)MPAST * 64 * 2;
constexpr size_t WS_KP = WS_SSPEP + (size_t)MPAST * 4;
constexpr size_t WS_VP = WS_KP + (size_t)MPAST * 2048 * 2;
constexpr size_t WS_SSP = WS_VP + (size_t)MPAST * 2048 * 2;
constexpr size_t WS_HB = WS_SSP + (size_t)MPAST * 16 * 4 * 4;
constexpr size_t WS_QRAW = WS_HB;
constexpr size_t WS_QLATF = WS_HB + (size_t)M * 3072 * 2;
constexpr size_t WS_QLATN = WS_QLATF + (size_t)M * 512 * 4;
constexpr size_t WS_CKVN = WS_QLATN + (size_t)M * 512 * 2;
constexpr size_t WS_ZM = WS_CKVN + (size_t)M * 512 * 2;
constexpr size_t WS_UB = WS_ZM + (size_t)M * 2048 * 2;
constexpr size_t WS_ZC = WS_UB + (size_t)M * 1024 * 2;
constexpr size_t WS_XQ = WS_ZC + (size_t)M * 1024 * 2;
constexpr size_t WS_ZX = WS_XQ + (size_t)M * 1024 * 2;
constexpr size_t WS_GATES = WS_ZX + (size_t)M * 1024 * 2;
constexpr size_t WS_CV = WS_GATES + (size_t)M * 6144 * 2;
constexpr size_t WS_Q = WS_CV + (size_t)M * 1024 * 2;
constexpr size_t WS_KC = WS_Q + (size_t)M * 3072 * 2;
constexpr size_t WS_VC = WS_KC + (size_t)M * 2048 * 2;
constexpr size_t WS_SSC = WS_VC + (size_t)M * 2048 * 2;
constexpr size_t WS_KPEC = WS_SSC + (size_t)M * 16 * 4 * 4;
constexpr size_t WS_SSPEC = WS_KPEC + (size_t)M * 64 * 2;
constexpr size_t WS_AMLA = al256(WS_SSPEC + (size_t)M * 4);
constexpr size_t WS_ACONV = WS_AMLA + (size_t)M * 2048 * 2;
constexpr size_t WS_AX = WS_ACONV + (size_t)M * 1024 * 2;
constexpr size_t WS_X1 = WS_AX + (size_t)M * 1024 * 2;
constexpr size_t WS_MEMN = WS_X1 + (size_t)M * 2048 * 4;
constexpr size_t WS_KVRAW = WS_MEMN + (size_t)256 * 2048 * 2;
constexpr size_t WS_MKB = WS_KVRAW + (size_t)256 * 2048 * 4;
constexpr size_t WS_MVB = WS_MKB + (size_t)256 * 1024 * 2;
constexpr size_t WS_RKC = WS_MVB + (size_t)256 * 1024 * 2;
constexpr size_t WS_RKP = WS_RKC + (size_t)16 * M * 4;
constexpr size_t WS_XQN = WS_RKP + (size_t)MPAST * 16 * 4;
constexpr size_t WS_WUK = WS_XQN + (size_t)M * 1024 * 2;
constexpr size_t WS_END = WS_WUK + (size_t)2048 * 512 * 2;
constexpr size_t WS_PB = WS_KP;
constexpr size_t WS_MERGED = WS_KP + 3 * (size_t)M * 2048 * 2;
static_assert(sizeof(void*) == 8, "");
static_assert(WS_END <= 2147483648ull, "workspace map exceeds 2 GiB");
static_assert(WS_MERGED + (size_t)M * 2048 * 2 <= WS_VP, "merged overlay inside KP");

constexpr int CW_BAR = 4096;
constexpr int CW_QHEAD = 16384;

constexpr int RING_BYTES = 131072, SCRATCH_TOP = 161536, MISC_OFF = SCRATCH_TOP + 320, LDS_BYTES = 163840;

typedef __bf16 bf16x2_t __attribute__((ext_vector_type(2)));
__device__ __forceinline__ unsigned cvt_pk_bf16(float lo, float hi) { f32x2 v = {lo, hi}; bf16x2_t b = __builtin_convertvector(v, bf16x2_t); return __builtin_bit_cast(unsigned, b); }
__device__ __forceinline__ float bf_lo(unsigned w) { return __uint_as_float(w << 16); }
__device__ __forceinline__ float bf_hi(unsigned w) { return __uint_as_float(w & 0xffff0000u); }
__device__ __forceinline__ float sigmoidf_(float x) { return __builtin_amdgcn_rcpf(1.0f + __builtin_amdgcn_exp2f(-x * LOG2E)); }
__device__ __forceinline__ float siluf_(float x) { return x * sigmoidf_(x); }
__device__ __forceinline__ float wave_sum(float v) {
#pragma unroll
    for (int o = 1; o < 64; o <<= 1) v += __shfl_xor(v, o);
    return v;
}
__device__ __forceinline__ u32x4 pack8(const f32x4 a, const f32x4 b) {
    u32x4 w; w.x = cvt_pk_bf16(a[0], a[1]); w.y = cvt_pk_bf16(a[2], a[3]); w.z = cvt_pk_bf16(b[0], b[1]); w.w = cvt_pk_bf16(b[2], b[3]); return w;
}
__device__ __forceinline__ void unpack8(const u32x4 w, f32x4& a, f32x4& b) {
    a = (f32x4){bf_lo(w.x), bf_hi(w.x), bf_lo(w.y), bf_hi(w.y)}; b = (f32x4){bf_lo(w.z), bf_hi(w.z), bf_lo(w.w), bf_hi(w.w)};
}
#define LDS_WAIT() asm volatile("s_waitcnt lgkmcnt(0)" ::: "memory")
#define VM_WAIT() asm volatile("s_waitcnt vmcnt(0)" ::: "memory")

namespace pg8 {
constexpr int BM = 256, BK = 64, HALF = 128, HTB = HALF * BK * 2, STAGE_BYTES = 8 * HTB, NXCD = 8, WGM = 8;
__host__ __device__ __forceinline__ int lds_byte(int r, int c) { const int st = (r >> 4) * 2 + (c >> 5), rr = r & 15, cc = c & 31, ob = rr * 64 + cc * 2; return st * 1024 + (ob ^ (((ob >> 9) & 1) << 5)); }
__host__ __device__ __forceinline__ void stage_rc(int b, int& R, int& C) { const int st = b / 1024, sb = b % 1024, swz = sb ^ (((sb >> 9) & 1) << 5); R = (st >> 1) * 16 + swz / 64; C = (st & 1) * 32 + (swz % 64) / 2; }
__host__ __device__ __forceinline__ int perm32(int rho) { const int n = rho >> 4, i = rho & 15; return 8 * (i >> 2) + 4 * n + (i & 3); }
struct Unit { int pm, pn; };
struct Gemm { const bf16_t* A; const bf16_t* Bt; int lda, ldb, K; };
struct StaticOrder {
    int nM, nN, nwg, G, c;
    __device__ void init(int M_, int N_, int G_, int c_) { nM = M_ / BM; nN = N_ / BM; nwg = nM * nN; G = G_; c = c_; }
    __device__ bool next(int i, Unit& u) const {
        const long L = (long)i * G + c; if (L >= nwg) return false;
        int wgid = (int)L; { const int q = nwg / NXCD, r = nwg % NXCD, xcd = wgid % NXCD, off = wgid / NXCD; wgid = (xcd < r ? xcd * (q + 1) : r * (q + 1) + (xcd - r) * q) + off; }
        const int nig = WGM * nN, gid = wgid / nig, fm = gid * WGM, gsz = (nM - fm) < WGM ? (nM - fm) : WGM;
        u.pm = fm + ((wgid % nig) % gsz); u.pn = (wgid % nig) / gsz; return true;
    }
};
struct ListOrder {
    int nM, nN, nwg, L0, n, stride;
    __device__ void init(int M_, int N_, int L0_, int n_, int stride_) { nM = M_ / BM; nN = N_ / BM; nwg = nM * nN; L0 = L0_; n = n_; stride = stride_; }
    __device__ bool next(int i, Unit& u) const {
        if (i >= n) return false;
        int wgid = L0 + i * stride; { const int q = nwg / NXCD, r = nwg % NXCD, xcd = wgid % NXCD, off = wgid / NXCD; wgid = (xcd < r ? xcd * (q + 1) : r * (q + 1) + (xcd - r) * q) + off; }
        const int nig = WGM * nN, gid = wgid / nig, fm = gid * WGM, gsz = (nM - fm) < WGM ? (nM - fm) : WGM;
        u.pm = fm + ((wgid % nig) % gsz); u.pn = (wgid % nig) / gsz; return true;
    }
};
template <class Epi, class Sched>
__device__ __forceinline__ void gemm_phase(LAS unsigned char* lds, const Gemm g, const Sched& S, const Epi& E) {
    int tid = threadIdx.x; asm volatile("" : "+v"(tid));
    const int wid = __builtin_amdgcn_readfirstlane(tid >> 6), lane = tid & 63, wr = wid >> 2, wc = wid & 3, fr = lane & 15, fq = lane >> 4;
    const int K = g.K, nt = K / BK;
    unsigned voffA[2], voffB[2];
#pragma unroll
    for (int i = 0; i < 2; ++i) { int R, C; stage_rc(tid * 16 + i * 8192, R, C); const int Rb = (R & ~31) + perm32(R & 31);
        voffA[i] = (unsigned)(R * g.lda + C) * 2u; voffB[i] = (unsigned)(Rb * g.ldb + C) * 2u; }
    const size_t kstep = (size_t)(BK * 2);
    const size_t hA = (size_t)HALF * g.lda * 2, hB = (size_t)HALF * g.ldb * 2;
    const size_t tA = 2 * hA, tB = 2 * hB;
    const unsigned ldsw = (unsigned)wid * 1024u;
    const int aoff = lds_byte(wr * 64 + fr, fq * 8), boff = lds_byte(wc * 32 + fr, fq * 8);
#define PG8_SA(b, h) (((b) * 2 + (h)) * HTB)
#define PG8_SB(b, h) ((4 + (b) * 2 + (h)) * HTB)
#define PG8_STAGE(bufoff, gbase, voff) do { _Pragma("unroll") for (int _i = 0; _i < 2; ++_i) \
        __builtin_amdgcn_global_load_lds((const unsigned*)((const char*)(gbase) + (voff)[_i]), (LAS unsigned*)(lds + (bufoff) + ldsw + _i * 8192), 16, 0, 0); } while (0)
#define PG8_LDA(dst, b, h) do { _Pragma("unroll") for (int m = 0; m < 4; ++m) _Pragma("unroll") for (int k = 0; k < 2; ++k) dst[m][k] = *(const LAS bf16x8*)(lds + PG8_SA(b, h) + aoff + m * 2048 + k * 1024); } while (0)
#define PG8_LDB(dst, b, h) do { _Pragma("unroll") for (int n = 0; n < 2; ++n) _Pragma("unroll") for (int k = 0; k < 2; ++k) dst[n][k] = *(const LAS bf16x8*)(lds + PG8_SB(b, h) + boff + n * 2048 + k * 1024); } while (0)
#define PG8_MMA(ai, bj, At, Bt) do { __builtin_amdgcn_s_setprio(1); _Pragma("unroll") for (int m = 0; m < 4; ++m) _Pragma("unroll") for (int n = 0; n < 2; ++n) _Pragma("unroll") for (int k = 0; k < 2; ++k) \
        acc[ai][bj][m][n] = __builtin_amdgcn_mfma_f32_16x16x32_bf16(Bt[n][k], At[m][k], acc[ai][bj][m][n], 0, 0, 0); __builtin_amdgcn_s_setprio(0); } while (0)
#define PG8_WAIT_V(n) asm volatile("s_waitcnt vmcnt(" #n ")" ::: "memory")
#define PG8_WAIT_L(n) asm volatile("s_waitcnt lgkmcnt(" #n ")" ::: "memory")
#define PG8_BAR __builtin_amdgcn_s_barrier()
#define PG8_SCHED __builtin_amdgcn_sched_barrier(0)
    Unit cur, nxt; int ui = 0;
    if (!S.next(0, cur)) return;
    f32x4 acc[2][2][4][2];
#pragma unroll
    for (int a = 0; a < 2; ++a)
#pragma unroll
        for (int b = 0; b < 2; ++b)
#pragma unroll
            for (int m = 0; m < 4; ++m)
#pragma unroll
                for (int n = 0; n < 2; ++n) acc[a][b][m][n] = (f32x4){0.f, 0.f, 0.f, 0.f};
    bf16x8 At[4][2], B0[2][2], B1[2][2];
    const char* cA = (const char*)g.A + (size_t)cur.pm * tA; const char* cB = (const char*)g.Bt + (size_t)cur.pn * tB;
    PG8_STAGE(PG8_SB(0, 0), cB, voffB); PG8_STAGE(PG8_SB(0, 1), cB + hB, voffB); PG8_STAGE(PG8_SA(0, 0), cA, voffA); PG8_STAGE(PG8_SA(0, 1), cA + hA, voffA);
    if (wr == 1) PG8_BAR;
    PG8_WAIT_V(2); PG8_BAR;
    PG8_STAGE(PG8_SB(1, 0), cB + kstep, voffB); PG8_STAGE(PG8_SA(1, 0), cA + kstep, voffA); PG8_STAGE(PG8_SB(1, 1), cB + hB + kstep, voffB);
    PG8_WAIT_V(6); PG8_BAR;
    for (;;) {
        const bool has_next = S.next(ui + 1, nxt);
        const char* nA = has_next ? (const char*)g.A + (size_t)nxt.pm * tA : cA; const char* nB = has_next ? (const char*)g.Bt + (size_t)nxt.pn * tB : cB;
        for (int t = 0; t < nt; t += 2) {
            const bool last = (t == nt - 2);
            const char* a1 = cA + (size_t)(t + 1) * kstep;
            const char* a2 = last ? nA : cA + (size_t)(t + 2) * kstep; const char* b2 = last ? nB : cB + (size_t)(t + 2) * kstep;
            const char* a3 = a2 + kstep; const char* b3 = b2 + kstep;
            PG8_LDB(B0, 0, 0); PG8_LDB(B1, 0, 1); PG8_SCHED; PG8_LDA(At, 0, 0); PG8_STAGE(PG8_SA(1, 1), a1 + hA, voffA);
            PG8_WAIT_V(8); PG8_WAIT_L(0); PG8_BAR; PG8_MMA(0, 0, At, B0); PG8_MMA(0, 1, At, B1); PG8_BAR; PG8_SCHED;
            PG8_LDA(At, 0, 1); PG8_STAGE(PG8_SB(0, 0), b2, voffB); PG8_STAGE(PG8_SB(0, 1), b2 + hB, voffB); PG8_STAGE(PG8_SA(0, 0), a2, voffA);
            PG8_WAIT_V(8); PG8_WAIT_L(0); PG8_BAR; PG8_MMA(1, 0, At, B0); PG8_MMA(1, 1, At, B1); PG8_BAR; PG8_SCHED;
            PG8_LDB(B0, 1, 0); PG8_LDB(B1, 1, 1); PG8_SCHED; PG8_LDA(At, 1, 0); PG8_STAGE(PG8_SA(0, 1), a2 + hA, voffA);
            PG8_WAIT_V(8); PG8_WAIT_L(0); PG8_BAR; PG8_MMA(0, 0, At, B0); PG8_MMA(0, 1, At, B1); PG8_BAR; PG8_SCHED;
            PG8_LDA(At, 1, 1); PG8_STAGE(PG8_SB(1, 0), b3, voffB); PG8_STAGE(PG8_SB(1, 1), b3 + hB, voffB); PG8_STAGE(PG8_SA(1, 0), a3, voffA);
            PG8_WAIT_V(8); PG8_WAIT_L(0); PG8_BAR; PG8_MMA(1, 0, At, B0); PG8_MMA(1, 1, At, B1); PG8_BAR; PG8_SCHED;
        }
        if (wr == 0) PG8_BAR;
        E(acc, cur);
        if (!has_next) break;
#pragma unroll
        for (int a = 0; a < 2; ++a)
#pragma unroll
            for (int b = 0; b < 2; ++b)
#pragma unroll
                for (int m = 0; m < 4; ++m)
#pragma unroll
                    for (int n = 0; n < 2; ++n) acc[a][b][m][n] = (f32x4){0.f, 0.f, 0.f, 0.f};
        cur = nxt; cA = nA; cB = nB; ++ui;
        if (wr == 1) PG8_BAR;
    }
    PG8_WAIT_V(0);
    PG8_BAR;
#undef PG8_SA
#undef PG8_SB
#undef PG8_STAGE
#undef PG8_LDA
#undef PG8_LDB
#undef PG8_MMA
#undef PG8_WAIT_V
#undef PG8_WAIT_L
#undef PG8_BAR
#undef PG8_SCHED
}
}
using pg8::Unit;

#define EPI_LANE int tz_ = threadIdx.x; asm volatile("" : "+v"(tz_)); const int wr = tz_ >> 8, wc = (tz_ >> 6) & 3, fr = tz_ & 15, fq = (tz_ >> 4) & 3; (void)wr; (void)wc; (void)fr; (void)fq;
#define EPI_LOOP_BEGIN \
    _Pragma("unroll") for (int ai = 0; ai < 2; ++ai) _Pragma("unroll") for (int m = 0; m < 4; ++m) { const int row = u.pm * 256 + ai * 128 + wr * 64 + m * 16 + fr; \
    _Pragma("unroll") for (int bj = 0; bj < 2; ++bj) { const int colt = bj * 128 + wc * 32 + 8 * fq; const f32x4 v0 = acc[ai][bj][m][0], v1 = acc[ai][bj][m][1]; (void)colt; (void)v0; (void)v1;
#define EPI_LOOP_END } }

struct EpiBf16 {
    bf16_t* O; int ldc;
    __device__ __forceinline__ void operator()(const f32x4 (&acc)[2][2][4][2], const Unit& u) const {
        EPI_LANE
        EPI_LOOP_BEGIN
            *(u32x4*)(O + (size_t)row * ldc + u.pn * 256 + colt) = pack8(v0, v1);
        EPI_LOOP_END
    }
};
struct EpiNone { __device__ __forceinline__ void operator()(const f32x4 (&acc)[2][2][4][2], const Unit& u) const { (void)u;
#pragma unroll
    for (int a = 0; a < 2; ++a)
#pragma unroll
        for (int b = 0; b < 2; ++b)
#pragma unroll
            for (int m = 0; m < 4; ++m) asm volatile("" :: "v"(acc[a][b][m][0]), "v"(acc[a][b][m][1])); } };
struct EpiF32 {
    float* C; int ldc;
    __device__ __forceinline__ void operator()(const f32x4 (&acc)[2][2][4][2], const Unit& u) const {
        EPI_LANE
        EPI_LOOP_BEGIN
            float* p = C + (size_t)row * ldc + u.pn * 256 + colt; *(f32x4*)p = v0; *(f32x4*)(p + 4) = v1;
        EPI_LOOP_END
    }
};
struct EpiWin {
    unsigned char* ws; float* out; const float* bmerge; int l;
    __device__ __forceinline__ void operator()(const f32x4 (&acc)[2][2][4][2], const Unit& u) const {
        EPI_LANE
        const int pn = u.pn;
        if (pn < 2) {
            float* qlat = (float*)(ws + WS_QLATF);
            EPI_LOOP_BEGIN
                float* p = qlat + (size_t)row * 512 + pn * 256 + colt; *(f32x4*)p = v0; *(f32x4*)(p + 4) = v1;
            EPI_LOOP_END
        } else if (pn < 4) {
            float* ckv_p = out + O_PCKV + (size_t)l * M_P * 512; float* ckv_s = out + O_SCKV + (size_t)l * M_S * 512;
            EPI_LOOP_BEGIN
                float* p = (row < M_P ? ckv_p + (size_t)row * 512 : ckv_s + (size_t)(row - M_P) * 512) + (pn - 2) * 256 + colt; *(f32x4*)p = v0; *(f32x4*)(p + 4) = v1;
            EPI_LOOP_END
        } else if (pn == 4) {
            float* kr_p = out + O_PKR + (size_t)l * M_P * 64; float* kr_s = out + O_SKR + (size_t)l * M_S * 64;
            EPI_LOOP_BEGIN
                if (colt < 64) { float* p = (row < M_P ? kr_p + (size_t)row * 64 : kr_s + (size_t)(row - M_P) * 64) + colt; *(f32x4*)p = v0; *(f32x4*)(p + 4) = v1; }
            EPI_LOOP_END
        } else if (pn < 13) {
            bf16_t* zm = (bf16_t*)(ws + WS_ZM);
            EPI_LOOP_BEGIN
                f32x4 a, b;
#pragma unroll
                for (int j = 0; j < 4; ++j) { a[j] = siluf_(v0[j]); b[j] = siluf_(v1[j]); }
                *(u32x4*)(zm + (size_t)row * 2048 + (pn - 5) * 256 + colt) = pack8(a, b);
            EPI_LOOP_END
        } else if (pn < 21) {
            const int t = pn - 13;
            bf16_t* ub = (bf16_t*)(ws + WS_UB);
            float* conv_p = out + O_PCONV + (size_t)l * CONV_ST * 1024; float* conv_s = out + O_SCONV + (size_t)l * NSTREAM * CONV_ST * 1024;
#pragma unroll
            for (int ai = 0; ai < 2; ++ai)
#pragma unroll
                for (int m = 0; m < 4; ++m) {
                    const int row = u.pm * 256 + ai * 128 + wr * 64 + m * 16 + fr; const int col = t * 128 + wc * 32 + 8 * fq;
                    f32x4 a, b;
#pragma unroll
                    for (int j = 0; j < 4; ++j) { a[j] = acc[ai][0][m][0][j] * sigmoidf_(acc[ai][1][m][0][j]); b[j] = acc[ai][0][m][1][j] * sigmoidf_(acc[ai][1][m][1][j]); }
                    *(u32x4*)(ub + (size_t)row * 1024 + col) = pack8(a, b);
                    if (row >= M_P - CONV_ST) {
                        if (row < M_P) { float* p = conv_p + (size_t)(row - (M_P - CONV_ST)) * 1024 + col; *(f32x4*)p = a; *(f32x4*)(p + 4) = b; }
                        else { const int rs = row - M_P, sq = rs & 63, bb = rs >> 6;
                            if (sq >= DEC_SEQ - CONV_ST) { float* p = conv_s + ((size_t)bb * CONV_ST + (sq - (DEC_SEQ - CONV_ST))) * 1024 + col; *(f32x4*)p = a; *(f32x4*)(p + 4) = b; } }
                    }
                }
        } else if (pn < 33) {
            const size_t dofs = pn < 25 ? WS_ZC : (pn < 29 ? WS_XQ : WS_ZX); const int tb = pn < 25 ? 21 : (pn < 29 ? 25 : 29); const bool act = !(pn >= 25 && pn < 29);
            bf16_t* dst = (bf16_t*)(ws + dofs);
            EPI_LOOP_BEGIN
                f32x4 a = v0, b = v1;
                if (act) {
#pragma unroll
                    for (int j = 0; j < 4; ++j) { a[j] = siluf_(v0[j]); b[j] = siluf_(v1[j]); } }
                *(u32x4*)(dst + (size_t)row * 1024 + (pn - tb) * 256 + colt) = pack8(a, b);
            EPI_LOOP_END
        } else {
            bf16_t* gates = (bf16_t*)(ws + WS_GATES);
            f32x4 bb[2][2];
#pragma unroll
            for (int bj = 0; bj < 2; ++bj) { const float* bp = bmerge + (pn - 33) * 256 + bj * 128 + wc * 32 + 8 * fq; bb[bj][0] = *(const f32x4*)bp; bb[bj][1] = *(const f32x4*)(bp + 4); }
            EPI_LOOP_BEGIN
                const int col = (pn - 33) * 256 + colt;
                f32x4 a, b;
#pragma unroll
                for (int j = 0; j < 4; ++j) { a[j] = sigmoidf_(v0[j] + bb[bj][0][j]); b[j] = sigmoidf_(v1[j] + bb[bj][1][j]); }
                *(u32x4*)(gates + (size_t)row * 6144 + col) = pack8(a, b);
            EPI_LOOP_END
        }
    }
};
template <bool PASTROWS> struct EpiKV {
    bf16_t* Kd; bf16_t* Vd; float* SS;
    __device__ __forceinline__ void operator()(const f32x4 (&acc)[2][2][4][2], const Unit& u) const {
        EPI_LANE
        const int h = u.pn;
#pragma unroll
        for (int ai = 0; ai < 2; ++ai)
#pragma unroll
            for (int m = 0; m < 4; ++m) {
                const int row = u.pm * 256 + ai * 128 + wr * 64 + m * 16 + fr;
                const size_t R = PASTROWS ? ((size_t)((row >> 12) * 16 + h) * 4096 + (row & 4095)) : ((size_t)h * M + row);
                const int c = wc * 32 + 8 * fq;
                const f32x4 k0 = acc[ai][0][m][0], k1 = acc[ai][0][m][1];
                *(u32x4*)(Kd + R * 128 + c) = pack8(k0, k1);
                *(u32x4*)(Vd + R * 128 + c) = pack8(acc[ai][1][m][0], acc[ai][1][m][1]);
                float s = (k0[0] * k0[0] + k0[1] * k0[1]) + (k0[2] * k0[2] + k0[3] * k0[3]) + (k1[0] * k1[0] + k1[1] * k1[1]) + (k1[2] * k1[2] + k1[3] * k1[3]);
                s += __shfl_xor(s, 16); s += __shfl_xor(s, 32);
                if (fq == 0) SS[R * 4 + wc] = s;
            }
    }
};
template <bool DOK = true, bool DOSS = true, bool TILED = true> struct EpiK {
    bf16_t* Kd; float* SS;
    __device__ __forceinline__ void operator()(const f32x4 (&acc)[2][2][4][2], const Unit& u) const {
        EPI_LANE
        float sq[2][4][2];
#pragma unroll
        for (int ai = 0; ai < 2; ++ai)
#pragma unroll
            for (int m = 0; m < 4; ++m)
#pragma unroll
                for (int bj = 0; bj < 2; ++bj) {
                    const f32x4 k0 = acc[ai][bj][m][0], k1 = acc[ai][bj][m][1];
                    if (DOK) *(u32x4*)(Kd + ((((((((size_t)u.pm * 8 + u.pn) * 2 + ai) * 2 + wr) * 4 + m) * 2 + bj) * 4 + wc) * 64 + (fq * 16 + fr)) * 8) = pack8(k0, k1);
                    sq[ai][m][bj] = (k0[0] * k0[0] + k0[1] * k0[1]) + (k0[2] * k0[2] + k0[3] * k0[3]) + (k1[0] * k1[0] + k1[1] * k1[1]) + (k1[2] * k1[2] + k1[3] * k1[3]);
                }
#pragma unroll
        for (int ai = 0; ai < 2; ++ai)
#pragma unroll
            for (int m = 0; m < 4; ++m)
#pragma unroll
                for (int bj = 0; bj < 2; ++bj) sq[ai][m][bj] += __shfl_xor(sq[ai][m][bj], 16);
#pragma unroll
        for (int ai = 0; ai < 2; ++ai)
#pragma unroll
            for (int m = 0; m < 4; ++m)
#pragma unroll
                for (int bj = 0; bj < 2; ++bj) sq[ai][m][bj] += __shfl_xor(sq[ai][m][bj], 32);
        if (DOSS) {
#pragma unroll
            for (int ai = 0; ai < 2; ++ai)
#pragma unroll
                for (int bj = 0; bj < 2; ++bj) {
                    const float v = fq == 0 ? sq[ai][0][bj] : (fq == 1 ? sq[ai][1][bj] : (fq == 2 ? sq[ai][2][bj] : sq[ai][3][bj]));
                    const int row = u.pm * 256 + ai * 128 + wr * 64 + fq * 16 + fr; const int h = u.pn * 2 + bj;
                    SS[(size_t)wc * ((size_t)MPAST * 16) + (size_t)((row >> 12) * 16 + h) * 4096 + (row & 4095)] = v;
                }
        }
        (void)TILED;
    }
};
struct EpiPw2 {
    bf16_t* O; const bf16_t* zc; const float* bias;
    __device__ __forceinline__ void operator()(const f32x4 (&acc)[2][2][4][2], const Unit& u) const {
        EPI_LANE
        f32x4 bb[2][2];
#pragma unroll
        for (int bj = 0; bj < 2; ++bj) { const float* bp = bias + u.pn * 256 + bj * 128 + wc * 32 + 8 * fq; bb[bj][0] = *(const f32x4*)bp; bb[bj][1] = *(const f32x4*)(bp + 4); }
#pragma unroll
        for (int ai = 0; ai < 2; ++ai) {
            u32x4 z[4][2];
#pragma unroll
            for (int m = 0; m < 4; ++m)
#pragma unroll
                for (int bj = 0; bj < 2; ++bj) { const int row = u.pm * 256 + ai * 128 + wr * 64 + m * 16 + fr; z[m][bj] = *(const u32x4*)(zc + (size_t)row * 1024 + u.pn * 256 + bj * 128 + wc * 32 + 8 * fq); }
#pragma unroll
            for (int m = 0; m < 4; ++m)
#pragma unroll
                for (int bj = 0; bj < 2; ++bj) { const int row = u.pm * 256 + ai * 128 + wr * 64 + m * 16 + fr; const int col = u.pn * 256 + bj * 128 + wc * 32 + 8 * fq;
                    f32x4 z0, z1; unpack8(z[m][bj], z0, z1);
                    *(u32x4*)(O + (size_t)row * 1024 + col) = pack8((acc[ai][bj][m][0] + bb[bj][0]) * z0, (acc[ai][bj][m][1] + bb[bj][1]) * z1); }
            asm volatile("" ::: "memory");
        }
    }
};
struct EpiGate {
    bf16_t* O; const bf16_t* gates; int goff;
    __device__ __forceinline__ void operator()(const f32x4 (&acc)[2][2][4][2], const Unit& u) const {
        EPI_LANE
#pragma unroll
        for (int ai = 0; ai < 2; ++ai) {
            u32x4 gg[4][2];
#pragma unroll
            for (int m = 0; m < 4; ++m)
#pragma unroll
                for (int bj = 0; bj < 2; ++bj) { const int row = u.pm * 256 + ai * 128 + wr * 64 + m * 16 + fr; gg[m][bj] = *(const u32x4*)(gates + (size_t)row * 6144 + goff + u.pn * 256 + bj * 128 + wc * 32 + 8 * fq); }
#pragma unroll
            for (int m = 0; m < 4; ++m)
#pragma unroll
                for (int bj = 0; bj < 2; ++bj) { const int row = u.pm * 256 + ai * 128 + wr * 64 + m * 16 + fr; const int col = u.pn * 256 + bj * 128 + wc * 32 + 8 * fq;
                    f32x4 g0, g1; unpack8(gg[m][bj], g0, g1);
                    *(u32x4*)(O + (size_t)row * 2048 + col) = pack8(g0 * acc[ai][bj][m][0], g1 * acc[ai][bj][m][1]); }
            asm volatile("" ::: "memory");
        }
    }
};
struct EpiOut {
    const float* src_p; const float* src_s; float* dst_p; float* dst_s;
    __device__ __forceinline__ void operator()(const f32x4 (&acc)[2][2][4][2], const Unit& u) const {
        EPI_LANE
        const bool pr = u.pm * 256 < M_P;
        const float* src = pr ? src_p : src_s; float* dst = pr ? dst_p : dst_s; const int rbase = u.pm * 256 - (pr ? 0 : M_P);
#pragma unroll
        for (int ai = 0; ai < 2; ++ai)
#pragma unroll
            for (int mh = 0; mh < 2; ++mh) {
                f32x4 xx[2][2][2];
#pragma unroll
                for (int mm = 0; mm < 2; ++mm)
#pragma unroll
                    for (int bj = 0; bj < 2; ++bj) { const int m = mh * 2 + mm; const size_t off = (size_t)(rbase + ai * 128 + wr * 64 + m * 16 + fr) * 2048 + u.pn * 256 + bj * 128 + wc * 32 + 8 * fq;
                        xx[mm][bj][0] = *(const f32x4*)(src + off); xx[mm][bj][1] = *(const f32x4*)(src + off + 4); }
#pragma unroll
                for (int mm = 0; mm < 2; ++mm)
#pragma unroll
                    for (int bj = 0; bj < 2; ++bj) { const int m = mh * 2 + mm; const size_t off = (size_t)(rbase + ai * 128 + wr * 64 + m * 16 + fr) * 2048 + u.pn * 256 + bj * 128 + wc * 32 + 8 * fq;
                        *(f32x4*)(dst + off) = xx[mm][bj][0] + acc[ai][bj][m][0]; *(f32x4*)(dst + off + 4) = xx[mm][bj][1] + acc[ai][bj][m][1]; }
                asm volatile("" ::: "memory");
            }
    }
};

namespace att {
__device__ __forceinline__ int crow(int r, int hi) { return (r & 3) + 8 * (r >> 2) + 4 * hi; }
template <int ROWB> __device__ __forceinline__ int kswz(int row, int colB) { return row * ROWB + (colB ^ ((row & 7) << 4)); }
template <int NDV> __device__ __forceinline__ int v_st(int k, int c) { const int kk = (k & ~0xC) | ((k & 4) << 1) | ((k & 8) >> 1); return ((kk >> 3) * NDV + (c >> 5)) * 512 + ((kk & 7) * 32 + (c & 31)) * 2; }
__device__ __forceinline__ int v_rd_base(int lane) { return ((lane & 3) << 3) | (((lane >> 2) & 3) << 6) | (((lane >> 4) & 1) << 5) | (((lane >> 5) & 1) << 8); }

template <int NQA, int NQB, int NDV, int NKB, bool HAS_RK, int KROWB, int KR = 3>
__device__ __forceinline__ void tile_step(const bf16x8 (&qr)[NQA + NQB], f32x16 (&o)[NDV], float& m_reg, float& l_reg,
                                          const LAS char* Ks, const LAS char* Kp, int vb, const LAS float* rk, LAS float* al_l, int r32, int hi) {
    f32x16 p[NKB];
#pragma unroll
    for (int kb = 0; kb < NKB; ++kb)
#pragma unroll
        for (int r = 0; r < 16; ++r) p[kb][r] = 0.f;
    {
        auto kfrag = [&](int kb, int d) -> bf16x8 { return d < NQA ? *(const LAS bf16x8*)(Ks + kswz<KROWB>(kb * 32 + r32, (d * 16 + hi * 8) * 2)) : *(const LAS bf16x8*)(Kp + kswz<128>(kb * 32 + r32, ((d - NQA) * 16 + hi * 8) * 2)); };
        bf16x8 kf[KR][NKB];
#pragma unroll
        for (int a = 0; a < KR - 1; ++a)
#pragma unroll
            for (int kb = 0; kb < NKB; ++kb) kf[a][kb] = kfrag(kb, a);
#pragma unroll
        for (int d0 = 0; d0 < NQA + NQB; ++d0) {
            if (d0 + KR - 1 < NQA + NQB) {
#pragma unroll
                for (int kb = 0; kb < NKB; ++kb) kf[(d0 + KR - 1) % KR][kb] = kfrag(kb, d0 + KR - 1); }
#pragma unroll
            for (int kb = 0; kb < NKB; ++kb) p[kb] = __builtin_amdgcn_mfma_f32_32x32x16_bf16(kf[d0 % KR][kb], qr[d0], p[kb], 0, 0, 0);
        }
    }
    if (HAS_RK) {
#pragma unroll
        for (int kb = 0; kb < NKB; ++kb)
#pragma unroll
            for (int i = 0; i < 4; ++i) { const f32x4 s = *(const LAS f32x4*)(rk + kb * 32 + 8 * i + 4 * hi);
#pragma unroll
                for (int j = 0; j < 4; ++j) p[kb][4 * i + j] *= s[j]; }
    }
    float pmax = p[0][0];
#pragma unroll
    for (int kb = 0; kb < NKB; ++kb)
#pragma unroll
        for (int r = 0; r < 16; ++r) pmax = fmaxf(pmax, p[kb][r]);
    { auto rr = __builtin_amdgcn_permlane32_swap(__float_as_uint(pmax), __float_as_uint(pmax), false, false); pmax = fmaxf(__uint_as_float(rr[0]), __uint_as_float(rr[1])); }
    const float mn = fmaxf(m_reg, pmax); const float alpha = __builtin_amdgcn_exp2f(m_reg - mn); m_reg = mn;
    float ps = 0.f;
#pragma unroll
    for (int kb = 0; kb < NKB; ++kb)
#pragma unroll
        for (int r = 0; r < 16; ++r) { p[kb][r] = __builtin_amdgcn_exp2f(p[kb][r] - mn); ps += p[kb][r]; }
    { auto rr = __builtin_amdgcn_permlane32_swap(__float_as_uint(ps), __float_as_uint(ps), false, false); ps = __uint_as_float(rr[0]) + __uint_as_float(rr[1]); }
    l_reg = l_reg * alpha + ps;
    if (__any(alpha < 1.f)) {
        if (hi == 0) al_l[r32] = alpha;
        LDS_WAIT();
        float al[16];
#pragma unroll
        for (int r = 0; r < 16; ++r) al[r] = al_l[crow(r, hi)];
#pragma unroll
        for (int d = 0; d < NDV; ++d)
#pragma unroll
            for (int r = 0; r < 16; ++r) o[d][r] *= al[r];
    }
    bf16x8 pa[2 * NKB];
#pragma unroll
    for (int kb = 0; kb < NKB; ++kb)
#pragma unroll
        for (int hf = 0; hf < 2; ++hf) { const int B = hf * 8;
            const unsigned a0 = cvt_pk_bf16(p[kb][B + 0], p[kb][B + 1]), a1 = cvt_pk_bf16(p[kb][B + 2], p[kb][B + 3]);
            const unsigned b0 = cvt_pk_bf16(p[kb][B + 4], p[kb][B + 5]), b1 = cvt_pk_bf16(p[kb][B + 6], p[kb][B + 7]);
            auto r0 = __builtin_amdgcn_permlane32_swap(a0, b0, false, false); auto r1 = __builtin_amdgcn_permlane32_swap(a1, b1, false, false);
            u32x4 w = {r0[0], r1[0], r0[1], r1[1]}; pa[kb * 2 + hf] = __builtin_bit_cast(bf16x8, w); }
#pragma unroll
    for (int d0 = 0; d0 < NDV; ++d0) {
        s16x4 lo[2 * NKB], hh[2 * NKB];
#pragma unroll
        for (int ks = 0; ks < 2 * NKB; ++ks) {
            asm volatile("ds_read_b64_tr_b16 %0, %1 offset:%c2" : "=&v"(lo[ks]) : "v"(vb), "i"(d0 * 512 + ks * (NDV * 1024)) : "memory");
            asm volatile("ds_read_b64_tr_b16 %0, %1 offset:%c2" : "=&v"(hh[ks]) : "v"(vb), "i"(d0 * 512 + ks * (NDV * 1024) + NDV * 512) : "memory"); }
        asm volatile("s_waitcnt lgkmcnt(0)" ::: "memory"); __builtin_amdgcn_sched_barrier(0);
#pragma unroll
        for (int ks = 0; ks < 2 * NKB; ++ks) { const bf16x8 vf = (bf16x8){lo[ks][0], lo[ks][1], lo[ks][2], lo[ks][3], hh[ks][0], hh[ks][1], hh[ks][2], hh[ks][3]};
            o[d0] = __builtin_amdgcn_mfma_f32_32x32x16_bf16(pa[ks], vf, o[d0], 0, 0, 0); }
    }
}
typedef short v4i16_t __attribute__((ext_vector_type(4)));
__device__ __forceinline__ s16x4 vtr(const LAS char* p) { return __builtin_bit_cast(s16x4, __builtin_amdgcn_ds_read_tr16_b64_v4i16((LAS v4i16_t*)p)); }
template <int NQA, int NQB, int NDV, int NKB, int KROWB, int NDVT = NDV>
__device__ __forceinline__ void tile_step_fs(const bf16x8 (&qr)[NQA + NQB], f32x16 (&o)[NDV], float& l_part,
                                             const LAS char* Ks, const LAS char* Kp, const LAS char* vbp, const LAS float* rk, float negB2, int r32, int hi) {
    f32x16 p[NKB];
#pragma unroll
    for (int kb = 0; kb < NKB; ++kb)
#pragma unroll
        for (int r = 0; r < 16; ++r) p[kb][r] = 0.f;
    bf16x8 ka[NKB], kn[NKB];
#pragma unroll
    for (int kb = 0; kb < NKB; ++kb) ka[kb] = *(const LAS bf16x8*)(Ks + kswz<KROWB>(kb * 32 + r32, hi * 16));
#pragma unroll
    for (int d0 = 0; d0 < NQA + NQB; ++d0) {
        if (d0 + 1 < NQA + NQB) {
#pragma unroll
            for (int kb = 0; kb < NKB; ++kb) { const int d1 = d0 + 1;
                kn[kb] = d1 < NQA ? *(const LAS bf16x8*)(Ks + kswz<KROWB>(kb * 32 + r32, (d1 * 16 + hi * 8) * 2)) : *(const LAS bf16x8*)(Kp + kswz<128>(kb * 32 + r32, ((d1 - NQA) * 16 + hi * 8) * 2)); } }
#pragma unroll
        for (int kb = 0; kb < NKB; ++kb) p[kb] = __builtin_amdgcn_mfma_f32_32x32x16_bf16(ka[kb], qr[d0], p[kb], 0, 0, 0);
#pragma unroll
        for (int kb = 0; kb < NKB; ++kb) ka[kb] = kn[kb];
    }
#pragma unroll
    for (int kb = 0; kb < NKB; ++kb) {
        float ps = 0.f;
#pragma unroll
        for (int i = 0; i < 4; ++i) { const f32x4 s = *(const LAS f32x4*)(rk + kb * 32 + 8 * i + 4 * hi);
#pragma unroll
            for (int j = 0; j < 4; ++j) { const float e = __builtin_amdgcn_exp2f(fmaf(p[kb][4 * i + j], s[j], negB2)); p[kb][4 * i + j] = e; ps += e; } }
        l_part += ps;
        bf16x8 pa[2];
#pragma unroll
        for (int hf = 0; hf < 2; ++hf) { const int B = hf * 8;
            const unsigned a0 = cvt_pk_bf16(p[kb][B + 0], p[kb][B + 1]), a1 = cvt_pk_bf16(p[kb][B + 2], p[kb][B + 3]);
            const unsigned b0 = cvt_pk_bf16(p[kb][B + 4], p[kb][B + 5]), b1 = cvt_pk_bf16(p[kb][B + 6], p[kb][B + 7]);
            auto r0 = __builtin_amdgcn_permlane32_swap(a0, b0, false, false); auto r1 = __builtin_amdgcn_permlane32_swap(a1, b1, false, false);
            u32x4 w = {r0[0], r1[0], r0[1], r1[1]}; pa[hf] = __builtin_bit_cast(bf16x8, w); }
#pragma unroll
        for (int hf = 0; hf < 2; ++hf) { const int ks = kb * 2 + hf;
            bf16x8 vf[NDV];
#pragma unroll
            for (int d0 = 0; d0 < NDV; ++d0) { const s16x4 lo = vtr(vbp + d0 * 512 + ks * (NDVT * 1024)), hh = vtr(vbp + d0 * 512 + ks * (NDVT * 1024) + NDVT * 512);
                vf[d0] = (bf16x8){lo[0], lo[1], lo[2], lo[3], hh[0], hh[1], hh[2], hh[3]}; }
#pragma unroll
            for (int d0 = 0; d0 < NDV; ++d0) o[d0] = __builtin_amdgcn_mfma_f32_32x32x16_bf16(pa[hf], vf[d0], o[d0], 0, 0, 0); }
    }
}
template <int NQA, int NQB, int NKB, int KROWB>
__device__ __forceinline__ void qk_sm(const bf16x8 (&qr)[NQA + NQB], float& l_part, const LAS char* Ks, const LAS char* Kp, const LAS float* rk, float negB2, int r32, int hi, bf16x8 (&pa)[2 * NKB]) {
    f32x16 p[NKB];
#pragma unroll
    for (int kb = 0; kb < NKB; ++kb)
#pragma unroll
        for (int r = 0; r < 16; ++r) p[kb][r] = 0.f;
    auto kfrag = [&](int kb, int d) -> bf16x8 { return d < NQA ? *(const LAS bf16x8*)(Ks + kswz<KROWB>(kb * 32 + r32, (d * 16 + hi * 8) * 2)) : *(const LAS bf16x8*)(Kp + kswz<128>(kb * 32 + r32, ((d - NQA) * 16 + hi * 8) * 2)); };
    bf16x8 kf[3][NKB];
#pragma unroll
    for (int kb = 0; kb < NKB; ++kb) { kf[0][kb] = kfrag(kb, 0); kf[1][kb] = kfrag(kb, 1); }
#pragma unroll
    for (int d0 = 0; d0 < NQA + NQB; ++d0) {
        if (d0 + 2 < NQA + NQB) {
#pragma unroll
            for (int kb = 0; kb < NKB; ++kb) kf[(d0 + 2) % 3][kb] = kfrag(kb, d0 + 2); }
#pragma unroll
        for (int kb = 0; kb < NKB; ++kb) p[kb] = __builtin_amdgcn_mfma_f32_32x32x16_bf16(kf[d0 % 3][kb], qr[d0], p[kb], 0, 0, 0);
    }
    f32x4 sc[NKB][4];
#pragma unroll
    for (int kb = 0; kb < NKB; ++kb)
#pragma unroll
        for (int i = 0; i < 4; ++i) sc[kb][i] = *(const LAS f32x4*)(rk + kb * 32 + 8 * i + 4 * hi);
#pragma unroll
    for (int kb = 0; kb < NKB; ++kb) {
        float ps = 0.f;
#pragma unroll
        for (int i = 0; i < 4; ++i) {
#pragma unroll
            for (int j = 0; j < 4; ++j) { const float e = __builtin_amdgcn_exp2f(fmaf(p[kb][4 * i + j], sc[kb][i][j], negB2)); p[kb][4 * i + j] = e; ps += e; } }
        l_part += ps;
#pragma unroll
        for (int hf = 0; hf < 2; ++hf) { const int B = hf * 8;
            const unsigned a0 = cvt_pk_bf16(p[kb][B + 0], p[kb][B + 1]), a1 = cvt_pk_bf16(p[kb][B + 2], p[kb][B + 3]);
            const unsigned b0 = cvt_pk_bf16(p[kb][B + 4], p[kb][B + 5]), b1 = cvt_pk_bf16(p[kb][B + 6], p[kb][B + 7]);
            auto r0 = __builtin_amdgcn_permlane32_swap(a0, b0, false, false); auto r1 = __builtin_amdgcn_permlane32_swap(a1, b1, false, false);
            u32x4 w = {r0[0], r1[0], r0[1], r1[1]}; pa[kb * 2 + hf] = __builtin_bit_cast(bf16x8, w); }
    }
}
template <int NDV, int NKB>
__device__ __forceinline__ void pv_fs(f32x16 (&o)[NDV], const LAS char* vbp, const bf16x8 (&pa)[2 * NKB]) {
    const int vb = (int)(uintptr_t)vbp;
    s16x4 lo[2][NDV], hh[2][NDV];
    __builtin_amdgcn_sched_barrier(0);
#pragma unroll
    for (int d0 = 0; d0 < NDV; ++d0) {
        asm volatile("ds_read_b64_tr_b16 %0, %1 offset:%c2" : "=&v"(lo[0][d0]) : "v"(vb), "i"(d0 * 512) : "memory");
        asm volatile("ds_read_b64_tr_b16 %0, %1 offset:%c2" : "=&v"(hh[0][d0]) : "v"(vb), "i"(d0 * 512 + NDV * 512) : "memory"); }
#pragma unroll
    for (int ks = 0; ks < 2 * NKB; ++ks) {
        if (ks + 1 < 2 * NKB) {
#pragma unroll
            for (int d0 = 0; d0 < NDV; ++d0) {
                asm volatile("ds_read_b64_tr_b16 %0, %1 offset:%c2" : "=&v"(lo[(ks + 1) & 1][d0]) : "v"(vb), "i"(d0 * 512 + (ks + 1) * (NDV * 1024)) : "memory");
                asm volatile("ds_read_b64_tr_b16 %0, %1 offset:%c2" : "=&v"(hh[(ks + 1) & 1][d0]) : "v"(vb), "i"(d0 * 512 + (ks + 1) * (NDV * 1024) + NDV * 512) : "memory"); }
            asm volatile("s_waitcnt lgkmcnt(%0)" :: "n"(2 * NDV) : "memory");
        } else asm volatile("s_waitcnt lgkmcnt(0)" ::: "memory");
        __builtin_amdgcn_sched_barrier(0);
#pragma unroll
        for (int d0 = 0; d0 < NDV; ++d0) { const s16x4 l_ = lo[ks & 1][d0], h_ = hh[ks & 1][d0];
            const bf16x8 vf = (bf16x8){l_[0], l_[1], l_[2], l_[3], h_[0], h_[1], h_[2], h_[3]};
            o[d0] = __builtin_amdgcn_mfma_f32_32x32x16_bf16(pa[ks], vf, o[d0], 0, 0, 0); }
        __builtin_amdgcn_sched_barrier(0);
    }
}
__device__ __forceinline__ float lane_pair_sum(float x) { auto rr = __builtin_amdgcn_permlane32_swap(__float_as_uint(x), __float_as_uint(x), false, false); return __uint_as_float(rr[0]) + __uint_as_float(rr[1]); }
template <int NDV>
__device__ __forceinline__ void finish(const f32x16 (&o)[NDV], float l_reg, LAS float* al_l, bf16_t* out, const bf16_t* z, int ld, int r32, int hi) {
    if (hi == 0) al_l[r32] = l_reg;
    LDS_WAIT();
    const bool odd = r32 & 1;
#pragma unroll
    for (int r = 0; r < 16; r += 2) { const int orow = crow(r, hi);
        const float rl0 = __builtin_amdgcn_rcpf(al_l[orow]), rl1 = __builtin_amdgcn_rcpf(al_l[orow + 1]);
#pragma unroll
        for (int d0 = 0; d0 < NDV; ++d0) {
            const float a = o[d0][r] * rl0, b = o[d0][r + 1] * rl1;
            const float recv = __shfl_xor(odd ? a : b, 1);
            const float v0 = odd ? recv : a, v1 = odd ? b : recv;
            const size_t idx = (size_t)(orow + (odd ? 1 : 0)) * ld + d0 * 32 + (r32 & ~1);
            const unsigned zw = *(const unsigned*)(z + idx);
            *(unsigned*)(out + idx) = cvt_pk_bf16(v0 * bf_lo(zw), v1 * bf_hi(zw)); } }
}
}

#define XB_TMO      128
#define XB_XCNT(j)  (256  + 64 * (j))
#define XB_XSUB(j)  (1280 + 64 * (j))
#define XB_XGEN(j)  (2304 + 64 * (j))
#define XB_TOP      3328
#define XB_TOPGEN   3392
#define XCD_BAR_WORDS 3456
#define XB_SPIN_CAP (1u << 18)
__device__ __forceinline__ unsigned xb_ld(unsigned* p)              { return __hip_atomic_load(p, __ATOMIC_RELAXED, __HIP_MEMORY_SCOPE_AGENT); }
__device__ __forceinline__ unsigned xb_add(unsigned* p, unsigned v) { return __hip_atomic_fetch_add(p, v, __ATOMIC_RELAXED, __HIP_MEMORY_SCOPE_AGENT); }
__device__ __forceinline__ unsigned xb_xcc_id() { return (unsigned)__builtin_amdgcn_s_getreg((3 << 11) | 20) & 0xFu; }
#define XB_SPIN(cond, bar) do { unsigned _sp = 0; while (cond) { __builtin_amdgcn_s_sleep(1); \
    if ((++_sp & 255u) == 0u) { if (xb_ld(&(bar)[XB_TMO])) break; if (_sp > XB_SPIN_CAP) { atomicAdd(&(bar)[XB_TMO], 1u); break; } } } } while (0)
struct XcdBarrier { unsigned* bar; unsigned x; volatile LAS unsigned* st; };
__device__ __forceinline__ XcdBarrier xcd_barrier_post(unsigned* bar, volatile LAS unsigned* st) {
    XcdBarrier b; b.bar = bar; b.x = xb_xcc_id(); b.st = st;
    if (threadIdx.x == 0) (void)xb_add(&bar[XB_XCNT(b.x)], 1u);
    return b;
}
__device__ __forceinline__ void xcd_barrier_complete(unsigned* bar, unsigned x, unsigned& nloc, unsigned& nx) {
    const unsigned G = gridDim.x * gridDim.y * gridDim.z;
    unsigned sum, cnt, mine, sp = 0u;
    for (;;) {
        sum = 0u; cnt = 0u; mine = 0u;
#pragma unroll
        for (unsigned j = 0; j < 16; ++j) { const unsigned c = xb_ld(&bar[XB_XCNT(j)]); sum += c; cnt += (c > 0u) ? 1u : 0u; mine = (j == x) ? c : mine; }
        if (sum == G) break;
        __builtin_amdgcn_s_sleep(1);
        if ((++sp & 255u) == 0u) { if (xb_ld(&bar[XB_TMO])) break; if (sp > XB_SPIN_CAP) { atomicAdd(&bar[XB_TMO], 1u); break; } }
    }
    nloc = mine > 0u ? mine : 1u; nx = cnt > 0u ? cnt : 1u;
}
__device__ __forceinline__ void xcd_barrier(const XcdBarrier& b) {
    asm volatile("s_waitcnt vmcnt(0)" ::: "memory");
    __syncthreads();
    if (threadIdx.x == 0) {
        unsigned* bar = b.bar; asm volatile("" : "+s"(bar));
        __builtin_amdgcn_s_waitcnt(0);
        unsigned nloc = b.st[0], nx = b.st[1];
        if (nloc == 0u) { xcd_barrier_complete(bar, b.x, nloc, nx); b.st[0] = nloc; b.st[1] = nx; }
        const unsigned old = xb_add(&bar[XB_XSUB(b.x)], 1u);
        const unsigned gen = old / nloc;
        if (old + 1u == (gen + 1u) * nloc) {
            __builtin_amdgcn_fence(__ATOMIC_RELEASE, "agent");
            asm volatile("s_waitcnt vmcnt(0)" ::: "memory");
            const unsigned og = xb_add(&bar[XB_TOP], 1u);
            const unsigned tg = og / nx;
            if (og + 1u == (tg + 1u) * nx) xb_add(&bar[XB_TOPGEN], 1u);
            else XB_SPIN(xb_ld(&bar[XB_TOPGEN]) == tg, bar);
            __builtin_amdgcn_fence(__ATOMIC_ACQUIRE, "agent");
            xb_add(&bar[XB_XGEN(b.x)], 1u);
            asm volatile("s_waitcnt vmcnt(0)" ::: "memory");
        } else {
            XB_SPIN(xb_ld(&bar[XB_XGEN(b.x)]) == gen, bar);
            __builtin_amdgcn_fence(__ATOMIC_ACQUIRE, "agent");
            asm volatile("s_waitcnt vmcnt(0)" ::: "memory");
        }
    }
    __syncthreads();
}

struct Args { const float* in[31]; float* out; unsigned char* ws; int ph_lo, ph_hi; };
typedef const float* const __attribute__((address_space(4)))* karg_in_t;
struct Ctx {
    LAS unsigned char* lds;
    karg_in_t in; float* out; unsigned char* ws;
    int tid, lane, wave, G, bid;
};
enum { I_XP = 0, I_XS, I_MEM, I_CCKV, I_CKR, I_CMK, I_CMV, I_SCONV, I_GPRE, I_WIN, I_GQLAT, I_WUQ, I_GKVLAT, I_WUKV, I_GQN, I_GKN, I_CONVW, I_CONVB, I_LNG, I_LNB,
       I_WPW2, I_BPW2, I_GMEM, I_WMEM, I_GXQ, I_GXK, I_WPM, I_WPC, I_WPX, I_BMERGE, I_WOUT };

__device__ __forceinline__ int win_src_col(int nd) {
    if (nd < 1088) return nd;
    if (nd < 1280) return -1;
    if (nd >= 3328 && nd < 5376) { const int t = (nd - 3328) >> 8, w = (nd - 3328) & 255; return w < 128 ? 3136 + t * 128 + w : 4160 + t * 128 + (w - 128); }
    return nd - 192;
}
__device__ __forceinline__ void transpose_item(const float* W, int K, int Nsrc, bf16_t* WT, const float* gain, int mapmode, LAS float* scr, int item, int nblk, int lane) {
    const int kb = item / nblk, nb = item % nblk, k0 = 64 * kb, nd0 = 64 * nb;
    const int ns0 = mapmode == 1 ? win_src_col(nd0) : (mapmode == 2 ? (nd0 >> 7) * 256 + (nd0 & 127) : nd0);
    const int lk = lane >> 4, ln4 = (lane & 15) * 4;
    f32x4 v[16];
#pragma unroll
    for (int i = 0; i < 16; ++i) v[i] = ns0 >= 0 ? *(const f32x4*)(W + (size_t)(k0 + lk + 4 * i) * Nsrc + ns0 + ln4) : (f32x4){0.f, 0.f, 0.f, 0.f};
#pragma unroll
    for (int i = 0; i < 16; ++i) { LAS float* p = scr + (lk + 4 * i) * 65 + ln4; p[0] = v[i][0]; p[1] = v[i][1]; p[2] = v[i][2]; p[3] = v[i][3]; }
    LDS_WAIT(); asm volatile("" ::: "memory");
    const int c = lane & 7;
    f32x4 g0 = {1.f, 1.f, 1.f, 1.f}, g1 = {1.f, 1.f, 1.f, 1.f};
    if (gain) { g0 = *(const f32x4*)(gain + k0 + 8 * c); g1 = *(const f32x4*)(gain + k0 + 8 * c + 4); }
#pragma unroll
    for (int j = 0; j < 8; ++j) { const int n = (lane >> 3) + 8 * j; const LAS float* sp = scr + (8 * c) * 65 + n;
        u32x4 o; o.x = cvt_pk_bf16(sp[0 * 65] * g0[0], sp[1 * 65] * g0[1]); o.y = cvt_pk_bf16(sp[2 * 65] * g0[2], sp[3 * 65] * g0[3]);
        o.z = cvt_pk_bf16(sp[4 * 65] * g1[0], sp[5 * 65] * g1[1]); o.w = cvt_pk_bf16(sp[6 * 65] * g1[2], sp[7 * 65] * g1[3]);
        *(u32x4*)(WT + (size_t)(nd0 + n) * K + k0 + 8 * c) = o; }
    LDS_WAIT(); asm volatile("" ::: "memory");
}
__device__ __forceinline__ bool h_early_ok(int G) { const int n2 = (M / 256) * (2048 / 256) - G; return n2 > 0 && n2 < G; }
constexpr unsigned PW_ALL = 0x3ffu, PW_EARLY = PW_ALL & ~(1u << 8);
__device__ __forceinline__ void prep_weights(const Ctx& F, int l, int gw, int NGW, unsigned jobs) {
    LAS float* scr = (LAS float*)(F.lds + F.wave * 16640);
    int base = 0;
#pragma unroll 1
    for (int job = 0; job < 10; ++job) {
        if (!((jobs >> job) & 1u)) continue;
        const float* W; int K, Nsrc, Ndst; size_t dst; const float* gain = nullptr; int winmap = 0;
        switch (job) {
            case 0: W = F.in[I_WIN] + (size_t)l * 2048 * IN_COLS; K = 2048; Nsrc = IN_COLS; Ndst = IN_PAD; dst = WS_WIN; gain = F.in[I_GPRE] + l * 2048; winmap = 1; break;
            case 1: W = F.in[I_WUQ] + (size_t)l * 512 * 3072; K = 512; Nsrc = 3072; Ndst = 3072; dst = WS_WUQ; gain = F.in[I_GQLAT] + l * 512; break;
            case 2: W = F.in[I_WUKV] + (size_t)l * 512 * 4096; K = 512; Nsrc = 4096; Ndst = 4096; dst = WS_WUKV; gain = F.in[I_GKVLAT] + l * 512; break;
            case 3: W = F.in[I_WPW2] + (size_t)l * 1024 * 1024; K = 1024; Nsrc = 1024; Ndst = 1024; dst = WS_WPW2; break;
            case 4: W = F.in[I_WMEM] + (size_t)l * 2048 * 2048; K = 2048; Nsrc = 2048; Ndst = 2048; dst = WS_WMEM; gain = F.in[I_GMEM] + l * 2048; break;
            case 5: W = F.in[I_WPM] + (size_t)l * 2048 * 2048; K = 2048; Nsrc = 2048; Ndst = 2048; dst = WS_WPM; break;
            case 6: W = F.in[I_WPC] + (size_t)l * 1024 * 2048; K = 1024; Nsrc = 2048; Ndst = 2048; dst = WS_WPC; break;
            case 7: W = F.in[I_WPX] + (size_t)l * 1024 * 2048; K = 1024; Nsrc = 2048; Ndst = 2048; dst = WS_WPX; break;
            case 8: W = F.in[I_WOUT] + (size_t)l * 2048 * 2048; K = 2048; Nsrc = 2048; Ndst = 2048; dst = WS_WOUT; break;
            default: W = F.in[I_WUKV] + (size_t)l * 512 * 4096; K = 512; Nsrc = 4096; Ndst = 2048; dst = WS_WUK; gain = F.in[I_GKVLAT] + l * 512; winmap = 2; break;
        }
        const int nblk = Ndst / 64, nitems = (K / 64) * nblk;
        bf16_t* WT = (bf16_t*)(F.ws + dst);
        int first = (gw - base) % NGW; if (first < 0) first += NGW;
        for (int it = first; it < nitems; it += NGW) transpose_item(W, K, Nsrc, WT, gain, winmap, scr, it, nblk, F.lane);
        base += nitems;
    }
}
__device__ __forceinline__ void rms_row_2048(const float* xrow, bf16_t* orow, int lane) {
    const f32x4* xr = (const f32x4*)xrow + lane;
    f32x4 v[8]; float s = 0.f;
#pragma unroll
    for (int j = 0; j < 8; ++j) { v[j] = xr[64 * j]; s += (v[j][0] * v[j][0] + v[j][1] * v[j][1]) + (v[j][2] * v[j][2] + v[j][3] * v[j][3]); }
    const float r = 1.0f / sqrtf(wave_sum(s) * (1.f / 2048.f) + EPS);
    u32x2* o8 = (u32x2*)orow + lane;
#pragma unroll
    for (int j = 0; j < 8; ++j) { u32x2 w; w.x = cvt_pk_bf16(v[j][0] * r, v[j][1] * r); w.y = cvt_pk_bf16(v[j][2] * r, v[j][3] * r); o8[64 * j] = w; }
}
__device__ __forceinline__ void rms_row_512(const float* xrow, bf16_t* orow, int lane) {
    const f32x4* xr = (const f32x4*)xrow + lane;
    f32x4 v[2]; float s = 0.f;
#pragma unroll
    for (int j = 0; j < 2; ++j) { v[j] = xr[64 * j]; s += (v[j][0] * v[j][0] + v[j][1] * v[j][1]) + (v[j][2] * v[j][2] + v[j][3] * v[j][3]); }
    const float r = 1.0f / sqrtf(wave_sum(s) * (1.f / 512.f) + EPS);
    u32x2* o8 = (u32x2*)orow + lane;
#pragma unroll
    for (int j = 0; j < 2; ++j) { u32x2 w; w.x = cvt_pk_bf16(v[j][0] * r, v[j][1] * r); w.y = cvt_pk_bf16(v[j][2] * r, v[j][3] * r); o8[64 * j] = w; }
}
__device__ __forceinline__ void kpe_row(const float* kr, const float* gkpe, const float* ropetab, int pos, bf16_t* kpe, float* sspe, int lane) {
    const float x = kr[lane]; const float ss = wave_sum(x * x);
    const float xg = x * gkpe[lane]; const float other = __shfl_xor(xg, 32);
    const f32x2 cs = *(const f32x2*)(ropetab + ((size_t)pos * 32 + (lane & 31)) * 2);
    const float o = lane < 32 ? xg * cs.x - other * cs.y : xg * cs.x + other * cs.y;
    kpe[lane] = (bf16_t)(cvt_pk_bf16(o, 0.f) & 0xffffu);
    if (lane == 0) *sspe = ss;
}
template <int R>
__device__ __forceinline__ void rms_rows_512(const float* x0, bf16_t* o0, int lane) {
    f32x4 v[R][2]; float s[R];
#pragma unroll
    for (int r = 0; r < R; ++r) { const f32x4* xr = (const f32x4*)(x0 + (size_t)r * 512) + lane;
#pragma unroll
        for (int j = 0; j < 2; ++j) v[r][j] = xr[64 * j]; }
#pragma unroll
    for (int r = 0; r < R; ++r) { s[r] = 0.f;
#pragma unroll
        for (int j = 0; j < 2; ++j) s[r] += (v[r][j][0] * v[r][j][0] + v[r][j][1] * v[r][j][1]) + (v[r][j][2] * v[r][j][2] + v[r][j][3] * v[r][j][3]); }
#pragma unroll
    for (int o = 1; o < 64; o <<= 1)
#pragma unroll
        for (int r = 0; r < R; ++r) s[r] += __shfl_xor(s[r], o);
#pragma unroll
    for (int r = 0; r < R; ++r) { const float rr = 1.0f / sqrtf(s[r] * (1.f / 512.f) + EPS); u32x2* o8 = (u32x2*)(o0 + (size_t)r * 512) + lane;
#pragma unroll
        for (int j = 0; j < 2; ++j) { u32x2 w; w.x = cvt_pk_bf16(v[r][j][0] * rr, v[r][j][1] * rr); w.y = cvt_pk_bf16(v[r][j][2] * rr, v[r][j][3] * rr); o8[64 * j] = w; } }
}
template <int R>
__device__ __forceinline__ void kpe_rows(const float* kr0, float gk, const float* ropetab, int pos0, bf16_t* kpe0, float* sspe0, int lane) {
    float x[R], ss[R]; f32x2 cs[R];
#pragma unroll
    for (int r = 0; r < R; ++r) { x[r] = kr0[(size_t)r * 64 + lane]; cs[r] = *(const f32x2*)(ropetab + ((size_t)(pos0 + r) * 32 + (lane & 31)) * 2); }
#pragma unroll
    for (int r = 0; r < R; ++r) ss[r] = x[r] * x[r];
#pragma unroll
    for (int o = 1; o < 64; o <<= 1)
#pragma unroll
        for (int r = 0; r < R; ++r) ss[r] += __shfl_xor(ss[r], o);
#pragma unroll
    for (int r = 0; r < R; ++r) { const float xg = x[r] * gk; const float other = __shfl_xor(xg, 32);
        const float o = lane < 32 ? xg * cs[r].x - other * cs[r].y : xg * cs[r].x + other * cs[r].y;
        kpe0[(size_t)r * 64 + lane] = (bf16_t)(cvt_pk_bf16(o, 0.f) & 0xffffu);
        if (lane == 0) sspe0[r] = ss[r]; }
}
__device__ __forceinline__ const float* x_row(const Ctx& F, int l, int row) {
    if (l == 0) return row < M_P ? F.in[I_XP] + (size_t)row * 2048 : F.in[I_XS] + (size_t)(row - M_P) * 2048;
    return (const float*)(F.ws + WS_X1) + (size_t)row * 2048;
}
__device__ __forceinline__ void phase_prep(const Ctx& F, int l) {
    const int gw = F.bid * 8 + F.wave, NGW = F.G * 8;
    float* ropetab = (float*)(F.ws + WS_ROPE);
    if (l == 0) {
        for (int i = gw * 64 + F.lane; i < 8192 * 32; i += NGW * 64) { const int pos = i >> 5, j = i & 31;
            const float inv = powf(10000.f, -(float)j / 32.f); const float ang = (float)pos * inv;
            const double a = (double)ang; const double n = rint(a * 0.15915494309189535); const float red = (float)(a - n * 6.283185307179586);
            ropetab[2 * i] = cosf(red); ropetab[2 * i + 1] = sinf(red); }
        for (int r = gw; r < N_MEM; r += NGW) rms_row_2048(F.in[I_MEM] + (size_t)r * 2048, (bf16_t*)(F.ws + WS_MEMN) + (size_t)r * 2048, F.lane);
    }
    prep_weights(F, l, gw, NGW, (l == 1 && h_early_ok(F.G)) ? (PW_ALL & ~PW_EARLY) : PW_ALL);
    for (int r = gw; r < M; r += NGW) rms_row_2048(x_row(F, l, r), (bf16_t*)(F.ws + WS_HB) + (size_t)r * 2048, F.lane);
#ifdef DUP_P2
    for (int r = gw; r < M; r += NGW) rms_row_2048(x_row(F, l, r), (bf16_t*)(F.ws + WS_HB) + (size_t)r * 2048, F.lane);
#endif
    const float* cc = F.in[I_CCKV] + (size_t)l * MPAST * 512;
    for (int r = gw * 4; r < MPAST; r += NGW * 4) rms_rows_512<4>(cc + (size_t)r * 512, (bf16_t*)(F.ws + WS_CNP) + (size_t)r * 512, F.lane);
#ifdef DUP_P3
    for (int r = gw * 4; r < MPAST; r += NGW * 4) rms_rows_512<4>(cc + (size_t)r * 512, (bf16_t*)(F.ws + WS_CNP) + (size_t)r * 512, F.lane);
#endif
}
__device__ __forceinline__ void past_kpe(const Ctx& F, int l) {
    const int gw = F.bid * 8 + F.wave, NGW = F.G * 8;
    const float* ropetab = (const float*)(F.ws + WS_ROPE);
    const float* ck = F.in[I_CKR] + (size_t)l * MPAST * 64; const float* gk = F.in[I_GKN] + l * QK_HEAD + 128;
    const float gkl = gk[F.lane];
    for (int r = gw * 4; r < MPAST; r += NGW * 4) kpe_rows<4>(ck + (size_t)r * 64, gkl, ropetab, r & (PAST - 1), (bf16_t*)(F.ws + WS_KPEP) + (size_t)r * 64, (float*)(F.ws + WS_SSPEP) + r, F.lane);
}

__device__ __forceinline__ void glds16(const void* g, LAS void* l) { unsigned keep; const unsigned dst = (unsigned)(uintptr_t)l;
    asm volatile("s_mov_b32 %0, m0\n\ts_mov_b32 m0, %2\n\ts_nop 0\n\tglobal_load_lds_dwordx4 %1, off\n\ts_mov_b32 m0, %0" : "=&s"(keep) : "v"(g), "s"(dst) : "memory"); }
__device__ __forceinline__ void glds16s(const void* sbase, unsigned voff, LAS void* l) { const unsigned dst = (unsigned)(uintptr_t)l;
    asm volatile("s_mov_b32 m0, %2\n\ts_nop 0\n\tglobal_load_lds_dwordx4 %0, %1" :: "v"(voff), "s"(sbase), "s"(dst) : "memory", "m0"); }
__device__ __forceinline__ void glds4s(const void* sbase, unsigned voff, LAS void* l) { const unsigned dst = (unsigned)(uintptr_t)l;
    asm volatile("s_mov_b32 m0, %2\n\ts_nop 0\n\tglobal_load_lds_dword %0, %1" :: "v"(voff), "s"(sbase), "s"(dst) : "memory", "m0"); }
__device__ __forceinline__ void glds4(const void* g, LAS void* l) { unsigned keep; const unsigned dst = (unsigned)(uintptr_t)l;
    asm volatile("s_mov_b32 %0, m0\n\ts_mov_b32 m0, %2\n\ts_nop 0\n\tglobal_load_lds_dword %1, off\n\ts_mov_b32 m0, %0" : "=&s"(keep) : "v"(g), "s"(dst) : "memory"); }
template <int CR, int SB>
__device__ __forceinline__ void conv_chunk(const Ctx& F, int l, int tid, int seq0, int r0, int seqlen, int bb) {
    constexpr int CWIN = CR + CONV_ST;
    const int lane = tid & 63, wv = __builtin_amdgcn_readfirstlane(tid >> 6);
    asm volatile("" : "+s"(l));
    const float* cw = F.in[I_CONVW] + (size_t)l * CONV_K * 1024; const float* cb = F.in[I_CONVB] + l * 1024;
    const float* lg = F.in[I_LNG] + l * 1024; const float* lb = F.in[I_LNB] + l * 1024;
    const float* st = F.in[I_SCONV] + (size_t)l * NSTREAM * CONV_ST * 1024;
    const bf16_t* ub = (const bf16_t*)(F.ws + WS_UB); bf16_t* cv = (bf16_t*)(F.ws + WS_CV);
    LAS unsigned char* win = F.lds;
    LAS f32x2* red = (LAS f32x2*)(F.lds + CWIN * 2048);
    LAS f32x2* stat = red + 8 * SB;
    const int nh = r0 < CONV_ST ? CONV_ST - r0 : 0;
    for (int hr = 2 * nh + wv; hr < 2 * CWIN; hr += 8)
#ifdef CONV_NODMA
        *(LAS u32x4*)(win + hr * 1024 + lane * 16) = *(const u32x4*)(ub + (size_t)(seq0 + r0 - CONV_ST + (hr >> 1)) * 1024 + (hr & 1) * 512 + lane * 8);
#else
        glds16(ub + (size_t)(seq0 + r0 - CONV_ST + (hr >> 1)) * 1024 + (hr & 1) * 512 + lane * 8, win + hr * 1024);
#endif
    if (bb >= 0) {
        for (int hr0 = wv; hr0 < 2 * nh; hr0 += 32) { f32x4 a[4], b[4];
#pragma unroll
            for (int q = 0; q < 4; ++q) { const int hr = min(hr0 + 8 * q, 2 * nh - 1); const float* sp = st + ((size_t)bb * CONV_ST + r0 + (hr >> 1)) * 1024 + (hr & 1) * 512 + lane * 8; a[q] = *(const f32x4*)sp; b[q] = *(const f32x4*)(sp + 4); }
#pragma unroll
            for (int q = 0; q < 4; ++q) if (hr0 + 8 * q < 2 * nh) *(LAS u32x4*)(win + (hr0 + 8 * q) * 1024 + lane * 16) = pack8(a[q], b[q]); }
    } else for (int hr = wv; hr < 2 * nh; hr += 8) *(LAS u32x4*)(win + hr * 1024 + lane * 16) = (u32x4){0u, 0u, 0u, 0u};
    asm volatile("" ::: "memory");
    const int c0 = 2 * tid;
    f32x2 w[CONV_K];
#pragma unroll
    for (int k = 0; k < CONV_K; ++k) w[k] = *(const f32x2*)(cw + (size_t)k * 1024 + c0);
    const f32x2 bia = *(const f32x2*)(cb + c0);
    const f32x2 g2 = *(const f32x2*)(lg + c0), b2 = *(const f32x2*)(lb + c0);
    asm volatile("s_waitcnt vmcnt(0)" ::: "memory");
    __syncthreads();
#pragma unroll 1
    for (int sb = 0; sb < CR / SB; ++sb) {
        LAS const unsigned char* wp = win + sb * SB * 2048 + c0 * 2;
        f32x2 y[SB];
#pragma unroll
        for (int r = 0; r < SB; ++r) y[r] = bia;
#pragma unroll
        for (int jj = 0; jj < SB + CONV_ST; ++jj) { const unsigned uu = *(const LAS unsigned*)(wp + jj * 2048); const f32x2 u = {bf_lo(uu), bf_hi(uu)};
#pragma unroll
            for (int r = 0; r < SB; ++r) { const int k = jj - r; if (k >= 0 && k < CONV_K) y[r] = w[k] * u + y[r]; } }
#pragma unroll
        for (int r = 0; r < SB; ++r) { const float s1 = wave_sum(y[r].x + y[r].y), s2 = wave_sum(y[r].x * y[r].x + y[r].y * y[r].y); if (lane == 0) red[wv * SB + r] = (f32x2){s1, s2}; }
        __syncthreads();
        if (tid < SB) { float s1 = 0.f, s2 = 0.f;
#pragma unroll
            for (int q = 0; q < 8; ++q) { const f32x2 t = red[q * SB + tid]; s1 += t.x; s2 += t.y; }
            const float mean = s1 * (1.f / 1024.f); const float var = fmaxf(s2 * (1.f / 1024.f) - mean * mean, 0.f);
            stat[tid] = (f32x2){mean, 1.0f / sqrtf(var + EPS)}; }
        __syncthreads();
        const int rb = r0 + sb * SB;
#pragma unroll
        for (int r = 0; r < SB; ++r) { const f32x2 ms = stat[r];
            const float a = siluf_((y[r].x - ms.x) * ms.y * g2.x + b2.x), b = siluf_((y[r].y - ms.x) * ms.y * g2.y + b2.y);
            if (rb + r < seqlen) *(unsigned*)(cv + (size_t)(seq0 + rb + r) * 1024 + c0) = cvt_pk_bf16(a, b); }
    }
    __syncthreads();
}
__device__ __forceinline__ void phase_c(const Ctx& F, int l) {
    int tid = F.tid; asm volatile("" : "+v"(tid)); const int gw = F.bid * 8 + F.wave, NGW = F.G * 8, lane = tid & 63;
    for (int c = F.bid; c < 187 + 64; c += F.G) {
        if (c < 187) conv_chunk<44, 11>(F, l, tid, 0, c * 44, M_P, -1);
        else { const int q = c - 187; conv_chunk<32, 8>(F, l, tid, M_P + (q >> 1) * 64, (q & 1) * 32, DEC_SEQ, q >> 1); }
    }
    {
        const float* ropetab = (const float*)(F.ws + WS_ROPE); const float gkl = (F.in[I_GKN] + l * QK_HEAD + 128)[lane];
        constexpr int RB = 5;
        for (int r0 = gw * RB; r0 < M; r0 += NGW * RB) {
            f32x4 a[RB][2], c[RB][2]; float kx[RB], s[3 * RB]; f32x2 cs[RB];
#pragma unroll
            for (int i = 0; i < RB; ++i) { const int r = r0 + i;
                const f32x4* ap = (const f32x4*)((const float*)(F.ws + WS_QLATF) + (size_t)r * 512) + lane;
                const float* ckv = r < M_P ? F.out + O_PCKV + ((size_t)l * M_P + r) * 512 : F.out + O_SCKV + ((size_t)l * M_S + (r - M_P)) * 512;
                const float* kr = r < M_P ? F.out + O_PKR + ((size_t)l * M_P + r) * 64 : F.out + O_SKR + ((size_t)l * M_S + (r - M_P)) * 64;
                const int pos = r < M_P ? r : PAST + ((r - M_P) & 63);
                a[i][0] = ap[0]; a[i][1] = ap[64]; c[i][0] = ((const f32x4*)ckv)[lane]; c[i][1] = ((const f32x4*)ckv)[lane + 64];
                kx[i] = kr[lane]; cs[i] = *(const f32x2*)(ropetab + ((size_t)pos * 32 + (lane & 31)) * 2); }
#pragma unroll
            for (int i = 0; i < RB; ++i) { s[3 * i] = 0.f; s[3 * i + 1] = 0.f;
#pragma unroll
                for (int j = 0; j < 2; ++j) { s[3 * i] += (a[i][j][0] * a[i][j][0] + a[i][j][1] * a[i][j][1]) + (a[i][j][2] * a[i][j][2] + a[i][j][3] * a[i][j][3]);
                    s[3 * i + 1] += (c[i][j][0] * c[i][j][0] + c[i][j][1] * c[i][j][1]) + (c[i][j][2] * c[i][j][2] + c[i][j][3] * c[i][j][3]); }
                s[3 * i + 2] = kx[i] * kx[i]; }
#pragma unroll
            for (int o = 1; o < 64; o <<= 1)
#pragma unroll
                for (int i = 0; i < 3 * RB; ++i) s[i] += __shfl_xor(s[i], o);
#pragma unroll
            for (int i = 0; i < RB; ++i) { const int r = r0 + i;
                const float ra = 1.0f / sqrtf(s[3 * i] * (1.f / 512.f) + EPS), rc = 1.0f / sqrtf(s[3 * i + 1] * (1.f / 512.f) + EPS);
                u32x2* oa = (u32x2*)((bf16_t*)(F.ws + WS_QLATN) + (size_t)r * 512) + lane; u32x2* oc = (u32x2*)((bf16_t*)(F.ws + WS_CKVN) + (size_t)r * 512) + lane;
#pragma unroll
                for (int j = 0; j < 2; ++j) { u32x2 w; w.x = cvt_pk_bf16(a[i][j][0] * ra, a[i][j][1] * ra); w.y = cvt_pk_bf16(a[i][j][2] * ra, a[i][j][3] * ra); oa[64 * j] = w;
                    w.x = cvt_pk_bf16(c[i][j][0] * rc, c[i][j][1] * rc); w.y = cvt_pk_bf16(c[i][j][2] * rc, c[i][j][3] * rc); oc[64 * j] = w; }
                const float xg = kx[i] * gkl; const float other = __shfl_xor(xg, 32);
                const float o = lane < 32 ? xg * cs[i].x - other * cs[i].y : xg * cs[i].x + other * cs[i].y;
                ((bf16_t*)(F.ws + WS_KPEC))[(size_t)r * 64 + lane] = (bf16_t)(cvt_pk_bf16(o, 0.f) & 0xffffu);
                if (lane == 0) ((float*)(F.ws + WS_SSPEC))[r] = s[3 * i + 2]; }
        }
    }
    {
        const float* kvraw = (const float*)(F.ws + WS_KVRAW); const float* gx = F.in[I_GXK] + l * 256;
        for (int it = gw; it < N_MEM * 8; it += NGW) { const int t = it >> 3, hv = it & 7, isv = hv >> 2, h = hv & 3;
            const f32x4 v = *(const f32x4*)(kvraw + (size_t)t * 2048 + isv * 1024 + h * 256 + 4 * lane);
            f32x4 o = v;
            if (!isv) { const float ss = wave_sum((v[0] * v[0] + v[1] * v[1]) + (v[2] * v[2] + v[3] * v[3])); const float r = 1.0f / sqrtf(ss * (1.f / 256.f) + EPS);
                const f32x4 g = *(const f32x4*)(gx + 4 * lane); o = v * r * g; }
            float* op = F.out + (isv ? O_PMV : O_PMK) + (size_t)l * N_MEM * 1024 + (size_t)t * 1024 + h * 256 + 4 * lane;
            *(f32x4*)op = o;
            u32x2 w; w.x = cvt_pk_bf16(o[0], o[1]); w.y = cvt_pk_bf16(o[2], o[3]);
            *(u32x2*)((bf16_t*)(F.ws + (isv ? WS_MVB : WS_MKB)) + (size_t)t * 1024 + h * 256 + 4 * lane) = w;
        }
    }
}
__device__ __forceinline__ void phase_e(const Ctx& F, int l) {
    const int gw = F.bid * 8 + F.wave, NGW = F.G * 8, lane = F.lane;
    const float* ropetab = (const float*)(F.ws + WS_ROPE);
    const float* gq = F.in[I_GQN] + l * QK_HEAD; const float* gk = F.in[I_GKN] + l * QK_HEAD; const float* gxq = F.in[I_GXQ] + l * 256;
    const f32x4 gx4 = *(const f32x4*)(gxq + 4 * lane) * C_X;
    const bf16_t* qraw = (const bf16_t*)(F.ws + WS_QRAW); bf16_t* Q = (bf16_t*)(F.ws + WS_Q); bf16_t* xq = (bf16_t*)(F.ws + WS_XQ);
    {
        const size_t gt = (size_t)F.bid * 512 + F.tid, GT = (size_t)F.G * 512;
        const float* SSC = (const float*)(F.ws + WS_SSC); const float* SSPEC = (const float*)(F.ws + WS_SSPEC); float* RKC = (float*)(F.ws + WS_RKC);
        for (size_t i = gt; i < (size_t)16 * M; i += GT) { const f32x4 s4 = *(const f32x4*)(SSC + i * 4); const int row = (int)(i % M);
            RKC[i] = 1.0f / sqrtf(((s4[0] + s4[1]) + (s4[2] + s4[3]) + SSPEC[row]) * (1.f / 192.f) + EPS); }
        const float* SSP = (const float*)(F.ws + WS_SSP); const float* SSPEP = (const float*)(F.ws + WS_SSPEP); float* RKP = (float*)(F.ws + WS_RKP);
        for (size_t i4 = gt; i4 < (size_t)MPAST * 4; i4 += GT) { const size_t PL = (size_t)MPAST * 16, i = i4 * 4; const size_t bb = i >> 16, t = i & 4095;
            const f32x4 s = (*(const f32x4*)(SSP + i) + *(const f32x4*)(SSP + PL + i)) + (*(const f32x4*)(SSP + 2 * PL + i) + *(const f32x4*)(SSP + 3 * PL + i)) + *(const f32x4*)(SSPEP + bb * 4096 + t);
            f32x4 o; o[0] = 1.0f / sqrtf(s[0] * (1.f / 192.f) + EPS); o[1] = 1.0f / sqrtf(s[1] * (1.f / 192.f) + EPS); o[2] = 1.0f / sqrtf(s[2] * (1.f / 192.f) + EPS); o[3] = 1.0f / sqrtf(s[3] * (1.f / 192.f) + EPS);
            *(f32x4*)(RKP + i) = o; }
    }
    f32x4 gsc;
    { const int e0 = lane < 32 ? 4 * lane : 128 + 4 * (lane & 15);
      const f32x4 q4 = *(const f32x4*)(gq + e0); gsc = q4 * C_MLA; if (lane < 32) gsc = gsc * *(const f32x4*)(gk + e0); }
    for (int r = gw; r < M; r += NGW) {
        const int pos = r < M_P ? r : PAST + ((r - M_P) & 63);
        const float* ct = ropetab + ((size_t)pos * 32 + 4 * (lane & 7)) * 2;
        const f32x4 c01 = *(const f32x4*)ct, c23 = *(const f32x4*)(ct + 4);
        u32x2 xw[4];
#pragma unroll
        for (int h = 0; h < 4; ++h) xw[h] = ((const u32x2*)(xq + (size_t)r * 1024 + h * 256))[lane];
        for (int h0 = 0; h0 < NH; h0 += 8) {
            f32x4 v[8]; float ss[8];
#pragma unroll
            for (int j = 0; j < 8; ++j) { u32x2 w = {0u, 0u}; if (lane < 48) w = *(const u32x2*)(qraw + (size_t)r * 3072 + (h0 + j) * 192 + 4 * lane);
                v[j] = (f32x4){bf_lo(w.x), bf_hi(w.x), bf_lo(w.y), bf_hi(w.y)}; ss[j] = (v[j][0] * v[j][0] + v[j][1] * v[j][1]) + (v[j][2] * v[j][2] + v[j][3] * v[j][3]); }
#pragma unroll
            for (int o = 1; o < 64; o <<= 1)
#pragma unroll
                for (int j = 0; j < 8; ++j) ss[j] += __shfl_xor(ss[j], o);
#pragma unroll
            for (int j = 0; j < 8; ++j) { const float rq = 1.0f / sqrtf(ss[j] * (1.f / 192.f) + EPS);
                f32x4 x = v[j] * rq * gsc;
                f32x4 ot; ot[0] = __shfl_xor(x[0], 8); ot[1] = __shfl_xor(x[1], 8); ot[2] = __shfl_xor(x[2], 8); ot[3] = __shfl_xor(x[3], 8);
                if (lane >= 32) { const float sg = lane < 40 ? -1.f : 1.f;
                    x = (f32x4){x[0] * c01[0] + sg * ot[0] * c01[1], x[1] * c01[2] + sg * ot[1] * c01[3], x[2] * c23[0] + sg * ot[2] * c23[1], x[3] * c23[2] + sg * ot[3] * c23[3]}; }
                if (lane < 48) { u32x2 ow; ow.x = cvt_pk_bf16(x[0], x[1]); ow.y = cvt_pk_bf16(x[2], x[3]); *(u32x2*)(Q + ((size_t)r * NH + h0 + j) * 192 + 4 * lane) = ow; } }
        }
#pragma unroll
        for (int h = 0; h < 4; ++h) {
            const u32x2 w = xw[h]; u32x2* po = (u32x2*)((bf16_t*)(F.ws + WS_XQN) + (size_t)r * 1024 + h * 256) + lane;
            const f32x4 v = (f32x4){bf_lo(w.x), bf_hi(w.x), bf_lo(w.y), bf_hi(w.y)};
            const float ss = wave_sum((v[0] * v[0] + v[1] * v[1]) + (v[2] * v[2] + v[3] * v[3])); const float rr = 1.0f / sqrtf(ss * (1.f / 256.f) + EPS);
            const f32x4 o = v * rr * gx4; u32x2 ow; ow.x = cvt_pk_bf16(o[0], o[1]); ow.y = cvt_pk_bf16(o[2], o[3]); *po = ow;
        }
    }
}

constexpr int AP_KN = 0, AP_KPE = 16384, AP_V = 24576, AP_RK = 40960;
constexpr int AX_K = 0, AX_V = 32768, AX_AL = 49152;

__device__ __forceinline__ int swap23(int k) { return (k & ~0xC) | ((k & 4) << 1) | ((k & 8) >> 1); }
__device__ __forceinline__ int src_kn(int o) { const int row = o >> 8, colB = (o & 255) ^ ((row & 7) << 4); return row * 128 + (colB >> 1); }
__device__ __forceinline__ int src_kpe(int o) { const int row = o >> 7, colB = (o & 127) ^ ((row & 7) << 4); return row * 64 + (colB >> 1); }
__device__ __forceinline__ int src_v1024(int o) { const int sub = o >> 9, kk = (sub >> 2) * 8 + ((o & 511) >> 6), c = (sub & 3) * 32 + ((o & 63) >> 1); return swap23(kk) * 1024 + c; }
__device__ __forceinline__ int src_v(int o) { const int sub = o >> 9, kk = (sub >> 2) * 8 + ((o & 511) >> 6), c = (sub & 3) * 32 + ((o & 63) >> 1); return swap23(kk) * 128 + c; }

constexpr int AQ_KBUF = 24832, AQ_KPE = 16384, AQ_RK = 24576, AQ_V0 = 3 * AQ_KBUF, AQ_VBUF = 16384, AQ_AL = AQ_V0 + 4 * AQ_VBUF;
__device__ __forceinline__ void mla_prompt_unit(const Ctx& F, int h, int qb, float negB2) {
    int tid = F.tid; asm volatile("" : "+v"(tid)); const int wid = F.wave, lane = tid & 63, r32 = lane & 31, hi = lane >> 5;
    const bf16_t* Q = (const bf16_t*)(F.ws + WS_Q); const bf16_t* KC = (const bf16_t*)(F.ws + WS_KC) + (size_t)h * M * 128; const bf16_t* VC = (const bf16_t*)(F.ws + WS_VC) + (size_t)h * M * 128;
    const float* RK = (const float*)(F.ws + WS_RKC) + (size_t)h * M; const bf16_t* KPE = (const bf16_t*)(F.ws + WS_KPEC);
    const int row0 = qb * 256 + wid * 32;
    f32x16 o[4];
#pragma unroll
    for (int d = 0; d < 4; ++d)
#pragma unroll
        for (int r = 0; r < 16; ++r) o[d][r] = 0.f;
    float l_part = 0.f;
    const int nt_all = 4 * qb + 4, nt_w = 4 * qb + (wid >> 1) + 1;
    const bool late = false;
    LAS char* L = (LAS char*)F.lds; LAS float* al_l = (LAS float*)(L + AQ_AL) + wid * 32;
    const LAS char* vb0 = L + AQ_V0 + att::v_rd_base(lane);
    unsigned okn[2], ov[2];
#pragma unroll
    for (int i = 0; i < 2; ++i) { const int o16 = ((wid * 2 + i) * 64 + lane) * 16; okn[i] = (unsigned)src_kn(o16) * 2u; ov[i] = (unsigned)src_v(o16) * 2u; }
    const unsigned okp = (unsigned)src_kpe((wid * 64 + lane) * 16) * 2u, ork = (unsigned)lane * 4u;
#define MP_ISSUE(t) do { LAS char* Lk = L + ((t) % 3) * AQ_KBUF; LAS char* Lv = L + AQ_V0 + ((t) & 3) * AQ_VBUF; const size_t kb_ = (size_t)(t) * 64; \
        glds16s(KC + kb_ * 128, okn[0], Lk + (wid * 2) * 1024); glds16s(KC + kb_ * 128, okn[1], Lk + (wid * 2 + 1) * 1024); \
        glds16s(VC + kb_ * 128, ov[0], Lv + (wid * 2) * 1024); glds16s(VC + kb_ * 128, ov[1], Lv + (wid * 2 + 1) * 1024); \
        glds16s(KPE + kb_ * 64, okp, Lk + AQ_KPE + wid * 1024); \
        if (wid == 0) glds4s(RK + kb_, ork, Lk + AQ_RK); } while (0)
    __builtin_amdgcn_s_barrier();
    MP_ISSUE(0); MP_ISSUE(1);
    bf16x8 qr[12];
    { const bf16_t* qp = Q + ((size_t)(row0 + r32) * NH + h) * 192 + hi * 8;
#pragma unroll
      for (int d0 = 0; d0 < 12; ++d0) qr[d0] = *(const bf16x8*)(qp + d0 * 16);
#pragma unroll
      for (int d0 = 0; d0 < 12; ++d0) asm volatile("" :: "v"(qr[d0])); }
    bf16x8 pa[4] = {};
    for (int t = 0; t < nt_all; ++t) {
        if (t + 1 < nt_all) { if (wid == 0) asm volatile("s_waitcnt vmcnt(6)" ::: "memory"); else asm volatile("s_waitcnt vmcnt(5)" ::: "memory"); }
        else asm volatile("s_waitcnt vmcnt(0)" ::: "memory");
        __builtin_amdgcn_s_barrier();
        asm volatile("" ::: "memory");
        if (t + 2 < nt_all) MP_ISSUE(t + 2);
        if (late && t >= 1 && t - 1 < nt_w) att::pv_fs<4, 2>(o, vb0 + ((t - 1) & 3) * AQ_VBUF, pa);
        if (t < nt_w) {
            const LAS char* Lk = L + (t % 3) * AQ_KBUF;
            att::qk_sm<8, 4, 2, 256>(qr, l_part, Lk, Lk + AQ_KPE, (const LAS float*)(Lk + AQ_RK), negB2, r32, hi, pa);
#ifdef PROBE_QK2
            { bf16x8 pa2[4]; float l2 = 0.f; int r32b = r32; asm volatile("" : "+v"(r32b)); att::qk_sm<8, 4, 2, 256>(qr, l2, Lk, Lk + AQ_KPE, (const LAS float*)(Lk + AQ_RK), negB2, r32b, hi, pa2);
              asm volatile("" :: "v"(pa2[0]), "v"(pa2[1]), "v"(pa2[2]), "v"(pa2[3]), "v"(l2)); }
#endif
#ifdef PROBE_PV2
            { f32x16 o2[4];
#pragma unroll
              for (int d = 0; d < 4; ++d)
#pragma unroll
                  for (int r = 0; r < 16; ++r) o2[d][r] = 0.f;
              att::pv_fs<4, 2>(o2, vb0 + (t & 3) * AQ_VBUF, pa);
              asm volatile("" :: "v"(o2[0]), "v"(o2[1]), "v"(o2[2]), "v"(o2[3])); }
#endif
            if (!late) att::pv_fs<4, 2>(o, vb0 + (t & 3) * AQ_VBUF, pa);
        }
    }
    if (late && nt_all - 1 < nt_w) att::pv_fs<4, 2>(o, vb0 + ((nt_all - 1) & 3) * AQ_VBUF, pa);
#undef MP_ISSUE
    att::finish<4>(o, att::lane_pair_sum(l_part), al_l, (bf16_t*)(F.ws + WS_AMLA) + (size_t)row0 * 2048 + h * 128, (const bf16_t*)(F.ws + WS_ZM) + (size_t)row0 * 2048 + h * 128, 2048, r32, hi);
}
constexpr int AC_KN = 0, AC_KPE = 8192, AC_CN = 10240, AC_RK = 26624, AC_BUF = 26752, AC_NB = 6, AC_AL = AC_NB * AC_BUF;
static_assert(AC_AL + 1024 <= SCRATCH_TOP, "sample attention ring + row-sum scratch inside the phase scratch");
__device__ __forceinline__ int src_cn(int o) { const int sub = o >> 9, kk = (sub >> 4) * 8 + ((o & 511) >> 6), c = (sub & 15) * 32 + ((o & 63) >> 1); return swap23(kk) * 512 + c; }
#ifndef PROBE_HOT
#define PROBE_HOT 0
#endif
__device__ __forceinline__ void mla_sample_unit(const Ctx& F, int b, int hp, float negB2, bool rep2 = false) {
    int tid = F.tid; asm volatile("" : "+v"(tid)); const int wid = F.wave, lane = tid & 63, r32 = lane & 31, hi = lane >> 5;
    const int g = wid >> 2, rg = (wid >> 1) & 1, lh = wid & 1, h = hp * 2 + g;
    const bf16_t* Q = (const bf16_t*)(F.ws + WS_Q);
    const int row0 = M_P + b * 64 + rg * 32;
    f32x16 o[8];
#pragma unroll
    for (int d = 0; d < 8; ++d)
#pragma unroll
        for (int r = 0; r < 16; ++r) o[d][r] = 0.f;
    float l_part = 0.f;
    constexpr int SC_CS = 16384, SC_NC = 5, SC_K0 = SC_CS * SC_NC, SC_KS = 10368, SC_NK = 6, SK_KPE = 8192, SK_RK = 10240, SC_P0 = SC_K0 + SC_KS * SC_NK, SC_AL = SC_P0 + 4 * 2048;
    static_assert(SC_AL + 1024 <= SCRATCH_TOP && SC_AL >= 131072, "sample attention LDS map");
    LAS char* L = (LAS char*)F.lds; LAS float* al_l = (LAS float*)(L + SC_AL) + wid * 32; LAS float* al_p = (LAS float*)(L + SC_AL) + (wid ^ 1) * 32;
    LAS char* Pb = L + SC_P0 + (wid >> 1) * 2048 + lane * 32;
    const int dg = wid >> 2, dh = hp * 2 + dg;
    const bf16_t* KPt = (const bf16_t*)(F.ws + WS_KP); const bf16_t* KCh = (const bf16_t*)(F.ws + WS_KC) + ((size_t)dh * M + M_P + b * 64) * 128;
    const bf16_t* CNP = (const bf16_t*)(F.ws + WS_CNP) + (size_t)b * 4096 * 512; const bf16_t* CNC = (const bf16_t*)(F.ws + WS_CKVN) + (size_t)(M_P + b * 64) * 512;
    const bf16_t* KPEP = (const bf16_t*)(F.ws + WS_KPEP) + (size_t)b * 4096 * 64; const bf16_t* KPEC = (const bf16_t*)(F.ws + WS_KPEC) + (size_t)(M_P + b * 64) * 64;
    const float* RKPb = (const float*)(F.ws + WS_RKP) + (size_t)(b * 16 + hp * 2) * 4096; const float* RKCb = (const float*)(F.ws + WS_RKC) + (size_t)(hp * 2) * M + M_P + b * 64;
    constexpr int NT = 260, NS = NT / 2;
    unsigned voffKp, voffKc, voffC0, voffC1, voffX;
    { const int o16 = ((wid & 3) * 64 + lane) * 16, r = o16 >> 8, cB = (o16 & 255) ^ ((r & 7) << 4), cc = cB >> 4;
      voffKp = (unsigned)((((dg * 4 + (cc >> 2)) * 64) + (cc & 3) * 16 + r) * 8) * 2u; voffKc = (unsigned)(r * 128 + (cB >> 1)) * 2u;
      voffC0 = (unsigned)src_cn(((wid * 2) * 64 + lane) * 16) * 2u; voffC1 = (unsigned)src_cn(((wid * 2 + 1) * 64 + lane) * 16) * 2u;
      voffX = wid < 2 ? (unsigned)src_kpe(((wid & 1) * 64 + lane) * 16) * 2u : (unsigned)((((lane >> 4) & 1) * 4096 + (lane & 15)) * 4); }
#define MS_ISSUE_C(tt) do { const int t_ = (tt) < NT ? (tt) : NT - 1; LAS char* Lc = L + ((tt) % SC_NC) * SC_CS; \
        if (t_ < 256) { const bf16_t* cs_ = CNP + (size_t)t_ * 16 * 512; glds16s(cs_, voffC0, Lc + (wid * 2) * 1024); glds16s(cs_, voffC1, Lc + (wid * 2 + 1) * 1024); } \
        else { const bf16_t* cs_ = CNC + (size_t)(t_ - 256) * 16 * 512; glds16s(cs_, voffC0, Lc + (wid * 2) * 1024); glds16s(cs_, voffC1, Lc + (wid * 2 + 1) * 1024); } } while (0)
#define MS_ISSUE_K(tt) do { const int t_ = (tt) < NT ? (tt) : NT - 1; LAS char* Lk = L + SC_K0 + ((tt) % SC_NK) * SC_KS; \
        if (t_ < 256) { const size_t kb_ = (size_t)t_ * 16, grow = (size_t)b * 4096 + kb_; const size_t blk = ((((grow >> 8) * 8 + hp) * 2 + ((grow >> 7) & 1)) * 2 + ((grow >> 6) & 1)) * 4 + ((grow >> 4) & 3); \
            glds16s(KPt + blk * 4096, voffKp, Lk + wid * 1024); \
            if (wid < 2) glds16s(KPEP + kb_ * 64, voffX, Lk + SK_KPE + wid * 1024); \
            if (wid == 2) { if (lane < 32) glds4s(RKPb + kb_, voffX, Lk + SK_RK); } } \
        else { const size_t kb_ = (size_t)(t_ - 256) * 16; \
            glds16s(KCh + kb_ * 128, voffKc, Lk + wid * 1024); \
            if (wid < 2) glds16s(KPEC + kb_ * 64, voffX, Lk + SK_KPE + wid * 1024); \
            if (wid == 2) { if (lane < 32) glds4s(RKCb + kb_, (unsigned)((((lane >> 4) & 1) * M + (lane & 15)) * 4), Lk + SK_RK); } } } while (0)
    __builtin_amdgcn_s_barrier();
    MS_ISSUE_K(0); MS_ISSUE_K(1); MS_ISSUE_K(2); MS_ISSUE_K(3); MS_ISSUE_C(0);
    bf16x8 qr[12];
    { const bf16_t* qp = Q + ((size_t)(row0 + r32) * NH + h) * 192 + hi * 8;
#pragma unroll
      for (int d0 = 0; d0 < 12; ++d0) qr[d0] = *(const bf16x8*)(qp + d0 * 16);
#pragma unroll
      for (int d0 = 0; d0 < 12; ++d0) asm volatile("" :: "v"(qr[d0])); }
    const int vrb = lh * 8 * 512 + att::v_rd_base(lane);
    bf16x8 pk[2] = {};
    for (int s = -1; s < NS; ++s) {
        if (s < 0) asm volatile("s_waitcnt vmcnt(0)" ::: "memory"); else if (wid < 3) asm volatile("s_waitcnt vmcnt(6)" ::: "memory"); else asm volatile("s_waitcnt vmcnt(4)" ::: "memory");
        __builtin_amdgcn_s_barrier();
        asm volatile("" ::: "memory");
        const bool mine = (lh == ((s + g) & 1));
        if (!mine && s >= 0) { pk[0] = *(const LAS bf16x8*)Pb; pk[1] = *(const LAS bf16x8*)(Pb + 16); }
        MS_ISSUE_C(2 * s + 3); MS_ISSUE_C(2 * s + 4); MS_ISSUE_K(2 * s + 6); MS_ISSUE_K(2 * s + 7);
        if (s >= 0) {
            asm volatile("" : "+v"(pk[0]), "+v"(pk[1]));
            const int vA = (int)(uintptr_t)(L + ((2 * s) % SC_NC) * SC_CS + vrb), vB = (int)(uintptr_t)(L + ((2 * s + 1) % SC_NC) * SC_CS + vrb);
            s16x4 lo[4], hh[4];
#define MS_TR(i) do { asm volatile("ds_read_b64_tr_b16 %0, %1 offset:%c2" : "=&v"(lo[(i) & 3]) : "v"((i) < 8 ? vA : vB), "i"(((i) & 7) * 512) : "memory"); \
                      asm volatile("ds_read_b64_tr_b16 %0, %1 offset:%c2" : "=&v"(hh[(i) & 3]) : "v"((i) < 8 ? vA : vB), "i"(((i) & 7) * 512 + 16 * 512) : "memory"); } while (0)
            __builtin_amdgcn_sched_barrier(0);
            MS_TR(0); MS_TR(1); MS_TR(2);
            __builtin_amdgcn_s_setprio(1);
#pragma unroll
            for (int i = 0; i < 16; ++i) {
                if (i + 3 < 16) { MS_TR(i + 3); asm volatile("s_waitcnt lgkmcnt(6)" ::: "memory"); }
                else if (i + 2 < 16) asm volatile("s_waitcnt lgkmcnt(4)" ::: "memory");
                else if (i + 1 < 16) asm volatile("s_waitcnt lgkmcnt(2)" ::: "memory");
                else asm volatile("s_waitcnt lgkmcnt(0)" ::: "memory");
                __builtin_amdgcn_sched_barrier(0);
                { const s16x4 l_ = lo[i & 3], h_ = hh[i & 3]; const bf16x8 vf = (bf16x8){l_[0], l_[1], l_[2], l_[3], h_[0], h_[1], h_[2], h_[3]};
                  o[i & 7] = __builtin_amdgcn_mfma_f32_32x32x16_bf16(pk[i >> 3], vf, o[i & 7], 0, 0, 0); }
                __builtin_amdgcn_sched_barrier(0);
            }
            __builtin_amdgcn_s_setprio(0);
#undef MS_TR
        }
        if (!mine && s + 1 < NS) {
            const LAS char* KA = L + SC_K0 + ((2 * s + 2) % SC_NK) * SC_KS; const LAS char* KB = L + SC_K0 + ((2 * s + 3) % SC_NK) * SC_KS;
            const LAS char* Lm = r32 < 16 ? KA : KB;
            const LAS char* Ks = Lm + g * 4096; const LAS char* Kp = Lm + SK_KPE; const int kr = r32 & 15;
            f32x16 p;
#pragma unroll
            for (int r = 0; r < 16; ++r) p[r] = 0.f;
            auto kfrag = [&](int d) -> bf16x8 { return d < 8 ? *(const LAS bf16x8*)(Ks + att::kswz<256>(kr, (d * 16 + hi * 8) * 2)) : *(const LAS bf16x8*)(Kp + att::kswz<128>(kr, ((d - 8) * 16 + hi * 8) * 2)); };
            bf16x8 kf[3];
            kf[0] = kfrag(0); kf[1] = kfrag(1);
            __builtin_amdgcn_s_setprio(1);
#pragma unroll
            for (int d0 = 0; d0 < 12; ++d0) {
                if (d0 + 2 < 12) kf[(d0 + 2) % 3] = kfrag(d0 + 2);
                p = __builtin_amdgcn_mfma_f32_32x32x16_bf16(kf[d0 % 3], qr[d0], p, 0, 0, 0);
            }
            __builtin_amdgcn_s_setprio(0);
            float ps = 0.f;
#pragma unroll
            for (int hf2 = 0; hf2 < 2; ++hf2) {
                f32x4 sc[2];
#pragma unroll
                for (int i2 = 0; i2 < 2; ++i2) { const LAS float* rk = (const LAS float*)((hf2 == 0 ? KA : KB) + SK_RK) + g * 16; sc[i2] = *(const LAS f32x4*)(rk + 8 * i2 + 4 * hi); }
#pragma unroll
                for (int i2 = 0; i2 < 2; ++i2)
#pragma unroll
                    for (int j = 0; j < 4; ++j) { const int i = hf2 * 2 + i2; const float e = __builtin_amdgcn_exp2f(fmaf(p[4 * i + j], sc[i2][j], negB2)); p[4 * i + j] = e; ps += e; }
                asm volatile("" ::: "memory");
            }
            l_part += ps;
#pragma unroll
            for (int hf = 0; hf < 2; ++hf) { const int B = hf * 8;
                const unsigned a0 = cvt_pk_bf16(p[B + 0], p[B + 1]), a1 = cvt_pk_bf16(p[B + 2], p[B + 3]), b0 = cvt_pk_bf16(p[B + 4], p[B + 5]), b1 = cvt_pk_bf16(p[B + 6], p[B + 7]);
                auto r0 = __builtin_amdgcn_permlane32_swap(a0, b0, false, false); auto r1 = __builtin_amdgcn_permlane32_swap(a1, b1, false, false);
                u32x4 w = {r0[0], r1[0], r0[1], r1[1]}; pk[hf] = __builtin_bit_cast(bf16x8, w); }
            *(LAS bf16x8*)Pb = pk[0]; *(LAS bf16x8*)(Pb + 16) = pk[1];
            LDS_WAIT();
        }
    }
#undef MS_ISSUE_C
#undef MS_ISSUE_K
    asm volatile("s_waitcnt vmcnt(0)" ::: "memory");
    const float lsum = att::lane_pair_sum(l_part);
    if (hi == 0) al_l[r32] = lsum;
    LDS_WAIT();
    __builtin_amdgcn_s_barrier();
    asm volatile("" ::: "memory");
    {
        const bool oddl = r32 & 1;
#pragma unroll
        for (int r = 0; r < 16; r += 2) { const int q = att::crow(r, hi); const float rl0 = __builtin_amdgcn_rcpf(al_l[q] + al_p[q]), rl1 = __builtin_amdgcn_rcpf(al_l[q + 1] + al_p[q + 1]);
            const int qrow = rg * 32 + q + (oddl ? 1 : 0);
#pragma unroll
            for (int d0 = 0; d0 < 8; ++d0) { const float va = o[d0][r] * rl0, vb2 = o[d0][r + 1] * rl1; const float recv = __shfl_xor(oddl ? va : vb2, 1);
                const int colB = ((lh * 8 + d0) * 32 + (r32 & ~1)) * 2;
                *(LAS unsigned*)(L + g * 65536 + att::kswz<1024>(qrow, colB)) = oddl ? cvt_pk_bf16(recv, vb2) : cvt_pk_bf16(va, recv); } }
    }
    LDS_WAIT();
    __builtin_amdgcn_s_barrier();
    asm volatile("" ::: "memory");
    {
        const int g2 = wid >> 2, rg2 = (wid >> 1) & 1, dvh = wid & 1, h2 = hp * 2 + g2;
        const bf16_t* Wuv = (const bf16_t*)(F.ws + WS_WUKV) + ((size_t)(h2 * 256 + 128 + dvh * 64 + r32)) * 512 + hi * 8;
        const int orow0 = M_P + b * 64 + rg2 * 32;
        bf16_t* out = (bf16_t*)(F.ws + ((PROBE_HOT != 0 && rep2) ? WS_VP : WS_AMLA)) + (size_t)orow0 * 2048 + h2 * 128 + dvh * 64; const bf16_t* z = (const bf16_t*)(F.ws + WS_ZM) + (size_t)orow0 * 2048 + h2 * 128 + dvh * 64;
        const bool odd = r32 & 1;
        unsigned zw[2][8];
#pragma unroll
        for (int k2 = 0; k2 < 2; ++k2)
#pragma unroll
            for (int r = 0; r < 16; r += 2) zw[k2][r >> 1] = *(const unsigned*)(z + (size_t)(att::crow(r, hi) + (odd ? 1 : 0)) * 2048 + k2 * 32 + (r32 & ~1));
        f32x16 acc[2];
#pragma unroll
        for (int k2 = 0; k2 < 2; ++k2)
#pragma unroll
            for (int r = 0; r < 16; ++r) acc[k2][r] = 0.f;
#pragma unroll 16
        for (int ks = 0; ks < 32; ++ks) {
            const bf16x8 a = *(const LAS bf16x8*)(L + g2 * 65536 + att::kswz<1024>(rg2 * 32 + r32, (ks * 16 + hi * 8) * 2));
            const bf16x8 bw0 = *(const bf16x8*)(Wuv + ks * 16), bw1 = *(const bf16x8*)(Wuv + (size_t)32 * 512 + ks * 16);
            acc[0] = __builtin_amdgcn_mfma_f32_32x32x16_bf16(a, bw0, acc[0], 0, 0, 0); acc[1] = __builtin_amdgcn_mfma_f32_32x32x16_bf16(a, bw1, acc[1], 0, 0, 0);
        }
#pragma unroll
        for (int k2 = 0; k2 < 2; ++k2)
#pragma unroll
            for (int r = 0; r < 16; r += 2) { const float va = acc[k2][r], vb2 = acc[k2][r + 1];
                const float recv = __shfl_xor(odd ? va : vb2, 1); const float v0 = odd ? recv : va, v1 = odd ? vb2 : recv; const unsigned w = zw[k2][r >> 1];
                *(unsigned*)(out + (size_t)(att::crow(r, hi) + (odd ? 1 : 0)) * 2048 + k2 * 32 + (r32 & ~1)) = cvt_pk_bf16(v0 * bf_lo(w), v1 * bf_hi(w)); }
    }
    __builtin_amdgcn_s_barrier();
}
template <bool SAMPLE>
__device__ __forceinline__ void cross_unit(const Ctx& F, int l, int x, int h, int dvh) {
    int tid = F.tid; asm volatile("" : "+v"(tid)); const int wid = F.wave, lane = tid & 63, r32 = lane & 31, hi = lane >> 5;
    if (SAMPLE) {
        LAS char* L = (LAS char*)F.lds; constexpr int XB = 49152; LAS float* al_l = (LAS float*)(L + 2 * XB) + wid * 32;
        const float* kf = F.in[I_CMK] + ((size_t)l * NSTREAM + x) * N_MEM * 1024 + h * 256; const float* vf = F.in[I_CMV] + ((size_t)l * NSTREAM + x) * N_MEM * 1024 + h * 256 + dvh * 128;
        __syncthreads();
        if (wid < 2) {
            const int row0 = M_P + x * 64 + wid * 32;
            bf16x8 qr[16];
            { const bf16_t* qp = (const bf16_t*)(F.ws + WS_XQN) + (size_t)(row0 + r32) * 1024 + h * 256 + hi * 8;
#pragma unroll
              for (int d0 = 0; d0 < 16; ++d0) qr[d0] = *(const bf16x8*)(qp + d0 * 16); }
            f32x16 o[4];
#pragma unroll
            for (int d = 0; d < 4; ++d)
#pragma unroll
                for (int r = 0; r < 16; ++r) o[d][r] = 0.f;
            float m_reg = -1e30f, l_reg = 0.f;
            const int vb = (int)(uintptr_t)(L + AX_V) + att::v_rd_base(lane);
            for (int t = 0; t < 4; ++t) {
                __builtin_amdgcn_s_barrier();
                asm volatile("" ::: "memory");
                att::tile_step<16, 0, 4, 2, false, 512>(qr, o, m_reg, l_reg, L + (t & 1) * XB + AX_K, L + (t & 1) * XB + AX_K, vb + (t & 1) * XB, (const LAS float*)nullptr, al_l, r32, hi);
            }
            att::finish<4>(o, l_reg, al_l, (bf16_t*)(F.ws + WS_AX) + (size_t)row0 * 1024 + h * 256 + dvh * 128, (const bf16_t*)(F.ws + WS_ZX) + (size_t)row0 * 1024 + h * 256 + dvh * 128, 1024, r32, hi);
        } else {
            const int lt = tid - 128;
            f32x4 ra[8][2], rb[8][2];
#define XS_LOAD(t, R) do { _Pragma("unroll") for (int i = 0; i < 8; ++i) { const int c = lt + 384 * i; const bool isk = c < 2048; const int cv = c - 2048; \
                const float* sp = isk ? kf + (size_t)((t) * 64 + (c >> 5)) * 1024 + (c & 31) * 8 : vf + (size_t)((t) * 64 + (cv >> 4)) * 1024 + (cv & 15) * 8; \
                R[i][0] = *(const f32x4*)sp; R[i][1] = *(const f32x4*)(sp + 4); } } while (0)
#define XS_STORE(t, R) do { LAS char* Lb = L + ((t) & 1) * XB; _Pragma("unroll") for (int i = 0; i < 8; ++i) { const int c = lt + 384 * i; const bool isk = c < 2048; const int cv = c - 2048; \
                const int dst = isk ? AX_K + att::kswz<512>(c >> 5, (c & 31) * 16) : AX_V + att::v_st<4>(cv >> 4, (cv & 15) * 8); \
                *(LAS u32x4*)(Lb + dst) = pack8(R[i][0], R[i][1]); } \
                LDS_WAIT(); __builtin_amdgcn_s_barrier(); asm volatile("" ::: "memory"); } while (0)
            XS_LOAD(0, ra);
            XS_LOAD(1, rb); XS_STORE(0, ra);
            XS_LOAD(2, ra); XS_STORE(1, rb);
            XS_LOAD(3, rb); XS_STORE(2, ra);
            XS_STORE(3, rb);
#undef XS_LOAD
#undef XS_STORE
        }
        return;
    }
    const int row0 = x * 256 + wid * 32;
    bf16x8 qr[16];
    { const bf16_t* qp = (const bf16_t*)(F.ws + WS_XQN) + (size_t)(row0 + r32) * 1024 + h * 256 + hi * 8;
#pragma unroll
      for (int d0 = 0; d0 < 16; ++d0) qr[d0] = *(const bf16x8*)(qp + d0 * 16);
#pragma unroll
      for (int d0 = 0; d0 < 16; ++d0) asm volatile("" :: "v"(qr[d0])); }
    f32x16 o[4];
#pragma unroll
    for (int d = 0; d < 4; ++d)
#pragma unroll
        for (int r = 0; r < 16; ++r) o[d][r] = 0.f;
    float m_reg = -1e30f, l_reg = 0.f;
    constexpr int XB = 49152;
    LAS char* L = (LAS char*)F.lds; LAS float* al_l = (LAS float*)(L + 3 * XB) + wid * 32;
    const int vb = (int)(uintptr_t)(L + AX_V) + att::v_rd_base(lane);
    const bf16_t* kb = (const bf16_t*)(F.ws + WS_MKB) + h * 256; const bf16_t* vbf = (const bf16_t*)(F.ws + WS_MVB) + h * 256 + dvh * 128;
#define XP_ISSUE(t) do { LAS char* Lb = L + ((t) % 3) * XB; const bf16_t* ks_ = kb + (size_t)(t) * 64 * 1024; const bf16_t* vs_ = vbf + (size_t)(t) * 64 * 1024; int ln_ = lane; asm volatile("" : "+v"(ln_)); \
        _Pragma("unroll") for (int j = 0; j < 4; ++j) { const int o16 = ((wid * 4 + j) * 64 + ln_) * 16, row = o16 >> 9, colB = (o16 & 511) ^ ((row & 7) << 4); glds16s(ks_, (unsigned)(row * 1024 + (colB >> 1)) * 2u, Lb + AX_K + (wid * 4 + j) * 1024); } \
        _Pragma("unroll") for (int j = 0; j < 2; ++j) glds16s(vs_, (unsigned)src_v1024(((wid * 2 + j) * 64 + ln_) * 16) * 2u, Lb + AX_V + (wid * 2 + j) * 1024); } while (0)
    __syncthreads();
    XP_ISSUE(0); XP_ISSUE(1); XP_ISSUE(2);
#pragma unroll 1
    for (int t = 0; t < 4; ++t) {
        if (t == 0) asm volatile("s_waitcnt vmcnt(12)" ::: "memory"); else if (t < 3) asm volatile("s_waitcnt vmcnt(6)" ::: "memory"); else asm volatile("s_waitcnt vmcnt(0)" ::: "memory");
        __builtin_amdgcn_s_barrier();
        asm volatile("" ::: "memory");
        if (t == 1) XP_ISSUE(3);
        att::tile_step<16, 0, 4, 2, false, 512, 2>(qr, o, m_reg, l_reg, L + (t % 3) * XB + AX_K, L + (t % 3) * XB + AX_K, vb + (t % 3) * XB, (const LAS float*)nullptr, al_l, r32, hi);
    }
#undef XP_ISSUE
    att::finish<4>(o, l_reg, al_l, (bf16_t*)(F.ws + WS_AX) + (size_t)row0 * 1024 + h * 256 + dvh * 128, (const bf16_t*)(F.ws + WS_ZX) + (size_t)row0 * 1024 + h * 256 + dvh * 128, 1024, r32, hi);
}
#ifndef ATT_ONLY
#define ATT_ONLY -1
#endif
#define ATT_ON(k) (ATT_ONLY < 0 || ATT_ONLY == (k))
constexpr int QN = 160;
__device__ __forceinline__ void phase_attention(const Ctx& F, int l, int rep) {
    (void)rep;
    unsigned* heads = (unsigned*)(F.ws + WS_CTL) + CW_QHEAD + 64 * 8 * l + 64 * 16 * rep;
    volatile LAS unsigned* slot = (volatile LAS unsigned*)(F.lds + MISC_OFF);
    float negB2;
    { const float* gq = F.in[I_GQN] + l * QK_HEAD; const float* gk = F.in[I_GKN] + l * QK_HEAD; const int ln = F.lane;
      float m1 = fmaxf(fabsf(gq[ln] * gk[ln]), fabsf(gq[64 + ln] * gk[64 + ln])), mq = fabsf(gq[128 + ln]), mk = fabsf(gk[128 + ln]);
#pragma unroll
      for (int o = 1; o < 64; o <<= 1) { m1 = fmaxf(m1, __shfl_xor(m1, o)); mq = fmaxf(mq, __shfl_xor(mq, o)); mk = fmaxf(mk, __shfl_xor(mk, o)); }
      negB2 = -(19.99f * 1.01f * fmaxf(m1, mq * mk) + 0.1f); }
    const int x0 = (int)(xb_xcc_id() & 7u);
    for (int step = 0; step < 8; ++step) {
        const int x = (x0 + step) & 7;
        for (;;) {
            if (F.tid == 0) slot[0] = __hip_atomic_fetch_add(heads + 64 * x, 1u, __ATOMIC_RELAXED, __HIP_MEMORY_SCOPE_AGENT);
            __syncthreads();
            int u = __builtin_amdgcn_readfirstlane((int)slot[0]);
            __syncthreads();
#ifdef QREP_TYPE
            if (u >= 2 * QN) break;
            bool rep2 = false;
            if (u >= QN) { u -= QN; rep2 = true; const int ty = u < 96 ? (u < 32 ? 0 : 1) : (u < 128 ? 2 : 3); if (QREP_TYPE != 9 && ty != QREP_TYPE) continue; }
#else
            const bool rep2 = false;
            if (u >= QN) break;
#endif
            if (u < 96) {
                if (u < 32) {
#if ATT_ON(0)
                    mla_sample_unit(F, 4 * x + (u >> 3), u & 7, negB2, rep2);
#endif
                } else {
#if ATT_ON(1)
                    const int j = u - 32; mla_prompt_unit(F, 2 * x + (j & 1), 31 - (j >> 1), negB2);
#endif
                }
            } else if (u < 128) {
#if ATT_ON(2)
                const int v = x * 32 + (u - 96); cross_unit<false>(F, l, v >> 3, (v >> 1) & 3, v & 1);
#endif
            } else {
#if ATT_ON(3)
                const int v = x * 32 + (u - 128); cross_unit<true>(F, l, v >> 3, (v >> 1) & 3, v & 1);
#endif
            }
        }
    }
}
#define rot(off) ((int)((F.bid + G - ((off) % G)) % G))
__device__ __forceinline__ void phase_b(const Ctx& F, int l) {
    const int G = F.G; (void)G;
            {
                pg8::Gemm g{(const bf16_t*)(F.ws + WS_HB), (const bf16_t*)(F.ws + WS_WIN), 2048, 2048, 2048};
                pg8::StaticOrder S; S.init(M, IN_PAD, G, rot(0));
                EpiWin E{F.ws, F.out, F.in[I_BMERGE] + (size_t)l * 6144, l};
                pg8::gemm_phase(F.lds, g, S, E);
            }
#ifdef DUP_B1
            {
                pg8::Gemm g{(const bf16_t*)(F.ws + WS_HB), (const bf16_t*)(F.ws + WS_WIN), 2048, 2048, 2048};
                pg8::StaticOrder S; S.init(M, IN_PAD, G, rot(0));
                EpiWin E{F.ws, F.out, F.in[I_BMERGE] + (size_t)l * 6144, l};
                pg8::gemm_phase(F.lds, g, S, E);
            }
#endif
#ifdef DUP_B1N
            {
                pg8::Gemm g{(const bf16_t*)(F.ws + WS_HB), (const bf16_t*)(F.ws + WS_WIN), 2048, 2048, 2048};
                pg8::StaticOrder S; S.init(M, IN_PAD, G, rot(0));
                EpiNone E{};
                pg8::gemm_phase(F.lds, g, S, E);
            }
#endif
            {
                pg8::Gemm g{(const bf16_t*)(F.ws + WS_MEMN), (const bf16_t*)(F.ws + WS_WMEM), 2048, 2048, 2048};
                pg8::StaticOrder S; S.init(N_MEM, 2048, G, rot(232));
                EpiF32 E{(float*)(F.ws + WS_KVRAW), 2048};
                pg8::gemm_phase(F.lds, g, S, E);
            }
            {
                pg8::Gemm g{(const bf16_t*)(F.ws + WS_CNP), (const bf16_t*)(F.ws + WS_WUK), 512, 512, 512};
                pg8::StaticOrder S; S.init(MPAST, 2048, G, rot(240));
                EpiK<> E{(bf16_t*)(F.ws + WS_KP), (float*)(F.ws + WS_SSP)};
                pg8::gemm_phase(F.lds, g, S, E);
            }
#ifdef DUP_B3
            {
                pg8::Gemm g{(const bf16_t*)(F.ws + WS_CNP), (const bf16_t*)(F.ws + WS_WUK), 512, 512, 512};
                pg8::StaticOrder S; S.init(MPAST, 2048, G, rot(240));
                EpiK<> E{(bf16_t*)(F.ws + WS_KP), (float*)(F.ws + WS_SSP)};
                pg8::gemm_phase(F.lds, g, S, E);
            }
#endif
#ifdef DUP_B3N
            {
                pg8::Gemm g{(const bf16_t*)(F.ws + WS_CNP), (const bf16_t*)(F.ws + WS_WUK), 512, 512, 512};
                pg8::StaticOrder S; S.init(MPAST, 2048, G, rot(240));
#ifndef DUP_B3N_K
#define DUP_B3N_K false
#endif
#ifndef DUP_B3N_S
#define DUP_B3N_S false
#endif
#ifndef DUP_B3N_T
#define DUP_B3N_T false
#endif
                EpiK<DUP_B3N_K, DUP_B3N_S, DUP_B3N_T> E{(bf16_t*)(F.ws + WS_VP), (float*)(F.ws + WS_VP) + (size_t)64 * 1024 * 1024};
                pg8::gemm_phase(F.lds, g, S, E);
            }
#endif
            past_kpe(F, l);
#ifdef DUP_B4
            past_kpe(F, l);
#endif
}
__device__ __forceinline__ void phase_d(const Ctx& F, int l) {
    const int G = F.G; (void)G;
            {
                pg8::Gemm g{(const bf16_t*)(F.ws + WS_QLATN), (const bf16_t*)(F.ws + WS_WUQ), 512, 512, 512};
                pg8::StaticOrder S; S.init(M, 3072, G, rot(0));
                EpiBf16 E{(bf16_t*)(F.ws + WS_QRAW), 3072};
                pg8::gemm_phase(F.lds, g, S, E);
            }
            {
                pg8::Gemm g{(const bf16_t*)(F.ws + WS_CKVN), (const bf16_t*)(F.ws + WS_WUKV), 512, 512, 512};
                pg8::StaticOrder S; S.init(M, 4096, G, rot(224));
                EpiKV<false> E{(bf16_t*)(F.ws + WS_KC), (bf16_t*)(F.ws + WS_VC), (float*)(F.ws + WS_SSC)};
                pg8::gemm_phase(F.lds, g, S, E);
            }
            {
                pg8::Gemm g{(const bf16_t*)(F.ws + WS_CV), (const bf16_t*)(F.ws + WS_WPW2), 1024, 1024, 1024};
                pg8::StaticOrder S; S.init(M, 1024, G, rot(96));
                EpiPw2 E{(bf16_t*)(F.ws + WS_ACONV), (const bf16_t*)(F.ws + WS_ZC), F.in[I_BPW2] + (size_t)l * 1024};
                pg8::gemm_phase(F.lds, g, S, E);
            }
}
__device__ __forceinline__ void phase_g(const Ctx& F, int l) {
    const int G = F.G; (void)G;
    const bool bal = (G == 256); const int cls = F.bid >> 6, j = F.bid & 63;
            {
                pg8::Gemm g{(const bf16_t*)(F.ws + WS_AMLA), (const bf16_t*)(F.ws + WS_WPM), 2048, 2048, 2048};
                EpiGate E{(bf16_t*)(F.ws + WS_PB), (const bf16_t*)(F.ws + WS_GATES), 0};
                pg8::ListOrder S; if (bal) S.init(M, 2048, (cls == 0 ? 0 : (cls == 1 ? 128 : 256)) + j, cls < 2 ? 2 : (cls == 2 ? 1 : 0), 64); else S.init(M, 2048, rot(0), (320 - rot(0) + G - 1) / G, G);
                pg8::gemm_phase(F.lds, g, S, E);
            }
            {
                pg8::Gemm g{(const bf16_t*)(F.ws + WS_ACONV), (const bf16_t*)(F.ws + WS_WPC), 1024, 1024, 1024};
                EpiGate E{(bf16_t*)(F.ws + WS_PB) + (size_t)M * 2048, (const bf16_t*)(F.ws + WS_GATES), 2048};
                pg8::ListOrder S; if (bal) S.init(M, 2048, (cls == 0 ? 0 : (cls == 2 ? 64 : 192)) + j, cls == 0 ? 1 : (cls == 1 ? 0 : 2), 64); else S.init(M, 2048, rot(64), (320 - rot(64) + G - 1) / G, G);
                pg8::gemm_phase(F.lds, g, S, E);
            }
            {
                pg8::Gemm g{(const bf16_t*)(F.ws + WS_AX), (const bf16_t*)(F.ws + WS_WPX), 1024, 1024, 1024};
                EpiGate E{(bf16_t*)(F.ws + WS_PB) + 2 * (size_t)M * 2048, (const bf16_t*)(F.ws + WS_GATES), 4096};
                pg8::ListOrder S; if (bal) S.init(M, 2048, (cls == 1 ? 0 : (cls == 2 ? 64 : 128)) + j, cls == 0 ? 0 : (cls == 3 ? 3 : 1), 64); else S.init(M, 2048, rot(128), (320 - rot(128) + G - 1) / G, G);
                pg8::gemm_phase(F.lds, g, S, E);
            }
}
__device__ __forceinline__ void phase_g2(const Ctx& F, int l) {
    const int G = F.G; (void)G;
            {
                const u32x4* p0 = (const u32x4*)(F.ws + WS_PB); const u32x4* p1 = p0 + (size_t)M * 256; const u32x4* p2 = p1 + (size_t)M * 256; u32x4* mo = (u32x4*)(F.ws + WS_MERGED);
                for (size_t i = (size_t)F.bid * 512 + F.tid; i < (size_t)M * 256; i += (size_t)G * 512) {
                    f32x4 a0, a1, b0, b1, c0, c1; unpack8(p0[i], a0, a1); unpack8(p1[i], b0, b1); unpack8(p2[i], c0, c1);
                    mo[i] = pack8(a0 + b0 + c0, a1 + b1 + c1);
                }
            }
}
__device__ __forceinline__ void phase_h(const Ctx& F, int l) {
    const int G = F.G; (void)G;
            {
                pg8::Gemm g{(const bf16_t*)(F.ws + WS_MERGED), (const bf16_t*)(F.ws + WS_WOUT), 2048, 2048, 2048};
                pg8::StaticOrder S; S.init(M, 2048, G, rot(64));
                const float* sp = l == 0 ? F.in[I_XP] : (const float*)(F.ws + WS_X1); const float* ss = l == 0 ? F.in[I_XS] : (const float*)(F.ws + WS_X1) + (size_t)M_P * 2048;
                float* dp = l == DEPTH - 1 ? F.out + O_YP : (float*)(F.ws + WS_X1); float* ds = l == DEPTH - 1 ? F.out + O_YS : (float*)(F.ws + WS_X1) + (size_t)M_P * 2048;
                EpiOut E{sp, ss, dp, ds};
                pg8::gemm_phase(F.lds, g, S, E);
            }
            if (l + 1 < DEPTH && h_early_ok(G)) { const int n2 = (M / 256) * (2048 / 256) - G, c = rot(64);
                if (c >= n2) prep_weights(F, l + 1, (c - n2) * 8 + F.wave, (G - n2) * 8, PW_EARLY); }
}
__global__ void __launch_bounds__(512, 2) trunk_fwd(Args args) {
    extern __shared__ __attribute__((aligned(16))) unsigned char lds_raw[];
    for (int u = threadIdx.x; u < (LDS_BYTES - SCRATCH_TOP) / 4; u += 512) ((LAS unsigned*)((LAS unsigned char*)lds_raw + SCRATCH_TOP))[u] = 0u;
    __syncthreads();
    XcdBarrier bar;
    { const __attribute__((address_space(4))) char* kp0 = (const __attribute__((address_space(4))) char*)__builtin_amdgcn_kernarg_segment_ptr();
      unsigned char* ws0 = *(unsigned char* const __attribute__((address_space(4)))*)(kp0 + 256);
      bar = xcd_barrier_post((unsigned*)(ws0 + WS_CTL) + CW_BAR, (volatile LAS unsigned*)((LAS unsigned char*)lds_raw + MISC_OFF) + 8); }
    const int lo = args.ph_lo, hi = args.ph_hi;
    int ph = 0;
#ifdef DBG_TIME
    if (blockIdx.x == 0 && threadIdx.x == 0) ((LAS unsigned long long*)((LAS unsigned char*)lds_raw + MISC_OFF + 256))[0] = __builtin_amdgcn_s_memrealtime();
#endif
#define PH_BEGIN if (ph >= lo && ph < hi) { Ctx F; { const __attribute__((address_space(4))) char* kp = (const __attribute__((address_space(4))) char*)__builtin_amdgcn_kernarg_segment_ptr(); asm volatile("" : "+s"(kp)); \
        F.in = (karg_in_t)kp; F.out = *(float* const __attribute__((address_space(4)))*)(kp + 248); F.ws = *(unsigned char* const __attribute__((address_space(4)))*)(kp + 256); \
        F.lds = (LAS unsigned char*)lds_raw; int tz = threadIdx.x; asm volatile("" : "+v"(tz)); F.tid = tz; F.lane = tz & 63; F.wave = __builtin_amdgcn_readfirstlane(tz >> 6); F.G = gridDim.x; F.bid = blockIdx.x; } const int G = F.G; (void)G;
#ifdef DBG_TIME
#define PH_END   if (ph + 1 < hi) xcd_barrier(bar); } ++ph; if (blockIdx.x == 0 && threadIdx.x == 0 && ph < 24) ((LAS unsigned long long*)((LAS unsigned char*)lds_raw + MISC_OFF + 256))[ph] = __builtin_amdgcn_s_memrealtime();
#else
#define PH_END   if (ph + 1 < hi) xcd_barrier(bar); } ++ph;
#endif

    for (int l = 0; l < DEPTH; ++l) {
        PH_BEGIN
#if PH_ON(0)
            REP(0) {
            phase_prep(F, l);
            }
#endif
        PH_END
        PH_BEGIN
#if PH_ON(1)
            phase_b(F, l);
#ifdef DUP_1
            phase_b(F, l);
#endif
#endif
        PH_END
        PH_BEGIN
#if PH_ON(2)
            REP(2) {
            phase_c(F, l);
#ifdef DUP_2
            phase_c(F, l);
#endif
            }
#endif
        PH_END
        PH_BEGIN
#if PH_ON(3)
            phase_d(F, l);
#ifdef DUP_3
            phase_d(F, l);
#endif
#endif
        PH_END
        PH_BEGIN
#if PH_ON(4)
            REP(4) {
            phase_e(F, l);
#ifdef DUP_4
            phase_e(F, l);
#endif
            }
#endif
        PH_END
        PH_BEGIN
#if PH_ON(5)
            REP(5) {
            phase_attention(F, l, 0);
#ifdef DUP_5
            phase_attention(F, l, 1);
#endif
            }
#endif
        PH_END
        PH_BEGIN
#if PH_ON(6)
            phase_g(F, l);
#ifdef DUP_6
            phase_g(F, l);
#endif
#endif
        PH_END
        PH_BEGIN
#if PH_ON(8)
            phase_g2(F, l);
#ifdef DUP_8
            phase_g2(F, l);
#endif
#endif
        PH_END
        PH_BEGIN
#if PH_ON(7)
            phase_h(F, l);
#ifdef DUP_7
            phase_h(F, l);
#endif
#endif
        PH_END
    }


#ifdef DBG_TIME
    {
        xcd_barrier(bar);
        if (blockIdx.x == 0) {
            const __attribute__((address_space(4))) char* kp = (const __attribute__((address_space(4))) char*)__builtin_amdgcn_kernarg_segment_ptr();
            float* outp = *(float* const __attribute__((address_space(4)))*)(kp + 248);
            const LAS unsigned long long* st = (const LAS unsigned long long*)((LAS unsigned char*)lds_raw + MISC_OFF + 256);
            __syncthreads();
            const size_t offs[10] = {O_YP, O_YS, O_PCKV, O_PKR, O_PMK, O_PMV, O_PCONV, O_SCKV, O_SKR, O_SCONV};
#pragma unroll
            for (int k = 0; k < 10; ++k) {
                const int a = DBG_TIME + k, b = (k == 9 ? 18 : DBG_TIME + k + 1);
                unsigned us = (unsigned)((st[b] - st[a]) / 100ull) + 1u; if (us > 60000u) us = 60000u;
                for (unsigned i = threadIdx.x; i < us; i += 512) outp[offs[k] + i] = __uint_as_float(0xAAAAAAAAu);
            }
        }
    }
#endif
#ifdef DBG_DUMP
    {
        const __attribute__((address_space(4))) char* kp = (const __attribute__((address_space(4))) char*)__builtin_amdgcn_kernarg_segment_ptr();
        float* outp = *(float* const __attribute__((address_space(4)))*)(kp + 248); unsigned char* wsp = *(unsigned char* const __attribute__((address_space(4)))*)(kp + 256);
        unsigned* bins = (unsigned*)wsp + 65536;
        if (hi == 1000 || (MK_N_LAUNCHES == 1 && hi == NPH_RUN)) {
            if (hi != 1000) xcd_barrier(bar);
            const size_t lo_b = DBG_LO, hi_b = DBG_HI;
            for (size_t i = (size_t)blockIdx.x * 512 + threadIdx.x; i < O_END; i += (size_t)gridDim.x * 512) outp[i] = 0.f;
            const int gwv = blockIdx.x * 8 + (threadIdx.x >> 6), lanev = threadIdx.x & 63;
            const size_t nchunk = (hi_b - lo_b) >> 10;
            for (size_t c = gwv; c < nchunk; c += (size_t)gridDim.x * 8) {
                const u32x4 w = *(const u32x4*)(wsp + lo_b + (c << 10) + lanev * 16);
                unsigned s = (w.x * 0x9E3779B1u) ^ (w.y * 0x85EBCA77u) ^ (w.z * 0xC2B2AE3Du) ^ (w.w * 0x27D4EB2Fu); s *= (2u * lanev + 1u) * 0x165667B1u; s ^= s >> 15;
#pragma unroll
                for (int o = 1; o < 64; o <<= 1) s += __shfl_xor(s, o);
                if (lanev == 0) __hip_atomic_fetch_xor(bins + (c & 1023), s * 0x9E3779B1u, __ATOMIC_RELAXED, __HIP_MEMORY_SCOPE_AGENT);
            }
            if (hi != 1000) xcd_barrier(bar);
        }
        if (hi == 1001 || (MK_N_LAUNCHES == 1 && hi == NPH_RUN)) {
            if (blockIdx.x == 0) for (int i = threadIdx.x; i < 1024; i += 512) outp[i] = (float)(__hip_atomic_load(bins + i, __ATOMIC_RELAXED, __HIP_MEMORY_SCOPE_AGENT) & 0xffffffu) + 1.0f;
        }
    }
#endif
#undef PH_BEGIN
#undef PH_END
}

extern "C" void kernel_launch(void* const* d_in, const int* in_sizes, int n_in, void* d_out, int out_size, void* d_ws, size_t ws_size, hipStream_t stream) {
    static int grid = 0;
    if (grid == 0) {
        if (n_in != 31 || (size_t)out_size != O_END || ws_size < WS_END) {
            fprintf(stderr, "kernel_launch: built for 31 inputs, %zu outputs, >= %zu bytes of workspace; got n_in %d, out %d, ws %zu; nothing launched\n", (size_t)O_END, (size_t)WS_END, n_in, out_size, ws_size);
            grid = -1; return; }
        int dev = 0, cus = 0, per_cu = 0;
        if (hipGetDevice(&dev) != hipSuccess || hipDeviceGetAttribute(&cus, hipDeviceAttributeMultiprocessorCount, dev) != hipSuccess) { fprintf(stderr, "kernel_launch: device query failed\n"); grid = -1; return; }
        if (hipFuncSetAttribute((const void*)trunk_fwd, hipFuncAttributeMaxDynamicSharedMemorySize, LDS_BYTES) != hipSuccess) { fprintf(stderr, "kernel_launch: hipFuncSetAttribute failed\n"); grid = -1; return; }
        if (hipOccupancyMaxActiveBlocksPerMultiprocessor(&per_cu, (const void*)trunk_fwd, 512, LDS_BYTES) != hipSuccess || per_cu < 1)
            fprintf(stderr, "kernel_launch: note: occupancy query reports %d workgroups per CU\n", per_cu);
        (void)hipGetLastError();
        grid = cus;
    }
    if (grid < 0) return;
    if (hipMemsetAsync((char*)d_ws + WS_CTL, 0, CTL_BYTES, stream) != hipSuccess) { fprintf(stderr, "kernel_launch: memset failed\n"); return; }
    Args a{};
    for (int i = 0; i < 31; ++i) a.in[i] = (const float*)d_in[i];
    a.out = (float*)d_out; a.ws = (unsigned char*)d_ws;
    constexpr int NPH = NPH_RUN;
    if (MK_N_LAUNCHES == 1) {
        a.ph_lo = 0; a.ph_hi = NPH;
        hipLaunchKernelGGL(trunk_fwd, dim3(grid), dim3(512), LDS_BYTES, stream, a);
    } else {
        for (int p = 0; p < NPH; ++p) { a.ph_lo = p; a.ph_hi = p + 1; hipLaunchKernelGGL(trunk_fwd, dim3(grid), dim3(512), LDS_BYTES, stream, a); }
#ifdef DBG_DUMP
        a.ph_lo = 1000; a.ph_hi = 1000; hipLaunchKernelGGL(trunk_fwd, dim3(grid), dim3(512), LDS_BYTES, stream, a);
        a.ph_lo = 1001; a.ph_hi = 1001; hipLaunchKernelGGL(trunk_fwd, dim3(grid), dim3(512), LDS_BYTES, stream, a);
#endif
    }
    const hipError_t le = hipPeekAtLastError();
    if (le != hipSuccess) fprintf(stderr, "kernel_launch: launch failed: %s\n", hipGetErrorName(le));
}
```

```cpp
#include <hip/hip_runtime.h>
#include <cstdio>
#include <cstdint>

#define LAS __attribute__((address_space(3)))
#define GAS __attribute__((address_space(1)))
typedef unsigned short bf16_t;
typedef short bf16x8 __attribute__((ext_vector_type(8)));
typedef short s16x4 __attribute__((ext_vector_type(4)));
typedef float f32x2 __attribute__((ext_vector_type(2)));
typedef float f32x4 __attribute__((ext_vector_type(4)));
typedef float f32x16 __attribute__((ext_vector_type(16)));
typedef unsigned u32x2 __attribute__((ext_vector_type(2)));
typedef unsigned u32x4 __attribute__((ext_vector_type(4)));
typedef GAS unsigned gu32;

#ifndef PH_ONLY
#define PH_ONLY -1
#endif
#define PH_ON(k) (PH_ONLY < 0 || PH_ONLY == (k))
#ifndef REPEAT_MASK
#define REPEAT_MASK 0
#endif
#define REP(k) for (int rep_ = 0; rep_ < (((REPEAT_MASK) >> (k)) & 1) + 1; ++rep_)
#ifndef NPH_RUN
#define NPH_RUN 18
#endif
#ifndef MK_N_LAUNCHES
#define MK_N_LAUNCHES 1
#endif

constexpr int D_MODEL = 2048, M_P = 8192, M_S = 2048, M = M_P + M_S, DEPTH = 2, NSTREAM = 32, DEC_SEQ = 64, PAST = 4096;
constexpr int NH = 16, QK_HEAD = 192, Q_LORA = 512, KV_LORA = 512;
constexpr int CONV_W = 1024, CONV_K = 31, CONV_ST = 30, N_MEM = 256, XW = 1024;
constexpr int IN_COLS = 14400, IN_PAD = 14592;
constexpr int MPAST = NSTREAM * PAST;
constexpr float EPS = 1e-6f;
constexpr float LOG2E = 1.4426950408889634f;
constexpr float C_MLA = 0.07216878364870323f * LOG2E;
constexpr float C_X = 0.0625f * LOG2E;

constexpr size_t O_YP = 0, O_YS = 16777216, O_PCKV = 20971520, O_PKR = 29360128, O_PMK = 30408704, O_PMV = 30932992,
                 O_PCONV = 31457280, O_SCKV = 31518720, O_SKR = 33615872, O_SCONV = 33878016, O_END = 35844096;

constexpr size_t al256(size_t x) { return (x + 255) / 256 * 256; }
constexpr size_t WS_CTL = 0, CTL_BYTES = 1u << 20;
constexpr size_t WS_WIN = WS_CTL + CTL_BYTES;
constexpr size_t WS_WUQ = WS_WIN + (size_t)IN_PAD * 2048 * 2;
constexpr size_t WS_WUKV = WS_WUQ + (size_t)3072 * 512 * 2;
constexpr size_t WS_WPW2 = WS_WUKV + (size_t)4096 * 512 * 2;
constexpr size_t WS_WMEM = WS_WPW2 + (size_t)1024 * 1024 * 2;
constexpr size_t WS_WPM = WS_WMEM + (size_t)2048 * 2048 * 2;
constexpr size_t WS_WPC = WS_WPM + (size_t)2048 * 2048 * 2;
constexpr size_t WS_WPX = WS_WPC + (size_t)2048 * 1024 * 2;
constexpr size_t WS_WOUT = WS_WPX + (size_t)2048 * 1024 * 2;
constexpr size_t WS_ROPE = WS_WOUT + (size_t)2048 * 2048 * 2;
constexpr size_t WS_CNP = WS_ROPE + (size_t)8192 * 64 * 4;
constexpr size_t WS_KPEP = WS_CNP + (size_t)MPAST * 512 * 2;
constexpr size_t WS_SSPEP = WS_KPEP + (size_t)MPAST * 64 * 2;
constexpr size_t WS_KP = WS_SSPEP + (size_t)MPAST * 4;
constexpr size_t WS_VP = WS_KP + (size_t)MPAST * 2048 * 2;
constexpr size_t WS_SSP = WS_VP + (size_t)MPAST * 2048 * 2;
constexpr size_t WS_HB = WS_SSP + (size_t)MPAST * 16 * 4 * 4;
constexpr size_t WS_QRAW = WS_HB;
constexpr size_t WS_QLATF = WS_HB + (size_t)M * 3072 * 2;
constexpr size_t WS_QLATN = WS_QLATF + (size_t)M * 512 * 4;
constexpr size_t WS_CKVN = WS_QLATN + (size_t)M * 512 * 2;
constexpr size_t WS_ZM = WS_CKVN + (size_t)M * 512 * 2;
constexpr size_t WS_UB = WS_ZM + (size_t)M * 2048 * 2;
constexpr size_t WS_ZC = WS_UB + (size_t)M * 1024 * 2;
constexpr size_t WS_XQ = WS_ZC + (size_t)M * 1024 * 2;
constexpr size_t WS_ZX = WS_XQ + (size_t)M * 1024 * 2;
constexpr size_t WS_GATES = WS_ZX + (size_t)M * 1024 * 2;
constexpr size_t WS_CV = WS_GATES + (size_t)M * 6144 * 2;
constexpr size_t WS_Q = WS_CV + (size_t)M * 1024 * 2;
constexpr size_t WS_KC = WS_Q + (size_t)M * 3072 * 2;
constexpr size_t WS_VC = WS_KC + (size_t)M * 2048 * 2;
constexpr size_t WS_SSC = WS_VC + (size_t)M * 2048 * 2;
constexpr size_t WS_KPEC = WS_SSC + (size_t)M * 16 * 4 * 4;
constexpr size_t WS_SSPEC = WS_KPEC + (size_t)M * 64 * 2;
constexpr size_t WS_AMLA = al256(WS_SSPEC + (size_t)M * 4);
constexpr size_t WS_ACONV = WS_AMLA + (size_t)M * 2048 * 2;
constexpr size_t WS_AX = WS_ACONV + (size_t)M * 1024 * 2;
constexpr size_t WS_X1 = WS_AX + (size_t)M * 1024 * 2;
constexpr size_t WS_MEMN = WS_X1 + (size_t)M * 2048 * 4;
constexpr size_t WS_KVRAW = WS_MEMN + (size_t)256 * 2048 * 2;
constexpr size_t WS_MKB = WS_KVRAW + (size_t)256 * 2048 * 4;
constexpr size_t WS_MVB = WS_MKB + (size_t)256 * 1024 * 2;
constexpr size_t WS_RKC = WS_MVB + (size_t)256 * 1024 * 2;
constexpr size_t WS_RKP = WS_RKC + (size_t)16 * M * 4;
constexpr size_t WS_XQN = WS_RKP + (size_t)MPAST * 16 * 4;
constexpr size_t WS_WUK = WS_XQN + (size_t)M * 1024 * 2;
constexpr size_t WS_END = WS_WUK + (size_t)2048 * 512 * 2;
constexpr size_t WS_PB = WS_KP;
constexpr size_t WS_MERGED = WS_KP + 3 * (size_t)M * 2048 * 2;
static_assert(sizeof(void*) == 8, "");
static_assert(WS_END <= 2147483648ull, "workspace map exceeds 2 GiB");
static_assert(WS_MERGED + (size_t)M * 2048 * 2 <= WS_VP, "merged overlay inside KP");

constexpr int CW_BAR = 4096;
constexpr int CW_QHEAD = 16384;

constexpr int RING_BYTES = 131072, SCRATCH_TOP = 161536, MISC_OFF = SCRATCH_TOP + 320, LDS_BYTES = 163840;

typedef __bf16 bf16x2_t __attribute__((ext_vector_type(2)));
__device__ __forceinline__ unsigned cvt_pk_bf16(float lo, float hi) { f32x2 v = {lo, hi}; bf16x2_t b = __builtin_convertvector(v, bf16x2_t); return __builtin_bit_cast(unsigned, b); }
__device__ __forceinline__ float bf_lo(unsigned w) { return __uint_as_float(w << 16); }
__device__ __forceinline__ float bf_hi(unsigned w) { return __uint_as_float(w & 0xffff0000u); }
__device__ __forceinline__ float sigmoidf_(float x) { return __builtin_amdgcn_rcpf(1.0f + __builtin_amdgcn_exp2f(-x * LOG2E)); }
__device__ __forceinline__ float siluf_(float x) { return x * sigmoidf_(x); }
__device__ __forceinline__ float wave_sum(float v) {
#pragma unroll
    for (int o = 1; o < 64; o <<= 1) v += __shfl_xor(v, o);
    return v;
}
__device__ __forceinline__ u32x4 pack8(const f32x4 a, const f32x4 b) {
    u32x4 w; w.x = cvt_pk_bf16(a[0], a[1]); w.y = cvt_pk_bf16(a[2], a[3]); w.z = cvt_pk_bf16(b[0], b[1]); w.w = cvt_pk_bf16(b[2], b[3]); return w;
}
__device__ __forceinline__ void unpack8(const u32x4 w, f32x4& a, f32x4& b) {
    a = (f32x4){bf_lo(w.x), bf_hi(w.x), bf_lo(w.y), bf_hi(w.y)}; b = (f32x4){bf_lo(w.z), bf_hi(w.z), bf_lo(w.w), bf_hi(w.w)};
}
#define LDS_WAIT() asm volatile("s_waitcnt lgkmcnt(0)" ::: "memory")
#define VM_WAIT() asm volatile("s_waitcnt vmcnt(0)" ::: "memory")

namespace pg8 {
constexpr int BM = 256, BK = 64, HALF = 128, HTB = HALF * BK * 2, STAGE_BYTES = 8 * HTB, NXCD = 8, WGM = 8;
__host__ __device__ __forceinline__ int lds_byte(int r, int c) { const int st = (r >> 4) * 2 + (c >> 5), rr = r & 15, cc = c & 31, ob = rr * 64 + cc * 2; return st * 1024 + (ob ^ (((ob >> 9) & 1) << 5)); }
__host__ __device__ __forceinline__ void stage_rc(int b, int& R, int& C) { const int st = b / 1024, sb = b % 1024, swz = sb ^ (((sb >> 9) & 1) << 5); R = (st >> 1) * 16 + swz / 64; C = (st & 1) * 32 + (swz % 64) / 2; }
__host__ __device__ __forceinline__ int perm32(int rho) { const int n = rho >> 4, i = rho & 15; return 8 * (i >> 2) + 4 * n + (i & 3); }
struct Unit { int pm, pn; };
struct Gemm { const bf16_t* A; const bf16_t* Bt; int lda, ldb, K; };
struct StaticOrder {
    int nM, nN, nwg, G, c;
    __device__ void init(int M_, int N_, int G_, int c_) { nM = M_ / BM; nN = N_ / BM; nwg = nM * nN; G = G_; c = c_; }
    __device__ bool next(int i, Unit& u) const {
        const long L = (long)i * G + c; if (L >= nwg) return false;
        int wgid = (int)L; { const int q = nwg / NXCD, r = nwg % NXCD, xcd = wgid % NXCD, off = wgid / NXCD; wgid = (xcd < r ? xcd * (q + 1) : r * (q + 1) + (xcd - r) * q) + off; }
        const int nig = WGM * nN, gid = wgid / nig, fm = gid * WGM, gsz = (nM - fm) < WGM ? (nM - fm) : WGM;
        u.pm = fm + ((wgid % nig) % gsz); u.pn = (wgid % nig) / gsz; return true;
    }
};
struct ListOrder {
    int nM, nN, nwg, L0, n, stride;
    __device__ void init(int M_, int N_, int L0_, int n_, int stride_) { nM = M_ / BM; nN = N_ / BM; nwg = nM * nN; L0 = L0_; n = n_; stride = stride_; }
    __device__ bool next(int i, Unit& u) const {
        if (i >= n) return false;
        int wgid = L0 + i * stride; { const int q = nwg / NXCD, r = nwg % NXCD, xcd = wgid % NXCD, off = wgid / NXCD; wgid = (xcd < r ? xcd * (q + 1) : r * (q + 1) + (xcd - r) * q) + off; }
        const int nig = WGM * nN, gid = wgid / nig, fm = gid * WGM, gsz = (nM - fm) < WGM ? (nM - fm) : WGM;
        u.pm = fm + ((wgid % nig) % gsz); u.pn = (wgid % nig) / gsz; return true;
    }
};
template <class Epi, class Sched>
__device__ __forceinline__ void gemm_phase(LAS unsigned char* lds, const Gemm g, const Sched& S, const Epi& E) {
    int tid = threadIdx.x; asm volatile("" : "+v"(tid));
    const int wid = __builtin_amdgcn_readfirstlane(tid >> 6), lane = tid & 63, wr = wid >> 2, wc = wid & 3, fr = lane & 15, fq = lane >> 4;
    const int K = g.K, nt = K / BK;
    unsigned voffA[2], voffB[2];
#pragma unroll
    for (int i = 0; i < 2; ++i) { int R, C; stage_rc(tid * 16 + i * 8192, R, C); const int Rb = (R & ~31) + perm32(R & 31);
        voffA[i] = (unsigned)(R * g.lda + C) * 2u; voffB[i] = (unsigned)(Rb * g.ldb + C) * 2u; }
    const size_t kstep = (size_t)(BK * 2);
    const size_t hA = (size_t)HALF * g.lda * 2, hB = (size_t)HALF * g.ldb * 2;
    const size_t tA = 2 * hA, tB = 2 * hB;
    const unsigned ldsw = (unsigned)wid * 1024u;
    const int aoff = lds_byte(wr * 64 + fr, fq * 8), boff = lds_byte(wc * 32 + fr, fq * 8);
#define PG8_SA(b, h) (((b) * 2 + (h)) * HTB)
#define PG8_SB(b, h) ((4 + (b) * 2 + (h)) * HTB)
#define PG8_STAGE(bufoff, gbase, voff) do { _Pragma("unroll") for (int _i = 0; _i < 2; ++_i) \
        __builtin_amdgcn_global_load_lds((const unsigned*)((const char*)(gbase) + (voff)[_i]), (LAS unsigned*)(lds + (bufoff) + ldsw + _i * 8192), 16, 0, 0); } while (0)
#define PG8_LDA(dst, b, h) do { _Pragma("unroll") for (int m = 0; m < 4; ++m) _Pragma("unroll") for (int k = 0; k < 2; ++k) dst[m][k] = *(const LAS bf16x8*)(lds + PG8_SA(b, h) + aoff + m * 2048 + k * 1024); } while (0)
#define PG8_LDB(dst, b, h) do { _Pragma("unroll") for (int n = 0; n < 2; ++n) _Pragma("unroll") for (int k = 0; k < 2; ++k) dst[n][k] = *(const LAS bf16x8*)(lds + PG8_SB(b, h) + boff + n * 2048 + k * 1024); } while (0)
#define PG8_MMA(ai, bj, At, Bt) do { __builtin_amdgcn_s_setprio(1); _Pragma("unroll") for (int m = 0; m < 4; ++m) _Pragma("unroll") for (int n = 0; n < 2; ++n) _Pragma("unroll") for (int k = 0; k < 2; ++k) \
        acc[ai][bj][m][n] = __builtin_amdgcn_mfma_f32_16x16x32_bf16(Bt[n][k], At[m][k], acc[ai][bj][m][n], 0, 0, 0); __builtin_amdgcn_s_setprio(0); } while (0)
#define PG8_WAIT_V(n) asm volatile("s_waitcnt vmcnt(" #n ")" ::: "memory")
#define PG8_WAIT_L(n) asm volatile("s_waitcnt lgkmcnt(" #n ")" ::: "memory")
#define PG8_BAR __builtin_amdgcn_s_barrier()
#define PG8_SCHED __builtin_amdgcn_sched_barrier(0)
    Unit cur, nxt; int ui = 0;
    if (!S.next(0, cur)) return;
    f32x4 acc[2][2][4][2];
#pragma unroll
    for (int a = 0; a < 2; ++a)
#pragma unroll
        for (int b = 0; b < 2; ++b)
#pragma unroll
            for (int m = 0; m < 4; ++m)
#pragma unroll
                for (int n = 0; n < 2; ++n) acc[a][b][m][n] = (f32x4){0.f, 0.f, 0.f, 0.f};
    bf16x8 At[4][2], B0[2][2], B1[2][2];
    const char* cA = (const char*)g.A + (size_t)cur.pm * tA; const char* cB = (const char*)g.Bt + (size_t)cur.pn * tB;
    PG8_STAGE(PG8_SB(0, 0), cB, voffB); PG8_STAGE(PG8_SB(0, 1), cB + hB, voffB); PG8_STAGE(PG8_SA(0, 0), cA, voffA); PG8_STAGE(PG8_SA(0, 1), cA + hA, voffA);
    if (wr == 1) PG8_BAR;
    PG8_WAIT_V(2); PG8_BAR;
    PG8_STAGE(PG8_SB(1, 0), cB + kstep, voffB); PG8_STAGE(PG8_SA(1, 0), cA + kstep, voffA); PG8_STAGE(PG8_SB(1, 1), cB + hB + kstep, voffB);
    PG8_WAIT_V(6); PG8_BAR;
    for (;;) {
        const bool has_next = S.next(ui + 1, nxt);
        const char* nA = has_next ? (const char*)g.A + (size_t)nxt.pm * tA : cA; const char* nB = has_next ? (const char*)g.Bt + (size_t)nxt.pn * tB : cB;
        for (int t = 0; t < nt; t += 2) {
            const bool last = (t == nt - 2);
            const char* a1 = cA + (size_t)(t + 1) * kstep;
            const char* a2 = last ? nA : cA + (size_t)(t + 2) * kstep; const char* b2 = last ? nB : cB + (size_t)(t + 2) * kstep;
            const char* a3 = a2 + kstep; const char* b3 = b2 + kstep;
            PG8_LDB(B0, 0, 0); PG8_LDB(B1, 0, 1); PG8_SCHED; PG8_LDA(At, 0, 0); PG8_STAGE(PG8_SA(1, 1), a1 + hA, voffA);
            PG8_WAIT_V(8); PG8_WAIT_L(0); PG8_BAR; PG8_MMA(0, 0, At, B0); PG8_MMA(0, 1, At, B1); PG8_BAR; PG8_SCHED;
            PG8_LDA(At, 0, 1); PG8_STAGE(PG8_SB(0, 0), b2, voffB); PG8_STAGE(PG8_SB(0, 1), b2 + hB, voffB); PG8_STAGE(PG8_SA(0, 0), a2, voffA);
            PG8_WAIT_V(8); PG8_WAIT_L(0); PG8_BAR; PG8_MMA(1, 0, At, B0); PG8_MMA(1, 1, At, B1); PG8_BAR; PG8_SCHED;
            PG8_LDB(B0, 1, 0); PG8_LDB(B1, 1, 1); PG8_SCHED; PG8_LDA(At, 1, 0); PG8_STAGE(PG8_SA(0, 1), a2 + hA, voffA);
            PG8_WAIT_V(8); PG8_WAIT_L(0); PG8_BAR; PG8_MMA(0, 0, At, B0); PG8_MMA(0, 1, At, B1); PG8_BAR; PG8_SCHED;
            PG8_LDA(At, 1, 1); PG8_STAGE(PG8_SB(1, 0), b3, voffB); PG8_STAGE(PG8_SB(1, 1), b3 + hB, voffB); PG8_STAGE(PG8_SA(1, 0), a3, voffA);
            PG8_WAIT_V(8); PG8_WAIT_L(0); PG8_BAR; PG8_MMA(1, 0, At, B0); PG8_MMA(1, 1, At, B1); PG8_BAR; PG8_SCHED;
        }
        if (wr == 0) PG8_BAR;
        E(acc, cur);
        if (!has_next) break;
#pragma unroll
        for (int a = 0; a < 2; ++a)
#pragma unroll
            for (int b = 0; b < 2; ++b)
#pragma unroll
                for (int m = 0; m < 4; ++m)
#pragma unroll
                    for (int n = 0; n < 2; ++n) acc[a][b][m][n] = (f32x4){0.f, 0.f, 0.f, 0.f};
        cur = nxt; cA = nA; cB = nB; ++ui;
        if (wr == 1) PG8_BAR;
    }
    PG8_WAIT_V(0);
    PG8_BAR;
#undef PG8_SA
#undef PG8_SB
#undef PG8_STAGE
#undef PG8_LDA
#undef PG8_LDB
#undef PG8_MMA
#undef PG8_WAIT_V
#undef PG8_WAIT_L
#undef PG8_BAR
#undef PG8_SCHED
}
}
using pg8::Unit;

#define EPI_LANE int tz_ = threadIdx.x; asm volatile("" : "+v"(tz_)); const int wr = tz_ >> 8, wc = (tz_ >> 6) & 3, fr = tz_ & 15, fq = (tz_ >> 4) & 3; (void)wr; (void)wc; (void)fr; (void)fq;
#define EPI_LOOP_BEGIN \
    _Pragma("unroll") for (int ai = 0; ai < 2; ++ai) _Pragma("unroll") for (int m = 0; m < 4; ++m) { const int row = u.pm * 256 + ai * 128 + wr * 64 + m * 16 + fr; \
    _Pragma("unroll") for (int bj = 0; bj < 2; ++bj) { const int colt = bj * 128 + wc * 32 + 8 * fq; const f32x4 v0 = acc[ai][bj][m][0], v1 = acc[ai][bj][m][1]; (void)colt; (void)v0; (void)v1;
#define EPI_LOOP_END } }

struct EpiBf16 {
    bf16_t* O; int ldc;
    __device__ __forceinline__ void operator()(const f32x4 (&acc)[2][2][4][2], const Unit& u) const {
        EPI_LANE
        EPI_LOOP_BEGIN
            *(u32x4*)(O + (size_t)row * ldc + u.pn * 256 + colt) = pack8(v0, v1);
        EPI_LOOP_END
    }
};
struct EpiNone { __device__ __forceinline__ void operator()(const f32x4 (&acc)[2][2][4][2], const Unit& u) const { (void)u;
#pragma unroll
    for (int a = 0; a < 2; ++a)
#pragma unroll
        for (int b = 0; b < 2; ++b)
#pragma unroll
            for (int m = 0; m < 4; ++m) asm volatile("" :: "v"(acc[a][b][m][0]), "v"(acc[a][b][m][1])); } };
struct EpiF32 {
    float* C; int ldc;
    __device__ __forceinline__ void operator()(const f32x4 (&acc)[2][2][4][2], const Unit& u) const {
        EPI_LANE
        EPI_LOOP_BEGIN
            float* p = C + (size_t)row * ldc + u.pn * 256 + colt; *(f32x4*)p = v0; *(f32x4*)(p + 4) = v1;
        EPI_LOOP_END
    }
};
struct EpiWin {
    unsigned char* ws; float* out; const float* bmerge; int l;
    __device__ __forceinline__ void operator()(const f32x4 (&acc)[2][2][4][2], const Unit& u) const {
        EPI_LANE
        const int pn = u.pn;
        if (pn < 2) {
            float* qlat = (float*)(ws + WS_QLATF);
            EPI_LOOP_BEGIN
                float* p = qlat + (size_t)row * 512 + pn * 256 + colt; *(f32x4*)p = v0; *(f32x4*)(p + 4) = v1;
            EPI_LOOP_END
        } else if (pn < 4) {
            float* ckv_p = out + O_PCKV + (size_t)l * M_P * 512; float* ckv_s = out + O_SCKV + (size_t)l * M_S * 512;
            EPI_LOOP_BEGIN
                float* p = (row < M_P ? ckv_p + (size_t)row * 512 : ckv_s + (size_t)(row - M_P) * 512) + (pn - 2) * 256 + colt; *(f32x4*)p = v0; *(f32x4*)(p + 4) = v1;
            EPI_LOOP_END
        } else if (pn == 4) {
            float* kr_p = out + O_PKR + (size_t)l * M_P * 64; float* kr_s = out + O_SKR + (size_t)l * M_S * 64;
            EPI_LOOP_BEGIN
                if (colt < 64) { float* p = (row < M_P ? kr_p + (size_t)row * 64 : kr_s + (size_t)(row - M_P) * 64) + colt; *(f32x4*)p = v0; *(f32x4*)(p + 4) = v1; }
            EPI_LOOP_END
        } else if (pn < 13) {
            bf16_t* zm = (bf16_t*)(ws + WS_ZM);
            EPI_LOOP_BEGIN
                f32x4 a, b;
#pragma unroll
                for (int j = 0; j < 4; ++j) { a[j] = siluf_(v0[j]); b[j] = siluf_(v1[j]); }
                *(u32x4*)(zm + (size_t)row * 2048 + (pn - 5) * 256 + colt) = pack8(a, b);
            EPI_LOOP_END
        } else if (pn < 21) {
            const int t = pn - 13;
            bf16_t* ub = (bf16_t*)(ws + WS_UB);
            float* conv_p = out + O_PCONV + (size_t)l * CONV_ST * 1024; float* conv_s = out + O_SCONV + (size_t)l * NSTREAM * CONV_ST * 1024;
#pragma unroll
            for (int ai = 0; ai < 2; ++ai)
#pragma unroll
                for (int m = 0; m < 4; ++m) {
                    const int row = u.pm * 256 + ai * 128 + wr * 64 + m * 16 + fr; const int col = t * 128 + wc * 32 + 8 * fq;
                    f32x4 a, b;
#pragma unroll
                    for (int j = 0; j < 4; ++j) { a[j] = acc[ai][0][m][0][j] * sigmoidf_(acc[ai][1][m][0][j]); b[j] = acc[ai][0][m][1][j] * sigmoidf_(acc[ai][1][m][1][j]); }
                    *(u32x4*)(ub + (size_t)row * 1024 + col) = pack8(a, b);
                    if (row >= M_P - CONV_ST) {
                        if (row < M_P) { float* p = conv_p + (size_t)(row - (M_P - CONV_ST)) * 1024 + col; *(f32x4*)p = a; *(f32x4*)(p + 4) = b; }
                        else { const int rs = row - M_P, sq = rs & 63, bb = rs >> 6;
                            if (sq >= DEC_SEQ - CONV_ST) { float* p = conv_s + ((size_t)bb * CONV_ST + (sq - (DEC_SEQ - CONV_ST))) * 1024 + col; *(f32x4*)p = a; *(f32x4*)(p + 4) = b; } }
                    }
                }
        } else if (pn < 33) {
            const size_t dofs = pn < 25 ? WS_ZC : (pn < 29 ? WS_XQ : WS_ZX); const int tb = pn < 25 ? 21 : (pn < 29 ? 25 : 29); const bool act = !(pn >= 25 && pn < 29);
            bf16_t* dst = (bf16_t*)(ws + dofs);
            EPI_LOOP_BEGIN
                f32x4 a = v0, b = v1;
                if (act) {
#pragma unroll
                    for (int j = 0; j < 4; ++j) { a[j] = siluf_(v0[j]); b[j] = siluf_(v1[j]); } }
                *(u32x4*)(dst + (size_t)row * 1024 + (pn - tb) * 256 + colt) = pack8(a, b);
            EPI_LOOP_END
        } else {
            bf16_t* gates = (bf16_t*)(ws + WS_GATES);
            f32x4 bb[2][2];
#pragma unroll
            for (int bj = 0; bj < 2; ++bj) { const float* bp = bmerge + (pn - 33) * 256 + bj * 128 + wc * 32 + 8 * fq; bb[bj][0] = *(const f32x4*)bp; bb[bj][1] = *(const f32x4*)(bp + 4); }
            EPI_LOOP_BEGIN
                const int col = (pn - 33) * 256 + colt;
                f32x4 a, b;
#pragma unroll
                for (int j = 0; j < 4; ++j) { a[j] = sigmoidf_(v0[j] + bb[bj][0][j]); b[j] = sigmoidf_(v1[j] + bb[bj][1][j]); }
                *(u32x4*)(gates + (size_t)row * 6144 + col) = pack8(a, b);
            EPI_LOOP_END
        }
    }
};
template <bool PASTROWS> struct EpiKV {
    bf16_t* Kd; bf16_t* Vd; float* SS;
    __device__ __forceinline__ void operator()(const f32x4 (&acc)[2][2][4][2], const Unit& u) const {
        EPI_LANE
        const int h = u.pn;
#pragma unroll
        for (int ai = 0; ai < 2; ++ai)
#pragma unroll
            for (int m = 0; m < 4; ++m) {
                const int row = u.pm * 256 + ai * 128 + wr * 64 + m * 16 + fr;
                const size_t R = PASTROWS ? ((size_t)((row >> 12) * 16 + h) * 4096 + (row & 4095)) : ((size_t)h * M + row);
                const int c = wc * 32 + 8 * fq;
                const f32x4 k0 = acc[ai][0][m][0], k1 = acc[ai][0][m][1];
                *(u32x4*)(Kd + R * 128 + c) = pack8(k0, k1);
                *(u32x4*)(Vd + R * 128 + c) = pack8(acc[ai][1][m][0], acc[ai][1][m][1]);
                float s = (k0[0] * k0[0] + k0[1] * k0[1]) + (k0[2] * k0[2] + k0[3] * k0[3]) + (k1[0] * k1[0] + k1[1] * k1[1]) + (k1[2] * k1[2] + k1[3] * k1[3]);
                s += __shfl_xor(s, 16); s += __shfl_xor(s, 32);
                if (fq == 0) SS[R * 4 + wc] = s;
            }
    }
};
template <bool DOK = true, bool DOSS = true, bool TILED = true> struct EpiK {
    bf16_t* Kd; float* SS;
    __device__ __forceinline__ void operator()(const f32x4 (&acc)[2][2][4][2], const Unit& u) const {
        EPI_LANE
        float sq[2][4][2];
#pragma unroll
        for (int ai = 0; ai < 2; ++ai)
#pragma unroll
            for (int m = 0; m < 4; ++m)
#pragma unroll
                for (int bj = 0; bj < 2; ++bj) {
                    const f32x4 k0 = acc[ai][bj][m][0], k1 = acc[ai][bj][m][1];
                    if (DOK) *(u32x4*)(Kd + ((((((((size_t)u.pm * 8 + u.pn) * 2 + ai) * 2 + wr) * 4 + m) * 2 + bj) * 4 + wc) * 64 + (fq * 16 + fr)) * 8) = pack8(k0, k1);
                    sq[ai][m][bj] = (k0[0] * k0[0] + k0[1] * k0[1]) + (k0[2] * k0[2] + k0[3] * k0[3]) + (k1[0] * k1[0] + k1[1] * k1[1]) + (k1[2] * k1[2] + k1[3] * k1[3]);
                }
#pragma unroll
        for (int ai = 0; ai < 2; ++ai)
#pragma unroll
            for (int m = 0; m < 4; ++m)
#pragma unroll
                for (int bj = 0; bj < 2; ++bj) sq[ai][m][bj] += __shfl_xor(sq[ai][m][bj], 16);
#pragma unroll
        for (int ai = 0; ai < 2; ++ai)
#pragma unroll
            for (int m = 0; m < 4; ++m)
#pragma unroll
                for (int bj = 0; bj < 2; ++bj) sq[ai][m][bj] += __shfl_xor(sq[ai][m][bj], 32);
        if (DOSS) {
#pragma unroll
            for (int ai = 0; ai < 2; ++ai)
#pragma unroll
                for (int bj = 0; bj < 2; ++bj) {
                    const float v = fq == 0 ? sq[ai][0][bj] : (fq == 1 ? sq[ai][1][bj] : (fq == 2 ? sq[ai][2][bj] : sq[ai][3][bj]));
                    const int row = u.pm * 256 + ai * 128 + wr * 64 + fq * 16 + fr; const int h = u.pn * 2 + bj;
                    SS[(size_t)wc * ((size_t)MPAST * 16) + (size_t)((row >> 12) * 16 + h) * 4096 + (row & 4095)] = v;
                }
        }
        (void)TILED;
    }
};
struct EpiPw2 {
    bf16_t* O; const bf16_t* zc; const float* bias;
    __device__ __forceinline__ void operator()(const f32x4 (&acc)[2][2][4][2], const Unit& u) const {
        EPI_LANE
        f32x4 bb[2][2];
#pragma unroll
        for (int bj = 0; bj < 2; ++bj) { const float* bp = bias + u.pn * 256 + bj * 128 + wc * 32 + 8 * fq; bb[bj][0] = *(const f32x4*)bp; bb[bj][1] = *(const f32x4*)(bp + 4); }
#pragma unroll
        for (int ai = 0; ai < 2; ++ai) {
            u32x4 z[4][2];
#pragma unroll
            for (int m = 0; m < 4; ++m)
#pragma unroll
                for (int bj = 0; bj < 2; ++bj) { const int row = u.pm * 256 + ai * 128 + wr * 64 + m * 16 + fr; z[m][bj] = *(const u32x4*)(zc + (size_t)row * 1024 + u.pn * 256 + bj * 128 + wc * 32 + 8 * fq); }
#pragma unroll
            for (int m = 0; m < 4; ++m)
#pragma unroll
                for (int bj = 0; bj < 2; ++bj) { const int row = u.pm * 256 + ai * 128 + wr * 64 + m * 16 + fr; const int col = u.pn * 256 + bj * 128 + wc * 32 + 8 * fq;
                    f32x4 z0, z1; unpack8(z[m][bj], z0, z1);
                    *(u32x4*)(O + (size_t)row * 1024 + col) = pack8((acc[ai][bj][m][0] + bb[bj][0]) * z0, (acc[ai][bj][m][1] + bb[bj][1]) * z1); }
            asm volatile("" ::: "memory");
        }
    }
};
struct EpiGate {
    bf16_t* O; const bf16_t* gates; int goff;
    __device__ __forceinline__ void operator()(const f32x4 (&acc)[2][2][4][2], const Unit& u) const {
        EPI_LANE
#pragma unroll
        for (int ai = 0; ai < 2; ++ai) {
            u32x4 gg[4][2];
#pragma unroll
            for (int m = 0; m < 4; ++m)
#pragma unroll
                for (int bj = 0; bj < 2; ++bj) { const int row = u.pm * 256 + ai * 128 + wr * 64 + m * 16 + fr; gg[m][bj] = *(const u32x4*)(gates + (size_t)row * 6144 + goff + u.pn * 256 + bj * 128 + wc * 32 + 8 * fq); }
#pragma unroll
            for (int m = 0; m < 4; ++m)
#pragma unroll
                for (int bj = 0; bj < 2; ++bj) { const int row = u.pm * 256 + ai * 128 + wr * 64 + m * 16 + fr; const int col = u.pn * 256 + bj * 128 + wc * 32 + 8 * fq;
                    f32x4 g0, g1; unpack8(gg[m][bj], g0, g1);
                    *(u32x4*)(O + (size_t)row * 2048 + col) = pack8(g0 * acc[ai][bj][m][0], g1 * acc[ai][bj][m][1]); }
            asm volatile("" ::: "memory");
        }
    }
};
struct EpiOut {
    const float* src_p; const float* src_s; float* dst_p; float* dst_s;
    __device__ __forceinline__ void operator()(const f32x4 (&acc)[2][2][4][2], const Unit& u) const {
        EPI_LANE
        const bool pr = u.pm * 256 < M_P;
        const float* src = pr ? src_p : src_s; float* dst = pr ? dst_p : dst_s; const int rbase = u.pm * 256 - (pr ? 0 : M_P);
#pragma unroll
        for (int ai = 0; ai < 2; ++ai)
#pragma unroll
            for (int mh = 0; mh < 2; ++mh) {
                f32x4 xx[2][2][2];
#pragma unroll
                for (int mm = 0; mm < 2; ++mm)
#pragma unroll
                    for (int bj = 0; bj < 2; ++bj) { const int m = mh * 2 + mm; const size_t off = (size_t)(rbase + ai * 128 + wr * 64 + m * 16 + fr) * 2048 + u.pn * 256 + bj * 128 + wc * 32 + 8 * fq;
                        xx[mm][bj][0] = *(const f32x4*)(src + off); xx[mm][bj][1] = *(const f32x4*)(src + off + 4); }
#pragma unroll
                for (int mm = 0; mm < 2; ++mm)
#pragma unroll
                    for (int bj = 0; bj < 2; ++bj) { const int m = mh * 2 + mm; const size_t off = (size_t)(rbase + ai * 128 + wr * 64 + m * 16 + fr) * 2048 + u.pn * 256 + bj * 128 + wc * 32 + 8 * fq;
                        *(f32x4*)(dst + off) = xx[mm][bj][0] + acc[ai][bj][m][0]; *(f32x4*)(dst + off + 4) = xx[mm][bj][1] + acc[ai][bj][m][1]; }
                asm volatile("" ::: "memory");
            }
    }
};

namespace att {
__device__ __forceinline__ int crow(int r, int hi) { return (r & 3) + 8 * (r >> 2) + 4 * hi; }
template <int ROWB> __device__ __forceinline__ int kswz(int row, int colB) { return row * ROWB + (colB ^ ((row & 7) << 4)); }
template <int NDV> __device__ __forceinline__ int v_st(int k, int c) { const int kk = (k & ~0xC) | ((k & 4) << 1) | ((k & 8) >> 1); return ((kk >> 3) * NDV + (c >> 5)) * 512 + ((kk & 7) * 32 + (c & 31)) * 2; }
__device__ __forceinline__ int v_rd_base(int lane) { return ((lane & 3) << 3) | (((lane >> 2) & 3) << 6) | (((lane >> 4) & 1) << 5) | (((lane >> 5) & 1) << 8); }

template <int NQA, int NQB, int NDV, int NKB, bool HAS_RK, int KROWB, int KR = 3>
__device__ __forceinline__ void tile_step(const bf16x8 (&qr)[NQA + NQB], f32x16 (&o)[NDV], float& m_reg, float& l_reg,
                                          const LAS char* Ks, const LAS char* Kp, int vb, const LAS float* rk, LAS float* al_l, int r32, int hi) {
    f32x16 p[NKB];
#pragma unroll
    for (int kb = 0; kb < NKB; ++kb)
#pragma unroll
        for (int r = 0; r < 16; ++r) p[kb][r] = 0.f;
    {
        auto kfrag = [&](int kb, int d) -> bf16x8 { return d < NQA ? *(const LAS bf16x8*)(Ks + kswz<KROWB>(kb * 32 + r32, (d * 16 + hi * 8) * 2)) : *(const LAS bf16x8*)(Kp + kswz<128>(kb * 32 + r32, ((d - NQA) * 16 + hi * 8) * 2)); };
        bf16x8 kf[KR][NKB];
#pragma unroll
        for (int a = 0; a < KR - 1; ++a)
#pragma unroll
            for (int kb = 0; kb < NKB; ++kb) kf[a][kb] = kfrag(kb, a);
#pragma unroll
        for (int d0 = 0; d0 < NQA + NQB; ++d0) {
            if (d0 + KR - 1 < NQA + NQB) {
#pragma unroll
                for (int kb = 0; kb < NKB; ++kb) kf[(d0 + KR - 1) % KR][kb] = kfrag(kb, d0 + KR - 1); }
#pragma unroll
            for (int kb = 0; kb < NKB; ++kb) p[kb] = __builtin_amdgcn_mfma_f32_32x32x16_bf16(kf[d0 % KR][kb], qr[d0], p[kb], 0, 0, 0);
        }
    }
    if (HAS_RK) {
#pragma unroll
        for (int kb = 0; kb < NKB; ++kb)
#pragma unroll
            for (int i = 0; i < 4; ++i) { const f32x4 s = *(const LAS f32x4*)(rk + kb * 32 + 8 * i + 4 * hi);
#pragma unroll
                for (int j = 0; j < 4; ++j) p[kb][4 * i + j] *= s[j]; }
    }
    float pmax = p[0][0];
#pragma unroll
    for (int kb = 0; kb < NKB; ++kb)
#pragma unroll
        for (int r = 0; r < 16; ++r) pmax = fmaxf(pmax, p[kb][r]);
    { auto rr = __builtin_amdgcn_permlane32_swap(__float_as_uint(pmax), __float_as_uint(pmax), false, false); pmax = fmaxf(__uint_as_float(rr[0]), __uint_as_float(rr[1])); }
    const float mn = fmaxf(m_reg, pmax); const float alpha = __builtin_amdgcn_exp2f(m_reg - mn); m_reg = mn;
    float ps = 0.f;
#pragma unroll
    for (int kb = 0; kb < NKB; ++kb)
#pragma unroll
        for (int r = 0; r < 16; ++r) { p[kb][r] = __builtin_amdgcn_exp2f(p[kb][r] - mn); ps += p[kb][r]; }
    { auto rr = __builtin_amdgcn_permlane32_swap(__float_as_uint(ps), __float_as_uint(ps), false, false); ps = __uint_as_float(rr[0]) + __uint_as_float(rr[1]); }
    l_reg = l_reg * alpha + ps;
    if (__any(alpha < 1.f)) {
        if (hi == 0) al_l[r32] = alpha;
        LDS_WAIT();
        float al[16];
#pragma unroll
        for (int r = 0; r < 16; ++r) al[r] = al_l[crow(r, hi)];
#pragma unroll
        for (int d = 0; d < NDV; ++d)
#pragma unroll
            for (int r = 0; r < 16; ++r) o[d][r] *= al[r];
    }
    bf16x8 pa[2 * NKB];
#pragma unroll
    for (int kb = 0; kb < NKB; ++kb)
#pragma unroll
        for (int hf = 0; hf < 2; ++hf) { const int B = hf * 8;
            const unsigned a0 = cvt_pk_bf16(p[kb][B + 0], p[kb][B + 1]), a1 = cvt_pk_bf16(p[kb][B + 2], p[kb][B + 3]);
            const unsigned b0 = cvt_pk_bf16(p[kb][B + 4], p[kb][B + 5]), b1 = cvt_pk_bf16(p[kb][B + 6], p[kb][B + 7]);
            auto r0 = __builtin_amdgcn_permlane32_swap(a0, b0, false, false); auto r1 = __builtin_amdgcn_permlane32_swap(a1, b1, false, false);
            u32x4 w = {r0[0], r1[0], r0[1], r1[1]}; pa[kb * 2 + hf] = __builtin_bit_cast(bf16x8, w); }
#pragma unroll
    for (int d0 = 0; d0 < NDV; ++d0) {
        s16x4 lo[2 * NKB], hh[2 * NKB];
#pragma unroll
        for (int ks = 0; ks < 2 * NKB; ++ks) {
            asm volatile("ds_read_b64_tr_b16 %0, %1 offset:%c2" : "=&v"(lo[ks]) : "v"(vb), "i"(d0 * 512 + ks * (NDV * 1024)) : "memory");
            asm volatile("ds_read_b64_tr_b16 %0, %1 offset:%c2" : "=&v"(hh[ks]) : "v"(vb), "i"(d0 * 512 + ks * (NDV * 1024) + NDV * 512) : "memory"); }
        asm volatile("s_waitcnt lgkmcnt(0)" ::: "memory"); __builtin_amdgcn_sched_barrier(0);
#pragma unroll
        for (int ks = 0; ks < 2 * NKB; ++ks) { const bf16x8 vf = (bf16x8){lo[ks][0], lo[ks][1], lo[ks][2], lo[ks][3], hh[ks][0], hh[ks][1], hh[ks][2], hh[ks][3]};
            o[d0] = __builtin_amdgcn_mfma_f32_32x32x16_bf16(pa[ks], vf, o[d0], 0, 0, 0); }
    }
}
typedef short v4i16_t __attribute__((ext_vector_type(4)));
__device__ __forceinline__ s16x4 vtr(const LAS char* p) { return __builtin_bit_cast(s16x4, __builtin_amdgcn_ds_read_tr16_b64_v4i16((LAS v4i16_t*)p)); }
template <int NQA, int NQB, int NDV, int NKB, int KROWB, int NDVT = NDV>
__device__ __forceinline__ void tile_step_fs(const bf16x8 (&qr)[NQA + NQB], f32x16 (&o)[NDV], float& l_part,
                                             const LAS char* Ks, const LAS char* Kp, const LAS char* vbp, const LAS float* rk, float negB2, int r32, int hi) {
    f32x16 p[NKB];
#pragma unroll
    for (int kb = 0; kb < NKB; ++kb)
#pragma unroll
        for (int r = 0; r < 16; ++r) p[kb][r] = 0.f;
    bf16x8 ka[NKB], kn[NKB];
#pragma unroll
    for (int kb = 0; kb < NKB; ++kb) ka[kb] = *(const LAS bf16x8*)(Ks + kswz<KROWB>(kb * 32 + r32, hi * 16));
#pragma unroll
    for (int d0 = 0; d0 < NQA + NQB; ++d0) {
        if (d0 + 1 < NQA + NQB) {
#pragma unroll
            for (int kb = 0; kb < NKB; ++kb) { const int d1 = d0 + 1;
                kn[kb] = d1 < NQA ? *(const LAS bf16x8*)(Ks + kswz<KROWB>(kb * 32 + r32, (d1 * 16 + hi * 8) * 2)) : *(const LAS bf16x8*)(Kp + kswz<128>(kb * 32 + r32, ((d1 - NQA) * 16 + hi * 8) * 2)); } }
#pragma unroll
        for (int kb = 0; kb < NKB; ++kb) p[kb] = __builtin_amdgcn_mfma_f32_32x32x16_bf16(ka[kb], qr[d0], p[kb], 0, 0, 0);
#pragma unroll
        for (int kb = 0; kb < NKB; ++kb) ka[kb] = kn[kb];
    }
#pragma unroll
    for (int kb = 0; kb < NKB; ++kb) {
        float ps = 0.f;
#pragma unroll
        for (int i = 0; i < 4; ++i) { const f32x4 s = *(const LAS f32x4*)(rk + kb * 32 + 8 * i + 4 * hi);
#pragma unroll
            for (int j = 0; j < 4; ++j) { const float e = __builtin_amdgcn_exp2f(fmaf(p[kb][4 * i + j], s[j], negB2)); p[kb][4 * i + j] = e; ps += e; } }
        l_part += ps;
        bf16x8 pa[2];
#pragma unroll
        for (int hf = 0; hf < 2; ++hf) { const int B = hf * 8;
            const unsigned a0 = cvt_pk_bf16(p[kb][B + 0], p[kb][B + 1]), a1 = cvt_pk_bf16(p[kb][B + 2], p[kb][B + 3]);
            const unsigned b0 = cvt_pk_bf16(p[kb][B + 4], p[kb][B + 5]), b1 = cvt_pk_bf16(p[kb][B + 6], p[kb][B + 7]);
            auto r0 = __builtin_amdgcn_permlane32_swap(a0, b0, false, false); auto r1 = __builtin_amdgcn_permlane32_swap(a1, b1, false, false);
            u32x4 w = {r0[0], r1[0], r0[1], r1[1]}; pa[hf] = __builtin_bit_cast(bf16x8, w); }
#pragma unroll
        for (int hf = 0; hf < 2; ++hf) { const int ks = kb * 2 + hf;
            bf16x8 vf[NDV];
#pragma unroll
            for (int d0 = 0; d0 < NDV; ++d0) { const s16x4 lo = vtr(vbp + d0 * 512 + ks * (NDVT * 1024)), hh = vtr(vbp + d0 * 512 + ks * (NDVT * 1024) + NDVT * 512);
                vf[d0] = (bf16x8){lo[0], lo[1], lo[2], lo[3], hh[0], hh[1], hh[2], hh[3]}; }
#pragma unroll
            for (int d0 = 0; d0 < NDV; ++d0) o[d0] = __builtin_amdgcn_mfma_f32_32x32x16_bf16(pa[hf], vf[d0], o[d0], 0, 0, 0); }
    }
}
template <int NQA, int NQB, int NKB, int KROWB>
__device__ __forceinline__ void qk_sm(const bf16x8 (&qr)[NQA + NQB], float& l_part, const LAS char* Ks, const LAS char* Kp, const LAS float* rk, float negB2, int r32, int hi, bf16x8 (&pa)[2 * NKB]) {
    f32x16 p[NKB];
#pragma unroll
    for (int kb = 0; kb < NKB; ++kb)
#pragma unroll
        for (int r = 0; r < 16; ++r) p[kb][r] = 0.f;
    auto kfrag = [&](int kb, int d) -> bf16x8 { return d < NQA ? *(const LAS bf16x8*)(Ks + kswz<KROWB>(kb * 32 + r32, (d * 16 + hi * 8) * 2)) : *(const LAS bf16x8*)(Kp + kswz<128>(kb * 32 + r32, ((d - NQA) * 16 + hi * 8) * 2)); };
    bf16x8 kf[3][NKB];
#pragma unroll
    for (int kb = 0; kb < NKB; ++kb) { kf[0][kb] = kfrag(kb, 0); kf[1][kb] = kfrag(kb, 1); }
#pragma unroll
    for (int d0 = 0; d0 < NQA + NQB; ++d0) {
        if (d0 + 2 < NQA + NQB) {
#pragma unroll
            for (int kb = 0; kb < NKB; ++kb) kf[(d0 + 2) % 3][kb] = kfrag(kb, d0 + 2); }
#pragma unroll
        for (int kb = 0; kb < NKB; ++kb) p[kb] = __builtin_amdgcn_mfma_f32_32x32x16_bf16(kf[d0 % 3][kb], qr[d0], p[kb], 0, 0, 0);
    }
    f32x4 sc[NKB][4];
#pragma unroll
    for (int kb = 0; kb < NKB; ++kb)
#pragma unroll
        for (int i = 0; i < 4; ++i) sc[kb][i] = *(const LAS f32x4*)(rk + kb * 32 + 8 * i + 4 * hi);
#pragma unroll
    for (int kb = 0; kb < NKB; ++kb) {
        float ps = 0.f;
#pragma unroll
        for (int i = 0; i < 4; ++i) {
#pragma unroll
            for (int j = 0; j < 4; ++j) { const float e = __builtin_amdgcn_exp2f(fmaf(p[kb][4 * i + j], sc[kb][i][j], negB2)); p[kb][4 * i + j] = e; ps += e; } }
        l_part += ps;
#pragma unroll
        for (int hf = 0; hf < 2; ++hf) { const int B = hf * 8;
            const unsigned a0 = cvt_pk_bf16(p[kb][B + 0], p[kb][B + 1]), a1 = cvt_pk_bf16(p[kb][B + 2], p[kb][B + 3]);
            const unsigned b0 = cvt_pk_bf16(p[kb][B + 4], p[kb][B + 5]), b1 = cvt_pk_bf16(p[kb][B + 6], p[kb][B + 7]);
            auto r0 = __builtin_amdgcn_permlane32_swap(a0, b0, false, false); auto r1 = __builtin_amdgcn_permlane32_swap(a1, b1, false, false);
            u32x4 w = {r0[0], r1[0], r0[1], r1[1]}; pa[kb * 2 + hf] = __builtin_bit_cast(bf16x8, w); }
    }
}
template <int NDV, int NKB>
__device__ __forceinline__ void pv_fs(f32x16 (&o)[NDV], const LAS char* vbp, const bf16x8 (&pa)[2 * NKB]) {
    const int vb = (int)(uintptr_t)vbp;
    s16x4 lo[2][NDV], hh[2][NDV];
    __builtin_amdgcn_sched_barrier(0);
#pragma unroll
    for (int d0 = 0; d0 < NDV; ++d0) {
        asm volatile("ds_read_b64_tr_b16 %0, %1 offset:%c2" : "=&v"(lo[0][d0]) : "v"(vb), "i"(d0 * 512) : "memory");
        asm volatile("ds_read_b64_tr_b16 %0, %1 offset:%c2" : "=&v"(hh[0][d0]) : "v"(vb), "i"(d0 * 512 + NDV * 512) : "memory"); }
#pragma unroll
    for (int ks = 0; ks < 2 * NKB; ++ks) {
        if (ks + 1 < 2 * NKB) {
#pragma unroll
            for (int d0 = 0; d0 < NDV; ++d0) {
                asm volatile("ds_read_b64_tr_b16 %0, %1 offset:%c2" : "=&v"(lo[(ks + 1) & 1][d0]) : "v"(vb), "i"(d0 * 512 + (ks + 1) * (NDV * 1024)) : "memory");
                asm volatile("ds_read_b64_tr_b16 %0, %1 offset:%c2" : "=&v"(hh[(ks + 1) & 1][d0]) : "v"(vb), "i"(d0 * 512 + (ks + 1) * (NDV * 1024) + NDV * 512) : "memory"); }
            asm volatile("s_waitcnt lgkmcnt(%0)" :: "n"(2 * NDV) : "memory");
        } else asm volatile("s_waitcnt lgkmcnt(0)" ::: "memory");
        __builtin_amdgcn_sched_barrier(0);
#pragma unroll
        for (int d0 = 0; d0 < NDV; ++d0) { const s16x4 l_ = lo[ks & 1][d0], h_ = hh[ks & 1][d0];
            const bf16x8 vf = (bf16x8){l_[0], l_[1], l_[2], l_[3], h_[0], h_[1], h_[2], h_[3]};
            o[d0] = __builtin_amdgcn_mfma_f32_32x32x16_bf16(pa[ks], vf, o[d0], 0, 0, 0); }
        __builtin_amdgcn_sched_barrier(0);
    }
}
__device__ __forceinline__ float lane_pair_sum(float x) { auto rr = __builtin_amdgcn_permlane32_swap(__float_as_uint(x), __float_as_uint(x), false, false); return __uint_as_float(rr[0]) + __uint_as_float(rr[1]); }
template <int NDV>
__device__ __forceinline__ void finish(const f32x16 (&o)[NDV], float l_reg, LAS float* al_l, bf16_t* out, const bf16_t* z, int ld, int r32, int hi) {
    if (hi == 0) al_l[r32] = l_reg;
    LDS_WAIT();
    const bool odd = r32 & 1;
#pragma unroll
    for (int r = 0; r < 16; r += 2) { const int orow = crow(r, hi);
        const float rl0 = __builtin_amdgcn_rcpf(al_l[orow]), rl1 = __builtin_amdgcn_rcpf(al_l[orow + 1]);
#pragma unroll
        for (int d0 = 0; d0 < NDV; ++d0) {
            const float a = o[d0][r] * rl0, b = o[d0][r + 1] * rl1;
            const float recv = __shfl_xor(odd ? a : b, 1);
            const float v0 = odd ? recv : a, v1 = odd ? b : recv;
            const size_t idx = (size_t)(orow + (odd ? 1 : 0)) * ld + d0 * 32 + (r32 & ~1);
            const unsigned zw = *(const unsigned*)(z + idx);
            *(unsigned*)(out + idx) = cvt_pk_bf16(v0 * bf_lo(zw), v1 * bf_hi(zw)); } }
}
}

#define XB_TMO      128
#define XB_XCNT(j)  (256  + 64 * (j))
#define XB_XSUB(j)  (1280 + 64 * (j))
#define XB_XGEN(j)  (2304 + 64 * (j))
#define XB_TOP      3328
#define XB_TOPGEN   3392
#define XCD_BAR_WORDS 3456
#define XB_SPIN_CAP (1u << 18)
__device__ __forceinline__ unsigned xb_ld(unsigned* p)              { return __hip_atomic_load(p, __ATOMIC_RELAXED, __HIP_MEMORY_SCOPE_AGENT); }
__device__ __forceinline__ unsigned xb_add(unsigned* p, unsigned v) { return __hip_atomic_fetch_add(p, v, __ATOMIC_RELAXED, __HIP_MEMORY_SCOPE_AGENT); }
__device__ __forceinline__ unsigned xb_xcc_id() { return (unsigned)__builtin_amdgcn_s_getreg((3 << 11) | 20) & 0xFu; }
#define XB_SPIN(cond, bar) do { unsigned _sp = 0; while (cond) { __builtin_amdgcn_s_sleep(1); \
    if ((++_sp & 255u) == 0u) { if (xb_ld(&(bar)[XB_TMO])) break; if (_sp > XB_SPIN_CAP) { atomicAdd(&(bar)[XB_TMO], 1u); break; } } } } while (0)
struct XcdBarrier { unsigned* bar; unsigned x; volatile LAS unsigned* st; };
__device__ __forceinline__ XcdBarrier xcd_barrier_post(unsigned* bar, volatile LAS unsigned* st) {
    XcdBarrier b; b.bar = bar; b.x = xb_xcc_id(); b.st = st;
    if (threadIdx.x == 0) (void)xb_add(&bar[XB_XCNT(b.x)], 1u);
    return b;
}
__device__ __forceinline__ void xcd_barrier_complete(unsigned* bar, unsigned x, unsigned& nloc, unsigned& nx) {
    const unsigned G = gridDim.x * gridDim.y * gridDim.z;
    unsigned sum, cnt, mine, sp = 0u;
    for (;;) {
        sum = 0u; cnt = 0u; mine = 0u;
#pragma unroll
        for (unsigned j = 0; j < 16; ++j) { const unsigned c = xb_ld(&bar[XB_XCNT(j)]); sum += c; cnt += (c > 0u) ? 1u : 0u; mine = (j == x) ? c : mine; }
        if (sum == G) break;
        __builtin_amdgcn_s_sleep(1);
        if ((++sp & 255u) == 0u) { if (xb_ld(&bar[XB_TMO])) break; if (sp > XB_SPIN_CAP) { atomicAdd(&bar[XB_TMO], 1u); break; } }
    }
    nloc = mine > 0u ? mine : 1u; nx = cnt > 0u ? cnt : 1u;
}
__device__ __forceinline__ void xcd_barrier(const XcdBarrier& b) {
    asm volatile("s_waitcnt vmcnt(0)" ::: "memory");
    __syncthreads();
    if (threadIdx.x == 0) {
        unsigned* bar = b.bar; asm volatile("" : "+s"(bar));
        __builtin_amdgcn_s_waitcnt(0);
        unsigned nloc = b.st[0], nx = b.st[1];
        if (nloc == 0u) { xcd_barrier_complete(bar, b.x, nloc, nx); b.st[0] = nloc; b.st[1] = nx; }
        const unsigned old = xb_add(&bar[XB_XSUB(b.x)], 1u);
        const unsigned gen = old / nloc;
        if (old + 1u == (gen + 1u) * nloc) {
            __builtin_amdgcn_fence(__ATOMIC_RELEASE, "agent");
            asm volatile("s_waitcnt vmcnt(0)" ::: "memory");
            const unsigned og = xb_add(&bar[XB_TOP], 1u);
            const unsigned tg = og / nx;
            if (og + 1u == (tg + 1u) * nx) xb_add(&bar[XB_TOPGEN], 1u);
            else XB_SPIN(xb_ld(&bar[XB_TOPGEN]) == tg, bar);
            __builtin_amdgcn_fence(__ATOMIC_ACQUIRE, "agent");
            xb_add(&bar[XB_XGEN(b.x)], 1u);
            asm volatile("s_waitcnt vmcnt(0)" ::: "memory");
        } else {
            XB_SPIN(xb_ld(&bar[XB_XGEN(b.x)]) == gen, bar);
            __builtin_amdgcn_fence(__ATOMIC_ACQUIRE, "agent");
            asm volatile("s_waitcnt vmcnt(0)" ::: "memory");
        }
    }
    __syncthreads();
}

struct Args { const float* in[31]; float* out; unsigned char* ws; int ph_lo, ph_hi; };
typedef const float* const __attribute__((address_space(4)))* karg_in_t;
struct Ctx {
    LAS unsigned char* lds;
    karg_in_t in; float* out; unsigned char* ws;
    int tid, lane, wave, G, bid;
};
enum { I_XP = 0, I_XS, I_MEM, I_CCKV, I_CKR, I_CMK, I_CMV, I_SCONV, I_GPRE, I_WIN, I_GQLAT, I_WUQ, I_GKVLAT, I_WUKV, I_GQN, I_GKN, I_CONVW, I_CONVB, I_LNG, I_LNB,
       I_WPW2, I_BPW2, I_GMEM, I_WMEM, I_GXQ, I_GXK, I_WPM, I_WPC, I_WPX, I_BMERGE, I_WOUT };

__device__ __forceinline__ int win_src_col(int nd) {
    if (nd < 1088) return nd;
    if (nd < 1280) return -1;
    if (nd >= 3328 && nd < 5376) { const int t = (nd - 3328) >> 8, w = (nd - 3328) & 255; return w < 128 ? 3136 + t * 128 + w : 4160 + t * 128 + (w - 128); }
    return nd - 192;
}
__device__ __forceinline__ void transpose_item(const float* W, int K, int Nsrc, bf16_t* WT, const float* gain, int mapmode, LAS float* scr, int item, int nblk, int lane) {
    const int kb = item / nblk, nb = item % nblk, k0 = 64 * kb, nd0 = 64 * nb;
    const int ns0 = mapmode == 1 ? win_src_col(nd0) : (mapmode == 2 ? (nd0 >> 7) * 256 + (nd0 & 127) : nd0);
    const int lk = lane >> 4, ln4 = (lane & 15) * 4;
    f32x4 v[16];
#pragma unroll
    for (int i = 0; i < 16; ++i) v[i] = ns0 >= 0 ? *(const f32x4*)(W + (size_t)(k0 + lk + 4 * i) * Nsrc + ns0 + ln4) : (f32x4){0.f, 0.f, 0.f, 0.f};
#pragma unroll
    for (int i = 0; i < 16; ++i) { LAS float* p = scr + (lk + 4 * i) * 65 + ln4; p[0] = v[i][0]; p[1] = v[i][1]; p[2] = v[i][2]; p[3] = v[i][3]; }
    LDS_WAIT(); asm volatile("" ::: "memory");
    const int c = lane & 7;
    f32x4 g0 = {1.f, 1.f, 1.f, 1.f}, g1 = {1.f, 1.f, 1.f, 1.f};
    if (gain) { g0 = *(const f32x4*)(gain + k0 + 8 * c); g1 = *(const f32x4*)(gain + k0 + 8 * c + 4); }
#pragma unroll
    for (int j = 0; j < 8; ++j) { const int n = (lane >> 3) + 8 * j; const LAS float* sp = scr + (8 * c) * 65 + n;
        u32x4 o; o.x = cvt_pk_bf16(sp[0 * 65] * g0[0], sp[1 * 65] * g0[1]); o.y = cvt_pk_bf16(sp[2 * 65] * g0[2], sp[3 * 65] * g0[3]);
        o.z = cvt_pk_bf16(sp[4 * 65] * g1[0], sp[5 * 65] * g1[1]); o.w = cvt_pk_bf16(sp[6 * 65] * g1[2], sp[7 * 65] * g1[3]);
        *(u32x4*)(WT + (size_t)(nd0 + n) * K + k0 + 8 * c) = o; }
    LDS_WAIT(); asm volatile("" ::: "memory");
}
__device__ __forceinline__ bool h_early_ok(int G) { const int n2 = (M / 256) * (2048 / 256) - G; return n2 > 0 && n2 < G; }
constexpr unsigned PW_ALL = 0x3ffu, PW_EARLY = PW_ALL & ~(1u << 8);
__device__ __forceinline__ void prep_weights(const Ctx& F, int l, int gw, int NGW, unsigned jobs) {
    LAS float* scr = (LAS float*)(F.lds + F.wave * 16640);
    int base = 0;
#pragma unroll 1
    for (int job = 0; job < 10; ++job) {
        if (!((jobs >> job) & 1u)) continue;
        const float* W; int K, Nsrc, Ndst; size_t dst; const float* gain = nullptr; int winmap = 0;
        switch (job) {
            case 0: W = F.in[I_WIN] + (size_t)l * 2048 * IN_COLS; K = 2048; Nsrc = IN_COLS; Ndst = IN_PAD; dst = WS_WIN; gain = F.in[I_GPRE] + l * 2048; winmap = 1; break;
            case 1: W = F.in[I_WUQ] + (size_t)l * 512 * 3072; K = 512; Nsrc = 3072; Ndst = 3072; dst = WS_WUQ; gain = F.in[I_GQLAT] + l * 512; break;
            case 2: W = F.in[I_WUKV] + (size_t)l * 512 * 4096; K = 512; Nsrc = 4096; Ndst = 4096; dst = WS_WUKV; gain = F.in[I_GKVLAT] + l * 512; break;
            case 3: W = F.in[I_WPW2] + (size_t)l * 1024 * 1024; K = 1024; Nsrc = 1024; Ndst = 1024; dst = WS_WPW2; break;
            case 4: W = F.in[I_WMEM] + (size_t)l * 2048 * 2048; K = 2048; Nsrc = 2048; Ndst = 2048; dst = WS_WMEM; gain = F.in[I_GMEM] + l * 2048; break;
            case 5: W = F.in[I_WPM] + (size_t)l * 2048 * 2048; K = 2048; Nsrc = 2048; Ndst = 2048; dst = WS_WPM; break;
            case 6: W = F.in[I_WPC] + (size_t)l * 1024 * 2048; K = 1024; Nsrc = 2048; Ndst = 2048; dst = WS_WPC; break;
            case 7: W = F.in[I_WPX] + (size_t)l * 1024 * 2048; K = 1024; Nsrc = 2048; Ndst = 2048; dst = WS_WPX; break;
            case 8: W = F.in[I_WOUT] + (size_t)l * 2048 * 2048; K = 2048; Nsrc = 2048; Ndst = 2048; dst = WS_WOUT; break;
            default: W = F.in[I_WUKV] + (size_t)l * 512 * 4096; K = 512; Nsrc = 4096; Ndst = 2048; dst = WS_WUK; gain = F.in[I_GKVLAT] + l * 512; winmap = 2; break;
        }
        const int nblk = Ndst / 64, nitems = (K / 64) * nblk;
        bf16_t* WT = (bf16_t*)(F.ws + dst);
        int first = (gw - base) % NGW; if (first < 0) first += NGW;
        for (int it = first; it < nitems; it += NGW) transpose_item(W, K, Nsrc, WT, gain, winmap, scr, it, nblk, F.lane);
        base += nitems;
    }
}
__device__ __forceinline__ void rms_row_2048(const float* xrow, bf16_t* orow, int lane) {
    const f32x4* xr = (const f32x4*)xrow + lane;
    f32x4 v[8]; float s = 0.f;
#pragma unroll
    for (int j = 0; j < 8; ++j) { v[j] = xr[64 * j]; s += (v[j][0] * v[j][0] + v[j][1] * v[j][1]) + (v[j][2] * v[j][2] + v[j][3] * v[j][3]); }
    const float r = 1.0f / sqrtf(wave_sum(s) * (1.f / 2048.f) + EPS);
    u32x2* o8 = (u32x2*)orow + lane;
#pragma unroll
    for (int j = 0; j < 8; ++j) { u32x2 w; w.x = cvt_pk_bf16(v[j][0] * r, v[j][1] * r); w.y = cvt_pk_bf16(v[j][2] * r, v[j][3] * r); o8[64 * j] = w; }
}
__device__ __forceinline__ void rms_row_512(const float* xrow, bf16_t* orow, int lane) {
    const f32x4* xr = (const f32x4*)xrow + lane;
    f32x4 v[2]; float s = 0.f;
#pragma unroll
    for (int j = 0; j < 2; ++j) { v[j] = xr[64 * j]; s += (v[j][0] * v[j][0] + v[j][1] * v[j][1]) + (v[j][2] * v[j][2] + v[j][3] * v[j][3]); }
    const float r = 1.0f / sqrtf(wave_sum(s) * (1.f / 512.f) + EPS);
    u32x2* o8 = (u32x2*)orow + lane;
#pragma unroll
    for (int j = 0; j < 2; ++j) { u32x2 w; w.x = cvt_pk_bf16(v[j][0] * r, v[j][1] * r); w.y = cvt_pk_bf16(v[j][2] * r, v[j][3] * r); o8[64 * j] = w; }
}
__device__ __forceinline__ void kpe_row(const float* kr, const float* gkpe, const float* ropetab, int pos, bf16_t* kpe, float* sspe, int lane) {
    const float x = kr[lane]; const float ss = wave_sum(x * x);
    const float xg = x * gkpe[lane]; const float other = __shfl_xor(xg, 32);
    const f32x2 cs = *(const f32x2*)(ropetab + ((size_t)pos * 32 + (lane & 31)) * 2);
    const float o = lane < 32 ? xg * cs.x - other * cs.y : xg * cs.x + other * cs.y;
    kpe[lane] = (bf16_t)(cvt_pk_bf16(o, 0.f) & 0xffffu);
    if (lane == 0) *sspe = ss;
}
template <int R>
__device__ __forceinline__ void rms_rows_512(const float* x0, bf16_t* o0, int lane) {
    f32x4 v[R][2]; float s[R];
#pragma unroll
    for (int r = 0; r < R; ++r) { const f32x4* xr = (const f32x4*)(x0 + (size_t)r * 512) + lane;
#pragma unroll
        for (int j = 0; j < 2; ++j) v[r][j] = xr[64 * j]; }
#pragma unroll
    for (int r = 0; r < R; ++r) { s[r] = 0.f;
#pragma unroll
        for (int j = 0; j < 2; ++j) s[r] += (v[r][j][0] * v[r][j][0] + v[r][j][1] * v[r][j][1]) + (v[r][j][2] * v[r][j][2] + v[r][j][3] * v[r][j][3]); }
#pragma unroll
    for (int o = 1; o < 64; o <<= 1)
#pragma unroll
        for (int r = 0; r < R; ++r) s[r] += __shfl_xor(s[r], o);
#pragma unroll
    for (int r = 0; r < R; ++r) { const float rr = 1.0f / sqrtf(s[r] * (1.f / 512.f) + EPS); u32x2* o8 = (u32x2*)(o0 + (size_t)r * 512) + lane;
#pragma unroll
        for (int j = 0; j < 2; ++j) { u32x2 w; w.x = cvt_pk_bf16(v[r][j][0] * rr, v[r][j][1] * rr); w.y = cvt_pk_bf16(v[r][j][2] * rr, v[r][j][3] * rr); o8[64 * j] = w; } }
}
template <int R>
__device__ __forceinline__ void kpe_rows(const float* kr0, float gk, const float* ropetab, int pos0, bf16_t* kpe0, float* sspe0, int lane) {
    float x[R], ss[R]; f32x2 cs[R];
#pragma unroll
    for (int r = 0; r < R; ++r) { x[r] = kr0[(size_t)r * 64 + lane]; cs[r] = *(const f32x2*)(ropetab + ((size_t)(pos0 + r) * 32 + (lane & 31)) * 2); }
#pragma unroll
    for (int r = 0; r < R; ++r) ss[r] = x[r] * x[r];
#pragma unroll
    for (int o = 1; o < 64; o <<= 1)
#pragma unroll
        for (int r = 0; r < R; ++r) ss[r] += __shfl_xor(ss[r], o);
#pragma unroll
    for (int r = 0; r < R; ++r) { const float xg = x[r] * gk; const float other = __shfl_xor(xg, 32);
        const float o = lane < 32 ? xg * cs[r].x - other * cs[r].y : xg * cs[r].x + other * cs[r].y;
        kpe0[(size_t)r * 64 + lane] = (bf16_t)(cvt_pk_bf16(o, 0.f) & 0xffffu);
        if (lane == 0) sspe0[r] = ss[r]; }
}
__device__ __forceinline__ const float* x_row(const Ctx& F, int l, int row) {
    if (l == 0) return row < M_P ? F.in[I_XP] + (size_t)row * 2048 : F.in[I_XS] + (size_t)(row - M_P) * 2048;
    return (const float*)(F.ws + WS_X1) + (size_t)row * 2048;
}
__device__ __forceinline__ void past_kpe(const Ctx& F, int l);
__device__ __forceinline__ void phase_prep(const Ctx& F, int l) {
    const int gw = F.bid * 8 + F.wave, NGW = F.G * 8;
    float* ropetab = (float*)(F.ws + WS_ROPE);
    if (l == 0) {
        for (int i = gw * 64 + F.lane; i < 8192 * 32; i += NGW * 64) { const int pos = i >> 5, j = i & 31;
            const float inv = powf(10000.f, -(float)j / 32.f); const float ang = (float)pos * inv;
            const double a = (double)ang; const double n = rint(a * 0.15915494309189535); const float red = (float)(a - n * 6.283185307179586);
            ropetab[2 * i] = cosf(red); ropetab[2 * i + 1] = sinf(red); }
        for (int r = gw; r < N_MEM; r += NGW) rms_row_2048(F.in[I_MEM] + (size_t)r * 2048, (bf16_t*)(F.ws + WS_MEMN) + (size_t)r * 2048, F.lane);
    }
    prep_weights(F, l, gw, NGW, (l == 1 && h_early_ok(F.G)) ? (PW_ALL & ~PW_EARLY) : PW_ALL);
    for (int r = gw; r < M; r += NGW) rms_row_2048(x_row(F, l, r), (bf16_t*)(F.ws + WS_HB) + (size_t)r * 2048, F.lane);
#ifdef DUP_P2
    for (int r = gw; r < M; r += NGW) rms_row_2048(x_row(F, l, r), (bf16_t*)(F.ws + WS_HB) + (size_t)r * 2048, F.lane);
#endif
    const float* cc = F.in[I_CCKV] + (size_t)l * MPAST * 512;
    for (int r = gw * 4; r < MPAST; r += NGW * 4) rms_rows_512<4>(cc + (size_t)r * 512, (bf16_t*)(F.ws + WS_CNP) + (size_t)r * 512, F.lane);
    if (l > 0) past_kpe(F, l);
#ifdef DUP_P3
    for (int r = gw * 4; r < MPAST; r += NGW * 4) rms_rows_512<4>(cc + (size_t)r * 512, (bf16_t*)(F.ws + WS_CNP) + (size_t)r * 512, F.lane);
#endif
}
__device__ __forceinline__ void past_kpe(const Ctx& F, int l) {
    const int gw = F.bid * 8 + F.wave, NGW = F.G * 8;
    const float* ropetab = (const float*)(F.ws + WS_ROPE);
    const float* ck = F.in[I_CKR] + (size_t)l * MPAST * 64; const float* gk = F.in[I_GKN] + l * QK_HEAD + 128;
    const float gkl = gk[F.lane];
    for (int r = gw * 4; r < MPAST; r += NGW * 4) kpe_rows<4>(ck + (size_t)r * 64, gkl, ropetab, r & (PAST - 1), (bf16_t*)(F.ws + WS_KPEP) + (size_t)r * 64, (float*)(F.ws + WS_SSPEP) + r, F.lane);
}

__device__ __forceinline__ void glds16(const void* g, LAS void* l) { unsigned keep; const unsigned dst = (unsigned)(uintptr_t)l;
    asm volatile("s_mov_b32 %0, m0\n\ts_mov_b32 m0, %2\n\ts_nop 0\n\tglobal_load_lds_dwordx4 %1, off\n\ts_mov_b32 m0, %0" : "=&s"(keep) : "v"(g), "s"(dst) : "memory"); }
__device__ __forceinline__ void glds16s(const void* sbase, unsigned voff, LAS void* l) { const unsigned dst = (unsigned)(uintptr_t)l;
    asm volatile("s_mov_b32 m0, %2\n\ts_nop 0\n\tglobal_load_lds_dwordx4 %0, %1" :: "v"(voff), "s"(sbase), "s"(dst) : "memory", "m0"); }
__device__ __forceinline__ void glds4s(const void* sbase, unsigned voff, LAS void* l) { const unsigned dst = (unsigned)(uintptr_t)l;
    asm volatile("s_mov_b32 m0, %2\n\ts_nop 0\n\tglobal_load_lds_dword %0, %1" :: "v"(voff), "s"(sbase), "s"(dst) : "memory", "m0"); }
__device__ __forceinline__ void glds4(const void* g, LAS void* l) { unsigned keep; const unsigned dst = (unsigned)(uintptr_t)l;
    asm volatile("s_mov_b32 %0, m0\n\ts_mov_b32 m0, %2\n\ts_nop 0\n\tglobal_load_lds_dword %1, off\n\ts_mov_b32 m0, %0" : "=&s"(keep) : "v"(g), "s"(dst) : "memory"); }
template <int CR, int SB>
__device__ __forceinline__ void conv_chunk(const Ctx& F, int l, int tid, int seq0, int r0, int seqlen, int bb) {
    constexpr int CWIN = CR + CONV_ST;
    const int lane = tid & 63, wv = __builtin_amdgcn_readfirstlane(tid >> 6);
    asm volatile("" : "+s"(l));
    const float* cw = F.in[I_CONVW] + (size_t)l * CONV_K * 1024; const float* cb = F.in[I_CONVB] + l * 1024;
    const float* lg = F.in[I_LNG] + l * 1024; const float* lb = F.in[I_LNB] + l * 1024;
    const float* st = F.in[I_SCONV] + (size_t)l * NSTREAM * CONV_ST * 1024;
    const bf16_t* ub = (const bf16_t*)(F.ws + WS_UB); bf16_t* cv = (bf16_t*)(F.ws + WS_CV);
    LAS unsigned char* win = F.lds;
    LAS f32x2* red = (LAS f32x2*)(F.lds + CWIN * 2048);
    LAS f32x2* stat = red + 8 * SB;
    const int nh = r0 < CONV_ST ? CONV_ST - r0 : 0;
    for (int hr = 2 * nh + wv; hr < 2 * CWIN; hr += 8)
#ifdef CONV_NODMA
        *(LAS u32x4*)(win + hr * 1024 + lane * 16) = *(const u32x4*)(ub + (size_t)(seq0 + r0 - CONV_ST + (hr >> 1)) * 1024 + (hr & 1) * 512 + lane * 8);
#else
        glds16(ub + (size_t)(seq0 + r0 - CONV_ST + (hr >> 1)) * 1024 + (hr & 1) * 512 + lane * 8, win + hr * 1024);
#endif
    if (bb >= 0) {
        for (int hr0 = wv; hr0 < 2 * nh; hr0 += 32) { f32x4 a[4], b[4];
#pragma unroll
            for (int q = 0; q < 4; ++q) { const int hr = min(hr0 + 8 * q, 2 * nh - 1); const float* sp = st + ((size_t)bb * CONV_ST + r0 + (hr >> 1)) * 1024 + (hr & 1) * 512 + lane * 8; a[q] = *(const f32x4*)sp; b[q] = *(const f32x4*)(sp + 4); }
#pragma unroll
            for (int q = 0; q < 4; ++q) if (hr0 + 8 * q < 2 * nh) *(LAS u32x4*)(win + (hr0 + 8 * q) * 1024 + lane * 16) = pack8(a[q], b[q]); }
    } else for (int hr = wv; hr < 2 * nh; hr += 8) *(LAS u32x4*)(win + hr * 1024 + lane * 16) = (u32x4){0u, 0u, 0u, 0u};
    asm volatile("" ::: "memory");
    const int c0 = 2 * tid;
    f32x2 w[CONV_K];
#pragma unroll
    for (int k = 0; k < CONV_K; ++k) w[k] = *(const f32x2*)(cw + (size_t)k * 1024 + c0);
    const f32x2 bia = *(const f32x2*)(cb + c0);
    const f32x2 g2 = *(const f32x2*)(lg + c0), b2 = *(const f32x2*)(lb + c0);
    asm volatile("s_waitcnt vmcnt(0)" ::: "memory");
    __syncthreads();
#pragma unroll 1
    for (int sb = 0; sb < CR / SB; ++sb) {
        LAS const unsigned char* wp = win + sb * SB * 2048 + c0 * 2;
        f32x2 y[SB];
#pragma unroll
        for (int r = 0; r < SB; ++r) y[r] = bia;
#pragma unroll
        for (int jj = 0; jj < SB + CONV_ST; ++jj) { const unsigned uu = *(const LAS unsigned*)(wp + jj * 2048); const f32x2 u = {bf_lo(uu), bf_hi(uu)};
#pragma unroll
            for (int r = 0; r < SB; ++r) { const int k = jj - r; if (k >= 0 && k < CONV_K) y[r] = w[k] * u + y[r]; } }
#pragma unroll
        for (int r = 0; r < SB; ++r) { const float s1 = wave_sum(y[r].x + y[r].y), s2 = wave_sum(y[r].x * y[r].x + y[r].y * y[r].y); if (lane == 0) red[wv * SB + r] = (f32x2){s1, s2}; }
        __syncthreads();
        if (tid < SB) { float s1 = 0.f, s2 = 0.f;
#pragma unroll
            for (int q = 0; q < 8; ++q) { const f32x2 t = red[q * SB + tid]; s1 += t.x; s2 += t.y; }
            const float mean = s1 * (1.f / 1024.f); const float var = fmaxf(s2 * (1.f / 1024.f) - mean * mean, 0.f);
            stat[tid] = (f32x2){mean, 1.0f / sqrtf(var + EPS)}; }
        __syncthreads();
        const int rb = r0 + sb * SB;
#pragma unroll
        for (int r = 0; r < SB; ++r) { const f32x2 ms = stat[r];
            const float a = siluf_((y[r].x - ms.x) * ms.y * g2.x + b2.x), b = siluf_((y[r].y - ms.x) * ms.y * g2.y + b2.y);
            if (rb + r < seqlen) *(unsigned*)(cv + (size_t)(seq0 + rb + r) * 1024 + c0) = cvt_pk_bf16(a, b); }
    }
    __syncthreads();
}
__device__ __forceinline__ void phase_c(const Ctx& F, int l) {
    int tid = F.tid; asm volatile("" : "+v"(tid)); const int gw = F.bid * 8 + F.wave, NGW = F.G * 8, lane = tid & 63;
    for (int c = F.bid; c < 187 + 64; c += F.G) {
        if (c < 187) conv_chunk<44, 11>(F, l, tid, 0, c * 44, M_P, -1);
        else { const int q = c - 187; conv_chunk<32, 8>(F, l, tid, M_P + (q >> 1) * 64, (q & 1) * 32, DEC_SEQ, q >> 1); }
    }
    {
        const float* ropetab = (const float*)(F.ws + WS_ROPE); const float gkl = (F.in[I_GKN] + l * QK_HEAD + 128)[lane];
        constexpr int RB = 5;
        for (int r0 = gw * RB; r0 < M; r0 += NGW * RB) {
            f32x4 a[RB][2], c[RB][2]; float kx[RB], s[3 * RB]; f32x2 cs[RB];
#pragma unroll
            for (int i = 0; i < RB; ++i) { const int r = r0 + i;
                const f32x4* ap = (const f32x4*)((const float*)(F.ws + WS_QLATF) + (size_t)r * 512) + lane;
                const float* ckv = r < M_P ? F.out + O_PCKV + ((size_t)l * M_P + r) * 512 : F.out + O_SCKV + ((size_t)l * M_S + (r - M_P)) * 512;
                const float* kr = r < M_P ? F.out + O_PKR + ((size_t)l * M_P + r) * 64 : F.out + O_SKR + ((size_t)l * M_S + (r - M_P)) * 64;
                const int pos = r < M_P ? r : PAST + ((r - M_P) & 63);
                a[i][0] = ap[0]; a[i][1] = ap[64]; c[i][0] = ((const f32x4*)ckv)[lane]; c[i][1] = ((const f32x4*)ckv)[lane + 64];
                kx[i] = kr[lane]; cs[i] = *(const f32x2*)(ropetab + ((size_t)pos * 32 + (lane & 31)) * 2); }
#pragma unroll
            for (int i = 0; i < RB; ++i) { s[3 * i] = 0.f; s[3 * i + 1] = 0.f;
#pragma unroll
                for (int j = 0; j < 2; ++j) { s[3 * i] += (a[i][j][0] * a[i][j][0] + a[i][j][1] * a[i][j][1]) + (a[i][j][2] * a[i][j][2] + a[i][j][3] * a[i][j][3]);
                    s[3 * i + 1] += (c[i][j][0] * c[i][j][0] + c[i][j][1] * c[i][j][1]) + (c[i][j][2] * c[i][j][2] + c[i][j][3] * c[i][j][3]); }
                s[3 * i + 2] = kx[i] * kx[i]; }
#pragma unroll
            for (int o = 1; o < 64; o <<= 1)
#pragma unroll
                for (int i = 0; i < 3 * RB; ++i) s[i] += __shfl_xor(s[i], o);
#pragma unroll
            for (int i = 0; i < RB; ++i) { const int r = r0 + i;
                const float ra = 1.0f / sqrtf(s[3 * i] * (1.f / 512.f) + EPS), rc = 1.0f / sqrtf(s[3 * i + 1] * (1.f / 512.f) + EPS);
                u32x2* oa = (u32x2*)((bf16_t*)(F.ws + WS_QLATN) + (size_t)r * 512) + lane; u32x2* oc = (u32x2*)((bf16_t*)(F.ws + WS_CKVN) + (size_t)r * 512) + lane;
#pragma unroll
                for (int j = 0; j < 2; ++j) { u32x2 w; w.x = cvt_pk_bf16(a[i][j][0] * ra, a[i][j][1] * ra); w.y = cvt_pk_bf16(a[i][j][2] * ra, a[i][j][3] * ra); oa[64 * j] = w;
                    w.x = cvt_pk_bf16(c[i][j][0] * rc, c[i][j][1] * rc); w.y = cvt_pk_bf16(c[i][j][2] * rc, c[i][j][3] * rc); oc[64 * j] = w; }
                const float xg = kx[i] * gkl; const float other = __shfl_xor(xg, 32);
                const float o = lane < 32 ? xg * cs[i].x - other * cs[i].y : xg * cs[i].x + other * cs[i].y;
                ((bf16_t*)(F.ws + WS_KPEC))[(size_t)r * 64 + lane] = (bf16_t)(cvt_pk_bf16(o, 0.f) & 0xffffu);
                if (lane == 0) ((float*)(F.ws + WS_SSPEC))[r] = s[3 * i + 2]; }
        }
    }
    {
        const float* kvraw = (const float*)(F.ws + WS_KVRAW); const float* gx = F.in[I_GXK] + l * 256;
        for (int it = gw; it < N_MEM * 8; it += NGW) { const int t = it >> 3, hv = it & 7, isv = hv >> 2, h = hv & 3;
            const f32x4 v = *(const f32x4*)(kvraw + (size_t)t * 2048 + isv * 1024 + h * 256 + 4 * lane);
            f32x4 o = v;
            if (!isv) { const float ss = wave_sum((v[0] * v[0] + v[1] * v[1]) + (v[2] * v[2] + v[3] * v[3])); const float r = 1.0f / sqrtf(ss * (1.f / 256.f) + EPS);
                const f32x4 g = *(const f32x4*)(gx + 4 * lane); o = v * r * g; }
            float* op = F.out + (isv ? O_PMV : O_PMK) + (size_t)l * N_MEM * 1024 + (size_t)t * 1024 + h * 256 + 4 * lane;
            *(f32x4*)op = o;
            u32x2 w; w.x = cvt_pk_bf16(o[0], o[1]); w.y = cvt_pk_bf16(o[2], o[3]);
            *(u32x2*)((bf16_t*)(F.ws + (isv ? WS_MVB : WS_MKB)) + (size_t)t * 1024 + h * 256 + 4 * lane) = w;
        }
    }
}
__device__ __forceinline__ void phase_e(const Ctx& F, int l) {
    const int gw = F.bid * 8 + F.wave, NGW = F.G * 8, lane = F.lane;
    const float* ropetab = (const float*)(F.ws + WS_ROPE);
    const float* gq = F.in[I_GQN] + l * QK_HEAD; const float* gk = F.in[I_GKN] + l * QK_HEAD; const float* gxq = F.in[I_GXQ] + l * 256;
    const f32x4 gx4 = *(const f32x4*)(gxq + 4 * lane) * C_X;
    const bf16_t* qraw = (const bf16_t*)(F.ws + WS_QRAW); bf16_t* Q = (bf16_t*)(F.ws + WS_Q); bf16_t* xq = (bf16_t*)(F.ws + WS_XQ);
    {
        const size_t gt = (size_t)F.bid * 512 + F.tid, GT = (size_t)F.G * 512;
        const float* SSC = (const float*)(F.ws + WS_SSC); const float* SSPEC = (const float*)(F.ws + WS_SSPEC); float* RKC = (float*)(F.ws + WS_RKC);
        for (size_t i = gt; i < (size_t)16 * M; i += GT) { const f32x4 s4 = *(const f32x4*)(SSC + i * 4); const int row = (int)(i % M);
            RKC[i] = 1.0f / sqrtf(((s4[0] + s4[1]) + (s4[2] + s4[3]) + SSPEC[row]) * (1.f / 192.f) + EPS); }
        const float* SSP = (const float*)(F.ws + WS_SSP); const float* SSPEP = (const float*)(F.ws + WS_SSPEP); float* RKP = (float*)(F.ws + WS_RKP);
        for (size_t i4 = gt; i4 < (size_t)MPAST * 4; i4 += GT) { const size_t PL = (size_t)MPAST * 16, i = i4 * 4; const size_t bb = i >> 16, t = i & 4095;
            const f32x4 s = (*(const f32x4*)(SSP + i) + *(const f32x4*)(SSP + PL + i)) + (*(const f32x4*)(SSP + 2 * PL + i) + *(const f32x4*)(SSP + 3 * PL + i)) + *(const f32x4*)(SSPEP + bb * 4096 + t);
            f32x4 o; o[0] = 1.0f / sqrtf(s[0] * (1.f / 192.f) + EPS); o[1] = 1.0f / sqrtf(s[1] * (1.f / 192.f) + EPS); o[2] = 1.0f / sqrtf(s[2] * (1.f / 192.f) + EPS); o[3] = 1.0f / sqrtf(s[3] * (1.f / 192.f) + EPS);
            *(f32x4*)(RKP + i) = o; }
    }
    f32x4 gsc;
    { const int e0 = lane < 32 ? 4 * lane : 128 + 4 * (lane & 15);
      const f32x4 q4 = *(const f32x4*)(gq + e0); gsc = q4 * C_MLA; if (lane < 32) gsc = gsc * *(const f32x4*)(gk + e0); }
    for (int r = gw; r < M; r += NGW) {
        const int pos = r < M_P ? r : PAST + ((r - M_P) & 63);
        const float* ct = ropetab + ((size_t)pos * 32 + 4 * (lane & 7)) * 2;
        const f32x4 c01 = *(const f32x4*)ct, c23 = *(const f32x4*)(ct + 4);
        u32x2 xw[4];
#pragma unroll
        for (int h = 0; h < 4; ++h) xw[h] = ((const u32x2*)(xq + (size_t)r * 1024 + h * 256))[lane];
        for (int h0 = 0; h0 < NH; h0 += 8) {
            f32x4 v[8]; float ss[8];
#pragma unroll
            for (int j = 0; j < 8; ++j) { u32x2 w = {0u, 0u}; if (lane < 48) w = *(const u32x2*)(qraw + (size_t)r * 3072 + (h0 + j) * 192 + 4 * lane);
                v[j] = (f32x4){bf_lo(w.x), bf_hi(w.x), bf_lo(w.y), bf_hi(w.y)}; ss[j] = (v[j][0] * v[j][0] + v[j][1] * v[j][1]) + (v[j][2] * v[j][2] + v[j][3] * v[j][3]); }
#pragma unroll
            for (int o = 1; o < 64; o <<= 1)
#pragma unroll
                for (int j = 0; j < 8; ++j) ss[j] += __shfl_xor(ss[j], o);
#pragma unroll
            for (int j = 0; j < 8; ++j) { const float rq = 1.0f / sqrtf(ss[j] * (1.f / 192.f) + EPS);
                f32x4 x = v[j] * rq * gsc;
                f32x4 ot; ot[0] = __shfl_xor(x[0], 8); ot[1] = __shfl_xor(x[1], 8); ot[2] = __shfl_xor(x[2], 8); ot[3] = __shfl_xor(x[3], 8);
                if (lane >= 32) { const float sg = lane < 40 ? -1.f : 1.f;
                    x = (f32x4){x[0] * c01[0] + sg * ot[0] * c01[1], x[1] * c01[2] + sg * ot[1] * c01[3], x[2] * c23[0] + sg * ot[2] * c23[1], x[3] * c23[2] + sg * ot[3] * c23[3]}; }
                if (lane < 48) { u32x2 ow; ow.x = cvt_pk_bf16(x[0], x[1]); ow.y = cvt_pk_bf16(x[2], x[3]); *(u32x2*)(Q + ((size_t)r * NH + h0 + j) * 192 + 4 * lane) = ow; } }
        }
#pragma unroll
        for (int h = 0; h < 4; ++h) {
            const u32x2 w = xw[h]; u32x2* po = (u32x2*)((bf16_t*)(F.ws + WS_XQN) + (size_t)r * 1024 + h * 256) + lane;
            const f32x4 v = (f32x4){bf_lo(w.x), bf_hi(w.x), bf_lo(w.y), bf_hi(w.y)};
            const float ss = wave_sum((v[0] * v[0] + v[1] * v[1]) + (v[2] * v[2] + v[3] * v[3])); const float rr = 1.0f / sqrtf(ss * (1.f / 256.f) + EPS);
            const f32x4 o = v * rr * gx4; u32x2 ow; ow.x = cvt_pk_bf16(o[0], o[1]); ow.y = cvt_pk_bf16(o[2], o[3]); *po = ow;
        }
    }
}

constexpr int AP_KN = 0, AP_KPE = 16384, AP_V = 24576, AP_RK = 40960;
constexpr int AX_K = 0, AX_V = 32768, AX_AL = 49152;

__device__ __forceinline__ int swap23(int k) { return (k & ~0xC) | ((k & 4) << 1) | ((k & 8) >> 1); }
__device__ __forceinline__ int src_kn(int o) { const int row = o >> 8, colB = (o & 255) ^ ((row & 7) << 4); return row * 128 + (colB >> 1); }
__device__ __forceinline__ int src_kpe(int o) { const int row = o >> 7, colB = (o & 127) ^ ((row & 7) << 4); return row * 64 + (colB >> 1); }
__device__ __forceinline__ int src_v1024(int o) { const int sub = o >> 9, kk = (sub >> 2) * 8 + ((o & 511) >> 6), c = (sub & 3) * 32 + ((o & 63) >> 1); return swap23(kk) * 1024 + c; }
__device__ __forceinline__ int src_v(int o) { const int sub = o >> 9, kk = (sub >> 2) * 8 + ((o & 511) >> 6), c = (sub & 3) * 32 + ((o & 63) >> 1); return swap23(kk) * 128 + c; }

constexpr int AQ_KBUF = 24832, AQ_KPE = 16384, AQ_RK = 24576, AQ_V0 = 3 * AQ_KBUF, AQ_VBUF = 16384, AQ_AL = AQ_V0 + 4 * AQ_VBUF;
__device__ __forceinline__ void mla_prompt_unit(const Ctx& F, int h, int qb, float negB2) {
    int tid = F.tid; asm volatile("" : "+v"(tid)); const int wid = F.wave, lane = tid & 63, r32 = lane & 31, hi = lane >> 5;
    const bf16_t* Q = (const bf16_t*)(F.ws + WS_Q); const bf16_t* KC = (const bf16_t*)(F.ws + WS_KC) + (size_t)h * M * 128; const bf16_t* VC = (const bf16_t*)(F.ws + WS_VC) + (size_t)h * M * 128;
    const float* RK = (const float*)(F.ws + WS_RKC) + (size_t)h * M; const bf16_t* KPE = (const bf16_t*)(F.ws + WS_KPEC);
    const int row0 = qb * 256 + wid * 32;
    f32x16 o[4];
#pragma unroll
    for (int d = 0; d < 4; ++d)
#pragma unroll
        for (int r = 0; r < 16; ++r) o[d][r] = 0.f;
    float l_part = 0.f;
    const int nt_all = 4 * qb + 4, nt_w = 4 * qb + (wid >> 1) + 1;
    const bool late = false;
    LAS char* L = (LAS char*)F.lds; LAS float* al_l = (LAS float*)(L + AQ_AL) + wid * 32;
    const LAS char* vb0 = L + AQ_V0 + att::v_rd_base(lane);
    unsigned okn[2], ov[2];
#pragma unroll
    for (int i = 0; i < 2; ++i) { const int o16 = ((wid * 2 + i) * 64 + lane) * 16; okn[i] = (unsigned)src_kn(o16) * 2u; ov[i] = (unsigned)src_v(o16) * 2u; }
    const unsigned okp = (unsigned)src_kpe((wid * 64 + lane) * 16) * 2u, ork = (unsigned)lane * 4u;
#define MP_ISSUE(t) do { LAS char* Lk = L + ((t) % 3) * AQ_KBUF; LAS char* Lv = L + AQ_V0 + ((t) & 3) * AQ_VBUF; const size_t kb_ = (size_t)(t) * 64; \
        glds16s(KC + kb_ * 128, okn[0], Lk + (wid * 2) * 1024); glds16s(KC + kb_ * 128, okn[1], Lk + (wid * 2 + 1) * 1024); \
        glds16s(VC + kb_ * 128, ov[0], Lv + (wid * 2) * 1024); glds16s(VC + kb_ * 128, ov[1], Lv + (wid * 2 + 1) * 1024); \
        glds16s(KPE + kb_ * 64, okp, Lk + AQ_KPE + wid * 1024); \
        if (wid == 0) glds4s(RK + kb_, ork, Lk + AQ_RK); } while (0)
    __builtin_amdgcn_s_barrier();
    MP_ISSUE(0); MP_ISSUE(1);
    bf16x8 qr[12];
    { const bf16_t* qp = Q + ((size_t)(row0 + r32) * NH + h) * 192 + hi * 8;
#pragma unroll
      for (int d0 = 0; d0 < 12; ++d0) qr[d0] = *(const bf16x8*)(qp + d0 * 16);
#pragma unroll
      for (int d0 = 0; d0 < 12; ++d0) asm volatile("" :: "v"(qr[d0])); }
    bf16x8 pa[4] = {};
    for (int t = 0; t < nt_all; ++t) {
        if (t + 1 < nt_all) { if (wid == 0) asm volatile("s_waitcnt vmcnt(6)" ::: "memory"); else asm volatile("s_waitcnt vmcnt(5)" ::: "memory"); }
        else asm volatile("s_waitcnt vmcnt(0)" ::: "memory");
        __builtin_amdgcn_s_barrier();
        asm volatile("" ::: "memory");
        if (t + 2 < nt_all) MP_ISSUE(t + 2);
        if (late && t >= 1 && t - 1 < nt_w) att::pv_fs<4, 2>(o, vb0 + ((t - 1) & 3) * AQ_VBUF, pa);
        if (t < nt_w) {
            const LAS char* Lk = L + (t % 3) * AQ_KBUF;
            att::qk_sm<8, 4, 2, 256>(qr, l_part, Lk, Lk + AQ_KPE, (const LAS float*)(Lk + AQ_RK), negB2, r32, hi, pa);
#ifdef PROBE_QK2
            { bf16x8 pa2[4]; float l2 = 0.f; int r32b = r32; asm volatile("" : "+v"(r32b)); att::qk_sm<8, 4, 2, 256>(qr, l2, Lk, Lk + AQ_KPE, (const LAS float*)(Lk + AQ_RK), negB2, r32b, hi, pa2);
              asm volatile("" :: "v"(pa2[0]), "v"(pa2[1]), "v"(pa2[2]), "v"(pa2[3]), "v"(l2)); }
#endif
#ifdef PROBE_PV2
            { f32x16 o2[4];
#pragma unroll
              for (int d = 0; d < 4; ++d)
#pragma unroll
                  for (int r = 0; r < 16; ++r) o2[d][r] = 0.f;
              att::pv_fs<4, 2>(o2, vb0 + (t & 3) * AQ_VBUF, pa);
              asm volatile("" :: "v"(o2[0]), "v"(o2[1]), "v"(o2[2]), "v"(o2[3])); }
#endif
            if (!late) att::pv_fs<4, 2>(o, vb0 + (t & 3) * AQ_VBUF, pa);
        }
    }
    if (late && nt_all - 1 < nt_w) att::pv_fs<4, 2>(o, vb0 + ((nt_all - 1) & 3) * AQ_VBUF, pa);
#undef MP_ISSUE
    att::finish<4>(o, att::lane_pair_sum(l_part), al_l, (bf16_t*)(F.ws + WS_AMLA) + (size_t)row0 * 2048 + h * 128, (const bf16_t*)(F.ws + WS_ZM) + (size_t)row0 * 2048 + h * 128, 2048, r32, hi);
}
constexpr int AC_KN = 0, AC_KPE = 8192, AC_CN = 10240, AC_RK = 26624, AC_BUF = 26752, AC_NB = 6, AC_AL = AC_NB * AC_BUF;
static_assert(AC_AL + 1024 <= SCRATCH_TOP, "sample attention ring + row-sum scratch inside the phase scratch");
__device__ __forceinline__ int src_cn(int o) { const int sub = o >> 9, kk = (sub >> 4) * 8 + ((o & 511) >> 6), c = (sub & 15) * 32 + ((o & 63) >> 1); return swap23(kk) * 512 + c; }
#ifndef PROBE_HOT
#define PROBE_HOT 0
#endif
__device__ __forceinline__ void mla_sample_unit(const Ctx& F, int b, int hp, float negB2, bool rep2 = false) {
    int tid = F.tid; asm volatile("" : "+v"(tid)); const int wid = F.wave, lane = tid & 63, r32 = lane & 31, hi = lane >> 5;
    const int g = wid >> 2, rg = (wid >> 1) & 1, lh = wid & 1, h = hp * 2 + g;
    const bf16_t* Q = (const bf16_t*)(F.ws + WS_Q);
    const int row0 = M_P + b * 64 + rg * 32;
    f32x16 o[8];
#pragma unroll
    for (int d = 0; d < 8; ++d)
#pragma unroll
        for (int r = 0; r < 16; ++r) o[d][r] = 0.f;
    float l_part = 0.f;
    constexpr int SC_CS = 16384, SC_NC = 5, SC_K0 = SC_CS * SC_NC, SC_KS = 10368, SC_NK = 6, SK_KPE = 8192, SK_RK = 10240, SC_P0 = SC_K0 + SC_KS * SC_NK, SC_AL = SC_P0 + 4 * 2048;
    static_assert(SC_AL + 1024 <= SCRATCH_TOP && SC_AL >= 131072, "sample attention LDS map");
    LAS char* L = (LAS char*)F.lds; LAS float* al_l = (LAS float*)(L + SC_AL) + wid * 32; LAS float* al_p = (LAS float*)(L + SC_AL) + (wid ^ 1) * 32;
    LAS char* Pb = L + SC_P0 + (wid >> 1) * 2048 + lane * 32;
    const int dg = wid >> 2, dh = hp * 2 + dg;
    const bf16_t* KPt = (const bf16_t*)(F.ws + WS_KP); const bf16_t* KCh = (const bf16_t*)(F.ws + WS_KC) + ((size_t)dh * M + M_P + b * 64) * 128;
    const bf16_t* CNP = (const bf16_t*)(F.ws + WS_CNP) + (size_t)b * 4096 * 512; const bf16_t* CNC = (const bf16_t*)(F.ws + WS_CKVN) + (size_t)(M_P + b * 64) * 512;
    const bf16_t* KPEP = (const bf16_t*)(F.ws + WS_KPEP) + (size_t)b * 4096 * 64; const bf16_t* KPEC = (const bf16_t*)(F.ws + WS_KPEC) + (size_t)(M_P + b * 64) * 64;
    const float* RKPb = (const float*)(F.ws + WS_RKP) + (size_t)(b * 16 + hp * 2) * 4096; const float* RKCb = (const float*)(F.ws + WS_RKC) + (size_t)(hp * 2) * M + M_P + b * 64;
    constexpr int NT = 260, NS = NT / 2;
    unsigned voffKp, voffKc, voffC0, voffC1, voffX;
    { const int o16 = ((wid & 3) * 64 + lane) * 16, r = o16 >> 8, cB = (o16 & 255) ^ ((r & 7) << 4), cc = cB >> 4;
      voffKp = (unsigned)((((dg * 4 + (cc >> 2)) * 64) + (cc & 3) * 16 + r) * 8) * 2u; voffKc = (unsigned)(r * 128 + (cB >> 1)) * 2u;
      voffC0 = (unsigned)src_cn(((wid * 2) * 64 + lane) * 16) * 2u; voffC1 = (unsigned)src_cn(((wid * 2 + 1) * 64 + lane) * 16) * 2u;
      voffX = wid < 2 ? (unsigned)src_kpe(((wid & 1) * 64 + lane) * 16) * 2u : (unsigned)((((lane >> 4) & 1) * 4096 + (lane & 15)) * 4); }
#define MS_ISSUE_C(tt) do { const int t_ = (tt) < NT ? (tt) : NT - 1; LAS char* Lc = L + ((tt) % SC_NC) * SC_CS; \
        if (t_ < 256) { const bf16_t* cs_ = CNP + (size_t)t_ * 16 * 512; glds16s(cs_, voffC0, Lc + (wid * 2) * 1024); glds16s(cs_, voffC1, Lc + (wid * 2 + 1) * 1024); } \
        else { const bf16_t* cs_ = CNC + (size_t)(t_ - 256) * 16 * 512; glds16s(cs_, voffC0, Lc + (wid * 2) * 1024); glds16s(cs_, voffC1, Lc + (wid * 2 + 1) * 1024); } } while (0)
#define MS_ISSUE_K(tt) do { const int t_ = (tt) < NT ? (tt) : NT - 1; LAS char* Lk = L + SC_K0 + ((tt) % SC_NK) * SC_KS; \
        if (t_ < 256) { const size_t kb_ = (size_t)t_ * 16, grow = (size_t)b * 4096 + kb_; const size_t blk = ((((grow >> 8) * 8 + hp) * 2 + ((grow >> 7) & 1)) * 2 + ((grow >> 6) & 1)) * 4 + ((grow >> 4) & 3); \
            glds16s(KPt + blk * 4096, voffKp, Lk + wid * 1024); \
            if (wid < 2) glds16s(KPEP + kb_ * 64, voffX, Lk + SK_KPE + wid * 1024); \
            if (wid == 2) { if (lane < 32) glds4s(RKPb + kb_, voffX, Lk + SK_RK); } } \
        else { const size_t kb_ = (size_t)(t_ - 256) * 16; \
            glds16s(KCh + kb_ * 128, voffKc, Lk + wid * 1024); \
            if (wid < 2) glds16s(KPEC + kb_ * 64, voffX, Lk + SK_KPE + wid * 1024); \
            if (wid == 2) { if (lane < 32) glds4s(RKCb + kb_, (unsigned)((((lane >> 4) & 1) * M + (lane & 15)) * 4), Lk + SK_RK); } } } while (0)
    __builtin_amdgcn_s_barrier();
    MS_ISSUE_K(0); MS_ISSUE_K(1); MS_ISSUE_K(2); MS_ISSUE_K(3); MS_ISSUE_C(0);
    bf16x8 qr[12];
    { const bf16_t* qp = Q + ((size_t)(row0 + r32) * NH + h) * 192 + hi * 8;
#pragma unroll
      for (int d0 = 0; d0 < 12; ++d0) qr[d0] = *(const bf16x8*)(qp + d0 * 16);
#pragma unroll
      for (int d0 = 0; d0 < 12; ++d0) asm volatile("" :: "v"(qr[d0])); }
    const int vrb = lh * 8 * 512 + att::v_rd_base(lane);
    bf16x8 pk[2] = {};
    for (int s = -1; s < NS; ++s) {
        if (s < 0) asm volatile("s_waitcnt vmcnt(0)" ::: "memory"); else if (wid < 3) asm volatile("s_waitcnt vmcnt(6)" ::: "memory"); else asm volatile("s_waitcnt vmcnt(4)" ::: "memory");
        __builtin_amdgcn_s_barrier();
        asm volatile("" ::: "memory");
        const bool mine = (lh == ((s + g) & 1));
        if (!mine && s >= 0) { pk[0] = *(const LAS bf16x8*)Pb; pk[1] = *(const LAS bf16x8*)(Pb + 16); }
        MS_ISSUE_C(2 * s + 3); MS_ISSUE_C(2 * s + 4); MS_ISSUE_K(2 * s + 6); MS_ISSUE_K(2 * s + 7);
        if (s >= 0) {
            asm volatile("" : "+v"(pk[0]), "+v"(pk[1]));
            const int vA = (int)(uintptr_t)(L + ((2 * s) % SC_NC) * SC_CS + vrb), vB = (int)(uintptr_t)(L + ((2 * s + 1) % SC_NC) * SC_CS + vrb);
            s16x4 lo[4], hh[4];
#define MS_TR(i) do { asm volatile("ds_read_b64_tr_b16 %0, %1 offset:%c2" : "=&v"(lo[(i) & 3]) : "v"((i) < 8 ? vA : vB), "i"(((i) & 7) * 512) : "memory"); \
                      asm volatile("ds_read_b64_tr_b16 %0, %1 offset:%c2" : "=&v"(hh[(i) & 3]) : "v"((i) < 8 ? vA : vB), "i"(((i) & 7) * 512 + 16 * 512) : "memory"); } while (0)
            __builtin_amdgcn_sched_barrier(0);
            MS_TR(0); MS_TR(1); MS_TR(2);
            __builtin_amdgcn_s_setprio(1);
#pragma unroll
            for (int i = 0; i < 16; ++i) {
                if (i + 3 < 16) { MS_TR(i + 3); asm volatile("s_waitcnt lgkmcnt(6)" ::: "memory"); }
                else if (i + 2 < 16) asm volatile("s_waitcnt lgkmcnt(4)" ::: "memory");
                else if (i + 1 < 16) asm volatile("s_waitcnt lgkmcnt(2)" ::: "memory");
                else asm volatile("s_waitcnt lgkmcnt(0)" ::: "memory");
                __builtin_amdgcn_sched_barrier(0);
                { const s16x4 l_ = lo[i & 3], h_ = hh[i & 3]; const bf16x8 vf = (bf16x8){l_[0], l_[1], l_[2], l_[3], h_[0], h_[1], h_[2], h_[3]};
                  o[i & 7] = __builtin_amdgcn_mfma_f32_32x32x16_bf16(pk[i >> 3], vf, o[i & 7], 0, 0, 0); }
                __builtin_amdgcn_sched_barrier(0);
            }
            __builtin_amdgcn_s_setprio(0);
#undef MS_TR
        }
        if (!mine && s + 1 < NS) {
            const LAS char* KA = L + SC_K0 + ((2 * s + 2) % SC_NK) * SC_KS; const LAS char* KB = L + SC_K0 + ((2 * s + 3) % SC_NK) * SC_KS;
            const LAS char* Lm = r32 < 16 ? KA : KB;
            const LAS char* Ks = Lm + g * 4096; const LAS char* Kp = Lm + SK_KPE; const int kr = r32 & 15;
            f32x16 p;
#pragma unroll
            for (int r = 0; r < 16; ++r) p[r] = 0.f;
            auto kfrag = [&](int d) -> bf16x8 { return d < 8 ? *(const LAS bf16x8*)(Ks + att::kswz<256>(kr, (d * 16 + hi * 8) * 2)) : *(const LAS bf16x8*)(Kp + att::kswz<128>(kr, ((d - 8) * 16 + hi * 8) * 2)); };
            bf16x8 kf[3];
            kf[0] = kfrag(0); kf[1] = kfrag(1);
            __builtin_amdgcn_s_setprio(1);
#pragma unroll
            for (int d0 = 0; d0 < 12; ++d0) {
                if (d0 + 2 < 12) kf[(d0 + 2) % 3] = kfrag(d0 + 2);
                p = __builtin_amdgcn_mfma_f32_32x32x16_bf16(kf[d0 % 3], qr[d0], p, 0, 0, 0);
            }
            __builtin_amdgcn_s_setprio(0);
            float ps = 0.f;
#pragma unroll
            for (int hf2 = 0; hf2 < 2; ++hf2) {
                f32x4 sc[2];
#pragma unroll
                for (int i2 = 0; i2 < 2; ++i2) { const LAS float* rk = (const LAS float*)((hf2 == 0 ? KA : KB) + SK_RK) + g * 16; sc[i2] = *(const LAS f32x4*)(rk + 8 * i2 + 4 * hi); }
#pragma unroll
                for (int i2 = 0; i2 < 2; ++i2)
#pragma unroll
                    for (int j = 0; j < 4; ++j) { const int i = hf2 * 2 + i2; const float e = __builtin_amdgcn_exp2f(fmaf(p[4 * i + j], sc[i2][j], negB2)); p[4 * i + j] = e; ps += e; }
                asm volatile("" ::: "memory");
            }
            l_part += ps;
#pragma unroll
            for (int hf = 0; hf < 2; ++hf) { const int B = hf * 8;
                const unsigned a0 = cvt_pk_bf16(p[B + 0], p[B + 1]), a1 = cvt_pk_bf16(p[B + 2], p[B + 3]), b0 = cvt_pk_bf16(p[B + 4], p[B + 5]), b1 = cvt_pk_bf16(p[B + 6], p[B + 7]);
                auto r0 = __builtin_amdgcn_permlane32_swap(a0, b0, false, false); auto r1 = __builtin_amdgcn_permlane32_swap(a1, b1, false, false);
                u32x4 w = {r0[0], r1[0], r0[1], r1[1]}; pk[hf] = __builtin_bit_cast(bf16x8, w); }
            *(LAS bf16x8*)Pb = pk[0]; *(LAS bf16x8*)(Pb + 16) = pk[1];
            LDS_WAIT();
        }
    }
#undef MS_ISSUE_C
#undef MS_ISSUE_K
    asm volatile("s_waitcnt vmcnt(0)" ::: "memory");
    const float lsum = att::lane_pair_sum(l_part);
    if (hi == 0) al_l[r32] = lsum;
    LDS_WAIT();
    __builtin_amdgcn_s_barrier();
    asm volatile("" ::: "memory");
    {
        const bool oddl = r32 & 1;
#pragma unroll
        for (int r = 0; r < 16; r += 2) { const int q = att::crow(r, hi); const float rl0 = __builtin_amdgcn_rcpf(al_l[q] + al_p[q]), rl1 = __builtin_amdgcn_rcpf(al_l[q + 1] + al_p[q + 1]);
            const int qrow = rg * 32 + q + (oddl ? 1 : 0);
#pragma unroll
            for (int d0 = 0; d0 < 8; ++d0) { const float va = o[d0][r] * rl0, vb2 = o[d0][r + 1] * rl1; const float recv = __shfl_xor(oddl ? va : vb2, 1);
                const int colB = ((lh * 8 + d0) * 32 + (r32 & ~1)) * 2;
                *(LAS unsigned*)(L + g * 65536 + att::kswz<1024>(qrow, colB)) = oddl ? cvt_pk_bf16(recv, vb2) : cvt_pk_bf16(va, recv); } }
    }
    LDS_WAIT();
    __builtin_amdgcn_s_barrier();
    asm volatile("" ::: "memory");
    {
        const int g2 = wid >> 2, rg2 = (wid >> 1) & 1, dvh = wid & 1, h2 = hp * 2 + g2;
        const bf16_t* Wuv = (const bf16_t*)(F.ws + WS_WUKV) + ((size_t)(h2 * 256 + 128 + dvh * 64 + r32)) * 512 + hi * 8;
        const int orow0 = M_P + b * 64 + rg2 * 32;
        bf16_t* out = (bf16_t*)(F.ws + ((PROBE_HOT != 0 && rep2) ? WS_VP : WS_AMLA)) + (size_t)orow0 * 2048 + h2 * 128 + dvh * 64; const bf16_t* z = (const bf16_t*)(F.ws + WS_ZM) + (size_t)orow0 * 2048 + h2 * 128 + dvh * 64;
        const bool odd = r32 & 1;
        unsigned zw[2][8];
#pragma unroll
        for (int k2 = 0; k2 < 2; ++k2)
#pragma unroll
            for (int r = 0; r < 16; r += 2) zw[k2][r >> 1] = *(const unsigned*)(z + (size_t)(att::crow(r, hi) + (odd ? 1 : 0)) * 2048 + k2 * 32 + (r32 & ~1));
        f32x16 acc[2];
#pragma unroll
        for (int k2 = 0; k2 < 2; ++k2)
#pragma unroll
            for (int r = 0; r < 16; ++r) acc[k2][r] = 0.f;
#pragma unroll 16
        for (int ks = 0; ks < 32; ++ks) {
            const bf16x8 a = *(const LAS bf16x8*)(L + g2 * 65536 + att::kswz<1024>(rg2 * 32 + r32, (ks * 16 + hi * 8) * 2));
            const bf16x8 bw0 = *(const bf16x8*)(Wuv + ks * 16), bw1 = *(const bf16x8*)(Wuv + (size_t)32 * 512 + ks * 16);
            acc[0] = __builtin_amdgcn_mfma_f32_32x32x16_bf16(a, bw0, acc[0], 0, 0, 0); acc[1] = __builtin_amdgcn_mfma_f32_32x32x16_bf16(a, bw1, acc[1], 0, 0, 0);
        }
#pragma unroll
        for (int k2 = 0; k2 < 2; ++k2)
#pragma unroll
            for (int r = 0; r < 16; r += 2) { const float va = acc[k2][r], vb2 = acc[k2][r + 1];
                const float recv = __shfl_xor(odd ? va : vb2, 1); const float v0 = odd ? recv : va, v1 = odd ? vb2 : recv; const unsigned w = zw[k2][r >> 1];
                *(unsigned*)(out + (size_t)(att::crow(r, hi) + (odd ? 1 : 0)) * 2048 + k2 * 32 + (r32 & ~1)) = cvt_pk_bf16(v0 * bf_lo(w), v1 * bf_hi(w)); }
    }
    __builtin_amdgcn_s_barrier();
}
template <bool SAMPLE>
__device__ __forceinline__ void cross_unit(const Ctx& F, int l, int x, int h, int dvh) {
    int tid = F.tid; asm volatile("" : "+v"(tid)); const int wid = F.wave, lane = tid & 63, r32 = lane & 31, hi = lane >> 5;
    if (SAMPLE) {
        LAS char* L = (LAS char*)F.lds; constexpr int XB = 49152; LAS float* al_l = (LAS float*)(L + 2 * XB) + wid * 32;
        const float* kf = F.in[I_CMK] + ((size_t)l * NSTREAM + x) * N_MEM * 1024 + h * 256; const float* vf = F.in[I_CMV] + ((size_t)l * NSTREAM + x) * N_MEM * 1024 + h * 256 + dvh * 128;
        __syncthreads();
        if (wid < 2) {
            const int row0 = M_P + x * 64 + wid * 32;
            bf16x8 qr[16];
            { const bf16_t* qp = (const bf16_t*)(F.ws + WS_XQN) + (size_t)(row0 + r32) * 1024 + h * 256 + hi * 8;
#pragma unroll
              for (int d0 = 0; d0 < 16; ++d0) qr[d0] = *(const bf16x8*)(qp + d0 * 16); }
            f32x16 o[4];
#pragma unroll
            for (int d = 0; d < 4; ++d)
#pragma unroll
                for (int r = 0; r < 16; ++r) o[d][r] = 0.f;
            float m_reg = -1e30f, l_reg = 0.f;
            const int vb = (int)(uintptr_t)(L + AX_V) + att::v_rd_base(lane);
            for (int t = 0; t < 4; ++t) {
                __builtin_amdgcn_s_barrier();
                asm volatile("" ::: "memory");
                att::tile_step<16, 0, 4, 2, false, 512>(qr, o, m_reg, l_reg, L + (t & 1) * XB + AX_K, L + (t & 1) * XB + AX_K, vb + (t & 1) * XB, (const LAS float*)nullptr, al_l, r32, hi);
            }
            att::finish<4>(o, l_reg, al_l, (bf16_t*)(F.ws + WS_AX) + (size_t)row0 * 1024 + h * 256 + dvh * 128, (const bf16_t*)(F.ws + WS_ZX) + (size_t)row0 * 1024 + h * 256 + dvh * 128, 1024, r32, hi);
        } else {
            const int lt = tid - 128;
            f32x4 ra[8][2], rb[8][2];
#define XS_LOAD(t, R) do { _Pragma("unroll") for (int i = 0; i < 8; ++i) { const int c = lt + 384 * i; const bool isk = c < 2048; const int cv = c - 2048; \
                const float* sp = isk ? kf + (size_t)((t) * 64 + (c >> 5)) * 1024 + (c & 31) * 8 : vf + (size_t)((t) * 64 + (cv >> 4)) * 1024 + (cv & 15) * 8; \
                R[i][0] = *(const f32x4*)sp; R[i][1] = *(const f32x4*)(sp + 4); } } while (0)
#define XS_STORE(t, R) do { LAS char* Lb = L + ((t) & 1) * XB; _Pragma("unroll") for (int i = 0; i < 8; ++i) { const int c = lt + 384 * i; const bool isk = c < 2048; const int cv = c - 2048; \
                const int dst = isk ? AX_K + att::kswz<512>(c >> 5, (c & 31) * 16) : AX_V + att::v_st<4>(cv >> 4, (cv & 15) * 8); \
                *(LAS u32x4*)(Lb + dst) = pack8(R[i][0], R[i][1]); } \
                LDS_WAIT(); __builtin_amdgcn_s_barrier(); asm volatile("" ::: "memory"); } while (0)
            XS_LOAD(0, ra);
            XS_LOAD(1, rb); XS_STORE(0, ra);
            XS_LOAD(2, ra); XS_STORE(1, rb);
            XS_LOAD(3, rb); XS_STORE(2, ra);
            XS_STORE(3, rb);
#undef XS_LOAD
#undef XS_STORE
        }
        return;
    }
    const int row0 = x * 256 + wid * 32;
    bf16x8 qr[16];
    { const bf16_t* qp = (const bf16_t*)(F.ws + WS_XQN) + (size_t)(row0 + r32) * 1024 + h * 256 + hi * 8;
#pragma unroll
      for (int d0 = 0; d0 < 16; ++d0) qr[d0] = *(const bf16x8*)(qp + d0 * 16);
#pragma unroll
      for (int d0 = 0; d0 < 16; ++d0) asm volatile("" :: "v"(qr[d0])); }
    f32x16 o[4];
#pragma unroll
    for (int d = 0; d < 4; ++d)
#pragma unroll
        for (int r = 0; r < 16; ++r) o[d][r] = 0.f;
    float m_reg = -1e30f, l_reg = 0.f;
    constexpr int XB = 49152;
    LAS char* L = (LAS char*)F.lds; LAS float* al_l = (LAS float*)(L + 3 * XB) + wid * 32;
    const int vb = (int)(uintptr_t)(L + AX_V) + att::v_rd_base(lane);
    const bf16_t* kb = (const bf16_t*)(F.ws + WS_MKB) + h * 256; const bf16_t* vbf = (const bf16_t*)(F.ws + WS_MVB) + h * 256 + dvh * 128;
#define XP_ISSUE(t) do { LAS char* Lb = L + ((t) % 3) * XB; const bf16_t* ks_ = kb + (size_t)(t) * 64 * 1024; const bf16_t* vs_ = vbf + (size_t)(t) * 64 * 1024; int ln_ = lane; asm volatile("" : "+v"(ln_)); \
        _Pragma("unroll") for (int j = 0; j < 4; ++j) { const int o16 = ((wid * 4 + j) * 64 + ln_) * 16, row = o16 >> 9, colB = (o16 & 511) ^ ((row & 7) << 4); glds16s(ks_, (unsigned)(row * 1024 + (colB >> 1)) * 2u, Lb + AX_K + (wid * 4 + j) * 1024); } \
        _Pragma("unroll") for (int j = 0; j < 2; ++j) glds16s(vs_, (unsigned)src_v1024(((wid * 2 + j) * 64 + ln_) * 16) * 2u, Lb + AX_V + (wid * 2 + j) * 1024); } while (0)
    __syncthreads();
    XP_ISSUE(0); XP_ISSUE(1); XP_ISSUE(2);
#pragma unroll 1
    for (int t = 0; t < 4; ++t) {
        if (t == 0) asm volatile("s_waitcnt vmcnt(12)" ::: "memory"); else if (t < 3) asm volatile("s_waitcnt vmcnt(6)" ::: "memory"); else asm volatile("s_waitcnt vmcnt(0)" ::: "memory");
        __builtin_amdgcn_s_barrier();
        asm volatile("" ::: "memory");
        if (t == 1) XP_ISSUE(3);
        att::tile_step<16, 0, 4, 2, false, 512, 2>(qr, o, m_reg, l_reg, L + (t % 3) * XB + AX_K, L + (t % 3) * XB + AX_K, vb + (t % 3) * XB, (const LAS float*)nullptr, al_l, r32, hi);
    }
#undef XP_ISSUE
    att::finish<4>(o, l_reg, al_l, (bf16_t*)(F.ws + WS_AX) + (size_t)row0 * 1024 + h * 256 + dvh * 128, (const bf16_t*)(F.ws + WS_ZX) + (size_t)row0 * 1024 + h * 256 + dvh * 128, 1024, r32, hi);
}
#ifndef ATT_ONLY
#define ATT_ONLY -1
#endif
#define ATT_ON(k) (ATT_ONLY < 0 || ATT_ONLY == (k))
constexpr int QN = 160;
__device__ __forceinline__ void phase_attention(const Ctx& F, int l, int rep) {
    (void)rep;
    unsigned* heads = (unsigned*)(F.ws + WS_CTL) + CW_QHEAD + 64 * 8 * l + 64 * 16 * rep;
    volatile LAS unsigned* slot = (volatile LAS unsigned*)(F.lds + MISC_OFF);
    float negB2;
    { const float* gq = F.in[I_GQN] + l * QK_HEAD; const float* gk = F.in[I_GKN] + l * QK_HEAD; const int ln = F.lane;
      float m1 = fmaxf(fabsf(gq[ln] * gk[ln]), fabsf(gq[64 + ln] * gk[64 + ln])), mq = fabsf(gq[128 + ln]), mk = fabsf(gk[128 + ln]);
#pragma unroll
      for (int o = 1; o < 64; o <<= 1) { m1 = fmaxf(m1, __shfl_xor(m1, o)); mq = fmaxf(mq, __shfl_xor(mq, o)); mk = fmaxf(mk, __shfl_xor(mk, o)); }
      negB2 = -(19.99f * 1.01f * fmaxf(m1, mq * mk) + 0.1f); }
    const int x0 = (int)(xb_xcc_id() & 7u);
    for (int step = 0; step < 8; ++step) {
        const int x = (x0 + step) & 7;
        for (;;) {
            if (F.tid == 0) slot[0] = __hip_atomic_fetch_add(heads + 64 * x, 1u, __ATOMIC_RELAXED, __HIP_MEMORY_SCOPE_AGENT);
            __syncthreads();
            int u = __builtin_amdgcn_readfirstlane((int)slot[0]);
            __syncthreads();
#ifdef QREP_TYPE
            if (u >= 2 * QN) break;
            bool rep2 = false;
            if (u >= QN) { u -= QN; rep2 = true; const int ty = u < 96 ? (u < 32 ? 0 : 1) : (u < 128 ? 2 : 3); if (QREP_TYPE != 9 && ty != QREP_TYPE) continue; }
#else
            const bool rep2 = false;
            if (u >= QN) break;
#endif
            if (u < 96) {
                if (u < 32) {
#if ATT_ON(0)
                    mla_sample_unit(F, 4 * x + (u >> 3), u & 7, negB2, rep2);
#endif
                } else {
#if ATT_ON(1)
                    const int j = u - 32; mla_prompt_unit(F, 2 * x + (j & 1), 31 - (j >> 1), negB2);
#endif
                }
            } else if (u < 128) {
#if ATT_ON(2)
                const int v = x * 32 + (u - 96); cross_unit<false>(F, l, v >> 3, (v >> 1) & 3, v & 1);
#endif
            } else {
#if ATT_ON(3)
                const int v = x * 32 + (u - 128); cross_unit<true>(F, l, v >> 3, (v >> 1) & 3, v & 1);
#endif
            }
        }
    }
}
#define rot(off) ((int)((F.bid + G - ((off) % G)) % G))
__device__ __forceinline__ void phase_b(const Ctx& F, int l) {
    const int G = F.G; (void)G;
            {
                pg8::Gemm g{(const bf16_t*)(F.ws + WS_HB), (const bf16_t*)(F.ws + WS_WIN), 2048, 2048, 2048};
                pg8::StaticOrder S; S.init(M, IN_PAD, G, rot(0));
                EpiWin E{F.ws, F.out, F.in[I_BMERGE] + (size_t)l * 6144, l};
                pg8::gemm_phase(F.lds, g, S, E);
            }
#ifdef DUP_B1
            {
                pg8::Gemm g{(const bf16_t*)(F.ws + WS_HB), (const bf16_t*)(F.ws + WS_WIN), 2048, 2048, 2048};
                pg8::StaticOrder S; S.init(M, IN_PAD, G, rot(0));
                EpiWin E{F.ws, F.out, F.in[I_BMERGE] + (size_t)l * 6144, l};
                pg8::gemm_phase(F.lds, g, S, E);
            }
#endif
#ifdef DUP_B1N
            {
                pg8::Gemm g{(const bf16_t*)(F.ws + WS_HB), (const bf16_t*)(F.ws + WS_WIN), 2048, 2048, 2048};
                pg8::StaticOrder S; S.init(M, IN_PAD, G, rot(0));
                EpiNone E{};
                pg8::gemm_phase(F.lds, g, S, E);
            }
#endif
            {
                pg8::Gemm g{(const bf16_t*)(F.ws + WS_MEMN), (const bf16_t*)(F.ws + WS_WMEM), 2048, 2048, 2048};
                pg8::StaticOrder S; S.init(N_MEM, 2048, G, rot(232));
                EpiF32 E{(float*)(F.ws + WS_KVRAW), 2048};
                pg8::gemm_phase(F.lds, g, S, E);
            }
            {
                pg8::Gemm g{(const bf16_t*)(F.ws + WS_CNP), (const bf16_t*)(F.ws + WS_WUK), 512, 512, 512};
                pg8::StaticOrder S; S.init(MPAST, 2048, G, rot(240));
                EpiK<> E{(bf16_t*)(F.ws + WS_KP), (float*)(F.ws + WS_SSP)};
                pg8::gemm_phase(F.lds, g, S, E);
            }
#ifdef DUP_B3
            {
                pg8::Gemm g{(const bf16_t*)(F.ws + WS_CNP), (const bf16_t*)(F.ws + WS_WUK), 512, 512, 512};
                pg8::StaticOrder S; S.init(MPAST, 2048, G, rot(240));
                EpiK<> E{(bf16_t*)(F.ws + WS_KP), (float*)(F.ws + WS_SSP)};
                pg8::gemm_phase(F.lds, g, S, E);
            }
#endif
#ifdef DUP_B3N
            {
                pg8::Gemm g{(const bf16_t*)(F.ws + WS_CNP), (const bf16_t*)(F.ws + WS_WUK), 512, 512, 512};
                pg8::StaticOrder S; S.init(MPAST, 2048, G, rot(240));
#ifndef DUP_B3N_K
#define DUP_B3N_K false
#endif
#ifndef DUP_B3N_S
#define DUP_B3N_S false
#endif
#ifndef DUP_B3N_T
#define DUP_B3N_T false
#endif
                EpiK<DUP_B3N_K, DUP_B3N_S, DUP_B3N_T> E{(bf16_t*)(F.ws + WS_VP), (float*)(F.ws + WS_VP) + (size_t)64 * 1024 * 1024};
                pg8::gemm_phase(F.lds, g, S, E);
            }
#endif
            if (l == 0) past_kpe(F, l);
#ifdef DUP_B4
            past_kpe(F, l);
#endif
}
__device__ __forceinline__ void phase_d(const Ctx& F, int l) {
    const int G = F.G; (void)G;
            {
                pg8::Gemm g{(const bf16_t*)(F.ws + WS_QLATN), (const bf16_t*)(F.ws + WS_WUQ), 512, 512, 512};
                pg8::StaticOrder S; S.init(M, 3072, G, rot(0));
                EpiBf16 E{(bf16_t*)(F.ws + WS_QRAW), 3072};
                pg8::gemm_phase(F.lds, g, S, E);
            }
            {
                pg8::Gemm g{(const bf16_t*)(F.ws + WS_CKVN), (const bf16_t*)(F.ws + WS_WUKV), 512, 512, 512};
                pg8::StaticOrder S; S.init(M, 4096, G, rot(224));
                EpiKV<false> E{(bf16_t*)(F.ws + WS_KC), (bf16_t*)(F.ws + WS_VC), (float*)(F.ws + WS_SSC)};
                pg8::gemm_phase(F.lds, g, S, E);
            }
            {
                pg8::Gemm g{(const bf16_t*)(F.ws + WS_CV), (const bf16_t*)(F.ws + WS_WPW2), 1024, 1024, 1024};
                pg8::StaticOrder S; S.init(M, 1024, G, rot(96));
                EpiPw2 E{(bf16_t*)(F.ws + WS_ACONV), (const bf16_t*)(F.ws + WS_ZC), F.in[I_BPW2] + (size_t)l * 1024};
                pg8::gemm_phase(F.lds, g, S, E);
            }
}
__device__ __forceinline__ void phase_g(const Ctx& F, int l) {
    const int G = F.G; (void)G;
    const bool bal = (G == 256); const int cls = F.bid >> 6, j = F.bid & 63;
            {
                pg8::Gemm g{(const bf16_t*)(F.ws + WS_AMLA), (const bf16_t*)(F.ws + WS_WPM), 2048, 2048, 2048};
                EpiGate E{(bf16_t*)(F.ws + WS_PB), (const bf16_t*)(F.ws + WS_GATES), 0};
                pg8::ListOrder S; if (bal) S.init(M, 2048, (cls == 0 ? 0 : (cls == 1 ? 128 : 256)) + j, cls < 2 ? 2 : (cls == 2 ? 1 : 0), 64); else S.init(M, 2048, rot(0), (320 - rot(0) + G - 1) / G, G);
                pg8::gemm_phase(F.lds, g, S, E);
            }
            {
                pg8::Gemm g{(const bf16_t*)(F.ws + WS_ACONV), (const bf16_t*)(F.ws + WS_WPC), 1024, 1024, 1024};
                EpiGate E{(bf16_t*)(F.ws + WS_PB) + (size_t)M * 2048, (const bf16_t*)(F.ws + WS_GATES), 2048};
                pg8::ListOrder S; if (bal) S.init(M, 2048, (cls == 0 ? 0 : (cls == 2 ? 64 : 192)) + j, cls == 0 ? 1 : (cls == 1 ? 0 : 2), 64); else S.init(M, 2048, rot(64), (320 - rot(64) + G - 1) / G, G);
                pg8::gemm_phase(F.lds, g, S, E);
            }
            {
                pg8::Gemm g{(const bf16_t*)(F.ws + WS_AX), (const bf16_t*)(F.ws + WS_WPX), 1024, 1024, 1024};
                EpiGate E{(bf16_t*)(F.ws + WS_PB) + 2 * (size_t)M * 2048, (const bf16_t*)(F.ws + WS_GATES), 4096};
                pg8::ListOrder S; if (bal) S.init(M, 2048, (cls == 1 ? 0 : (cls == 2 ? 64 : 128)) + j, cls == 0 ? 0 : (cls == 3 ? 3 : 1), 64); else S.init(M, 2048, rot(128), (320 - rot(128) + G - 1) / G, G);
                pg8::gemm_phase(F.lds, g, S, E);
            }
}
__device__ __forceinline__ void phase_g2(const Ctx& F, int l) {
    const int G = F.G; (void)G;
            {
                const u32x4* p0 = (const u32x4*)(F.ws + WS_PB); const u32x4* p1 = p0 + (size_t)M * 256; const u32x4* p2 = p1 + (size_t)M * 256; u32x4* mo = (u32x4*)(F.ws + WS_MERGED);
                for (size_t i = (size_t)F.bid * 512 + F.tid; i < (size_t)M * 256; i += (size_t)G * 512) {
                    f32x4 a0, a1, b0, b1, c0, c1; unpack8(p0[i], a0, a1); unpack8(p1[i], b0, b1); unpack8(p2[i], c0, c1);
                    mo[i] = pack8(a0 + b0 + c0, a1 + b1 + c1);
                }
            }
}
__device__ __forceinline__ void phase_h(const Ctx& F, int l) {
    const int G = F.G; (void)G;
            {
                pg8::Gemm g{(const bf16_t*)(F.ws + WS_MERGED), (const bf16_t*)(F.ws + WS_WOUT), 2048, 2048, 2048};
                pg8::StaticOrder S; S.init(M, 2048, G, rot(64));
                const float* sp = l == 0 ? F.in[I_XP] : (const float*)(F.ws + WS_X1); const float* ss = l == 0 ? F.in[I_XS] : (const float*)(F.ws + WS_X1) + (size_t)M_P * 2048;
                float* dp = l == DEPTH - 1 ? F.out + O_YP : (float*)(F.ws + WS_X1); float* ds = l == DEPTH - 1 ? F.out + O_YS : (float*)(F.ws + WS_X1) + (size_t)M_P * 2048;
                EpiOut E{sp, ss, dp, ds};
                pg8::gemm_phase(F.lds, g, S, E);
            }
            if (l + 1 < DEPTH && h_early_ok(G)) { const int n2 = (M / 256) * (2048 / 256) - G, c = rot(64);
                if (c >= n2) prep_weights(F, l + 1, (c - n2) * 8 + F.wave, (G - n2) * 8, PW_EARLY); }
}
__global__ void __launch_bounds__(512, 2) trunk_fwd(Args args) {
    extern __shared__ __attribute__((aligned(16))) unsigned char lds_raw[];
    for (int u = threadIdx.x; u < (LDS_BYTES - SCRATCH_TOP) / 4; u += 512) ((LAS unsigned*)((LAS unsigned char*)lds_raw + SCRATCH_TOP))[u] = 0u;
    __syncthreads();
    XcdBarrier bar;
    { const __attribute__((address_space(4))) char* kp0 = (const __attribute__((address_space(4))) char*)__builtin_amdgcn_kernarg_segment_ptr();
      unsigned char* ws0 = *(unsigned char* const __attribute__((address_space(4)))*)(kp0 + 256);
      bar = xcd_barrier_post((unsigned*)(ws0 + WS_CTL) + CW_BAR, (volatile LAS unsigned*)((LAS unsigned char*)lds_raw + MISC_OFF) + 8); }
    const int lo = args.ph_lo, hi = args.ph_hi;
    int ph = 0;
#ifdef DBG_TIME
    if (blockIdx.x == 0 && threadIdx.x == 0) ((LAS unsigned long long*)((LAS unsigned char*)lds_raw + MISC_OFF + 256))[0] = __builtin_amdgcn_s_memrealtime();
#endif
#define PH_BEGIN if (ph >= lo && ph < hi) { Ctx F; { const __attribute__((address_space(4))) char* kp = (const __attribute__((address_space(4))) char*)__builtin_amdgcn_kernarg_segment_ptr(); asm volatile("" : "+s"(kp)); \
        F.in = (karg_in_t)kp; F.out = *(float* const __attribute__((address_space(4)))*)(kp + 248); F.ws = *(unsigned char* const __attribute__((address_space(4)))*)(kp + 256); \
        F.lds = (LAS unsigned char*)lds_raw; int tz = threadIdx.x; asm volatile("" : "+v"(tz)); F.tid = tz; F.lane = tz & 63; F.wave = __builtin_amdgcn_readfirstlane(tz >> 6); F.G = gridDim.x; F.bid = blockIdx.x; } const int G = F.G; (void)G;
#ifdef DBG_TIME
#define PH_END   if (ph + 1 < hi) xcd_barrier(bar); } ++ph; if (blockIdx.x == 0 && threadIdx.x == 0 && ph < 24) ((LAS unsigned long long*)((LAS unsigned char*)lds_raw + MISC_OFF + 256))[ph] = __builtin_amdgcn_s_memrealtime();
#else
#define PH_END   if (ph + 1 < hi) xcd_barrier(bar); } ++ph;
#endif

    for (int l = 0; l < DEPTH; ++l) {
        PH_BEGIN
#if PH_ON(0)
            REP(0) {
            phase_prep(F, l);
            }
#endif
        PH_END
        PH_BEGIN
#if PH_ON(1)
            phase_b(F, l);
#ifdef DUP_1
            phase_b(F, l);
#endif
#endif
        PH_END
        PH_BEGIN
#if PH_ON(2)
            REP(2) {
            phase_c(F, l);
#ifdef DUP_2
            phase_c(F, l);
#endif
            }
#endif
        PH_END
        PH_BEGIN
#if PH_ON(3)
            phase_d(F, l);
#ifdef DUP_3
            phase_d(F, l);
#endif
#endif
        PH_END
        PH_BEGIN
#if PH_ON(4)
            REP(4) {
            phase_e(F, l);
#ifdef DUP_4
            phase_e(F, l);
#endif
            }
#endif
        PH_END
        PH_BEGIN
#if PH_ON(5)
            REP(5) {
            phase_attention(F, l, 0);
#ifdef DUP_5
            phase_attention(F, l, 1);
#endif
            }
#endif
        PH_END
        PH_BEGIN
#if PH_ON(6)
            phase_g(F, l);
#ifdef DUP_6
            phase_g(F, l);
#endif
#endif
        PH_END
        PH_BEGIN
#if PH_ON(8)
            phase_g2(F, l);
#ifdef DUP_8
            phase_g2(F, l);
#endif
#endif
        PH_END
        PH_BEGIN
#if PH_ON(7)
            phase_h(F, l);
#ifdef DUP_7
            phase_h(F, l);
#endif
#endif
        PH_END
    }


#ifdef DBG_TIME
    {
        xcd_barrier(bar);
        if (blockIdx.x == 0) {
            const __attribute__((address_space(4))) char* kp = (const __attribute__((address_space(4))) char*)__builtin_amdgcn_kernarg_segment_ptr();
            float* outp = *(float* const __attribute__((address_space(4)))*)(kp + 248);
            const LAS unsigned long long* st = (const LAS unsigned long long*)((LAS unsigned char*)lds_raw + MISC_OFF + 256);
            __syncthreads();
            const size_t offs[10] = {O_YP, O_YS, O_PCKV, O_PKR, O_PMK, O_PMV, O_PCONV, O_SCKV, O_SKR, O_SCONV};
#pragma unroll
            for (int k = 0; k < 10; ++k) {
                const int a = DBG_TIME + k, b = (k == 9 ? 18 : DBG_TIME + k + 1);
                unsigned us = (unsigned)((st[b] - st[a]) / 100ull) + 1u; if (us > 60000u) us = 60000u;
                for (unsigned i = threadIdx.x; i < us; i += 512) outp[offs[k] + i] = __uint_as_float(0xAAAAAAAAu);
            }
        }
    }
#endif
#ifdef DBG_DUMP
    {
        const __attribute__((address_space(4))) char* kp = (const __attribute__((address_space(4))) char*)__builtin_amdgcn_kernarg_segment_ptr();
        float* outp = *(float* const __attribute__((address_space(4)))*)(kp + 248); unsigned char* wsp = *(unsigned char* const __attribute__((address_space(4)))*)(kp + 256);
        unsigned* bins = (unsigned*)wsp + 65536;
        if (hi == 1000 || (MK_N_LAUNCHES == 1 && hi == NPH_RUN)) {
            if (hi != 1000) xcd_barrier(bar);
            const size_t lo_b = DBG_LO, hi_b = DBG_HI;
            for (size_t i = (size_t)blockIdx.x * 512 + threadIdx.x; i < O_END; i += (size_t)gridDim.x * 512) outp[i] = 0.f;
            const int gwv = blockIdx.x * 8 + (threadIdx.x >> 6), lanev = threadIdx.x & 63;
            const size_t nchunk = (hi_b - lo_b) >> 10;
            for (size_t c = gwv; c < nchunk; c += (size_t)gridDim.x * 8) {
                const u32x4 w = *(const u32x4*)(wsp + lo_b + (c << 10) + lanev * 16);
                unsigned s = (w.x * 0x9E3779B1u) ^ (w.y * 0x85EBCA77u) ^ (w.z * 0xC2B2AE3Du) ^ (w.w * 0x27D4EB2Fu); s *= (2u * lanev + 1u) * 0x165667B1u; s ^= s >> 15;
#pragma unroll
                for (int o = 1; o < 64; o <<= 1) s += __shfl_xor(s, o);
                if (lanev == 0) __hip_atomic_fetch_xor(bins + (c & 1023), s * 0x9E3779B1u, __ATOMIC_RELAXED, __HIP_MEMORY_SCOPE_AGENT);
            }
            if (hi != 1000) xcd_barrier(bar);
        }
        if (hi == 1001 || (MK_N_LAUNCHES == 1 && hi == NPH_RUN)) {
            if (blockIdx.x == 0) for (int i = threadIdx.x; i < 1024; i += 512) outp[i] = (float)(__hip_atomic_load(bins + i, __ATOMIC_RELAXED, __HIP_MEMORY_SCOPE_AGENT) & 0xffffffu) + 1.0f;
        }
    }
#endif
#undef PH_BEGIN
#undef PH_END
}

extern "C" void kernel_launch(void* const* d_in, const int* in_sizes, int n_in, void* d_out, int out_size, void* d_ws, size_t ws_size, hipStream_t stream) {
    static int grid = 0;
    if (grid == 0) {
        if (n_in != 31 || (size_t)out_size != O_END || ws_size < WS_END) {
            fprintf(stderr, "kernel_launch: built for 31 inputs, %zu outputs, >= %zu bytes of workspace; got n_in %d, out %d, ws %zu; nothing launched\n", (size_t)O_END, (size_t)WS_END, n_in, out_size, ws_size);
            grid = -1; return; }
        int dev = 0, cus = 0, per_cu = 0;
        if (hipGetDevice(&dev) != hipSuccess || hipDeviceGetAttribute(&cus, hipDeviceAttributeMultiprocessorCount, dev) != hipSuccess) { fprintf(stderr, "kernel_launch: device query failed\n"); grid = -1; return; }
        if (hipFuncSetAttribute((const void*)trunk_fwd, hipFuncAttributeMaxDynamicSharedMemorySize, LDS_BYTES) != hipSuccess) { fprintf(stderr, "kernel_launch: hipFuncSetAttribute failed\n"); grid = -1; return; }
        if (hipOccupancyMaxActiveBlocksPerMultiprocessor(&per_cu, (const void*)trunk_fwd, 512, LDS_BYTES) != hipSuccess || per_cu < 1)
            fprintf(stderr, "kernel_launch: note: occupancy query reports %d workgroups per CU\n", per_cu);
        (void)hipGetLastError();
        grid = cus;
    }
    if (grid < 0) return;
    if (hipMemsetAsync((char*)d_ws + WS_CTL, 0, 131072, stream) != hipSuccess) { fprintf(stderr, "kernel_launch: memset failed\n"); return; }
    Args a{};
    for (int i = 0; i < 31; ++i) a.in[i] = (const float*)d_in[i];
    a.out = (float*)d_out; a.ws = (unsigned char*)d_ws;
    constexpr int NPH = NPH_RUN;
    if (MK_N_LAUNCHES == 1) {
        a.ph_lo = 0; a.ph_hi = NPH;
        hipLaunchKernelGGL(trunk_fwd, dim3(grid), dim3(512), LDS_BYTES, stream, a);
    } else {
        for (int p = 0; p < NPH; ++p) { a.ph_lo = p; a.ph_hi = p + 1; hipLaunchKernelGGL(trunk_fwd, dim3(grid), dim3(512), LDS_BYTES, stream, a); }
#ifdef DBG_DUMP
        a.ph_lo = 1000; a.ph_hi = 1000; hipLaunchKernelGGL(trunk_fwd, dim3(grid), dim3(512), LDS_BYTES, stream, a);
        a.ph_lo = 1001; a.ph_hi = 1001; hipLaunchKernelGGL(trunk_fwd, dim3(grid), dim3(512), LDS_BYTES, stream, a);
#endif
    }
    const hipError_t le = hipPeekAtLastError();
    if (le != hipSuccess) fprintf(stderr, "kernel_launch: launch failed: %s\n", hipGetErrorName(le));
}
```

```cpp
#include <hip/hip_runtime.h>
#include <cstdio>
#include <cstdint>

#define LAS __attribute__((address_space(3)))
#define GAS __attribute__((address_space(1)))
typedef unsigned short bf16_t;
typedef short bf16x8 __attribute__((ext_vector_type(8)));
typedef short s16x4 __attribute__((ext_vector_type(4)));
typedef float f32x2 __attribute__((ext_vector_type(2)));
typedef float f32x4 __attribute__((ext_vector_type(4)));
typedef float f32x16 __attribute__((ext_vector_type(16)));
typedef unsigned u32x2 __attribute__((ext_vector_type(2)));
typedef unsigned u32x4 __attribute__((ext_vector_type(4)));
typedef GAS unsigned gu32;

#ifndef PH_ONLY
#define PH_ONLY -1
#endif
#define PH_ON(k) (PH_ONLY < 0 || PH_ONLY == (k))
#ifndef REPEAT_MASK
#define REPEAT_MASK 0
#endif
#define REP(k) for (int rep_ = 0; rep_ < (((REPEAT_MASK) >> (k)) & 1) + 1; ++rep_)
#ifndef NPH_RUN
#define NPH_RUN 18
#endif
#ifndef MK_N_LAUNCHES
#define MK_N_LAUNCHES 1
#endif

constexpr int D_MODEL = 2048, M_P = 8192, M_S = 2048, M = M_P + M_S, DEPTH = 2, NSTREAM = 32, DEC_SEQ = 64, PAST = 4096;
constexpr int NH = 16, QK_HEAD = 192, Q_LORA = 512, KV_LORA = 512;
constexpr int CONV_W = 1024, CONV_K = 31, CONV_ST = 30, N_MEM = 256, XW = 1024;
constexpr int IN_COLS = 14400, IN_PAD = 14592;
constexpr int MPAST = NSTREAM * PAST;
constexpr float EPS = 1e-6f;
constexpr float LOG2E = 1.4426950408889634f;
constexpr float C_MLA = 0.07216878364870323f * LOG2E;
constexpr float C_X = 0.0625f * LOG2E;

constexpr size_t O_YP = 0, O_YS = 16777216, O_PCKV = 20971520, O_PKR = 29360128, O_PMK = 30408704, O_PMV = 30932992,
                 O_PCONV = 31457280, O_SCKV = 31518720, O_SKR = 33615872, O_SCONV = 33878016, O_END = 35844096;

constexpr size_t al256(size_t x) { return (x + 255) / 256 * 256; }
constexpr size_t WS_CTL = 0, CTL_BYTES = 1u << 20;
constexpr size_t WS_WIN = WS_CTL + CTL_BYTES;
constexpr size_t WS_WUQ = WS_WIN + (size_t)IN_PAD * 2048 * 2;
constexpr size_t WS_WUKV = WS_WUQ + (size_t)3072 * 512 * 2;
constexpr size_t WS_WPW2 = WS_WUKV + (size_t)4096 * 512 * 2;
constexpr size_t WS_WMEM = WS_WPW2 + (size_t)1024 * 1024 * 2;
constexpr size_t WS_WPM = WS_WMEM + (size_t)2048 * 2048 * 2;
constexpr size_t WS_WPC = WS_WPM + (size_t)2048 * 2048 * 2;
constexpr size_t WS_WPX = WS_WPC + (size_t)2048 * 1024 * 2;
constexpr size_t WS_WOUT = WS_WPX + (size_t)2048 * 1024 * 2;
constexpr size_t WS_ROPE = WS_WOUT + (size_t)2048 * 2048 * 2;
constexpr size_t WS_CNP = WS_ROPE + (size_t)8192 * 64 * 4;
constexpr size_t WS_KPEP = WS_CNP + (size_t)MPAST * 512 * 2;
constexpr size_t WS_SSPEP = WS_KPEP + (size_t)MPAST * 64 * 2;
constexpr size_t WS_KP = WS_SSPEP + (size_t)MPAST * 4;
constexpr size_t WS_VP = WS_KP + (size_t)MPAST * 2048 * 2;
constexpr size_t WS_SSP = WS_VP + (size_t)MPAST * 2048 * 2;
constexpr size_t WS_HB = WS_SSP + (size_t)MPAST * 16 * 4 * 4;
constexpr size_t WS_QRAW = WS_HB;
constexpr size_t WS_QLATF = WS_HB + (size_t)M * 3072 * 2;
constexpr size_t WS_QLATN = WS_QLATF + (size_t)M * 512 * 4;
constexpr size_t WS_CKVN = WS_QLATN + (size_t)M * 512 * 2;
constexpr size_t WS_ZM = WS_CKVN + (size_t)M * 512 * 2;
constexpr size_t WS_UB = WS_ZM + (size_t)M * 2048 * 2;
constexpr size_t WS_ZC = WS_UB + (size_t)M * 1024 * 2;
constexpr size_t WS_XQ = WS_ZC + (size_t)M * 1024 * 2;
constexpr size_t WS_ZX = WS_XQ + (size_t)M * 1024 * 2;
constexpr size_t WS_GATES = WS_ZX + (size_t)M * 1024 * 2;
constexpr size_t WS_CV = WS_GATES + (size_t)M * 6144 * 2;
constexpr size_t WS_Q = WS_CV + (size_t)M * 1024 * 2;
constexpr size_t WS_KC = WS_Q + (size_t)M * 3072 * 2;
constexpr size_t WS_VC = WS_KC + (size_t)M * 2048 * 2;
constexpr size_t WS_SSC = WS_VC + (size_t)M * 2048 * 2;
constexpr size_t WS_KPEC = WS_SSC + (size_t)M * 16 * 4 * 4;
constexpr size_t WS_SSPEC = WS_KPEC + (size_t)M * 64 * 2;
constexpr size_t WS_AMLA = al256(WS_SSPEC + (size_t)M * 4);
constexpr size_t WS_ACONV = WS_AMLA + (size_t)M * 2048 * 2;
constexpr size_t WS_AX = WS_ACONV + (size_t)M * 1024 * 2;
constexpr size_t WS_X1 = WS_AX + (size_t)M * 1024 * 2;
constexpr size_t WS_MEMN = WS_X1 + (size_t)M * 2048 * 4;
constexpr size_t WS_KVRAW = WS_MEMN + (size_t)256 * 2048 * 2;
constexpr size_t WS_MKB = WS_KVRAW + (size_t)256 * 2048 * 4;
constexpr size_t WS_MVB = WS_MKB + (size_t)256 * 1024 * 2;
constexpr size_t WS_RKC = WS_MVB + (size_t)256 * 1024 * 2;
constexpr size_t WS_RKP = WS_RKC + (size_t)16 * M * 4;
constexpr size_t WS_XQN = WS_RKP + (size_t)MPAST * 16 * 4;
constexpr size_t WS_WUK = WS_XQN + (size_t)M * 1024 * 2;
constexpr size_t WS_END = WS_WUK + (size_t)2048 * 512 * 2;
constexpr size_t WS_PB = WS_KP;
constexpr size_t WS_MERGED = WS_KP + 3 * (size_t)M * 2048 * 2;
static_assert(sizeof(void*) == 8, "");
static_assert(WS_END <= 2147483648ull, "workspace map exceeds 2 GiB");
static_assert(WS_MERGED + (size_t)M * 2048 * 2 <= WS_VP, "merged overlay inside KP");

constexpr int CW_BAR = 4096;
constexpr int CW_QHEAD = 16384;

constexpr int RING_BYTES = 131072, SCRATCH_TOP = 161536, MISC_OFF = SCRATCH_TOP + 320, LDS_BYTES = 163840;

typedef __bf16 bf16x2_t __attribute__((ext_vector_type(2)));
__device__ __forceinline__ unsigned cvt_pk_bf16(float lo, float hi) { f32x2 v = {lo, hi}; bf16x2_t b = __builtin_convertvector(v, bf16x2_t); return __builtin_bit_cast(unsigned, b); }
__device__ __forceinline__ float bf_lo(unsigned w) { return __uint_as_float(w << 16); }
__device__ __forceinline__ float bf_hi(unsigned w) { return __uint_as_float(w & 0xffff0000u); }
__device__ __forceinline__ float sigmoidf_(float x) { return __builtin_amdgcn_rcpf(1.0f + __builtin_amdgcn_exp2f(-x * LOG2E)); }
__device__ __forceinline__ float siluf_(float x) { return x * sigmoidf_(x); }
__device__ __forceinline__ float wave_sum(float v) {
#pragma unroll
    for (int o = 1; o < 64; o <<= 1) v += __shfl_xor(v, o);
    return v;
}
__device__ __forceinline__ u32x4 pack8(const f32x4 a, const f32x4 b) {
    u32x4 w; w.x = cvt_pk_bf16(a[0], a[1]); w.y = cvt_pk_bf16(a[2], a[3]); w.z = cvt_pk_bf16(b[0], b[1]); w.w = cvt_pk_bf16(b[2], b[3]); return w;
}
__device__ __forceinline__ void unpack8(const u32x4 w, f32x4& a, f32x4& b) {
    a = (f32x4){bf_lo(w.x), bf_hi(w.x), bf_lo(w.y), bf_hi(w.y)}; b = (f32x4){bf_lo(w.z), bf_hi(w.z), bf_lo(w.w), bf_hi(w.w)};
}
#define LDS_WAIT() asm volatile("s_waitcnt lgkmcnt(0)" ::: "memory")
#define VM_WAIT() asm volatile("s_waitcnt vmcnt(0)" ::: "memory")

namespace pg8 {
constexpr int BM = 256, BK = 64, HALF = 128, HTB = HALF * BK * 2, STAGE_BYTES = 8 * HTB, NXCD = 8, WGM = 8;
__host__ __device__ __forceinline__ int lds_byte(int r, int c) { const int st = (r >> 4) * 2 + (c >> 5), rr = r & 15, cc = c & 31, ob = rr * 64 + cc * 2; return st * 1024 + (ob ^ (((ob >> 9) & 1) << 5)); }
__host__ __device__ __forceinline__ void stage_rc(int b, int& R, int& C) { const int st = b / 1024, sb = b % 1024, swz = sb ^ (((sb >> 9) & 1) << 5); R = (st >> 1) * 16 + swz / 64; C = (st & 1) * 32 + (swz % 64) / 2; }
__host__ __device__ __forceinline__ int perm32(int rho) { const int n = rho >> 4, i = rho & 15; return 8 * (i >> 2) + 4 * n + (i & 3); }
struct Unit { int pm, pn; };
struct Gemm { const bf16_t* A; const bf16_t* Bt; int lda, ldb, K; };
struct StaticOrder {
    int nM, nN, nwg, G, c;
    __device__ void init(int M_, int N_, int G_, int c_) { nM = M_ / BM; nN = N_ / BM; nwg = nM * nN; G = G_; c = c_; }
    __device__ bool next(int i, Unit& u) const {
        const long L = (long)i * G + c; if (L >= nwg) return false;
        int wgid = (int)L; { const int q = nwg / NXCD, r = nwg % NXCD, xcd = wgid % NXCD, off = wgid / NXCD; wgid = (xcd < r ? xcd * (q + 1) : r * (q + 1) + (xcd - r) * q) + off; }
        const int nig = WGM * nN, gid = wgid / nig, fm = gid * WGM, gsz = (nM - fm) < WGM ? (nM - fm) : WGM;
        u.pm = fm + ((wgid % nig) % gsz); u.pn = (wgid % nig) / gsz; return true;
    }
};
struct ListOrder {
    int nM, nN, nwg, L0, n, stride;
    __device__ void init(int M_, int N_, int L0_, int n_, int stride_) { nM = M_ / BM; nN = N_ / BM; nwg = nM * nN; L0 = L0_; n = n_; stride = stride_; }
    __device__ bool next(int i, Unit& u) const {
        if (i >= n) return false;
        int wgid = L0 + i * stride; { const int q = nwg / NXCD, r = nwg % NXCD, xcd = wgid % NXCD, off = wgid / NXCD; wgid = (xcd < r ? xcd * (q + 1) : r * (q + 1) + (xcd - r) * q) + off; }
        const int nig = WGM * nN, gid = wgid / nig, fm = gid * WGM, gsz = (nM - fm) < WGM ? (nM - fm) : WGM;
        u.pm = fm + ((wgid % nig) % gsz); u.pn = (wgid % nig) / gsz; return true;
    }
};
template <class Epi, class Sched>
__device__ __forceinline__ void gemm_phase(LAS unsigned char* lds, const Gemm g, const Sched& S, const Epi& E) {
    int tid = threadIdx.x; asm volatile("" : "+v"(tid));
    const int wid = __builtin_amdgcn_readfirstlane(tid >> 6), lane = tid & 63, wr = wid >> 2, wc = wid & 3, fr = lane & 15, fq = lane >> 4;
    const int K = g.K, nt = K / BK;
    unsigned voffA[2], voffB[2];
#pragma unroll
    for (int i = 0; i < 2; ++i) { int R, C; stage_rc(tid * 16 + i * 8192, R, C); const int Rb = (R & ~31) + perm32(R & 31);
        voffA[i] = (unsigned)(R * g.lda + C) * 2u; voffB[i] = (unsigned)(Rb * g.ldb + C) * 2u; }
    const size_t kstep = (size_t)(BK * 2);
    const size_t hA = (size_t)HALF * g.lda * 2, hB = (size_t)HALF * g.ldb * 2;
    const size_t tA = 2 * hA, tB = 2 * hB;
    const unsigned ldsw = (unsigned)wid * 1024u;
    const int aoff = lds_byte(wr * 64 + fr, fq * 8), boff = lds_byte(wc * 32 + fr, fq * 8);
#define PG8_SA(b, h) (((b) * 2 + (h)) * HTB)
#define PG8_SB(b, h) ((4 + (b) * 2 + (h)) * HTB)
#define PG8_STAGE(bufoff, gbase, voff) do { _Pragma("unroll") for (int _i = 0; _i < 2; ++_i) \
        __builtin_amdgcn_global_load_lds((const unsigned*)((const char*)(gbase) + (voff)[_i]), (LAS unsigned*)(lds + (bufoff) + ldsw + _i * 8192), 16, 0, 0); } while (0)
#define PG8_LDA(dst, b, h) do { _Pragma("unroll") for (int m = 0; m < 4; ++m) _Pragma("unroll") for (int k = 0; k < 2; ++k) dst[m][k] = *(const LAS bf16x8*)(lds + PG8_SA(b, h) + aoff + m * 2048 + k * 1024); } while (0)
#define PG8_LDB(dst, b, h) do { _Pragma("unroll") for (int n = 0; n < 2; ++n) _Pragma("unroll") for (int k = 0; k < 2; ++k) dst[n][k] = *(const LAS bf16x8*)(lds + PG8_SB(b, h) + boff + n * 2048 + k * 1024); } while (0)
#define PG8_MMA(ai, bj, At, Bt) do { __builtin_amdgcn_s_setprio(1); _Pragma("unroll") for (int m = 0; m < 4; ++m) _Pragma("unroll") for (int n = 0; n < 2; ++n) _Pragma("unroll") for (int k = 0; k < 2; ++k) \
        acc[ai][bj][m][n] = __builtin_amdgcn_mfma_f32_16x16x32_bf16(Bt[n][k], At[m][k], acc[ai][bj][m][n], 0, 0, 0); __builtin_amdgcn_s_setprio(0); } while (0)
#define PG8_WAIT_V(n) asm volatile("s_waitcnt vmcnt(" #n ")" ::: "memory")
#define PG8_WAIT_L(n) asm volatile("s_waitcnt lgkmcnt(" #n ")" ::: "memory")
#define PG8_BAR __builtin_amdgcn_s_barrier()
#define PG8_SCHED __builtin_amdgcn_sched_barrier(0)
    Unit cur, nxt; int ui = 0;
    if (!S.next(0, cur)) return;
    f32x4 acc[2][2][4][2];
#pragma unroll
    for (int a = 0; a < 2; ++a)
#pragma unroll
        for (int b = 0; b < 2; ++b)
#pragma unroll
            for (int m = 0; m < 4; ++m)
#pragma unroll
                for (int n = 0; n < 2; ++n) acc[a][b][m][n] = (f32x4){0.f, 0.f, 0.f, 0.f};
    bf16x8 At[4][2], B0[2][2], B1[2][2];
    const char* cA = (const char*)g.A + (size_t)cur.pm * tA; const char* cB = (const char*)g.Bt + (size_t)cur.pn * tB;
    PG8_STAGE(PG8_SB(0, 0), cB, voffB); PG8_STAGE(PG8_SB(0, 1), cB + hB, voffB); PG8_STAGE(PG8_SA(0, 0), cA, voffA); PG8_STAGE(PG8_SA(0, 1), cA + hA, voffA);
    if (wr == 1) PG8_BAR;
    PG8_WAIT_V(2); PG8_BAR;
    PG8_STAGE(PG8_SB(1, 0), cB + kstep, voffB); PG8_STAGE(PG8_SA(1, 0), cA + kstep, voffA); PG8_STAGE(PG8_SB(1, 1), cB + hB + kstep, voffB);
    PG8_WAIT_V(6); PG8_BAR;
    for (;;) {
        const bool has_next = S.next(ui + 1, nxt);
        const char* nA = has_next ? (const char*)g.A + (size_t)nxt.pm * tA : cA; const char* nB = has_next ? (const char*)g.Bt + (size_t)nxt.pn * tB : cB;
        for (int t = 0; t < nt; t += 2) {
            const bool last = (t == nt - 2);
            const char* a1 = cA + (size_t)(t + 1) * kstep;
            const char* a2 = last ? nA : cA + (size_t)(t + 2) * kstep; const char* b2 = last ? nB : cB + (size_t)(t + 2) * kstep;
            const char* a3 = a2 + kstep; const char* b3 = b2 + kstep;
            PG8_LDB(B0, 0, 0); PG8_LDB(B1, 0, 1); PG8_SCHED; PG8_LDA(At, 0, 0); PG8_STAGE(PG8_SA(1, 1), a1 + hA, voffA);
            PG8_WAIT_V(8); PG8_WAIT_L(0); PG8_BAR; PG8_MMA(0, 0, At, B0); PG8_MMA(0, 1, At, B1); PG8_BAR; PG8_SCHED;
            PG8_LDA(At, 0, 1); PG8_STAGE(PG8_SB(0, 0), b2, voffB); PG8_STAGE(PG8_SB(0, 1), b2 + hB, voffB); PG8_STAGE(PG8_SA(0, 0), a2, voffA);
            PG8_WAIT_V(8); PG8_WAIT_L(0); PG8_BAR; PG8_MMA(1, 0, At, B0); PG8_MMA(1, 1, At, B1); PG8_BAR; PG8_SCHED;
            PG8_LDB(B0, 1, 0); PG8_LDB(B1, 1, 1); PG8_SCHED; PG8_LDA(At, 1, 0); PG8_STAGE(PG8_SA(0, 1), a2 + hA, voffA);
            PG8_WAIT_V(8); PG8_WAIT_L(0); PG8_BAR; PG8_MMA(0, 0, At, B0); PG8_MMA(0, 1, At, B1); PG8_BAR; PG8_SCHED;
            PG8_LDA(At, 1, 1); PG8_STAGE(PG8_SB(1, 0), b3, voffB); PG8_STAGE(PG8_SB(1, 1), b3 + hB, voffB); PG8_STAGE(PG8_SA(1, 0), a3, voffA);
            PG8_WAIT_V(8); PG8_WAIT_L(0); PG8_BAR; PG8_MMA(1, 0, At, B0); PG8_MMA(1, 1, At, B1); PG8_BAR; PG8_SCHED;
        }
        if (wr == 0) PG8_BAR;
        E(acc, cur);
        if (!has_next) break;
#pragma unroll
        for (int a = 0; a < 2; ++a)
#pragma unroll
            for (int b = 0; b < 2; ++b)
#pragma unroll
                for (int m = 0; m < 4; ++m)
#pragma unroll
                    for (int n = 0; n < 2; ++n) acc[a][b][m][n] = (f32x4){0.f, 0.f, 0.f, 0.f};
        cur = nxt; cA = nA; cB = nB; ++ui;
        if (wr == 1) PG8_BAR;
    }
    PG8_WAIT_V(0);
    PG8_BAR;
#undef PG8_SA
#undef PG8_SB
#undef PG8_STAGE
#undef PG8_LDA
#undef PG8_LDB
#undef PG8_MMA
#undef PG8_WAIT_V
#undef PG8_WAIT_L
#undef PG8_BAR
#undef PG8_SCHED
}
}
using pg8::Unit;

#define EPI_LANE int tz_ = threadIdx.x; asm volatile("" : "+v"(tz_)); const int wr = tz_ >> 8, wc = (tz_ >> 6) & 3, fr = tz_ & 15, fq = (tz_ >> 4) & 3; (void)wr; (void)wc; (void)fr; (void)fq;
#define EPI_LOOP_BEGIN \
    _Pragma("unroll") for (int ai = 0; ai < 2; ++ai) _Pragma("unroll") for (int m = 0; m < 4; ++m) { const int row = u.pm * 256 + ai * 128 + wr * 64 + m * 16 + fr; \
    _Pragma("unroll") for (int bj = 0; bj < 2; ++bj) { const int colt = bj * 128 + wc * 32 + 8 * fq; const f32x4 v0 = acc[ai][bj][m][0], v1 = acc[ai][bj][m][1]; (void)colt; (void)v0; (void)v1;
#define EPI_LOOP_END } }

struct EpiBf16 {
    bf16_t* O; int ldc;
    __device__ __forceinline__ void operator()(const f32x4 (&acc)[2][2][4][2], const Unit& u) const {
        EPI_LANE
        EPI_LOOP_BEGIN
            *(u32x4*)(O + (size_t)row * ldc + u.pn * 256 + colt) = pack8(v0, v1);
        EPI_LOOP_END
    }
};
struct EpiNone { __device__ __forceinline__ void operator()(const f32x4 (&acc)[2][2][4][2], const Unit& u) const { (void)u;
#pragma unroll
    for (int a = 0; a < 2; ++a)
#pragma unroll
        for (int b = 0; b < 2; ++b)
#pragma unroll
            for (int m = 0; m < 4; ++m) asm volatile("" :: "v"(acc[a][b][m][0]), "v"(acc[a][b][m][1])); } };
struct EpiF32 {
    float* C; int ldc;
    __device__ __forceinline__ void operator()(const f32x4 (&acc)[2][2][4][2], const Unit& u) const {
        EPI_LANE
        EPI_LOOP_BEGIN
            float* p = C + (size_t)row * ldc + u.pn * 256 + colt; *(f32x4*)p = v0; *(f32x4*)(p + 4) = v1;
        EPI_LOOP_END
    }
};
struct EpiWin {
    unsigned char* ws; float* out; const float* bmerge; int l;
    __device__ __forceinline__ void operator()(const f32x4 (&acc)[2][2][4][2], const Unit& u) const {
        EPI_LANE
        const int pn = u.pn;
        if (pn < 2) {
            float* qlat = (float*)(ws + WS_QLATF);
            EPI_LOOP_BEGIN
                float* p = qlat + (size_t)row * 512 + pn * 256 + colt; *(f32x4*)p = v0; *(f32x4*)(p + 4) = v1;
            EPI_LOOP_END
        } else if (pn < 4) {
            float* ckv_p = out + O_PCKV + (size_t)l * M_P * 512; float* ckv_s = out + O_SCKV + (size_t)l * M_S * 512;
            EPI_LOOP_BEGIN
                float* p = (row < M_P ? ckv_p + (size_t)row * 512 : ckv_s + (size_t)(row - M_P) * 512) + (pn - 2) * 256 + colt; *(f32x4*)p = v0; *(f32x4*)(p + 4) = v1;
            EPI_LOOP_END
        } else if (pn == 4) {
            float* kr_p = out + O_PKR + (size_t)l * M_P * 64; float* kr_s = out + O_SKR + (size_t)l * M_S * 64;
            EPI_LOOP_BEGIN
                if (colt < 64) { float* p = (row < M_P ? kr_p + (size_t)row * 64 : kr_s + (size_t)(row - M_P) * 64) + colt; *(f32x4*)p = v0; *(f32x4*)(p + 4) = v1; }
            EPI_LOOP_END
        } else if (pn < 13) {
            bf16_t* zm = (bf16_t*)(ws + WS_ZM);
            EPI_LOOP_BEGIN
                f32x4 a, b;
#pragma unroll
                for (int j = 0; j < 4; ++j) { a[j] = siluf_(v0[j]); b[j] = siluf_(v1[j]); }
                *(u32x4*)(zm + (size_t)row * 2048 + (pn - 5) * 256 + colt) = pack8(a, b);
            EPI_LOOP_END
        } else if (pn < 21) {
            const int t = pn - 13;
            bf16_t* ub = (bf16_t*)(ws + WS_UB);
            float* conv_p = out + O_PCONV + (size_t)l * CONV_ST * 1024; float* conv_s = out + O_SCONV + (size_t)l * NSTREAM * CONV_ST * 1024;
#pragma unroll
            for (int ai = 0; ai < 2; ++ai)
#pragma unroll
                for (int m = 0; m < 4; ++m) {
                    const int row = u.pm * 256 + ai * 128 + wr * 64 + m * 16 + fr; const int col = t * 128 + wc * 32 + 8 * fq;
                    f32x4 a, b;
#pragma unroll
                    for (int j = 0; j < 4; ++j) { a[j] = acc[ai][0][m][0][j] * sigmoidf_(acc[ai][1][m][0][j]); b[j] = acc[ai][0][m][1][j] * sigmoidf_(acc[ai][1][m][1][j]); }
                    *(u32x4*)(ub + (size_t)row * 1024 + col) = pack8(a, b);
                    if (row >= M_P - CONV_ST) {
                        if (row < M_P) { float* p = conv_p + (size_t)(row - (M_P - CONV_ST)) * 1024 + col; *(f32x4*)p = a; *(f32x4*)(p + 4) = b; }
                        else { const int rs = row - M_P, sq = rs & 63, bb = rs >> 6;
                            if (sq >= DEC_SEQ - CONV_ST) { float* p = conv_s + ((size_t)bb * CONV_ST + (sq - (DEC_SEQ - CONV_ST))) * 1024 + col; *(f32x4*)p = a; *(f32x4*)(p + 4) = b; } }
                    }
                }
        } else if (pn < 33) {
            const size_t dofs = pn < 25 ? WS_ZC : (pn < 29 ? WS_XQ : WS_ZX); const int tb = pn < 25 ? 21 : (pn < 29 ? 25 : 29); const bool act = !(pn >= 25 && pn < 29);
            bf16_t* dst = (bf16_t*)(ws + dofs);
            EPI_LOOP_BEGIN
                f32x4 a = v0, b = v1;
                if (act) {
#pragma unroll
                    for (int j = 0; j < 4; ++j) { a[j] = siluf_(v0[j]); b[j] = siluf_(v1[j]); } }
                *(u32x4*)(dst + (size_t)row * 1024 + (pn - tb) * 256 + colt) = pack8(a, b);
            EPI_LOOP_END
        } else {
            bf16_t* gates = (bf16_t*)(ws + WS_GATES);
            f32x4 bb[2][2];
#pragma unroll
            for (int bj = 0; bj < 2; ++bj) { const float* bp = bmerge + (pn - 33) * 256 + bj * 128 + wc * 32 + 8 * fq; bb[bj][0] = *(const f32x4*)bp; bb[bj][1] = *(const f32x4*)(bp + 4); }
            EPI_LOOP_BEGIN
                const int col = (pn - 33) * 256 + colt;
                f32x4 a, b;
#pragma unroll
                for (int j = 0; j < 4; ++j) { a[j] = sigmoidf_(v0[j] + bb[bj][0][j]); b[j] = sigmoidf_(v1[j] + bb[bj][1][j]); }
                *(u32x4*)(gates + (size_t)row * 6144 + col) = pack8(a, b);
            EPI_LOOP_END
        }
    }
};
template <bool PASTROWS> struct EpiKV {
    bf16_t* Kd; bf16_t* Vd; float* SS;
    __device__ __forceinline__ void operator()(const f32x4 (&acc)[2][2][4][2], const Unit& u) const {
        EPI_LANE
        const int h = u.pn;
#pragma unroll
        for (int ai = 0; ai < 2; ++ai)
#pragma unroll
            for (int m = 0; m < 4; ++m) {
                const int row = u.pm * 256 + ai * 128 + wr * 64 + m * 16 + fr;
                const size_t R = PASTROWS ? ((size_t)((row >> 12) * 16 + h) * 4096 + (row & 4095)) : ((size_t)h * M + row);
                const int c = wc * 32 + 8 * fq;
                const f32x4 k0 = acc[ai][0][m][0], k1 = acc[ai][0][m][1];
                *(u32x4*)(Kd + R * 128 + c) = pack8(k0, k1);
                *(u32x4*)(Vd + R * 128 + c) = pack8(acc[ai][1][m][0], acc[ai][1][m][1]);
                float s = (k0[0] * k0[0] + k0[1] * k0[1]) + (k0[2] * k0[2] + k0[3] * k0[3]) + (k1[0] * k1[0] + k1[1] * k1[1]) + (k1[2] * k1[2] + k1[3] * k1[3]);
                s += __shfl_xor(s, 16); s += __shfl_xor(s, 32);
                if (fq == 0) SS[R * 4 + wc] = s;
            }
    }
};
template <bool DOK = true, bool DOSS = true, bool TILED = true> struct EpiK {
    bf16_t* Kd; float* SS;
    __device__ __forceinline__ void operator()(const f32x4 (&acc)[2][2][4][2], const Unit& u) const {
        EPI_LANE
        float sq[2][4][2];
#pragma unroll
        for (int ai = 0; ai < 2; ++ai)
#pragma unroll
            for (int m = 0; m < 4; ++m)
#pragma unroll
                for (int bj = 0; bj < 2; ++bj) {
                    const f32x4 k0 = acc[ai][bj][m][0], k1 = acc[ai][bj][m][1];
                    if (DOK) *(u32x4*)(Kd + ((((((((size_t)u.pm * 8 + u.pn) * 2 + ai) * 2 + wr) * 4 + m) * 2 + bj) * 4 + wc) * 64 + (fq * 16 + fr)) * 8) = pack8(k0, k1);
                    sq[ai][m][bj] = (k0[0] * k0[0] + k0[1] * k0[1]) + (k0[2] * k0[2] + k0[3] * k0[3]) + (k1[0] * k1[0] + k1[1] * k1[1]) + (k1[2] * k1[2] + k1[3] * k1[3]);
                }
#pragma unroll
        for (int ai = 0; ai < 2; ++ai)
#pragma unroll
            for (int m = 0; m < 4; ++m)
#pragma unroll
                for (int bj = 0; bj < 2; ++bj) sq[ai][m][bj] += __shfl_xor(sq[ai][m][bj], 16);
#pragma unroll
        for (int ai = 0; ai < 2; ++ai)
#pragma unroll
            for (int m = 0; m < 4; ++m)
#pragma unroll
                for (int bj = 0; bj < 2; ++bj) sq[ai][m][bj] += __shfl_xor(sq[ai][m][bj], 32);
        if (DOSS) {
#pragma unroll
            for (int ai = 0; ai < 2; ++ai)
#pragma unroll
                for (int bj = 0; bj < 2; ++bj) {
                    const float v = fq == 0 ? sq[ai][0][bj] : (fq == 1 ? sq[ai][1][bj] : (fq == 2 ? sq[ai][2][bj] : sq[ai][3][bj]));
                    const int row = u.pm * 256 + ai * 128 + wr * 64 + fq * 16 + fr; const int h = u.pn * 2 + bj;
                    SS[(size_t)wc * ((size_t)MPAST * 16) + (size_t)((row >> 12) * 16 + h) * 4096 + (row & 4095)] = v;
                }
        }
        (void)TILED;
    }
};
struct EpiPw2 {
    bf16_t* O; const bf16_t* zc; const float* bias;
    __device__ __forceinline__ void operator()(const f32x4 (&acc)[2][2][4][2], const Unit& u) const {
        EPI_LANE
        f32x4 bb[2][2];
#pragma unroll
        for (int bj = 0; bj < 2; ++bj) { const float* bp = bias + u.pn * 256 + bj * 128 + wc * 32 + 8 * fq; bb[bj][0] = *(const f32x4*)bp; bb[bj][1] = *(const f32x4*)(bp + 4); }
#pragma unroll
        for (int ai = 0; ai < 2; ++ai) {
            u32x4 z[4][2];
#pragma unroll
            for (int m = 0; m < 4; ++m)
#pragma unroll
                for (int bj = 0; bj < 2; ++bj) { const int row = u.pm * 256 + ai * 128 + wr * 64 + m * 16 + fr; z[m][bj] = *(const u32x4*)(zc + (size_t)row * 1024 + u.pn * 256 + bj * 128 + wc * 32 + 8 * fq); }
#pragma unroll
            for (int m = 0; m < 4; ++m)
#pragma unroll
                for (int bj = 0; bj < 2; ++bj) { const int row = u.pm * 256 + ai * 128 + wr * 64 + m * 16 + fr; const int col = u.pn * 256 + bj * 128 + wc * 32 + 8 * fq;
                    f32x4 z0, z1; unpack8(z[m][bj], z0, z1);
                    *(u32x4*)(O + (size_t)row * 1024 + col) = pack8((acc[ai][bj][m][0] + bb[bj][0]) * z0, (acc[ai][bj][m][1] + bb[bj][1]) * z1); }
            asm volatile("" ::: "memory");
        }
    }
};
struct EpiGate {
    bf16_t* O; const bf16_t* gates; int goff;
    __device__ __forceinline__ void operator()(const f32x4 (&acc)[2][2][4][2], const Unit& u) const {
        EPI_LANE
#pragma unroll
        for (int ai = 0; ai < 2; ++ai) {
            u32x4 gg[4][2];
#pragma unroll
            for (int m = 0; m < 4; ++m)
#pragma unroll
                for (int bj = 0; bj < 2; ++bj) { const int row = u.pm * 256 + ai * 128 + wr * 64 + m * 16 + fr; gg[m][bj] = *(const u32x4*)(gates + (size_t)row * 6144 + goff + u.pn * 256 + bj * 128 + wc * 32 + 8 * fq); }
#pragma unroll
            for (int m = 0; m < 4; ++m)
#pragma unroll
                for (int bj = 0; bj < 2; ++bj) { const int row = u.pm * 256 + ai * 128 + wr * 64 + m * 16 + fr; const int col = u.pn * 256 + bj * 128 + wc * 32 + 8 * fq;
                    f32x4 g0, g1; unpack8(gg[m][bj], g0, g1);
                    *(u32x4*)(O + (size_t)row * 2048 + col) = pack8(g0 * acc[ai][bj][m][0], g1 * acc[ai][bj][m][1]); }
            asm volatile("" ::: "memory");
        }
    }
};
struct EpiOut {
    const float* src_p; const float* src_s; float* dst_p; float* dst_s;
    __device__ __forceinline__ void operator()(const f32x4 (&acc)[2][2][4][2], const Unit& u) const {
        EPI_LANE
        const bool pr = u.pm * 256 < M_P;
        const float* src = pr ? src_p : src_s; float* dst = pr ? dst_p : dst_s; const int rbase = u.pm * 256 - (pr ? 0 : M_P);
#pragma unroll
        for (int ai = 0; ai < 2; ++ai)
#pragma unroll
            for (int mh = 0; mh < 2; ++mh) {
                f32x4 xx[2][2][2];
#pragma unroll
                for (int mm = 0; mm < 2; ++mm)
#pragma unroll
                    for (int bj = 0; bj < 2; ++bj) { const int m = mh * 2 + mm; const size_t off = (size_t)(rbase + ai * 128 + wr * 64 + m * 16 + fr) * 2048 + u.pn * 256 + bj * 128 + wc * 32 + 8 * fq;
                        xx[mm][bj][0] = *(const f32x4*)(src + off); xx[mm][bj][1] = *(const f32x4*)(src + off + 4); }
#pragma unroll
                for (int mm = 0; mm < 2; ++mm)
#pragma unroll
                    for (int bj = 0; bj < 2; ++bj) { const int m = mh * 2 + mm; const size_t off = (size_t)(rbase + ai * 128 + wr * 64 + m * 16 + fr) * 2048 + u.pn * 256 + bj * 128 + wc * 32 + 8 * fq;
                        *(f32x4*)(dst + off) = xx[mm][bj][0] + acc[ai][bj][m][0]; *(f32x4*)(dst + off + 4) = xx[mm][bj][1] + acc[ai][bj][m][1]; }
                asm volatile("" ::: "memory");
            }
    }
};

namespace att {
__device__ __forceinline__ int crow(int r, int hi) { return (r & 3) + 8 * (r >> 2) + 4 * hi; }
template <int ROWB> __device__ __forceinline__ int kswz(int row, int colB) { return row * ROWB + (colB ^ ((row & 7) << 4)); }
template <int NDV> __device__ __forceinline__ int v_st(int k, int c) { const int kk = (k & ~0xC) | ((k & 4) << 1) | ((k & 8) >> 1); return ((kk >> 3) * NDV + (c >> 5)) * 512 + ((kk & 7) * 32 + (c & 31)) * 2; }
__device__ __forceinline__ int v_rd_base(int lane) { return ((lane & 3) << 3) | (((lane >> 2) & 3) << 6) | (((lane >> 4) & 1) << 5) | (((lane >> 5) & 1) << 8); }

template <int NQA, int NQB, int NDV, int NKB, bool HAS_RK, int KROWB, int KR = 3>
__device__ __forceinline__ void tile_step(const bf16x8 (&qr)[NQA + NQB], f32x16 (&o)[NDV], float& m_reg, float& l_reg,
                                          const LAS char* Ks, const LAS char* Kp, int vb, const LAS float* rk, LAS float* al_l, int r32, int hi) {
    f32x16 p[NKB];
#pragma unroll
    for (int kb = 0; kb < NKB; ++kb)
#pragma unroll
        for (int r = 0; r < 16; ++r) p[kb][r] = 0.f;
    {
        auto kfrag = [&](int kb, int d) -> bf16x8 { return d < NQA ? *(const LAS bf16x8*)(Ks + kswz<KROWB>(kb * 32 + r32, (d * 16 + hi * 8) * 2)) : *(const LAS bf16x8*)(Kp + kswz<128>(kb * 32 + r32, ((d - NQA) * 16 + hi * 8) * 2)); };
        bf16x8 kf[KR][NKB];
#pragma unroll
        for (int a = 0; a < KR - 1; ++a)
#pragma unroll
            for (int kb = 0; kb < NKB; ++kb) kf[a][kb] = kfrag(kb, a);
#pragma unroll
        for (int d0 = 0; d0 < NQA + NQB; ++d0) {
            if (d0 + KR - 1 < NQA + NQB) {
#pragma unroll
                for (int kb = 0; kb < NKB; ++kb) kf[(d0 + KR - 1) % KR][kb] = kfrag(kb, d0 + KR - 1); }
#pragma unroll
            for (int kb = 0; kb < NKB; ++kb) p[kb] = __builtin_amdgcn_mfma_f32_32x32x16_bf16(kf[d0 % KR][kb], qr[d0], p[kb], 0, 0, 0);
        }
    }
    if (HAS_RK) {
#pragma unroll
        for (int kb = 0; kb < NKB; ++kb)
#pragma unroll
            for (int i = 0; i < 4; ++i) { const f32x4 s = *(const LAS f32x4*)(rk + kb * 32 + 8 * i + 4 * hi);
#pragma unroll
                for (int j = 0; j < 4; ++j) p[kb][4 * i + j] *= s[j]; }
    }
    float pmax = p[0][0];
#pragma unroll
    for (int kb = 0; kb < NKB; ++kb)
#pragma unroll
        for (int r = 0; r < 16; ++r) pmax = fmaxf(pmax, p[kb][r]);
    { auto rr = __builtin_amdgcn_permlane32_swap(__float_as_uint(pmax), __float_as_uint(pmax), false, false); pmax = fmaxf(__uint_as_float(rr[0]), __uint_as_float(rr[1])); }
    const float mn = fmaxf(m_reg, pmax); const float alpha = __builtin_amdgcn_exp2f(m_reg - mn); m_reg = mn;
    float ps = 0.f;
#pragma unroll
    for (int kb = 0; kb < NKB; ++kb)
#pragma unroll
        for (int r = 0; r < 16; ++r) { p[kb][r] = __builtin_amdgcn_exp2f(p[kb][r] - mn); ps += p[kb][r]; }
    { auto rr = __builtin_amdgcn_permlane32_swap(__float_as_uint(ps), __float_as_uint(ps), false, false); ps = __uint_as_float(rr[0]) + __uint_as_float(rr[1]); }
    l_reg = l_reg * alpha + ps;
    if (__any(alpha < 1.f)) {
        if (hi == 0) al_l[r32] = alpha;
        LDS_WAIT();
        float al[16];
#pragma unroll
        for (int r = 0; r < 16; ++r) al[r] = al_l[crow(r, hi)];
#pragma unroll
        for (int d = 0; d < NDV; ++d)
#pragma unroll
            for (int r = 0; r < 16; ++r) o[d][r] *= al[r];
    }
    bf16x8 pa[2 * NKB];
#pragma unroll
    for (int kb = 0; kb < NKB; ++kb)
#pragma unroll
        for (int hf = 0; hf < 2; ++hf) { const int B = hf * 8;
            const unsigned a0 = cvt_pk_bf16(p[kb][B + 0], p[kb][B + 1]), a1 = cvt_pk_bf16(p[kb][B + 2], p[kb][B + 3]);
            const unsigned b0 = cvt_pk_bf16(p[kb][B + 4], p[kb][B + 5]), b1 = cvt_pk_bf16(p[kb][B + 6], p[kb][B + 7]);
            auto r0 = __builtin_amdgcn_permlane32_swap(a0, b0, false, false); auto r1 = __builtin_amdgcn_permlane32_swap(a1, b1, false, false);
            u32x4 w = {r0[0], r1[0], r0[1], r1[1]}; pa[kb * 2 + hf] = __builtin_bit_cast(bf16x8, w); }
#pragma unroll
    for (int d0 = 0; d0 < NDV; ++d0) {
        s16x4 lo[2 * NKB], hh[2 * NKB];
#pragma unroll
        for (int ks = 0; ks < 2 * NKB; ++ks) {
            asm volatile("ds_read_b64_tr_b16 %0, %1 offset:%c2" : "=&v"(lo[ks]) : "v"(vb), "i"(d0 * 512 + ks * (NDV * 1024)) : "memory");
            asm volatile("ds_read_b64_tr_b16 %0, %1 offset:%c2" : "=&v"(hh[ks]) : "v"(vb), "i"(d0 * 512 + ks * (NDV * 1024) + NDV * 512) : "memory"); }
        asm volatile("s_waitcnt lgkmcnt(0)" ::: "memory"); __builtin_amdgcn_sched_barrier(0);
#pragma unroll
        for (int ks = 0; ks < 2 * NKB; ++ks) { const bf16x8 vf = (bf16x8){lo[ks][0], lo[ks][1], lo[ks][2], lo[ks][3], hh[ks][0], hh[ks][1], hh[ks][2], hh[ks][3]};
            o[d0] = __builtin_amdgcn_mfma_f32_32x32x16_bf16(pa[ks], vf, o[d0], 0, 0, 0); }
    }
}
typedef short v4i16_t __attribute__((ext_vector_type(4)));
__device__ __forceinline__ s16x4 vtr(const LAS char* p) { return __builtin_bit_cast(s16x4, __builtin_amdgcn_ds_read_tr16_b64_v4i16((LAS v4i16_t*)p)); }
template <int NQA, int NQB, int NDV, int NKB, int KROWB, int NDVT = NDV>
__device__ __forceinline__ void tile_step_fs(const bf16x8 (&qr)[NQA + NQB], f32x16 (&o)[NDV], float& l_part,
                                             const LAS char* Ks, const LAS char* Kp, const LAS char* vbp, const LAS float* rk, float negB2, int r32, int hi) {
    f32x16 p[NKB];
#pragma unroll
    for (int kb = 0; kb < NKB; ++kb)
#pragma unroll
        for (int r = 0; r < 16; ++r) p[kb][r] = 0.f;
    bf16x8 ka[NKB], kn[NKB];
#pragma unroll
    for (int kb = 0; kb < NKB; ++kb) ka[kb] = *(const LAS bf16x8*)(Ks + kswz<KROWB>(kb * 32 + r32, hi * 16));
#pragma unroll
    for (int d0 = 0; d0 < NQA + NQB; ++d0) {
        if (d0 + 1 < NQA + NQB) {
#pragma unroll
            for (int kb = 0; kb < NKB; ++kb) { const int d1 = d0 + 1;
                kn[kb] = d1 < NQA ? *(const LAS bf16x8*)(Ks + kswz<KROWB>(kb * 32 + r32, (d1 * 16 + hi * 8) * 2)) : *(const LAS bf16x8*)(Kp + kswz<128>(kb * 32 + r32, ((d1 - NQA) * 16 + hi * 8) * 2)); } }
#pragma unroll
        for (int kb = 0; kb < NKB; ++kb) p[kb] = __builtin_amdgcn_mfma_f32_32x32x16_bf16(ka[kb], qr[d0], p[kb], 0, 0, 0);
#pragma unroll
        for (int kb = 0; kb < NKB; ++kb) ka[kb] = kn[kb];
    }
#pragma unroll
    for (int kb = 0; kb < NKB; ++kb) {
        float ps = 0.f;
#pragma unroll
        for (int i = 0; i < 4; ++i) { const f32x4 s = *(const LAS f32x4*)(rk + kb * 32 + 8 * i + 4 * hi);
#pragma unroll
            for (int j = 0; j < 4; ++j) { const float e = __builtin_amdgcn_exp2f(fmaf(p[kb][4 * i + j], s[j], negB2)); p[kb][4 * i + j] = e; ps += e; } }
        l_part += ps;
        bf16x8 pa[2];
#pragma unroll
        for (int hf = 0; hf < 2; ++hf) { const int B = hf * 8;
            const unsigned a0 = cvt_pk_bf16(p[kb][B + 0], p[kb][B + 1]), a1 = cvt_pk_bf16(p[kb][B + 2], p[kb][B + 3]);
            const unsigned b0 = cvt_pk_bf16(p[kb][B + 4], p[kb][B + 5]), b1 = cvt_pk_bf16(p[kb][B + 6], p[kb][B + 7]);
            auto r0 = __builtin_amdgcn_permlane32_swap(a0, b0, false, false); auto r1 = __builtin_amdgcn_permlane32_swap(a1, b1, false, false);
            u32x4 w = {r0[0], r1[0], r0[1], r1[1]}; pa[hf] = __builtin_bit_cast(bf16x8, w); }
#pragma unroll
        for (int hf = 0; hf < 2; ++hf) { const int ks = kb * 2 + hf;
            bf16x8 vf[NDV];
#pragma unroll
            for (int d0 = 0; d0 < NDV; ++d0) { const s16x4 lo = vtr(vbp + d0 * 512 + ks * (NDVT * 1024)), hh = vtr(vbp + d0 * 512 + ks * (NDVT * 1024) + NDVT * 512);
                vf[d0] = (bf16x8){lo[0], lo[1], lo[2], lo[3], hh[0], hh[1], hh[2], hh[3]}; }
#pragma unroll
            for (int d0 = 0; d0 < NDV; ++d0) o[d0] = __builtin_amdgcn_mfma_f32_32x32x16_bf16(pa[hf], vf[d0], o[d0], 0, 0, 0); }
    }
}
template <int NQA, int NQB, int NKB, int KROWB>
__device__ __forceinline__ void qk_sm(const bf16x8 (&qr)[NQA + NQB], float& l_part, const LAS char* Ks, const LAS char* Kp, const LAS float* rk, float negB2, int r32, int hi, bf16x8 (&pa)[2 * NKB]) {
    f32x16 p[NKB];
#pragma unroll
    for (int kb = 0; kb < NKB; ++kb)
#pragma unroll
        for (int r = 0; r < 16; ++r) p[kb][r] = 0.f;
    auto kfrag = [&](int kb, int d) -> bf16x8 { return d < NQA ? *(const LAS bf16x8*)(Ks + kswz<KROWB>(kb * 32 + r32, (d * 16 + hi * 8) * 2)) : *(const LAS bf16x8*)(Kp + kswz<128>(kb * 32 + r32, ((d - NQA) * 16 + hi * 8) * 2)); };
    bf16x8 kf[3][NKB];
#pragma unroll
    for (int kb = 0; kb < NKB; ++kb) { kf[0][kb] = kfrag(kb, 0); kf[1][kb] = kfrag(kb, 1); }
#pragma unroll
    for (int d0 = 0; d0 < NQA + NQB; ++d0) {
        if (d0 + 2 < NQA + NQB) {
#pragma unroll
            for (int kb = 0; kb < NKB; ++kb) kf[(d0 + 2) % 3][kb] = kfrag(kb, d0 + 2); }
#pragma unroll
        for (int kb = 0; kb < NKB; ++kb) p[kb] = __builtin_amdgcn_mfma_f32_32x32x16_bf16(kf[d0 % 3][kb], qr[d0], p[kb], 0, 0, 0);
    }
    f32x4 sc[NKB][4];
#pragma unroll
    for (int kb = 0; kb < NKB; ++kb)
#pragma unroll
        for (int i = 0; i < 4; ++i) sc[kb][i] = *(const LAS f32x4*)(rk + kb * 32 + 8 * i + 4 * hi);
#pragma unroll
    for (int kb = 0; kb < NKB; ++kb) {
        float ps = 0.f;
#pragma unroll
        for (int i = 0; i < 4; ++i) {
#pragma unroll
            for (int j = 0; j < 4; ++j) { const float e = __builtin_amdgcn_exp2f(fmaf(p[kb][4 * i + j], sc[kb][i][j], negB2)); p[kb][4 * i + j] = e; ps += e; } }
        l_part += ps;
#pragma unroll
        for (int hf = 0; hf < 2; ++hf) { const int B = hf * 8;
            const unsigned a0 = cvt_pk_bf16(p[kb][B + 0], p[kb][B + 1]), a1 = cvt_pk_bf16(p[kb][B + 2], p[kb][B + 3]);
            const unsigned b0 = cvt_pk_bf16(p[kb][B + 4], p[kb][B + 5]), b1 = cvt_pk_bf16(p[kb][B + 6], p[kb][B + 7]);
            auto r0 = __builtin_amdgcn_permlane32_swap(a0, b0, false, false); auto r1 = __builtin_amdgcn_permlane32_swap(a1, b1, false, false);
            u32x4 w = {r0[0], r1[0], r0[1], r1[1]}; pa[kb * 2 + hf] = __builtin_bit_cast(bf16x8, w); }
    }
}
template <int NDV, int NKB>
__device__ __forceinline__ void pv_fs(f32x16 (&o)[NDV], const LAS char* vbp, const bf16x8 (&pa)[2 * NKB]) {
    const int vb = (int)(uintptr_t)vbp;
    s16x4 lo[2][NDV], hh[2][NDV];
    __builtin_amdgcn_sched_barrier(0);
#pragma unroll
    for (int d0 = 0; d0 < NDV; ++d0) {
        asm volatile("ds_read_b64_tr_b16 %0, %1 offset:%c2" : "=&v"(lo[0][d0]) : "v"(vb), "i"(d0 * 512) : "memory");
        asm volatile("ds_read_b64_tr_b16 %0, %1 offset:%c2" : "=&v"(hh[0][d0]) : "v"(vb), "i"(d0 * 512 + NDV * 512) : "memory"); }
#pragma unroll
    for (int ks = 0; ks < 2 * NKB; ++ks) {
        if (ks + 1 < 2 * NKB) {
#pragma unroll
            for (int d0 = 0; d0 < NDV; ++d0) {
                asm volatile("ds_read_b64_tr_b16 %0, %1 offset:%c2" : "=&v"(lo[(ks + 1) & 1][d0]) : "v"(vb), "i"(d0 * 512 + (ks + 1) * (NDV * 1024)) : "memory");
                asm volatile("ds_read_b64_tr_b16 %0, %1 offset:%c2" : "=&v"(hh[(ks + 1) & 1][d0]) : "v"(vb), "i"(d0 * 512 + (ks + 1) * (NDV * 1024) + NDV * 512) : "memory"); }
            asm volatile("s_waitcnt lgkmcnt(%0)" :: "n"(2 * NDV) : "memory");
        } else asm volatile("s_waitcnt lgkmcnt(0)" ::: "memory");
        __builtin_amdgcn_sched_barrier(0);
#pragma unroll
        for (int d0 = 0; d0 < NDV; ++d0) { const s16x4 l_ = lo[ks & 1][d0], h_ = hh[ks & 1][d0];
            const bf16x8 vf = (bf16x8){l_[0], l_[1], l_[2], l_[3], h_[0], h_[1], h_[2], h_[3]};
            o[d0] = __builtin_amdgcn_mfma_f32_32x32x16_bf16(pa[ks], vf, o[d0], 0, 0, 0); }
        __builtin_amdgcn_sched_barrier(0);
    }
}
__device__ __forceinline__ float lane_pair_sum(float x) { auto rr = __builtin_amdgcn_permlane32_swap(__float_as_uint(x), __float_as_uint(x), false, false); return __uint_as_float(rr[0]) + __uint_as_float(rr[1]); }
template <int NDV>
__device__ __forceinline__ void finish(const f32x16 (&o)[NDV], float l_reg, LAS float* al_l, bf16_t* out, const bf16_t* z, int ld, int r32, int hi) {
    if (hi == 0) al_l[r32] = l_reg;
    LDS_WAIT();
    const bool odd = r32 & 1;
#pragma unroll
    for (int r = 0; r < 16; r += 2) { const int orow = crow(r, hi);
        const float rl0 = __builtin_amdgcn_rcpf(al_l[orow]), rl1 = __builtin_amdgcn_rcpf(al_l[orow + 1]);
#pragma unroll
        for (int d0 = 0; d0 < NDV; ++d0) {
            const float a = o[d0][r] * rl0, b = o[d0][r + 1] * rl1;
            const float recv = __shfl_xor(odd ? a : b, 1);
            const float v0 = odd ? recv : a, v1 = odd ? b : recv;
            const size_t idx = (size_t)(orow + (odd ? 1 : 0)) * ld + d0 * 32 + (r32 & ~1);
            const unsigned zw = *(const unsigned*)(z + idx);
            *(unsigned*)(out + idx) = cvt_pk_bf16(v0 * bf_lo(zw), v1 * bf_hi(zw)); } }
}
}

#define XB_TMO      128
#define XB_XCNT(j)  (256  + 64 * (j))
#define XB_XSUB(j)  (1280 + 64 * (j))
#define XB_XGEN(j)  (2304 + 64 * (j))
#define XB_TOP      3328
#define XB_TOPGEN   3392
#define XCD_BAR_WORDS 3456
#define XB_SPIN_CAP (1u << 18)
__device__ __forceinline__ unsigned xb_ld(unsigned* p)              { return __hip_atomic_load(p, __ATOMIC_RELAXED, __HIP_MEMORY_SCOPE_AGENT); }
__device__ __forceinline__ unsigned xb_add(unsigned* p, unsigned v) { return __hip_atomic_fetch_add(p, v, __ATOMIC_RELAXED, __HIP_MEMORY_SCOPE_AGENT); }
__device__ __forceinline__ unsigned xb_xcc_id() { return (unsigned)__builtin_amdgcn_s_getreg((3 << 11) | 20) & 0xFu; }
#define XB_SPIN(cond, bar) do { unsigned _sp = 0; while (cond) { __builtin_amdgcn_s_sleep(1); \
    if ((++_sp & 255u) == 0u) { if (xb_ld(&(bar)[XB_TMO])) break; if (_sp > XB_SPIN_CAP) { atomicAdd(&(bar)[XB_TMO], 1u); break; } } } } while (0)
struct XcdBarrier { unsigned* bar; unsigned x; volatile LAS unsigned* st; };
__device__ __forceinline__ XcdBarrier xcd_barrier_post(unsigned* bar, volatile LAS unsigned* st) {
    XcdBarrier b; b.bar = bar; b.x = xb_xcc_id(); b.st = st;
    if (threadIdx.x == 0) (void)xb_add(&bar[XB_XCNT(b.x)], 1u);
    return b;
}
__device__ __forceinline__ void xcd_barrier_complete(unsigned* bar, unsigned x, unsigned& nloc, unsigned& nx) {
    const unsigned G = gridDim.x * gridDim.y * gridDim.z;
    unsigned sum, cnt, mine, sp = 0u;
    for (;;) {
        sum = 0u; cnt = 0u; mine = 0u;
#pragma unroll
        for (unsigned j = 0; j < 16; ++j) { const unsigned c = xb_ld(&bar[XB_XCNT(j)]); sum += c; cnt += (c > 0u) ? 1u : 0u; mine = (j == x) ? c : mine; }
        if (sum == G) break;
        __builtin_amdgcn_s_sleep(1);
        if ((++sp & 255u) == 0u) { if (xb_ld(&bar[XB_TMO])) break; if (sp > XB_SPIN_CAP) { atomicAdd(&bar[XB_TMO], 1u); break; } }
    }
    nloc = mine > 0u ? mine : 1u; nx = cnt > 0u ? cnt : 1u;
}
__device__ __forceinline__ void xcd_barrier(const XcdBarrier& b) {
    asm volatile("s_waitcnt vmcnt(0)" ::: "memory");
    __syncthreads();
    if (threadIdx.x == 0) {
        unsigned* bar = b.bar; asm volatile("" : "+s"(bar));
        __builtin_amdgcn_s_waitcnt(0);
        unsigned nloc = b.st[0], nx = b.st[1];
        if (nloc == 0u) { xcd_barrier_complete(bar, b.x, nloc, nx); b.st[0] = nloc; b.st[1] = nx; }
        const unsigned old = xb_add(&bar[XB_XSUB(b.x)], 1u);
        const unsigned gen = old / nloc;
        if (old + 1u == (gen + 1u) * nloc) {
            __builtin_amdgcn_fence(__ATOMIC_RELEASE, "agent");
            asm volatile("s_waitcnt vmcnt(0)" ::: "memory");
            const unsigned og = xb_add(&bar[XB_TOP], 1u);
            const unsigned tg = og / nx;
            if (og + 1u == (tg + 1u) * nx) xb_add(&bar[XB_TOPGEN], 1u);
            else XB_SPIN(xb_ld(&bar[XB_TOPGEN]) == tg, bar);
            __builtin_amdgcn_fence(__ATOMIC_ACQUIRE, "agent");
            xb_add(&bar[XB_XGEN(b.x)], 1u);
            asm volatile("s_waitcnt vmcnt(0)" ::: "memory");
        } else {
            XB_SPIN(xb_ld(&bar[XB_XGEN(b.x)]) == gen, bar);
            __builtin_amdgcn_fence(__ATOMIC_ACQUIRE, "agent");
            asm volatile("s_waitcnt vmcnt(0)" ::: "memory");
        }
    }
    __syncthreads();
}

struct Args { const float* in[31]; float* out; unsigned char* ws; int ph_lo, ph_hi; };
typedef const float* const __attribute__((address_space(4)))* karg_in_t;
struct Ctx {
    LAS unsigned char* lds;
    karg_in_t in; float* out; unsigned char* ws;
    int tid, lane, wave, G, bid;
};
enum { I_XP = 0, I_XS, I_MEM, I_CCKV, I_CKR, I_CMK, I_CMV, I_SCONV, I_GPRE, I_WIN, I_GQLAT, I_WUQ, I_GKVLAT, I_WUKV, I_GQN, I_GKN, I_CONVW, I_CONVB, I_LNG, I_LNB,
       I_WPW2, I_BPW2, I_GMEM, I_WMEM, I_GXQ, I_GXK, I_WPM, I_WPC, I_WPX, I_BMERGE, I_WOUT };

__device__ __forceinline__ int win_src_col(int nd) {
    if (nd < 1088) return nd;
    if (nd < 1280) return -1;
    if (nd >= 3328 && nd < 5376) { const int t = (nd - 3328) >> 8, w = (nd - 3328) & 255; return w < 128 ? 3136 + t * 128 + w : 4160 + t * 128 + (w - 128); }
    return nd - 192;
}
__device__ __forceinline__ void transpose_item(const float* W, int K, int Nsrc, bf16_t* WT, const float* gain, int mapmode, LAS float* scr, int item, int nblk, int lane) {
    const int kb = item / nblk, nb = item % nblk, k0 = 64 * kb, nd0 = 64 * nb;
    const int ns0 = mapmode == 1 ? win_src_col(nd0) : (mapmode == 2 ? (nd0 >> 7) * 256 + (nd0 & 127) : nd0);
    const int lk = lane >> 4, ln4 = (lane & 15) * 4;
    f32x4 v[16];
#pragma unroll
    for (int i = 0; i < 16; ++i) v[i] = ns0 >= 0 ? *(const f32x4*)(W + (size_t)(k0 + lk + 4 * i) * Nsrc + ns0 + ln4) : (f32x4){0.f, 0.f, 0.f, 0.f};
#pragma unroll
    for (int i = 0; i < 16; ++i) { LAS float* p = scr + (lk + 4 * i) * 65 + ln4; p[0] = v[i][0]; p[1] = v[i][1]; p[2] = v[i][2]; p[3] = v[i][3]; }
    LDS_WAIT(); asm volatile("" ::: "memory");
    const int c = lane & 7;
    f32x4 g0 = {1.f, 1.f, 1.f, 1.f}, g1 = {1.f, 1.f, 1.f, 1.f};
    if (gain) { g0 = *(const f32x4*)(gain + k0 + 8 * c); g1 = *(const f32x4*)(gain + k0 + 8 * c + 4); }
#pragma unroll
    for (int j = 0; j < 8; ++j) { const int n = (lane >> 3) + 8 * j; const LAS float* sp = scr + (8 * c) * 65 + n;
        u32x4 o; o.x = cvt_pk_bf16(sp[0 * 65] * g0[0], sp[1 * 65] * g0[1]); o.y = cvt_pk_bf16(sp[2 * 65] * g0[2], sp[3 * 65] * g0[3]);
        o.z = cvt_pk_bf16(sp[4 * 65] * g1[0], sp[5 * 65] * g1[1]); o.w = cvt_pk_bf16(sp[6 * 65] * g1[2], sp[7 * 65] * g1[3]);
        *(u32x4*)(WT + (size_t)(nd0 + n) * K + k0 + 8 * c) = o; }
    LDS_WAIT(); asm volatile("" ::: "memory");
}
__device__ __forceinline__ bool h_early_ok(int G) { const int n2 = (M / 256) * (2048 / 256) - G; return n2 > 0 && n2 < G; }
constexpr unsigned PW_ALL = 0x3ffu, PW_EARLY = PW_ALL & ~(1u << 8);
__device__ __forceinline__ void prep_weights(const Ctx& F, int l, int gw, int NGW, unsigned jobs) {
    LAS float* scr = (LAS float*)(F.lds + F.wave * 16640);
    int base = 0;
#pragma unroll 1
    for (int job = 0; job < 10; ++job) {
        if (!((jobs >> job) & 1u)) continue;
        const float* W; int K, Nsrc, Ndst; size_t dst; const float* gain = nullptr; int winmap = 0;
        switch (job) {
            case 0: W = F.in[I_WIN] + (size_t)l * 2048 * IN_COLS; K = 2048; Nsrc = IN_COLS; Ndst = IN_PAD; dst = WS_WIN; gain = F.in[I_GPRE] + l * 2048; winmap = 1; break;
            case 1: W = F.in[I_WUQ] + (size_t)l * 512 * 3072; K = 512; Nsrc = 3072; Ndst = 3072; dst = WS_WUQ; gain = F.in[I_GQLAT] + l * 512; break;
            case 2: W = F.in[I_WUKV] + (size_t)l * 512 * 4096; K = 512; Nsrc = 4096; Ndst = 4096; dst = WS_WUKV; gain = F.in[I_GKVLAT] + l * 512; break;
            case 3: W = F.in[I_WPW2] + (size_t)l * 1024 * 1024; K = 1024; Nsrc = 1024; Ndst = 1024; dst = WS_WPW2; break;
            case 4: W = F.in[I_WMEM] + (size_t)l * 2048 * 2048; K = 2048; Nsrc = 2048; Ndst = 2048; dst = WS_WMEM; gain = F.in[I_GMEM] + l * 2048; break;
            case 5: W = F.in[I_WPM] + (size_t)l * 2048 * 2048; K = 2048; Nsrc = 2048; Ndst = 2048; dst = WS_WPM; break;
            case 6: W = F.in[I_WPC] + (size_t)l * 1024 * 2048; K = 1024; Nsrc = 2048; Ndst = 2048; dst = WS_WPC; break;
            case 7: W = F.in[I_WPX] + (size_t)l * 1024 * 2048; K = 1024; Nsrc = 2048; Ndst = 2048; dst = WS_WPX; break;
            case 8: W = F.in[I_WOUT] + (size_t)l * 2048 * 2048; K = 2048; Nsrc = 2048; Ndst = 2048; dst = WS_WOUT; break;
            default: W = F.in[I_WUKV] + (size_t)l * 512 * 4096; K = 512; Nsrc = 4096; Ndst = 2048; dst = WS_WUK; gain = F.in[I_GKVLAT] + l * 512; winmap = 2; break;
        }
        const int nblk = Ndst / 64, nitems = (K / 64) * nblk;
        bf16_t* WT = (bf16_t*)(F.ws + dst);
        int first = (gw - base) % NGW; if (first < 0) first += NGW;
        for (int it = first; it < nitems; it += NGW) transpose_item(W, K, Nsrc, WT, gain, winmap, scr, it, nblk, F.lane);
        base += nitems;
    }
}
__device__ __forceinline__ void rms_row_2048(const float* xrow, bf16_t* orow, int lane) {
    const f32x4* xr = (const f32x4*)xrow + lane;
    f32x4 v[8]; float s = 0.f;
#pragma unroll
    for (int j = 0; j < 8; ++j) { v[j] = xr[64 * j]; s += (v[j][0] * v[j][0] + v[j][1] * v[j][1]) + (v[j][2] * v[j][2] + v[j][3] * v[j][3]); }
    const float r = 1.0f / sqrtf(wave_sum(s) * (1.f / 2048.f) + EPS);
    u32x2* o8 = (u32x2*)orow + lane;
#pragma unroll
    for (int j = 0; j < 8; ++j) { u32x2 w; w.x = cvt_pk_bf16(v[j][0] * r, v[j][1] * r); w.y = cvt_pk_bf16(v[j][2] * r, v[j][3] * r); o8[64 * j] = w; }
}
__device__ __forceinline__ void rms_row_512(const float* xrow, bf16_t* orow, int lane) {
    const f32x4* xr = (const f32x4*)xrow + lane;
    f32x4 v[2]; float s = 0.f;
#pragma unroll
    for (int j = 0; j < 2; ++j) { v[j] = xr[64 * j]; s += (v[j][0] * v[j][0] + v[j][1] * v[j][1]) + (v[j][2] * v[j][2] + v[j][3] * v[j][3]); }
    const float r = 1.0f / sqrtf(wave_sum(s) * (1.f / 512.f) + EPS);
    u32x2* o8 = (u32x2*)orow + lane;
#pragma unroll
    for (int j = 0; j < 2; ++j) { u32x2 w; w.x = cvt_pk_bf16(v[j][0] * r, v[j][1] * r); w.y = cvt_pk_bf16(v[j][2] * r, v[j][3] * r); o8[64 * j] = w; }
}
__device__ __forceinline__ void kpe_row(const float* kr, const float* gkpe, const float* ropetab, int pos, bf16_t* kpe, float* sspe, int lane) {
    const float x = kr[lane]; const float ss = wave_sum(x * x);
    const float xg = x * gkpe[lane]; const float other = __shfl_xor(xg, 32);
    const f32x2 cs = *(const f32x2*)(ropetab + ((size_t)pos * 32 + (lane & 31)) * 2);
    const float o = lane < 32 ? xg * cs.x - other * cs.y : xg * cs.x + other * cs.y;
    kpe[lane] = (bf16_t)(cvt_pk_bf16(o, 0.f) & 0xffffu);
    if (lane == 0) *sspe = ss;
}
template <int R>
__device__ __forceinline__ void rms_rows_512(const float* x0, bf16_t* o0, int lane) {
    f32x4 v[R][2]; float s[R];
#pragma unroll
    for (int r = 0; r < R; ++r) { const f32x4* xr = (const f32x4*)(x0 + (size_t)r * 512) + lane;
#pragma unroll
        for (int j = 0; j < 2; ++j) v[r][j] = xr[64 * j]; }
#pragma unroll
    for (int r = 0; r < R; ++r) { s[r] = 0.f;
#pragma unroll
        for (int j = 0; j < 2; ++j) s[r] += (v[r][j][0] * v[r][j][0] + v[r][j][1] * v[r][j][1]) + (v[r][j][2] * v[r][j][2] + v[r][j][3] * v[r][j][3]); }
#pragma unroll
    for (int o = 1; o < 64; o <<= 1)
#pragma unroll
        for (int r = 0; r < R; ++r) s[r] += __shfl_xor(s[r], o);
#pragma unroll
    for (int r = 0; r < R; ++r) { const float rr = 1.0f / sqrtf(s[r] * (1.f / 512.f) + EPS); u32x2* o8 = (u32x2*)(o0 + (size_t)r * 512) + lane;
#pragma unroll
        for (int j = 0; j < 2; ++j) { u32x2 w; w.x = cvt_pk_bf16(v[r][j][0] * rr, v[r][j][1] * rr); w.y = cvt_pk_bf16(v[r][j][2] * rr, v[r][j][3] * rr); o8[64 * j] = w; } }
}
template <int R>
__device__ __forceinline__ void kpe_rows(const float* kr0, float gk, const float* ropetab, int pos0, bf16_t* kpe0, float* sspe0, int lane) {
    float x[R], ss[R]; f32x2 cs[R];
#pragma unroll
    for (int r = 0; r < R; ++r) { x[r] = kr0[(size_t)r * 64 + lane]; cs[r] = *(const f32x2*)(ropetab + ((size_t)(pos0 + r) * 32 + (lane & 31)) * 2); }
#pragma unroll
    for (int r = 0; r < R; ++r) ss[r] = x[r] * x[r];
#pragma unroll
    for (int o = 1; o < 64; o <<= 1)
#pragma unroll
        for (int r = 0; r < R; ++r) ss[r] += __shfl_xor(ss[r], o);
#pragma unroll
    for (int r = 0; r < R; ++r) { const float xg = x[r] * gk; const float other = __shfl_xor(xg, 32);
        const float o = lane < 32 ? xg * cs[r].x - other * cs[r].y : xg * cs[r].x + other * cs[r].y;
        kpe0[(size_t)r * 64 + lane] = (bf16_t)(cvt_pk_bf16(o, 0.f) & 0xffffu);
        if (lane == 0) sspe0[r] = ss[r]; }
}
__device__ __forceinline__ const float* x_row(const Ctx& F, int l, int row) {
    if (l == 0) return row < M_P ? F.in[I_XP] + (size_t)row * 2048 : F.in[I_XS] + (size_t)(row - M_P) * 2048;
    return (const float*)(F.ws + WS_X1) + (size_t)row * 2048;
}
__device__ __forceinline__ void past_kpe(const Ctx& F, int l);
__device__ __forceinline__ void phase_prep(const Ctx& F, int l) {
    const int gw = F.bid * 8 + F.wave, NGW = F.G * 8;
    float* ropetab = (float*)(F.ws + WS_ROPE);
    if (l == 0) {
        for (int i = gw * 64 + F.lane; i < 8192 * 32; i += NGW * 64) { const int pos = i >> 5, j = i & 31;
            const float inv = powf(10000.f, -(float)j / 32.f); const float ang = (float)pos * inv;
            const double a = (double)ang; const double n = rint(a * 0.15915494309189535); const float red = (float)(a - n * 6.283185307179586);
            ropetab[2 * i] = cosf(red); ropetab[2 * i + 1] = sinf(red); }
        for (int r = gw; r < N_MEM; r += NGW) rms_row_2048(F.in[I_MEM] + (size_t)r * 2048, (bf16_t*)(F.ws + WS_MEMN) + (size_t)r * 2048, F.lane);
    }
    prep_weights(F, l, gw, NGW, (l == 1 && h_early_ok(F.G)) ? (PW_ALL & ~PW_EARLY) : PW_ALL);
    for (int r = gw; r < M; r += NGW) rms_row_2048(x_row(F, l, r), (bf16_t*)(F.ws + WS_HB) + (size_t)r * 2048, F.lane);
#ifdef DUP_P2
    for (int r = gw; r < M; r += NGW) rms_row_2048(x_row(F, l, r), (bf16_t*)(F.ws + WS_HB) + (size_t)r * 2048, F.lane);
#endif
    const float* cc = F.in[I_CCKV] + (size_t)l * MPAST * 512;
    for (int r = gw * 4; r < MPAST; r += NGW * 4) rms_rows_512<4>(cc + (size_t)r * 512, (bf16_t*)(F.ws + WS_CNP) + (size_t)r * 512, F.lane);
    if (l > 0) past_kpe(F, l);
#ifdef DUP_P3
    for (int r = gw * 4; r < MPAST; r += NGW * 4) rms_rows_512<4>(cc + (size_t)r * 512, (bf16_t*)(F.ws + WS_CNP) + (size_t)r * 512, F.lane);
#endif
}
__device__ __forceinline__ void past_kpe(const Ctx& F, int l) {
    const int gw = F.bid * 8 + F.wave, NGW = F.G * 8;
    const float* ropetab = (const float*)(F.ws + WS_ROPE);
    const float* ck = F.in[I_CKR] + (size_t)l * MPAST * 64; const float* gk = F.in[I_GKN] + l * QK_HEAD + 128;
    const float gkl = gk[F.lane];
    for (int r = gw * 4; r < MPAST; r += NGW * 4) kpe_rows<4>(ck + (size_t)r * 64, gkl, ropetab, r & (PAST - 1), (bf16_t*)(F.ws + WS_KPEP) + (size_t)r * 64, (float*)(F.ws + WS_SSPEP) + r, F.lane);
}

__device__ __forceinline__ void glds16(const void* g, LAS void* l) { unsigned keep; const unsigned dst = (unsigned)(uintptr_t)l;
    asm volatile("s_mov_b32 %0, m0\n\ts_mov_b32 m0, %2\n\ts_nop 0\n\tglobal_load_lds_dwordx4 %1, off\n\ts_mov_b32 m0, %0" : "=&s"(keep) : "v"(g), "s"(dst) : "memory"); }
__device__ __forceinline__ void glds16s(const void* sbase, unsigned voff, LAS void* l) { const unsigned dst = (unsigned)(uintptr_t)l;
    asm volatile("s_mov_b32 m0, %2\n\ts_nop 0\n\tglobal_load_lds_dwordx4 %0, %1" :: "v"(voff), "s"(sbase), "s"(dst) : "memory", "m0"); }
__device__ __forceinline__ void glds4s(const void* sbase, unsigned voff, LAS void* l) { const unsigned dst = (unsigned)(uintptr_t)l;
    asm volatile("s_mov_b32 m0, %2\n\ts_nop 0\n\tglobal_load_lds_dword %0, %1" :: "v"(voff), "s"(sbase), "s"(dst) : "memory", "m0"); }
__device__ __forceinline__ void glds4(const void* g, LAS void* l) { unsigned keep; const unsigned dst = (unsigned)(uintptr_t)l;
    asm volatile("s_mov_b32 %0, m0\n\ts_mov_b32 m0, %2\n\ts_nop 0\n\tglobal_load_lds_dword %1, off\n\ts_mov_b32 m0, %0" : "=&s"(keep) : "v"(g), "s"(dst) : "memory"); }
template <int CR, int SB>
__device__ __forceinline__ void conv_chunk(const Ctx& F, int l, int tid, int seq0, int r0, int seqlen, int bb) {
    constexpr int CWIN = CR + CONV_ST;
    const int lane = tid & 63, wv = __builtin_amdgcn_readfirstlane(tid >> 6);
    asm volatile("" : "+s"(l));
    const float* cw = F.in[I_CONVW] + (size_t)l * CONV_K * 1024; const float* cb = F.in[I_CONVB] + l * 1024;
    const float* lg = F.in[I_LNG] + l * 1024; const float* lb = F.in[I_LNB] + l * 1024;
    const float* st = F.in[I_SCONV] + (size_t)l * NSTREAM * CONV_ST * 1024;
    const bf16_t* ub = (const bf16_t*)(F.ws + WS_UB); bf16_t* cv = (bf16_t*)(F.ws + WS_CV);
    LAS unsigned char* win = F.lds;
    LAS f32x2* red = (LAS f32x2*)(F.lds + CWIN * 2048);
    LAS f32x2* stat = red + 8 * SB;
    const int nh = r0 < CONV_ST ? CONV_ST - r0 : 0;
    for (int hr = 2 * nh + wv; hr < 2 * CWIN; hr += 8)
#ifdef CONV_NODMA
        *(LAS u32x4*)(win + hr * 1024 + lane * 16) = *(const u32x4*)(ub + (size_t)(seq0 + r0 - CONV_ST + (hr >> 1)) * 1024 + (hr & 1) * 512 + lane * 8);
#else
        glds16(ub + (size_t)(seq0 + r0 - CONV_ST + (hr >> 1)) * 1024 + (hr & 1) * 512 + lane * 8, win + hr * 1024);
#endif
    if (bb >= 0) {
        for (int hr0 = wv; hr0 < 2 * nh; hr0 += 32) { f32x4 a[4], b[4];
#pragma unroll
            for (int q = 0; q < 4; ++q) { const int hr = min(hr0 + 8 * q, 2 * nh - 1); const float* sp = st + ((size_t)bb * CONV_ST + r0 + (hr >> 1)) * 1024 + (hr & 1) * 512 + lane * 8; a[q] = *(const f32x4*)sp; b[q] = *(const f32x4*)(sp + 4); }
#pragma unroll
            for (int q = 0; q < 4; ++q) if (hr0 + 8 * q < 2 * nh) *(LAS u32x4*)(win + (hr0 + 8 * q) * 1024 + lane * 16) = pack8(a[q], b[q]); }
    } else for (int hr = wv; hr < 2 * nh; hr += 8) *(LAS u32x4*)(win + hr * 1024 + lane * 16) = (u32x4){0u, 0u, 0u, 0u};
    asm volatile("" ::: "memory");
    const int c0 = 2 * tid;
    f32x2 w[CONV_K];
#pragma unroll
    for (int k = 0; k < CONV_K; ++k) w[k] = *(const f32x2*)(cw + (size_t)k * 1024 + c0);
    const f32x2 bia = *(const f32x2*)(cb + c0);
    const f32x2 g2 = *(const f32x2*)(lg + c0), b2 = *(const f32x2*)(lb + c0);
    asm volatile("s_waitcnt vmcnt(0)" ::: "memory");
    __syncthreads();
#pragma unroll 1
    for (int sb = 0; sb < CR / SB; ++sb) {
        LAS const unsigned char* wp = win + sb * SB * 2048 + c0 * 2;
        f32x2 y[SB];
#pragma unroll
        for (int r = 0; r < SB; ++r) y[r] = bia;
#pragma unroll
        for (int jj = 0; jj < SB + CONV_ST; ++jj) { const unsigned uu = *(const LAS unsigned*)(wp + jj * 2048); const f32x2 u = {bf_lo(uu), bf_hi(uu)};
#pragma unroll
            for (int r = 0; r < SB; ++r) { const int k = jj - r; if (k >= 0 && k < CONV_K) y[r] = w[k] * u + y[r]; } }
#pragma unroll
        for (int r = 0; r < SB; ++r) { const float s1 = wave_sum(y[r].x + y[r].y), s2 = wave_sum(y[r].x * y[r].x + y[r].y * y[r].y); if (lane == 0) red[wv * SB + r] = (f32x2){s1, s2}; }
        __syncthreads();
        if (tid < SB) { float s1 = 0.f, s2 = 0.f;
#pragma unroll
            for (int q = 0; q < 8; ++q) { const f32x2 t = red[q * SB + tid]; s1 += t.x; s2 += t.y; }
            const float mean = s1 * (1.f / 1024.f); const float var = fmaxf(s2 * (1.f / 1024.f) - mean * mean, 0.f);
            stat[tid] = (f32x2){mean, 1.0f / sqrtf(var + EPS)}; }
        __syncthreads();
        const int rb = r0 + sb * SB;
#pragma unroll
        for (int r = 0; r < SB; ++r) { const f32x2 ms = stat[r];
            const float a = siluf_((y[r].x - ms.x) * ms.y * g2.x + b2.x), b = siluf_((y[r].y - ms.x) * ms.y * g2.y + b2.y);
            if (rb + r < seqlen) *(unsigned*)(cv + (size_t)(seq0 + rb + r) * 1024 + c0) = cvt_pk_bf16(a, b); }
    }
    __syncthreads();
}
__device__ __forceinline__ void phase_c(const Ctx& F, int l) {
    int tid = F.tid; asm volatile("" : "+v"(tid)); const int gw = F.bid * 8 + F.wave, NGW = F.G * 8, lane = tid & 63;
    for (int c = F.bid; c < 187 + 64; c += F.G) {
        if (c < 187) conv_chunk<44, 11>(F, l, tid, 0, c * 44, M_P, -1);
        else { const int q = c - 187; conv_chunk<32, 8>(F, l, tid, M_P + (q >> 1) * 64, (q & 1) * 32, DEC_SEQ, q >> 1); }
    }
    {
        const float* ropetab = (const float*)(F.ws + WS_ROPE); const float gkl = (F.in[I_GKN] + l * QK_HEAD + 128)[lane];
        constexpr int RB = 5;
        for (int r0 = gw * RB; r0 < M; r0 += NGW * RB) {
            f32x4 a[RB][2], c[RB][2]; float kx[RB], s[3 * RB]; f32x2 cs[RB];
#pragma unroll
            for (int i = 0; i < RB; ++i) { const int r = r0 + i;
                const f32x4* ap = (const f32x4*)((const float*)(F.ws + WS_QLATF) + (size_t)r * 512) + lane;
                const float* ckv = r < M_P ? F.out + O_PCKV + ((size_t)l * M_P + r) * 512 : F.out + O_SCKV + ((size_t)l * M_S + (r - M_P)) * 512;
                const float* kr = r < M_P ? F.out + O_PKR + ((size_t)l * M_P + r) * 64 : F.out + O_SKR + ((size_t)l * M_S + (r - M_P)) * 64;
                const int pos = r < M_P ? r : PAST + ((r - M_P) & 63);
                a[i][0] = ap[0]; a[i][1] = ap[64]; c[i][0] = ((const f32x4*)ckv)[lane]; c[i][1] = ((const f32x4*)ckv)[lane + 64];
                kx[i] = kr[lane]; cs[i] = *(const f32x2*)(ropetab + ((size_t)pos * 32 + (lane & 31)) * 2); }
#pragma unroll
            for (int i = 0; i < RB; ++i) { s[3 * i] = 0.f; s[3 * i + 1] = 0.f;
#pragma unroll
                for (int j = 0; j < 2; ++j) { s[3 * i] += (a[i][j][0] * a[i][j][0] + a[i][j][1] * a[i][j][1]) + (a[i][j][2] * a[i][j][2] + a[i][j][3] * a[i][j][3]);
                    s[3 * i + 1] += (c[i][j][0] * c[i][j][0] + c[i][j][1] * c[i][j][1]) + (c[i][j][2] * c[i][j][2] + c[i][j][3] * c[i][j][3]); }
                s[3 * i + 2] = kx[i] * kx[i]; }
#pragma unroll
            for (int o = 1; o < 64; o <<= 1)
#pragma unroll
                for (int i = 0; i < 3 * RB; ++i) s[i] += __shfl_xor(s[i], o);
#pragma unroll
            for (int i = 0; i < RB; ++i) { const int r = r0 + i;
                const float ra = 1.0f / sqrtf(s[3 * i] * (1.f / 512.f) + EPS), rc = 1.0f / sqrtf(s[3 * i + 1] * (1.f / 512.f) + EPS);
                u32x2* oa = (u32x2*)((bf16_t*)(F.ws + WS_QLATN) + (size_t)r * 512) + lane; u32x2* oc = (u32x2*)((bf16_t*)(F.ws + WS_CKVN) + (size_t)r * 512) + lane;
#pragma unroll
                for (int j = 0; j < 2; ++j) { u32x2 w; w.x = cvt_pk_bf16(a[i][j][0] * ra, a[i][j][1] * ra); w.y = cvt_pk_bf16(a[i][j][2] * ra, a[i][j][3] * ra); oa[64 * j] = w;
                    w.x = cvt_pk_bf16(c[i][j][0] * rc, c[i][j][1] * rc); w.y = cvt_pk_bf16(c[i][j][2] * rc, c[i][j][3] * rc); oc[64 * j] = w; }
                const float xg = kx[i] * gkl; const float other = __shfl_xor(xg, 32);
                const float o = lane < 32 ? xg * cs[i].x - other * cs[i].y : xg * cs[i].x + other * cs[i].y;
                ((bf16_t*)(F.ws + WS_KPEC))[(size_t)r * 64 + lane] = (bf16_t)(cvt_pk_bf16(o, 0.f) & 0xffffu);
                if (lane == 0) ((float*)(F.ws + WS_SSPEC))[r] = s[3 * i + 2]; }
        }
    }
    {
        const float* kvraw = (const float*)(F.ws + WS_KVRAW); const float* gx = F.in[I_GXK] + l * 256;
        for (int it = gw; it < N_MEM * 8; it += NGW) { const int t = it >> 3, hv = it & 7, isv = hv >> 2, h = hv & 3;
            const f32x4 v = *(const f32x4*)(kvraw + (size_t)t * 2048 + isv * 1024 + h * 256 + 4 * lane);
            f32x4 o = v;
            if (!isv) { const float ss = wave_sum((v[0] * v[0] + v[1] * v[1]) + (v[2] * v[2] + v[3] * v[3])); const float r = 1.0f / sqrtf(ss * (1.f / 256.f) + EPS);
                const f32x4 g = *(const f32x4*)(gx + 4 * lane); o = v * r * g; }
            float* op = F.out + (isv ? O_PMV : O_PMK) + (size_t)l * N_MEM * 1024 + (size_t)t * 1024 + h * 256 + 4 * lane;
            *(f32x4*)op = o;
            u32x2 w; w.x = cvt_pk_bf16(o[0], o[1]); w.y = cvt_pk_bf16(o[2], o[3]);
            *(u32x2*)((bf16_t*)(F.ws + (isv ? WS_MVB : WS_MKB)) + (size_t)t * 1024 + h * 256 + 4 * lane) = w;
        }
    }
}
__device__ __forceinline__ void phase_e(const Ctx& F, int l) {
    const int gw = F.bid * 8 + F.wave, NGW = F.G * 8, lane = F.lane;
    const float* ropetab = (const float*)(F.ws + WS_ROPE);
    const float* gq = F.in[I_GQN] + l * QK_HEAD; const float* gk = F.in[I_GKN] + l * QK_HEAD; const float* gxq = F.in[I_GXQ] + l * 256;
    const f32x4 gx4 = *(const f32x4*)(gxq + 4 * lane) * C_X;
    const bf16_t* qraw = (const bf16_t*)(F.ws + WS_QRAW); bf16_t* Q = (bf16_t*)(F.ws + WS_Q); bf16_t* xq = (bf16_t*)(F.ws + WS_XQ);
    {
        const size_t gt = (size_t)F.bid * 512 + F.tid, GT = (size_t)F.G * 512;
        const float* SSC = (const float*)(F.ws + WS_SSC); const float* SSPEC = (const float*)(F.ws + WS_SSPEC); float* RKC = (float*)(F.ws + WS_RKC);
        for (size_t i = gt; i < (size_t)16 * M; i += GT) { const f32x4 s4 = *(const f32x4*)(SSC + i * 4); const int row = (int)(i % M);
            RKC[i] = 1.0f / sqrtf(((s4[0] + s4[1]) + (s4[2] + s4[3]) + SSPEC[row]) * (1.f / 192.f) + EPS); }
        const float* SSP = (const float*)(F.ws + WS_SSP); const float* SSPEP = (const float*)(F.ws + WS_SSPEP); float* RKP = (float*)(F.ws + WS_RKP);
        for (size_t i4 = gt; i4 < (size_t)MPAST * 4; i4 += GT) { const size_t PL = (size_t)MPAST * 16, i = i4 * 4; const size_t bb = i >> 16, t = i & 4095;
            const f32x4 s = (*(const f32x4*)(SSP + i) + *(const f32x4*)(SSP + PL + i)) + (*(const f32x4*)(SSP + 2 * PL + i) + *(const f32x4*)(SSP + 3 * PL + i)) + *(const f32x4*)(SSPEP + bb * 4096 + t);
            f32x4 o; o[0] = 1.0f / sqrtf(s[0] * (1.f / 192.f) + EPS); o[1] = 1.0f / sqrtf(s[1] * (1.f / 192.f) + EPS); o[2] = 1.0f / sqrtf(s[2] * (1.f / 192.f) + EPS); o[3] = 1.0f / sqrtf(s[3] * (1.f / 192.f) + EPS);
            *(f32x4*)(RKP + i) = o; }
    }
    f32x4 gsc;
    { const int e0 = lane < 32 ? 4 * lane : 128 + 4 * (lane & 15);
      const f32x4 q4 = *(const f32x4*)(gq + e0); gsc = q4 * C_MLA; if (lane < 32) gsc = gsc * *(const f32x4*)(gk + e0); }
    for (int r = gw; r < M; r += NGW) {
        const int pos = r < M_P ? r : PAST + ((r - M_P) & 63);
        const float* ct = ropetab + ((size_t)pos * 32 + 4 * (lane & 7)) * 2;
        const f32x4 c01 = *(const f32x4*)ct, c23 = *(const f32x4*)(ct + 4);
        u32x2 xw[4];
#pragma unroll
        for (int h = 0; h < 4; ++h) xw[h] = ((const u32x2*)(xq + (size_t)r * 1024 + h * 256))[lane];
        for (int h0 = 0; h0 < NH; h0 += 8) {
            f32x4 v[8]; float ss[8];
#pragma unroll
            for (int j = 0; j < 8; ++j) { u32x2 w = {0u, 0u}; if (lane < 48) w = *(const u32x2*)(qraw + (size_t)r * 3072 + (h0 + j) * 192 + 4 * lane);
                v[j] = (f32x4){bf_lo(w.x), bf_hi(w.x), bf_lo(w.y), bf_hi(w.y)}; ss[j] = (v[j][0] * v[j][0] + v[j][1] * v[j][1]) + (v[j][2] * v[j][2] + v[j][3] * v[j][3]); }
#pragma unroll
            for (int o = 1; o < 64; o <<= 1)
#pragma unroll
                for (int j = 0; j < 8; ++j) ss[j] += __shfl_xor(ss[j], o);
#pragma unroll
            for (int j = 0; j < 8; ++j) { const float rq = 1.0f / sqrtf(ss[j] * (1.f / 192.f) + EPS);
                f32x4 x = v[j] * rq * gsc;
                f32x4 ot; ot[0] = __shfl_xor(x[0], 8); ot[1] = __shfl_xor(x[1], 8); ot[2] = __shfl_xor(x[2], 8); ot[3] = __shfl_xor(x[3], 8);
                if (lane >= 32) { const float sg = lane < 40 ? -1.f : 1.f;
                    x = (f32x4){x[0] * c01[0] + sg * ot[0] * c01[1], x[1] * c01[2] + sg * ot[1] * c01[3], x[2] * c23[0] + sg * ot[2] * c23[1], x[3] * c23[2] + sg * ot[3] * c23[3]}; }
                if (lane < 48) { u32x2 ow; ow.x = cvt_pk_bf16(x[0], x[1]); ow.y = cvt_pk_bf16(x[2], x[3]); *(u32x2*)(Q + ((size_t)r * NH + h0 + j) * 192 + 4 * lane) = ow; } }
        }
#pragma unroll
        for (int h = 0; h < 4; ++h) {
            const u32x2 w = xw[h]; u32x2* po = (u32x2*)((bf16_t*)(F.ws + WS_XQN) + (size_t)r * 1024 + h * 256) + lane;
            const f32x4 v = (f32x4){bf_lo(w.x), bf_hi(w.x), bf_lo(w.y), bf_hi(w.y)};
            const float ss = wave_sum((v[0] * v[0] + v[1] * v[1]) + (v[2] * v[2] + v[3] * v[3])); const float rr = 1.0f / sqrtf(ss * (1.f / 256.f) + EPS);
            const f32x4 o = v * rr * gx4; u32x2 ow; ow.x = cvt_pk_bf16(o[0], o[1]); ow.y = cvt_pk_bf16(o[2], o[3]); *po = ow;
        }
    }
}

constexpr int AP_KN = 0, AP_KPE = 16384, AP_V = 24576, AP_RK = 40960;
constexpr int AX_K = 0, AX_V = 32768, AX_AL = 49152;

__device__ __forceinline__ int swap23(int k) { return (k & ~0xC) | ((k & 4) << 1) | ((k & 8) >> 1); }
__device__ __forceinline__ int src_kn(int o) { const int row = o >> 8, colB = (o & 255) ^ ((row & 7) << 4); return row * 128 + (colB >> 1); }
__device__ __forceinline__ int src_kpe(int o) { const int row = o >> 7, colB = (o & 127) ^ ((row & 7) << 4); return row * 64 + (colB >> 1); }
__device__ __forceinline__ int src_v1024(int o) { const int sub = o >> 9, kk = (sub >> 2) * 8 + ((o & 511) >> 6), c = (sub & 3) * 32 + ((o & 63) >> 1); return swap23(kk) * 1024 + c; }
__device__ __forceinline__ int src_v(int o) { const int sub = o >> 9, kk = (sub >> 2) * 8 + ((o & 511) >> 6), c = (sub & 3) * 32 + ((o & 63) >> 1); return swap23(kk) * 128 + c; }

constexpr int AQ_KBUF = 24832, AQ_KPE = 16384, AQ_RK = 24576, AQ_V0 = 3 * AQ_KBUF, AQ_VBUF = 16384, AQ_AL = AQ_V0 + 4 * AQ_VBUF;
__device__ __forceinline__ void mla_prompt_unit(const Ctx& F, int h, int qb, float negB2) {
    int tid = F.tid; asm volatile("" : "+v"(tid)); const int wid = F.wave, lane = tid & 63, r32 = lane & 31, hi = lane >> 5;
    const bf16_t* Q = (const bf16_t*)(F.ws + WS_Q); const bf16_t* KC = (const bf16_t*)(F.ws + WS_KC) + (size_t)h * M * 128; const bf16_t* VC = (const bf16_t*)(F.ws + WS_VC) + (size_t)h * M * 128;
    const float* RK = (const float*)(F.ws + WS_RKC) + (size_t)h * M; const bf16_t* KPE = (const bf16_t*)(F.ws + WS_KPEC);
    const int row0 = qb * 256 + wid * 32;
    f32x16 o[4];
#pragma unroll
    for (int d = 0; d < 4; ++d)
#pragma unroll
        for (int r = 0; r < 16; ++r) o[d][r] = 0.f;
    float l_part = 0.f;
    const int nt_all = 4 * qb + 4, nt_w = 4 * qb + (wid >> 1) + 1;
    const bool late = false;
    LAS char* L = (LAS char*)F.lds; LAS float* al_l = (LAS float*)(L + AQ_AL) + wid * 32;
    const LAS char* vb0 = L + AQ_V0 + att::v_rd_base(lane);
    unsigned okn[2], ov[2];
#pragma unroll
    for (int i = 0; i < 2; ++i) { const int o16 = ((wid * 2 + i) * 64 + lane) * 16; okn[i] = (unsigned)src_kn(o16) * 2u; ov[i] = (unsigned)src_v(o16) * 2u; }
    const unsigned okp = (unsigned)src_kpe((wid * 64 + lane) * 16) * 2u, ork = (unsigned)lane * 4u;
#define MP_ISSUE(t) do { LAS char* Lk = L + ((t) % 3) * AQ_KBUF; LAS char* Lv = L + AQ_V0 + ((t) & 3) * AQ_VBUF; const size_t kb_ = (size_t)(t) * 64; \
        glds16s(KC + kb_ * 128, okn[0], Lk + (wid * 2) * 1024); glds16s(KC + kb_ * 128, okn[1], Lk + (wid * 2 + 1) * 1024); \
        glds16s(VC + kb_ * 128, ov[0], Lv + (wid * 2) * 1024); glds16s(VC + kb_ * 128, ov[1], Lv + (wid * 2 + 1) * 1024); \
        glds16s(KPE + kb_ * 64, okp, Lk + AQ_KPE + wid * 1024); \
        if (wid == 0) glds4s(RK + kb_, ork, Lk + AQ_RK); } while (0)
    __builtin_amdgcn_s_barrier();
    MP_ISSUE(0); MP_ISSUE(1);
    bf16x8 qr[12];
    { const bf16_t* qp = Q + ((size_t)(row0 + r32) * NH + h) * 192 + hi * 8;
#pragma unroll
      for (int d0 = 0; d0 < 12; ++d0) qr[d0] = *(const bf16x8*)(qp + d0 * 16);
#pragma unroll
      for (int d0 = 0; d0 < 12; ++d0) asm volatile("" :: "v"(qr[d0])); }
    bf16x8 pa[4] = {};
    for (int t = 0; t < nt_all; ++t) {
        if (t + 1 < nt_all) { if (wid == 0) asm volatile("s_waitcnt vmcnt(6)" ::: "memory"); else asm volatile("s_waitcnt vmcnt(5)" ::: "memory"); }
        else asm volatile("s_waitcnt vmcnt(0)" ::: "memory");
        __builtin_amdgcn_s_barrier();
        asm volatile("" ::: "memory");
        if (t + 2 < nt_all) MP_ISSUE(t + 2);
        if (late && t >= 1 && t - 1 < nt_w) att::pv_fs<4, 2>(o, vb0 + ((t - 1) & 3) * AQ_VBUF, pa);
        if (t < nt_w) {
            const LAS char* Lk = L + (t % 3) * AQ_KBUF;
            att::qk_sm<8, 4, 2, 256>(qr, l_part, Lk, Lk + AQ_KPE, (const LAS float*)(Lk + AQ_RK), negB2, r32, hi, pa);
#ifdef PROBE_QK2
            { bf16x8 pa2[4]; float l2 = 0.f; int r32b = r32; asm volatile("" : "+v"(r32b)); att::qk_sm<8, 4, 2, 256>(qr, l2, Lk, Lk + AQ_KPE, (const LAS float*)(Lk + AQ_RK), negB2, r32b, hi, pa2);
              asm volatile("" :: "v"(pa2[0]), "v"(pa2[1]), "v"(pa2[2]), "v"(pa2[3]), "v"(l2)); }
#endif
#ifdef PROBE_PV2
            { f32x16 o2[4];
#pragma unroll
              for (int d = 0; d < 4; ++d)
#pragma unroll
                  for (int r = 0; r < 16; ++r) o2[d][r] = 0.f;
              att::pv_fs<4, 2>(o2, vb0 + (t & 3) * AQ_VBUF, pa);
              asm volatile("" :: "v"(o2[0]), "v"(o2[1]), "v"(o2[2]), "v"(o2[3])); }
#endif
            if (!late) att::pv_fs<4, 2>(o, vb0 + (t & 3) * AQ_VBUF, pa);
        }
    }
    if (late && nt_all - 1 < nt_w) att::pv_fs<4, 2>(o, vb0 + ((nt_all - 1) & 3) * AQ_VBUF, pa);
#undef MP_ISSUE
    att::finish<4>(o, att::lane_pair_sum(l_part), al_l, (bf16_t*)(F.ws + WS_AMLA) + (size_t)row0 * 2048 + h * 128, (const bf16_t*)(F.ws + WS_ZM) + (size_t)row0 * 2048 + h * 128, 2048, r32, hi);
}
constexpr int AC_KN = 0, AC_KPE = 8192, AC_CN = 10240, AC_RK = 26624, AC_BUF = 26752, AC_NB = 6, AC_AL = AC_NB * AC_BUF;
static_assert(AC_AL + 1024 <= SCRATCH_TOP, "sample attention ring + row-sum scratch inside the phase scratch");
__device__ __forceinline__ int src_cn(int o) { const int sub = o >> 9, kk = (sub >> 4) * 8 + ((o & 511) >> 6), c = (sub & 15) * 32 + ((o & 63) >> 1); return swap23(kk) * 512 + c; }
#ifndef PROBE_HOT
#define PROBE_HOT 0
#endif
__device__ __forceinline__ void mla_sample_unit(const Ctx& F, int b, int hp, float negB2, bool rep2 = false) {
    int tid = F.tid; asm volatile("" : "+v"(tid)); const int wid = F.wave, lane = tid & 63, r32 = lane & 31, hi = lane >> 5;
    const int g = wid >> 2, rg = (wid >> 1) & 1, lh = wid & 1, h = hp * 2 + g;
    const bf16_t* Q = (const bf16_t*)(F.ws + WS_Q);
    const int row0 = M_P + b * 64 + rg * 32;
    f32x16 o[8];
#pragma unroll
    for (int d = 0; d < 8; ++d)
#pragma unroll
        for (int r = 0; r < 16; ++r) o[d][r] = 0.f;
    float l_part = 0.f;
    constexpr int SC_CS = 16384, SC_NC = 5, SC_K0 = SC_CS * SC_NC, SC_KS = 10368, SC_NK = 6, SK_KPE = 8192, SK_RK = 10240, SC_P0 = SC_K0 + SC_KS * SC_NK, SC_AL = SC_P0 + 4 * 2048;
    static_assert(SC_AL + 1024 <= SCRATCH_TOP && SC_AL >= 131072, "sample attention LDS map");
    LAS char* L = (LAS char*)F.lds; LAS float* al_l = (LAS float*)(L + SC_AL) + wid * 32; LAS float* al_p = (LAS float*)(L + SC_AL) + (wid ^ 1) * 32;
    LAS char* Pb = L + SC_P0 + (wid >> 1) * 2048 + lane * 32;
    const int dg = wid >> 2, dh = hp * 2 + dg;
    const bf16_t* KPt = (const bf16_t*)(F.ws + WS_KP); const bf16_t* KCh = (const bf16_t*)(F.ws + WS_KC) + ((size_t)dh * M + M_P + b * 64) * 128;
    const bf16_t* CNP = (const bf16_t*)(F.ws + WS_CNP) + (size_t)b * 4096 * 512; const bf16_t* CNC = (const bf16_t*)(F.ws + WS_CKVN) + (size_t)(M_P + b * 64) * 512;
    const bf16_t* KPEP = (const bf16_t*)(F.ws + WS_KPEP) + (size_t)b * 4096 * 64; const bf16_t* KPEC = (const bf16_t*)(F.ws + WS_KPEC) + (size_t)(M_P + b * 64) * 64;
    const float* RKPb = (const float*)(F.ws + WS_RKP) + (size_t)(b * 16 + hp * 2) * 4096; const float* RKCb = (const float*)(F.ws + WS_RKC) + (size_t)(hp * 2) * M + M_P + b * 64;
    constexpr int NT = 260, NS = NT / 2;
    unsigned voffKp, voffKc, voffC0, voffC1, voffX;
    { const int o16 = ((wid & 3) * 64 + lane) * 16, r = o16 >> 8, cB = (o16 & 255) ^ ((r & 7) << 4), cc = cB >> 4;
      voffKp = (unsigned)((((dg * 4 + (cc >> 2)) * 64) + (cc & 3) * 16 + r) * 8) * 2u; voffKc = (unsigned)(r * 128 + (cB >> 1)) * 2u;
      voffC0 = (unsigned)src_cn(((wid * 2) * 64 + lane) * 16) * 2u; voffC1 = (unsigned)src_cn(((wid * 2 + 1) * 64 + lane) * 16) * 2u;
      voffX = wid < 2 ? (unsigned)src_kpe(((wid & 1) * 64 + lane) * 16) * 2u : (unsigned)((((lane >> 4) & 1) * 4096 + (lane & 15)) * 4); }
#define MS_ISSUE_C(tt) do { const int t_ = (tt) < NT ? (tt) : NT - 1; LAS char* Lc = L + ((tt) % SC_NC) * SC_CS; \
        if (t_ < 256) { const bf16_t* cs_ = CNP + (size_t)t_ * 16 * 512; glds16s(cs_, voffC0, Lc + (wid * 2) * 1024); glds16s(cs_, voffC1, Lc + (wid * 2 + 1) * 1024); } \
        else { const bf16_t* cs_ = CNC + (size_t)(t_ - 256) * 16 * 512; glds16s(cs_, voffC0, Lc + (wid * 2) * 1024); glds16s(cs_, voffC1, Lc + (wid * 2 + 1) * 1024); } } while (0)
#define MS_ISSUE_K(tt) do { const int t_ = (tt) < NT ? (tt) : NT - 1; LAS char* Lk = L + SC_K0 + ((tt) % SC_NK) * SC_KS; \
        if (t_ < 256) { const size_t kb_ = (size_t)t_ * 16, grow = (size_t)b * 4096 + kb_; const size_t blk = ((((grow >> 8) * 8 + hp) * 2 + ((grow >> 7) & 1)) * 2 + ((grow >> 6) & 1)) * 4 + ((grow >> 4) & 3); \
            glds16s(KPt + blk * 4096, voffKp, Lk + wid * 1024); \
            if (wid < 2) glds16s(KPEP + kb_ * 64, voffX, Lk + SK_KPE + wid * 1024); \
            if (wid == 2) { if (lane < 32) glds4s(RKPb + kb_, voffX, Lk + SK_RK); } } \
        else { const size_t kb_ = (size_t)(t_ - 256) * 16; \
            glds16s(KCh + kb_ * 128, voffKc, Lk + wid * 1024); \
            if (wid < 2) glds16s(KPEC + kb_ * 64, voffX, Lk + SK_KPE + wid * 1024); \
            if (wid == 2) { if (lane < 32) glds4s(RKCb + kb_, (unsigned)((((lane >> 4) & 1) * M + (lane & 15)) * 4), Lk + SK_RK); } } } while (0)
    __builtin_amdgcn_s_barrier();
    MS_ISSUE_K(0); MS_ISSUE_K(1); MS_ISSUE_K(2); MS_ISSUE_K(3); MS_ISSUE_C(0);
    bf16x8 qr[12];
    { const bf16_t* qp = Q + ((size_t)(row0 + r32) * NH + h) * 192 + hi * 8;
#pragma unroll
      for (int d0 = 0; d0 < 12; ++d0) qr[d0] = *(const bf16x8*)(qp + d0 * 16);
#pragma unroll
      for (int d0 = 0; d0 < 12; ++d0) asm volatile("" :: "v"(qr[d0])); }
    const int vrb = lh * 8 * 512 + att::v_rd_base(lane);
    bf16x8 pk[2] = {};
    for (int s = -1; s < NS; ++s) {
        if (s < 0) asm volatile("s_waitcnt vmcnt(0)" ::: "memory"); else if (wid < 3) asm volatile("s_waitcnt vmcnt(6)" ::: "memory"); else asm volatile("s_waitcnt vmcnt(4)" ::: "memory");
        __builtin_amdgcn_s_barrier();
        asm volatile("" ::: "memory");
        const bool mine = (lh == ((s + g) & 1));
        if (!mine && s >= 0) { pk[0] = *(const LAS bf16x8*)Pb; pk[1] = *(const LAS bf16x8*)(Pb + 16); }
        MS_ISSUE_C(2 * s + 3); MS_ISSUE_C(2 * s + 4); MS_ISSUE_K(2 * s + 6); MS_ISSUE_K(2 * s + 7);
        if (s >= 0) {
            asm volatile("" : "+v"(pk[0]), "+v"(pk[1]));
            const int vA = (int)(uintptr_t)(L + ((2 * s) % SC_NC) * SC_CS + vrb), vB = (int)(uintptr_t)(L + ((2 * s + 1) % SC_NC) * SC_CS + vrb);
            s16x4 lo[4], hh[4];
#define MS_TR(i) do { asm volatile("ds_read_b64_tr_b16 %0, %1 offset:%c2" : "=&v"(lo[(i) & 3]) : "v"((i) < 8 ? vA : vB), "i"(((i) & 7) * 512) : "memory"); \
                      asm volatile("ds_read_b64_tr_b16 %0, %1 offset:%c2" : "=&v"(hh[(i) & 3]) : "v"((i) < 8 ? vA : vB), "i"(((i) & 7) * 512 + 16 * 512) : "memory"); } while (0)
            __builtin_amdgcn_sched_barrier(0);
            MS_TR(0); MS_TR(1); MS_TR(2);
            __builtin_amdgcn_s_setprio(1);
#pragma unroll
            for (int i = 0; i < 16; ++i) {
                if (i + 3 < 16) { MS_TR(i + 3); asm volatile("s_waitcnt lgkmcnt(6)" ::: "memory"); }
                else if (i + 2 < 16) asm volatile("s_waitcnt lgkmcnt(4)" ::: "memory");
                else if (i + 1 < 16) asm volatile("s_waitcnt lgkmcnt(2)" ::: "memory");
                else asm volatile("s_waitcnt lgkmcnt(0)" ::: "memory");
                __builtin_amdgcn_sched_barrier(0);
                { const s16x4 l_ = lo[i & 3], h_ = hh[i & 3]; const bf16x8 vf = (bf16x8){l_[0], l_[1], l_[2], l_[3], h_[0], h_[1], h_[2], h_[3]};
                  o[i & 7] = __builtin_amdgcn_mfma_f32_32x32x16_bf16(pk[i >> 3], vf, o[i & 7], 0, 0, 0); }
                __builtin_amdgcn_sched_barrier(0);
            }
            __builtin_amdgcn_s_setprio(0);
#undef MS_TR
        }
        if (!mine && s + 1 < NS) {
            const LAS char* KA = L + SC_K0 + ((2 * s + 2) % SC_NK) * SC_KS; const LAS char* KB = L + SC_K0 + ((2 * s + 3) % SC_NK) * SC_KS;
            const LAS char* Lm = r32 < 16 ? KA : KB;
            const LAS char* Ks = Lm + g * 4096; const LAS char* Kp = Lm + SK_KPE; const int kr = r32 & 15;
            f32x16 p;
#pragma unroll
            for (int r = 0; r < 16; ++r) p[r] = 0.f;
            auto kfrag = [&](int d) -> bf16x8 { return d < 8 ? *(const LAS bf16x8*)(Ks + att::kswz<256>(kr, (d * 16 + hi * 8) * 2)) : *(const LAS bf16x8*)(Kp + att::kswz<128>(kr, ((d - 8) * 16 + hi * 8) * 2)); };
            bf16x8 kf[3];
            kf[0] = kfrag(0); kf[1] = kfrag(1);
            __builtin_amdgcn_s_setprio(1);
#pragma unroll
            for (int d0 = 0; d0 < 12; ++d0) {
                if (d0 + 2 < 12) kf[(d0 + 2) % 3] = kfrag(d0 + 2);
                p = __builtin_amdgcn_mfma_f32_32x32x16_bf16(kf[d0 % 3], qr[d0], p, 0, 0, 0);
            }
            __builtin_amdgcn_s_setprio(0);
            float ps = 0.f;
#pragma unroll
            for (int hf2 = 0; hf2 < 2; ++hf2) {
                f32x4 sc[2];
#pragma unroll
                for (int i2 = 0; i2 < 2; ++i2) { const LAS float* rk = (const LAS float*)((hf2 == 0 ? KA : KB) + SK_RK) + g * 16; sc[i2] = *(const LAS f32x4*)(rk + 8 * i2 + 4 * hi); }
#pragma unroll
                for (int i2 = 0; i2 < 2; ++i2)
#pragma unroll
                    for (int j = 0; j < 4; ++j) { const int i = hf2 * 2 + i2; const float e = __builtin_amdgcn_exp2f(fmaf(p[4 * i + j], sc[i2][j], negB2)); p[4 * i + j] = e; ps += e; }
                asm volatile("" ::: "memory");
            }
            l_part += ps;
#pragma unroll
            for (int hf = 0; hf < 2; ++hf) { const int B = hf * 8;
                const unsigned a0 = cvt_pk_bf16(p[B + 0], p[B + 1]), a1 = cvt_pk_bf16(p[B + 2], p[B + 3]), b0 = cvt_pk_bf16(p[B + 4], p[B + 5]), b1 = cvt_pk_bf16(p[B + 6], p[B + 7]);
                auto r0 = __builtin_amdgcn_permlane32_swap(a0, b0, false, false); auto r1 = __builtin_amdgcn_permlane32_swap(a1, b1, false, false);
                u32x4 w = {r0[0], r1[0], r0[1], r1[1]}; pk[hf] = __builtin_bit_cast(bf16x8, w); }
            *(LAS bf16x8*)Pb = pk[0]; *(LAS bf16x8*)(Pb + 16) = pk[1];
            LDS_WAIT();
        }
    }
#undef MS_ISSUE_C
#undef MS_ISSUE_K
    asm volatile("s_waitcnt vmcnt(0)" ::: "memory");
    const float lsum = att::lane_pair_sum(l_part);
    if (hi == 0) al_l[r32] = lsum;
    LDS_WAIT();
    __builtin_amdgcn_s_barrier();
    asm volatile("" ::: "memory");
    const bf16_t* Wuv = (const bf16_t*)(F.ws + WS_WUKV) + ((size_t)((hp * 2 + (wid >> 2)) * 256 + 128 + (wid & 1) * 64 + r32)) * 512 + hi * 8;
    bf16x8 bpre[4][2];
#pragma unroll
    for (int ks = 0; ks < 4; ++ks) { bpre[ks][0] = *(const bf16x8*)(Wuv + ks * 16); bpre[ks][1] = *(const bf16x8*)(Wuv + (size_t)32 * 512 + ks * 16); }
    {
        const bool oddl = r32 & 1;
#pragma unroll
        for (int r = 0; r < 16; r += 2) { const int q = att::crow(r, hi); const float rl0 = __builtin_amdgcn_rcpf(al_l[q] + al_p[q]), rl1 = __builtin_amdgcn_rcpf(al_l[q + 1] + al_p[q + 1]);
            const int qrow = rg * 32 + q + (oddl ? 1 : 0);
#pragma unroll
            for (int d0 = 0; d0 < 8; ++d0) { const float va = o[d0][r] * rl0, vb2 = o[d0][r + 1] * rl1; const float recv = __shfl_xor(oddl ? va : vb2, 1);
                const int colB = ((lh * 8 + d0) * 32 + (r32 & ~1)) * 2;
                *(LAS unsigned*)(L + g * 65536 + att::kswz<1024>(qrow, colB)) = oddl ? cvt_pk_bf16(recv, vb2) : cvt_pk_bf16(va, recv); } }
    }
    LDS_WAIT();
    __builtin_amdgcn_s_barrier();
    asm volatile("" ::: "memory");
    {
        const int g2 = wid >> 2, rg2 = (wid >> 1) & 1, dvh = wid & 1, h2 = hp * 2 + g2;
        const int orow0 = M_P + b * 64 + rg2 * 32;
        bf16_t* out = (bf16_t*)(F.ws + ((PROBE_HOT != 0 && rep2) ? WS_VP : WS_AMLA)) + (size_t)orow0 * 2048 + h2 * 128 + dvh * 64; const bf16_t* z = (const bf16_t*)(F.ws + WS_ZM) + (size_t)orow0 * 2048 + h2 * 128 + dvh * 64;
        const bool odd = r32 & 1;
        unsigned zw[2][8];
#pragma unroll
        for (int k2 = 0; k2 < 2; ++k2)
#pragma unroll
            for (int r = 0; r < 16; r += 2) zw[k2][r >> 1] = *(const unsigned*)(z + (size_t)(att::crow(r, hi) + (odd ? 1 : 0)) * 2048 + k2 * 32 + (r32 & ~1));
        f32x16 acc[2];
#pragma unroll
        for (int k2 = 0; k2 < 2; ++k2)
#pragma unroll
            for (int r = 0; r < 16; ++r) acc[k2][r] = 0.f;
#pragma unroll
        for (int ks = 0; ks < 4; ++ks) {
            const bf16x8 a = *(const LAS bf16x8*)(L + g2 * 65536 + att::kswz<1024>(rg2 * 32 + r32, (ks * 16 + hi * 8) * 2));
            acc[0] = __builtin_amdgcn_mfma_f32_32x32x16_bf16(a, bpre[ks][0], acc[0], 0, 0, 0); acc[1] = __builtin_amdgcn_mfma_f32_32x32x16_bf16(a, bpre[ks][1], acc[1], 0, 0, 0);
        }
#pragma unroll 14
        for (int ks = 4; ks < 32; ++ks) {
            const bf16x8 a = *(const LAS bf16x8*)(L + g2 * 65536 + att::kswz<1024>(rg2 * 32 + r32, (ks * 16 + hi * 8) * 2));
            const bf16x8 bw0 = *(const bf16x8*)(Wuv + ks * 16), bw1 = *(const bf16x8*)(Wuv + (size_t)32 * 512 + ks * 16);
            acc[0] = __builtin_amdgcn_mfma_f32_32x32x16_bf16(a, bw0, acc[0], 0, 0, 0); acc[1] = __builtin_amdgcn_mfma_f32_32x32x16_bf16(a, bw1, acc[1], 0, 0, 0);
        }
#pragma unroll
        for (int k2 = 0; k2 < 2; ++k2)
#pragma unroll
            for (int r = 0; r < 16; r += 2) { const float va = acc[k2][r], vb2 = acc[k2][r + 1];
                const float recv = __shfl_xor(odd ? va : vb2, 1); const float v0 = odd ? recv : va, v1 = odd ? vb2 : recv; const unsigned w = zw[k2][r >> 1];
                *(unsigned*)(out + (size_t)(att::crow(r, hi) + (odd ? 1 : 0)) * 2048 + k2 * 32 + (r32 & ~1)) = cvt_pk_bf16(v0 * bf_lo(w), v1 * bf_hi(w)); }
    }
    __builtin_amdgcn_s_barrier();
}
template <bool SAMPLE>
__device__ __forceinline__ void cross_unit(const Ctx& F, int l, int x, int h, int dvh) {
    int tid = F.tid; asm volatile("" : "+v"(tid)); const int wid = F.wave, lane = tid & 63, r32 = lane & 31, hi = lane >> 5;
    if (SAMPLE) {
        LAS char* L = (LAS char*)F.lds; constexpr int XB = 49152; LAS float* al_l = (LAS float*)(L + 2 * XB) + wid * 32;
        const float* kf = F.in[I_CMK] + ((size_t)l * NSTREAM + x) * N_MEM * 1024 + h * 256; const float* vf = F.in[I_CMV] + ((size_t)l * NSTREAM + x) * N_MEM * 1024 + h * 256 + dvh * 128;
        __syncthreads();
        if (wid < 2) {
            const int row0 = M_P + x * 64 + wid * 32;
            bf16x8 qr[16];
            { const bf16_t* qp = (const bf16_t*)(F.ws + WS_XQN) + (size_t)(row0 + r32) * 1024 + h * 256 + hi * 8;
#pragma unroll
              for (int d0 = 0; d0 < 16; ++d0) qr[d0] = *(const bf16x8*)(qp + d0 * 16); }
            f32x16 o[4];
#pragma unroll
            for (int d = 0; d < 4; ++d)
#pragma unroll
                for (int r = 0; r < 16; ++r) o[d][r] = 0.f;
            float m_reg = -1e30f, l_reg = 0.f;
            const int vb = (int)(uintptr_t)(L + AX_V) + att::v_rd_base(lane);
            for (int t = 0; t < 4; ++t) {
                __builtin_amdgcn_s_barrier();
                asm volatile("" ::: "memory");
                att::tile_step<16, 0, 4, 2, false, 512>(qr, o, m_reg, l_reg, L + (t & 1) * XB + AX_K, L + (t & 1) * XB + AX_K, vb + (t & 1) * XB, (const LAS float*)nullptr, al_l, r32, hi);
            }
            att::finish<4>(o, l_reg, al_l, (bf16_t*)(F.ws + WS_AX) + (size_t)row0 * 1024 + h * 256 + dvh * 128, (const bf16_t*)(F.ws + WS_ZX) + (size_t)row0 * 1024 + h * 256 + dvh * 128, 1024, r32, hi);
        } else {
            const int lt = tid - 128;
            f32x4 ra[8][2], rb[8][2];
#define XS_LOAD(t, R) do { _Pragma("unroll") for (int i = 0; i < 8; ++i) { const int c = lt + 384 * i; const bool isk = c < 2048; const int cv = c - 2048; \
                const float* sp = isk ? kf + (size_t)((t) * 64 + (c >> 5)) * 1024 + (c & 31) * 8 : vf + (size_t)((t) * 64 + (cv >> 4)) * 1024 + (cv & 15) * 8; \
                R[i][0] = *(const f32x4*)sp; R[i][1] = *(const f32x4*)(sp + 4); } } while (0)
#define XS_STORE(t, R) do { LAS char* Lb = L + ((t) & 1) * XB; _Pragma("unroll") for (int i = 0; i < 8; ++i) { const int c = lt + 384 * i; const bool isk = c < 2048; const int cv = c - 2048; \
                const int dst = isk ? AX_K + att::kswz<512>(c >> 5, (c & 31) * 16) : AX_V + att::v_st<4>(cv >> 4, (cv & 15) * 8); \
                *(LAS u32x4*)(Lb + dst) = pack8(R[i][0], R[i][1]); } \
                LDS_WAIT(); __builtin_amdgcn_s_barrier(); asm volatile("" ::: "memory"); } while (0)
            XS_LOAD(0, ra);
            XS_LOAD(1, rb); XS_STORE(0, ra);
            XS_LOAD(2, ra); XS_STORE(1, rb);
            XS_LOAD(3, rb); XS_STORE(2, ra);
            XS_STORE(3, rb);
#undef XS_LOAD
#undef XS_STORE
        }
        return;
    }
    const int row0 = x * 256 + wid * 32;
    bf16x8 qr[16];
    { const bf16_t* qp = (const bf16_t*)(F.ws + WS_XQN) + (size_t)(row0 + r32) * 1024 + h * 256 + hi * 8;
#pragma unroll
      for (int d0 = 0; d0 < 16; ++d0) qr[d0] = *(const bf16x8*)(qp + d0 * 16);
#pragma unroll
      for (int d0 = 0; d0 < 16; ++d0) asm volatile("" :: "v"(qr[d0])); }
    f32x16 o[4];
#pragma unroll
    for (int d = 0; d < 4; ++d)
#pragma unroll
        for (int r = 0; r < 16; ++r) o[d][r] = 0.f;
    float m_reg = -1e30f, l_reg = 0.f;
    constexpr int XB = 49152;
    LAS char* L = (LAS char*)F.lds; LAS float* al_l = (LAS float*)(L + 3 * XB) + wid * 32;
    const int vb = (int)(uintptr_t)(L + AX_V) + att::v_rd_base(lane);
    const bf16_t* kb = (const bf16_t*)(F.ws + WS_MKB) + h * 256; const bf16_t* vbf = (const bf16_t*)(F.ws + WS_MVB) + h * 256 + dvh * 128;
#define XP_ISSUE(t) do { LAS char* Lb = L + ((t) % 3) * XB; const bf16_t* ks_ = kb + (size_t)(t) * 64 * 1024; const bf16_t* vs_ = vbf + (size_t)(t) * 64 * 1024; int ln_ = lane; asm volatile("" : "+v"(ln_)); \
        _Pragma("unroll") for (int j = 0; j < 4; ++j) { const int o16 = ((wid * 4 + j) * 64 + ln_) * 16, row = o16 >> 9, colB = (o16 & 511) ^ ((row & 7) << 4); glds16s(ks_, (unsigned)(row * 1024 + (colB >> 1)) * 2u, Lb + AX_K + (wid * 4 + j) * 1024); } \
        _Pragma("unroll") for (int j = 0; j < 2; ++j) glds16s(vs_, (unsigned)src_v1024(((wid * 2 + j) * 64 + ln_) * 16) * 2u, Lb + AX_V + (wid * 2 + j) * 1024); } while (0)
    __syncthreads();
    XP_ISSUE(0); XP_ISSUE(1); XP_ISSUE(2);
#pragma unroll 1
    for (int t = 0; t < 4; ++t) {
        if (t == 0) asm volatile("s_waitcnt vmcnt(12)" ::: "memory"); else if (t < 3) asm volatile("s_waitcnt vmcnt(6)" ::: "memory"); else asm volatile("s_waitcnt vmcnt(0)" ::: "memory");
        __builtin_amdgcn_s_barrier();
        asm volatile("" ::: "memory");
        if (t == 1) XP_ISSUE(3);
        att::tile_step<16, 0, 4, 2, false, 512, 2>(qr, o, m_reg, l_reg, L + (t % 3) * XB + AX_K, L + (t % 3) * XB + AX_K, vb + (t % 3) * XB, (const LAS float*)nullptr, al_l, r32, hi);
    }
#undef XP_ISSUE
    att::finish<4>(o, l_reg, al_l, (bf16_t*)(F.ws + WS_AX) + (size_t)row0 * 1024 + h * 256 + dvh * 128, (const bf16_t*)(F.ws + WS_ZX) + (size_t)row0 * 1024 + h * 256 + dvh * 128, 1024, r32, hi);
}
#ifndef ATT_ONLY
#define ATT_ONLY -1
#endif
#define ATT_ON(k) (ATT_ONLY < 0 || ATT_ONLY == (k))
constexpr int QN = 160;
__device__ __forceinline__ void phase_attention(const Ctx& F, int l, int rep) {
    (void)rep;
    unsigned* heads = (unsigned*)(F.ws + WS_CTL) + CW_QHEAD + 64 * 8 * l + 64 * 16 * rep;
    volatile LAS unsigned* slot = (volatile LAS unsigned*)(F.lds + MISC_OFF);
    float negB2;
    { const float* gq = F.in[I_GQN] + l * QK_HEAD; const float* gk = F.in[I_GKN] + l * QK_HEAD; const int ln = F.lane;
      float m1 = fmaxf(fabsf(gq[ln] * gk[ln]), fabsf(gq[64 + ln] * gk[64 + ln])), mq = fabsf(gq[128 + ln]), mk = fabsf(gk[128 + ln]);
#pragma unroll
      for (int o = 1; o < 64; o <<= 1) { m1 = fmaxf(m1, __shfl_xor(m1, o)); mq = fmaxf(mq, __shfl_xor(mq, o)); mk = fmaxf(mk, __shfl_xor(mk, o)); }
      negB2 = -(19.99f * 1.01f * fmaxf(m1, mq * mk) + 0.1f); }
    const int x0 = (int)(xb_xcc_id() & 7u);
    for (int step = 0; step < 8; ++step) {
        const int x = (x0 + step) & 7;
        for (;;) {
            if (F.tid == 0) slot[0] = __hip_atomic_fetch_add(heads + 64 * x, 1u, __ATOMIC_RELAXED, __HIP_MEMORY_SCOPE_AGENT);
            __syncthreads();
            int u = __builtin_amdgcn_readfirstlane((int)slot[0]);
            __syncthreads();
#ifdef QREP_TYPE
            if (u >= 2 * QN) break;
            bool rep2 = false;
            if (u >= QN) { u -= QN; rep2 = true; const int ty = u < 96 ? (u < 32 ? 0 : 1) : (u < 128 ? 2 : 3); if (QREP_TYPE != 9 && ty != QREP_TYPE) continue; }
#else
            const bool rep2 = false;
            if (u >= QN) break;
#endif
            if (u < 96) {
                if (u < 32) {
#if ATT_ON(0)
                    mla_sample_unit(F, 4 * x + (u >> 3), u & 7, negB2, rep2);
#endif
                } else {
#if ATT_ON(1)
                    const int j = u - 32; mla_prompt_unit(F, 2 * x + (j & 1), 31 - (j >> 1), negB2);
#endif
                }
            } else if (u < 128) {
#if ATT_ON(2)
                const int v = x * 32 + (u - 96); cross_unit<false>(F, l, v >> 3, (v >> 1) & 3, v & 1);
#endif
            } else {
#if ATT_ON(3)
                const int v = x * 32 + (u - 128); cross_unit<true>(F, l, v >> 3, (v >> 1) & 3, v & 1);
#endif
            }
        }
    }
}
#define rot(off) ((int)((F.bid + G - ((off) % G)) % G))
__device__ __forceinline__ void phase_b(const Ctx& F, int l) {
    const int G = F.G; (void)G;
            {
                pg8::Gemm g{(const bf16_t*)(F.ws + WS_HB), (const bf16_t*)(F.ws + WS_WIN), 2048, 2048, 2048};
                pg8::StaticOrder S; S.init(M, IN_PAD, G, rot(0));
                EpiWin E{F.ws, F.out, F.in[I_BMERGE] + (size_t)l * 6144, l};
                pg8::gemm_phase(F.lds, g, S, E);
            }
#ifdef DUP_B1
            {
                pg8::Gemm g{(const bf16_t*)(F.ws + WS_HB), (const bf16_t*)(F.ws + WS_WIN), 2048, 2048, 2048};
                pg8::StaticOrder S; S.init(M, IN_PAD, G, rot(0));
                EpiWin E{F.ws, F.out, F.in[I_BMERGE] + (size_t)l * 6144, l};
                pg8::gemm_phase(F.lds, g, S, E);
            }
#endif
#ifdef DUP_B1N
            {
                pg8::Gemm g{(const bf16_t*)(F.ws + WS_HB), (const bf16_t*)(F.ws + WS_WIN), 2048, 2048, 2048};
                pg8::StaticOrder S; S.init(M, IN_PAD, G, rot(0));
                EpiNone E{};
                pg8::gemm_phase(F.lds, g, S, E);
            }
#endif
            {
                pg8::Gemm g{(const bf16_t*)(F.ws + WS_MEMN), (const bf16_t*)(F.ws + WS_WMEM), 2048, 2048, 2048};
                pg8::StaticOrder S; S.init(N_MEM, 2048, G, rot(232));
                EpiF32 E{(float*)(F.ws + WS_KVRAW), 2048};
                pg8::gemm_phase(F.lds, g, S, E);
            }
            {
                pg8::Gemm g{(const bf16_t*)(F.ws + WS_CNP), (const bf16_t*)(F.ws + WS_WUK), 512, 512, 512};
                pg8::StaticOrder S; S.init(MPAST, 2048, G, rot(240));
                EpiK<> E{(bf16_t*)(F.ws + WS_KP), (float*)(F.ws + WS_SSP)};
                pg8::gemm_phase(F.lds, g, S, E);
            }
#ifdef DUP_B3
            {
                pg8::Gemm g{(const bf16_t*)(F.ws + WS_CNP), (const bf16_t*)(F.ws + WS_WUK), 512, 512, 512};
                pg8::StaticOrder S; S.init(MPAST, 2048, G, rot(240));
                EpiK<> E{(bf16_t*)(F.ws + WS_KP), (float*)(F.ws + WS_SSP)};
                pg8::gemm_phase(F.lds, g, S, E);
            }
#endif
#ifdef DUP_B3N
            {
                pg8::Gemm g{(const bf16_t*)(F.ws + WS_CNP), (const bf16_t*)(F.ws + WS_WUK), 512, 512, 512};
                pg8::StaticOrder S; S.init(MPAST, 2048, G, rot(240));
#ifndef DUP_B3N_K
#define DUP_B3N_K false
#endif
#ifndef DUP_B3N_S
#define DUP_B3N_S false
#endif
#ifndef DUP_B3N_T
#define DUP_B3N_T false
#endif
                EpiK<DUP_B3N_K, DUP_B3N_S, DUP_B3N_T> E{(bf16_t*)(F.ws + WS_VP), (float*)(F.ws + WS_VP) + (size_t)64 * 1024 * 1024};
                pg8::gemm_phase(F.lds, g, S, E);
            }
#endif
            if (l == 0) past_kpe(F, l);
#ifdef DUP_B4
            past_kpe(F, l);
#endif
}
__device__ __forceinline__ void phase_d(const Ctx& F, int l) {
    const int G = F.G; (void)G;
            {
                pg8::Gemm g{(const bf16_t*)(F.ws + WS_QLATN), (const bf16_t*)(F.ws + WS_WUQ), 512, 512, 512};
                pg8::StaticOrder S; S.init(M, 3072, G, rot(0));
                EpiBf16 E{(bf16_t*)(F.ws + WS_QRAW), 3072};
                pg8::gemm_phase(F.lds, g, S, E);
            }
            {
                pg8::Gemm g{(const bf16_t*)(F.ws + WS_CKVN), (const bf16_t*)(F.ws + WS_WUKV), 512, 512, 512};
                pg8::StaticOrder S; S.init(M, 4096, G, rot(224));
                EpiKV<false> E{(bf16_t*)(F.ws + WS_KC), (bf16_t*)(F.ws + WS_VC), (float*)(F.ws + WS_SSC)};
                pg8::gemm_phase(F.lds, g, S, E);
            }
            {
                pg8::Gemm g{(const bf16_t*)(F.ws + WS_CV), (const bf16_t*)(F.ws + WS_WPW2), 1024, 1024, 1024};
                pg8::StaticOrder S; S.init(M, 1024, G, rot(96));
                EpiPw2 E{(bf16_t*)(F.ws + WS_ACONV), (const bf16_t*)(F.ws + WS_ZC), F.in[I_BPW2] + (size_t)l * 1024};
                pg8::gemm_phase(F.lds, g, S, E);
            }
}
__device__ __forceinline__ void phase_g(const Ctx& F, int l) {
    const int G = F.G; (void)G;
    const bool bal = (G == 256); const int cls = F.bid >> 6, j = F.bid & 63;
            {
                pg8::Gemm g{(const bf16_t*)(F.ws + WS_AMLA), (const bf16_t*)(F.ws + WS_WPM), 2048, 2048, 2048};
                EpiGate E{(bf16_t*)(F.ws + WS_PB), (const bf16_t*)(F.ws + WS_GATES), 0};
                pg8::ListOrder S; if (bal) S.init(M, 2048, (cls == 0 ? 0 : (cls == 1 ? 128 : 256)) + j, cls < 2 ? 2 : (cls == 2 ? 1 : 0), 64); else S.init(M, 2048, rot(0), (320 - rot(0) + G - 1) / G, G);
                pg8::gemm_phase(F.lds, g, S, E);
            }
            {
                pg8::Gemm g{(const bf16_t*)(F.ws + WS_ACONV), (const bf16_t*)(F.ws + WS_WPC), 1024, 1024, 1024};
                EpiGate E{(bf16_t*)(F.ws + WS_PB) + (size_t)M * 2048, (const bf16_t*)(F.ws + WS_GATES), 2048};
                pg8::ListOrder S; if (bal) S.init(M, 2048, (cls == 0 ? 0 : (cls == 2 ? 64 : 192)) + j, cls == 0 ? 1 : (cls == 1 ? 0 : 2), 64); else S.init(M, 2048, rot(64), (320 - rot(64) + G - 1) / G, G);
                pg8::gemm_phase(F.lds, g, S, E);
            }
            {
                pg8::Gemm g{(const bf16_t*)(F.ws + WS_AX), (const bf16_t*)(F.ws + WS_WPX), 1024, 1024, 1024};
                EpiGate E{(bf16_t*)(F.ws + WS_PB) + 2 * (size_t)M * 2048, (const bf16_t*)(F.ws + WS_GATES), 4096};
                pg8::ListOrder S; if (bal) S.init(M, 2048, (cls == 1 ? 0 : (cls == 2 ? 64 : 128)) + j, cls == 0 ? 0 : (cls == 3 ? 3 : 1), 64); else S.init(M, 2048, rot(128), (320 - rot(128) + G - 1) / G, G);
                pg8::gemm_phase(F.lds, g, S, E);
            }
}
__device__ __forceinline__ void phase_g2(const Ctx& F, int l) {
    const int G = F.G; (void)G;
            {
                const u32x4* p0 = (const u32x4*)(F.ws + WS_PB); const u32x4* p1 = p0 + (size_t)M * 256; const u32x4* p2 = p1 + (size_t)M * 256; u32x4* mo = (u32x4*)(F.ws + WS_MERGED);
                for (size_t i = (size_t)F.bid * 512 + F.tid; i < (size_t)M * 256; i += (size_t)G * 512) {
                    f32x4 a0, a1, b0, b1, c0, c1; unpack8(p0[i], a0, a1); unpack8(p1[i], b0, b1); unpack8(p2[i], c0, c1);
                    mo[i] = pack8(a0 + b0 + c0, a1 + b1 + c1);
                }
            }
}
__device__ __forceinline__ void phase_h(const Ctx& F, int l) {
    const int G = F.G; (void)G;
            {
                pg8::Gemm g{(const bf16_t*)(F.ws + WS_MERGED), (const bf16_t*)(F.ws + WS_WOUT), 2048, 2048, 2048};
                pg8::StaticOrder S; S.init(M, 2048, G, rot(64));
                const float* sp = l == 0 ? F.in[I_XP] : (const float*)(F.ws + WS_X1); const float* ss = l == 0 ? F.in[I_XS] : (const float*)(F.ws + WS_X1) + (size_t)M_P * 2048;
                float* dp = l == DEPTH - 1 ? F.out + O_YP : (float*)(F.ws + WS_X1); float* ds = l == DEPTH - 1 ? F.out + O_YS : (float*)(F.ws + WS_X1) + (size_t)M_P * 2048;
                EpiOut E{sp, ss, dp, ds};
                pg8::gemm_phase(F.lds, g, S, E);
            }
            if (l + 1 < DEPTH && h_early_ok(G)) { const int n2 = (M / 256) * (2048 / 256) - G, c = rot(64);
                if (c >= n2) prep_weights(F, l + 1, (c - n2) * 8 + F.wave, (G - n2) * 8, PW_EARLY); }
}
__global__ void __launch_bounds__(512, 2) trunk_fwd(Args args) {
    extern __shared__ __attribute__((aligned(16))) unsigned char lds_raw[];
    for (int u = threadIdx.x; u < (LDS_BYTES - SCRATCH_TOP) / 4; u += 512) ((LAS unsigned*)((LAS unsigned char*)lds_raw + SCRATCH_TOP))[u] = 0u;
    __syncthreads();
    XcdBarrier bar;
    { const __attribute__((address_space(4))) char* kp0 = (const __attribute__((address_space(4))) char*)__builtin_amdgcn_kernarg_segment_ptr();
      unsigned char* ws0 = *(unsigned char* const __attribute__((address_space(4)))*)(kp0 + 256);
      bar = xcd_barrier_post((unsigned*)(ws0 + WS_CTL) + CW_BAR, (volatile LAS unsigned*)((LAS unsigned char*)lds_raw + MISC_OFF) + 8); }
    const int lo = args.ph_lo, hi = args.ph_hi;
    int ph = 0;
#ifdef DBG_TIME
    if (blockIdx.x == 0 && threadIdx.x == 0) ((LAS unsigned long long*)((LAS unsigned char*)lds_raw + MISC_OFF + 256))[0] = __builtin_amdgcn_s_memrealtime();
#endif
#define PH_BEGIN if (ph >= lo && ph < hi) { Ctx F; { const __attribute__((address_space(4))) char* kp = (const __attribute__((address_space(4))) char*)__builtin_amdgcn_kernarg_segment_ptr(); asm volatile("" : "+s"(kp)); \
        F.in = (karg_in_t)kp; F.out = *(float* const __attribute__((address_space(4)))*)(kp + 248); F.ws = *(unsigned char* const __attribute__((address_space(4)))*)(kp + 256); \
        F.lds = (LAS unsigned char*)lds_raw; int tz = threadIdx.x; asm volatile("" : "+v"(tz)); F.tid = tz; F.lane = tz & 63; F.wave = __builtin_amdgcn_readfirstlane(tz >> 6); F.G = gridDim.x; F.bid = blockIdx.x; } const int G = F.G; (void)G;
#ifdef DBG_TIME
#define PH_END   if (ph + 1 < hi) xcd_barrier(bar); } ++ph; if (blockIdx.x == 0 && threadIdx.x == 0 && ph < 24) ((LAS unsigned long long*)((LAS unsigned char*)lds_raw + MISC_OFF + 256))[ph] = __builtin_amdgcn_s_memrealtime();
#else
#define PH_END   if (ph + 1 < hi) xcd_barrier(bar); } ++ph;
#endif

    for (int l = 0; l < DEPTH; ++l) {
        PH_BEGIN
#if PH_ON(0)
            REP(0) {
            phase_prep(F, l);
            }
#endif
        PH_END
        PH_BEGIN
#if PH_ON(1)
            phase_b(F, l);
#ifdef DUP_1
            phase_b(F, l);
#endif
#endif
        PH_END
        PH_BEGIN
#if PH_ON(2)
            REP(2) {
            phase_c(F, l);
#ifdef DUP_2
            phase_c(F, l);
#endif
            }
#endif
        PH_END
        PH_BEGIN
#if PH_ON(3)
            phase_d(F, l);
#ifdef DUP_3
            phase_d(F, l);
#endif
#endif
        PH_END
        PH_BEGIN
#if PH_ON(4)
            REP(4) {
            phase_e(F, l);
#ifdef DUP_4
            phase_e(F, l);
#endif
            }
#endif
        PH_END
        PH_BEGIN
#if PH_ON(5)
            REP(5) {
            phase_attention(F, l, 0);
#ifdef DUP_5
            phase_attention(F, l, 1);
#endif
            }
#endif
        PH_END
        PH_BEGIN
#if PH_ON(6)
            phase_g(F, l);
#ifdef DUP_6
            phase_g(F, l);
#endif
#endif
        PH_END
        PH_BEGIN
#if PH_ON(8)
            phase_g2(F, l);
#ifdef DUP_8
            phase_g2(F, l);
#endif
#endif
        PH_END
        PH_BEGIN
#if PH_ON(7)
            phase_h(F, l);
#ifdef DUP_7
            phase_h(F, l);
#endif
#endif
        PH_END
    }


#ifdef DBG_TIME
    {
        xcd_barrier(bar);
        if (blockIdx.x == 0) {
            const __attribute__((address_space(4))) char* kp = (const __attribute__((address_space(4))) char*)__builtin_amdgcn_kernarg_segment_ptr();
            float* outp = *(float* const __attribute__((address_space(4)))*)(kp + 248);
            const LAS unsigned long long* st = (const LAS unsigned long long*)((LAS unsigned char*)lds_raw + MISC_OFF + 256);
            __syncthreads();
            const size_t offs[10] = {O_YP, O_YS, O_PCKV, O_PKR, O_PMK, O_PMV, O_PCONV, O_SCKV, O_SKR, O_SCONV};
#pragma unroll
            for (int k = 0; k < 10; ++k) {
                const int a = DBG_TIME + k, b = (k == 9 ? 18 : DBG_TIME + k + 1);
                unsigned us = (unsigned)((st[b] - st[a]) / 100ull) + 1u; if (us > 60000u) us = 60000u;
                for (unsigned i = threadIdx.x; i < us; i += 512) outp[offs[k] + i] = __uint_as_float(0xAAAAAAAAu);
            }
        }
    }
#endif
#ifdef DBG_DUMP
    {
        const __attribute__((address_space(4))) char* kp = (const __attribute__((address_space(4))) char*)__builtin_amdgcn_kernarg_segment_ptr();
        float* outp = *(float* const __attribute__((address_space(4)))*)(kp + 248); unsigned char* wsp = *(unsigned char* const __attribute__((address_space(4)))*)(kp + 256);
        unsigned* bins = (unsigned*)wsp + 65536;
        if (hi == 1000 || (MK_N_LAUNCHES == 1 && hi == NPH_RUN)) {
            if (hi != 1000) xcd_barrier(bar);
            const size_t lo_b = DBG_LO, hi_b = DBG_HI;
            for (size_t i = (size_t)blockIdx.x * 512 + threadIdx.x; i < O_END; i += (size_t)gridDim.x * 512) outp[i] = 0.f;
            const int gwv = blockIdx.x * 8 + (threadIdx.x >> 6), lanev = threadIdx.x & 63;
            const size_t nchunk = (hi_b - lo_b) >> 10;
            for (size_t c = gwv; c < nchunk; c += (size_t)gridDim.x * 8) {
                const u32x4 w = *(const u32x4*)(wsp + lo_b + (c << 10) + lanev * 16);
                unsigned s = (w.x * 0x9E3779B1u) ^ (w.y * 0x85EBCA77u) ^ (w.z * 0xC2B2AE3Du) ^ (w.w * 0x27D4EB2Fu); s *= (2u * lanev + 1u) * 0x165667B1u; s ^= s >> 15;
#pragma unroll
                for (int o = 1; o < 64; o <<= 1) s += __shfl_xor(s, o);
                if (lanev == 0) __hip_atomic_fetch_xor(bins + (c & 1023), s * 0x9E3779B1u, __ATOMIC_RELAXED, __HIP_MEMORY_SCOPE_AGENT);
            }
            if (hi != 1000) xcd_barrier(bar);
        }
        if (hi == 1001 || (MK_N_LAUNCHES == 1 && hi == NPH_RUN)) {
            if (blockIdx.x == 0) for (int i = threadIdx.x; i < 1024; i += 512) outp[i] = (float)(__hip_atomic_load(bins + i, __ATOMIC_RELAXED, __HIP_MEMORY_SCOPE_AGENT) & 0xffffffu) + 1.0f;
        }
    }
#endif
#undef PH_BEGIN
#undef PH_END
}

extern "C" void kernel_launch(void* const* d_in, const int* in_sizes, int n_in, void* d_out, int out_size, void* d_ws, size_t ws_size, hipStream_t stream) {
    static int grid = 0;
    if (grid == 0) {
        if (n_in != 31 || (size_t)out_size != O_END || ws_size < WS_END) {
            fprintf(stderr, "kernel_launch: built for 31 inputs, %zu outputs, >= %zu bytes of workspace; got n_in %d, out %d, ws %zu; nothing launched\n", (size_t)O_END, (size_t)WS_END, n_in, out_size, ws_size);
            grid = -1; return; }
        int dev = 0, cus = 0, per_cu = 0;
        if (hipGetDevice(&dev) != hipSuccess || hipDeviceGetAttribute(&cus, hipDeviceAttributeMultiprocessorCount, dev) != hipSuccess) { fprintf(stderr, "kernel_launch: device query failed\n"); grid = -1; return; }
        if (hipFuncSetAttribute((const void*)trunk_fwd, hipFuncAttributeMaxDynamicSharedMemorySize, LDS_BYTES) != hipSuccess) { fprintf(stderr, "kernel_launch: hipFuncSetAttribute failed\n"); grid = -1; return; }
        if (hipOccupancyMaxActiveBlocksPerMultiprocessor(&per_cu, (const void*)trunk_fwd, 512, LDS_BYTES) != hipSuccess || per_cu < 1)
            fprintf(stderr, "kernel_launch: note: occupancy query reports %d workgroups per CU\n", per_cu);
        (void)hipGetLastError();
        grid = cus;
    }
    if (grid < 0) return;
    if (hipMemsetAsync((char*)d_ws + WS_CTL, 0, 131072, stream) != hipSuccess) { fprintf(stderr, "kernel_launch: memset failed\n"); return; }
    Args a{};
    for (int i = 0; i < 31; ++i) a.in[i] = (const float*)d_in[i];
    a.out = (float*)d_out; a.ws = (unsigned char*)d_ws;
    constexpr int NPH = NPH_RUN;
    if (MK_N_LAUNCHES == 1) {
        a.ph_lo = 0; a.ph_hi = NPH;
        hipLaunchKernelGGL(trunk_fwd, dim3(grid), dim3(512), LDS_BYTES, stream, a);
    } else {
        for (int p = 0; p < NPH; ++p) { a.ph_lo = p; a.ph_hi = p + 1; hipLaunchKernelGGL(trunk_fwd, dim3(grid), dim3(512), LDS_BYTES, stream, a); }
#ifdef DBG_DUMP
        a.ph_lo = 1000; a.ph_hi = 1000; hipLaunchKernelGGL(trunk_fwd, dim3(grid), dim3(512), LDS_BYTES, stream, a);
        a.ph_lo = 1001; a.ph_hi = 1001; hipLaunchKernelGGL(trunk_fwd, dim3(grid), dim3(512), LDS_BYTES, stream, a);
#endif
    }
    const hipError_t le = hipPeekAtLastError();
    if (le != hipSuccess) fprintf(stderr, "kernel_launch: launch failed: %s\n", hipGetErrorName(le));
}
```
